# Optimizing an MI355X kernel written in HIP

```python
import jax, jax.numpy as jnp
from jax import lax
import numpy as np

D_MODEL = 1024
BATCH = 32
SEQ = 2048
DEPTH = 1

HG_HEADS = 4
HG_DIM = 128
HG_WIDTH = HG_HEADS * HG_DIM
HG_CHUNK = 64
DIL_PAIRS = ((128, 1), (512, 4), (2048, 16))
N_DIL = len(DIL_PAIRS)
ATT_SLOTS = 4
ATT_HEAD_DIM = 64
ATT_HEADS = N_DIL * ATT_SLOTS
ATT_WIDTH = ATT_HEADS * ATT_HEAD_DIM
ATT_OUT = ATT_SLOTS * ATT_HEAD_DIM
ROT_DIM = ATT_HEAD_DIM // 4
ROPE_THETA = 500000.0
COL_SIZES = (HG_WIDTH,) * 5 + (ATT_WIDTH,) * 3 + (D_MODEL,) * 2
IN_COLS = sum(COL_SIZES)
N_EXPERTS = 256
TOP_K = 8
N_GROUPS = 8
TOPK_GROUPS = 4
EXPERT_HIDDEN = 256
SHARED_HIDDEN = 256
ROUTED_SCALE = 2.5
MOE_BLOCK = 256
PLE_DIM = 256
DN_ALPHA = (2 * DEPTH) ** 0.25
DN_BETA = (8 * DEPTH) ** -0.25
LN_EPS = 1e-5
NEG_INF = -1e30

kernel_name = 'hybrid_hgrn2_dilated_moe_encoder_block'


def layer_norm(x, g, b):
    xf = x.astype(jnp.float32)
    mu = jnp.mean(xf, axis=-1, keepdims=True)
    xc = xf - mu
    var = jnp.mean(xc * xc, axis=-1, keepdims=True)
    return (xc * lax.rsqrt(var + LN_EPS) * g + b).astype(x.dtype)


def hgrn2_chunked(q, k, v, log_f):
    B, H, L, dk = q.shape
    dv = v.shape[-1]
    n = L // HG_CHUNK
    q = q.reshape(B, H, n, HG_CHUNK, dk)
    k = k.reshape(B, H, n, HG_CHUNK, dk)
    log_f = log_f.reshape(B, H, n, HG_CHUNK, dk)
    v = v.reshape(B, H, n, HG_CHUNK, dv)
    b = jnp.cumsum(log_f, axis=3)
    b_ref = b[:, :, :, HG_CHUNK // 2 - 1:HG_CHUNK // 2]
    b_last = b[:, :, :, -1:]
    prefix = jnp.tril(jnp.ones((HG_CHUNK, HG_CHUNK), dtype=bool))
    scores = jnp.einsum('bhnce,bhnse->bhncs', q * jnp.exp(b - b_ref), k * jnp.exp(b_ref - b))
    o_intra = jnp.einsum('bhncs,bhnsv->bhncv', jnp.where(prefix, scores, 0.0), v)
    q_in = q * jnp.exp(b)
    k_out = k * jnp.exp(b_last - b)
    decay = jnp.exp(b_last[:, :, :, 0])

    def step(S, xs):
        qc, kc, vc, dc = xs
        o = jnp.einsum('bhce,bhev->bhcv', qc, S)
        S = dc[..., None] * S + jnp.einsum('bhce,bhcv->bhev', kc, vc)
        return S, o

    S0 = jnp.zeros((B, H, dk, dv), jnp.float32)
    mv = lambda t: jnp.moveaxis(t, 2, 0)
    _, o_inter = lax.scan(step, S0, (mv(q_in), mv(k_out), mv(v), mv(decay)))
    o = o_intra + jnp.moveaxis(o_inter, 0, 2)
    return o.reshape(B, H, L, dv)


def hgrn2_branch(q_raw, i_raw, ff_raw, fb_raw, g_raw, lb_fwd, lb_bwd, norm_g):
    B, L, _ = q_raw.shape
    heads = lambda t: t.astype(jnp.float32).reshape(B, L, HG_HEADS, HG_DIM).transpose(0, 2, 1, 3)
    q = jax.nn.silu(heads(q_raw))
    v = heads(i_raw)

    def gates(f_raw, lb):
        lb = lb.reshape(HG_HEADS, 1, HG_DIM)
        f = lb + (1.0 - lb) * jax.nn.sigmoid(heads(f_raw))
        return 1.0 - f, jnp.log(f)

    k_f, lf_f = gates(ff_raw, lb_fwd)
    k_b, lf_b = gates(fb_raw, lb_bwd)
    o_fwd = hgrn2_chunked(q, k_f, v, lf_f)
    rev = lambda t: jnp.flip(t, axis=2)
    o_bwd = rev(hgrn2_chunked(rev(q), rev(k_b), rev(v), rev(lf_b)))
    o = (o_fwd + o_bwd).transpose(0, 2, 1, 3)
    o = o * lax.rsqrt(jnp.mean(o * o, axis=-1, keepdims=True) + LN_EPS) * norm_g.reshape(HG_HEADS, HG_DIM)
    o = o.reshape(B, L, HG_WIDTH) * jax.nn.silu(g_raw.astype(jnp.float32))
    return o.astype(q_raw.dtype)


def partial_rotary(t, pos):
    half = ROT_DIM // 2
    inv_freq = ROPE_THETA ** (-jnp.arange(half, dtype=jnp.float32) / half)
    ang = pos[:, None] * inv_freq[None, :]
    cos = jnp.cos(ang)[:, None, :]
    sin = jnp.sin(ang)[:, None, :]
    t1 = t[..., :half]
    t2 = t[..., half:ROT_DIM]
    return jnp.concatenate([t1 * cos - t2 * sin, t2 * cos + t1 * sin, t[..., ROT_DIM:]], axis=-1)


def dilated_group_attention(q, k, v, window, dilation):
    B, L, H, dh = q.shape
    span = window // (2 * dilation)
    m_len = L // dilation
    nb = -(-m_len // span)
    mp = nb * span

    def to_sub(t):
        t = t.reshape(B, m_len, dilation, H, dh).transpose(0, 2, 3, 1, 4)
        return jnp.pad(t, ((0, 0), (0, 0), (0, 0), (0, mp - m_len), (0, 0)))

    def neighbours(t):
        t = jnp.pad(to_sub(t), ((0, 0), (0, 0), (0, 0), (span, span), (0, 0)))
        t = t.reshape(B, dilation, H, nb + 2, span, dh)
        return jnp.concatenate([t[:, :, :, j:j + nb] for j in range(3)], axis=4)

    qb = to_sub(q).reshape(B, dilation, H, nb, span, dh)
    kb = neighbours(k)
    vb = neighbours(v)
    qi = jnp.arange(nb)[:, None] * span + jnp.arange(span)[None, :]
    ki = (jnp.arange(nb)[:, None] - 1) * span + jnp.arange(3 * span)[None, :]
    mask = ((jnp.abs(qi[:, :, None] - ki[:, None, :]) <= span)
            & (ki[:, None, :] >= 0) & (ki[:, None, :] < m_len))
    s = jnp.einsum('bdhnqe,bdhnke->bdhnqk', qb, kb) * (dh ** -0.5)
    s = jnp.where(mask, s, NEG_INF)
    mx = jnp.max(s, axis=-1, keepdims=True)
    e = jnp.exp(s - mx)
    den = jnp.sum(e, axis=-1, keepdims=True)
    o = jnp.einsum('bdhnqk,bdhnke->bdhnqe', e, vb) / den
    lse = (mx + jnp.log(den))[..., 0]
    o = o.reshape(B, dilation, H, mp, dh)[:, :, :, :m_len].transpose(0, 3, 1, 2, 4).reshape(B, L, H, dh)
    lse = lse.reshape(B, dilation, H, mp)[..., :m_len].transpose(0, 3, 1, 2).reshape(B, L, H)
    return o, lse


def dilated_branch(q_raw, k_raw, v_raw):
    B, L, _ = q_raw.shape
    pos = jnp.arange(L, dtype=jnp.float32)
    sh = lambda t: t.astype(jnp.float32).reshape(B, L, ATT_HEADS, ATT_HEAD_DIM)
    q = partial_rotary(sh(q_raw), pos)
    k = partial_rotary(sh(k_raw), pos)
    v = sh(v_raw)
    outs, lses = [], []
    for g, (window, dilation) in enumerate(DIL_PAIRS):
        hs = slice(g * ATT_SLOTS, (g + 1) * ATT_SLOTS)
        o, lse = dilated_group_attention(q[:, :, hs], k[:, :, hs], v[:, :, hs], window, dilation)
        outs.append(o)
        lses.append(lse)
    o = jnp.stack(outs, axis=2)
    w = jax.nn.softmax(jnp.stack(lses, axis=2), axis=2)
    o = jnp.sum(w[..., None] * o, axis=2).reshape(B, L, ATT_OUT)
    return o.astype(q_raw.dtype)


def moe_ffn(xt, w_router, router_bias, w_gate, w_up, w_down, ws_gate, ws_up, ws_down):
    T, D = xt.shape
    scores = jax.nn.sigmoid((xt @ w_router).astype(jnp.float32))
    biased = scores + router_bias.astype(jnp.float32)
    per_group = N_EXPERTS // N_GROUPS
    group_score = jnp.sum(lax.top_k(biased.reshape(T, N_GROUPS, per_group), 2)[0], axis=-1)
    _, top_groups = lax.top_k(group_score, TOPK_GROUPS)
    group_mask = jnp.any(top_groups[:, :, None] == jnp.arange(N_GROUPS)[None, None, :], axis=1)
    expert_mask = jnp.repeat(group_mask, per_group, axis=1)
    _, top_e = lax.top_k(jnp.where(expert_mask, biased, -jnp.inf), TOP_K)
    gate = jnp.take_along_axis(scores, top_e, axis=1)
    gate = gate / jnp.sum(gate, axis=-1, keepdims=True) * ROUTED_SCALE

    n_assign = T * TOP_K
    e_flat = top_e.reshape(-1)
    tok_flat = jnp.repeat(jnp.arange(T, dtype=jnp.int32), TOP_K)
    g_flat = gate.reshape(-1)
    order = jnp.argsort(e_flat)
    e_sorted = e_flat[order]
    tok_sorted = tok_flat[order]
    g_sorted = g_flat[order]
    counts = jnp.bincount(e_flat, length=N_EXPERTS)
    starts = jnp.cumsum(counts) - counts
    padded = (counts + MOE_BLOCK - 1) // MOE_BLOCK * MOE_BLOCK
    padded_end = jnp.cumsum(padded)
    padded_start = padded_end - padded
    dest = padded_start[e_sorted] + jnp.arange(n_assign) - starts[e_sorted]
    n_blocks = (n_assign + N_EXPERTS * (MOE_BLOCK - 1) + MOE_BLOCK - 1) // MOE_BLOCK
    n_slots = n_blocks * MOE_BLOCK
    slot_tok = jnp.zeros((n_slots,), jnp.int32).at[dest].set(tok_sorted)
    slot_gate = jnp.zeros((n_slots,), jnp.float32).at[dest].set(g_sorted)
    block_expert = jnp.minimum(
        jnp.searchsorted(padded_end, jnp.arange(n_blocks) * MOE_BLOCK, side='right'), N_EXPERTS - 1)

    def expert_block(acc, blk):
        tok, g, e = blk
        xb = xt[tok]
        h = jax.nn.silu(xb @ w_gate[e]) * (xb @ w_up[e])
        y = (h @ w_down[e]) * g[:, None].astype(xt.dtype)
        return acc.at[tok].add(y), None

    routed, _ = lax.scan(expert_block, jnp.zeros_like(xt),
                         (slot_tok.reshape(n_blocks, MOE_BLOCK), slot_gate.reshape(n_blocks, MOE_BLOCK), block_expert))
    shared = (jax.nn.silu(xt @ ws_gate) * (xt @ ws_up)) @ ws_down
    return routed + shared


def setup_inputs(seed: int = 0) -> dict:
    key = jax.random.key(seed)
    ks = jax.random.split(key, 32)
    f32 = jnp.float32
    nrm = lambda k, shape, fan_in, scale=1.0: jax.random.normal(k, shape, f32) * (scale * fan_in ** -0.5)
    gain = lambda k, n: 1.0 + 0.02 * jax.random.normal(k, (DEPTH, n), f32)
    bias = lambda k, n: 0.02 * jax.random.normal(k, (DEPTH, n), f32)
    col_scale = np.ones((IN_COLS,), np.float32)
    col_scale[HG_WIDTH:2 * HG_WIDTH] = DN_BETA
    v0 = 5 * HG_WIDTH + 2 * ATT_WIDTH
    col_scale[v0:v0 + ATT_WIDTH] = DN_BETA
    return {
        'x': jax.random.normal(ks[0], (BATCH, SEQ, D_MODEL), f32),
        'p': jax.random.normal(ks[1], (DEPTH, BATCH, SEQ, PLE_DIM), f32),
        'w_in': nrm(ks[2], (DEPTH, D_MODEL, IN_COLS), D_MODEL) * jnp.asarray(col_scale),
        'hg_lb_fwd': 0.1 * jax.random.normal(ks[3], (DEPTH + 1, HG_WIDTH), f32),
        'hg_lb_bwd': 0.1 * jax.random.normal(ks[4], (DEPTH + 1, HG_WIDTH), f32),
        'hg_norm_g': gain(ks[5], HG_WIDTH),
        'w_branch_hg': nrm(ks[6], (DEPTH, HG_WIDTH, D_MODEL), HG_WIDTH, DN_BETA),
        'w_branch_att': nrm(ks[7], (DEPTH, ATT_OUT, D_MODEL), ATT_OUT, DN_BETA),
        'w_out': nrm(ks[8], (DEPTH, D_MODEL, D_MODEL), D_MODEL, DN_BETA),
        'ln1_g': gain(ks[9], D_MODEL),
        'ln1_b': bias(ks[10], D_MODEL),
        'w_router': nrm(ks[11], (DEPTH, D_MODEL, N_EXPERTS), D_MODEL),
        'router_bias': 0.01 * jax.random.normal(ks[12], (DEPTH, N_EXPERTS), f32),
        'w_exp_gate': nrm(ks[13], (DEPTH, N_EXPERTS, D_MODEL, EXPERT_HIDDEN), D_MODEL, DN_BETA),
        'w_exp_up': nrm(ks[14], (DEPTH, N_EXPERTS, D_MODEL, EXPERT_HIDDEN), D_MODEL, DN_BETA),
        'w_exp_down': nrm(ks[15], (DEPTH, N_EXPERTS, EXPERT_HIDDEN, D_MODEL), EXPERT_HIDDEN, DN_BETA),
        'w_sh_gate': nrm(ks[16], (DEPTH, D_MODEL, SHARED_HIDDEN), D_MODEL, DN_BETA),
        'w_sh_up': nrm(ks[17], (DEPTH, D_MODEL, SHARED_HIDDEN), D_MODEL, DN_BETA),
        'w_sh_down': nrm(ks[18], (DEPTH, SHARED_HIDDEN, D_MODEL), SHARED_HIDDEN, DN_BETA),
        'ln2_g': gain(ks[19], D_MODEL),
        'ln2_b': bias(ks[20], D_MODEL),
        'w_ple_gate': nrm(ks[21], (DEPTH, D_MODEL, D_MODEL), D_MODEL),
        'w_ple_proj': nrm(ks[22], (DEPTH, PLE_DIM, D_MODEL), PLE_DIM, DN_BETA),
        'ln3_g': gain(ks[23], D_MODEL),
        'ln3_b': bias(ks[24], D_MODEL),
    }


def reference(x, p, w_in, hg_lb_fwd, hg_lb_bwd, hg_norm_g, w_branch_hg, w_branch_att, w_out,
              ln1_g, ln1_b, w_router, router_bias, w_exp_gate, w_exp_up, w_exp_down,
              w_sh_gate, w_sh_up, w_sh_down, ln2_g, ln2_b, w_ple_gate, w_ple_proj, ln3_g, ln3_b):
    B, L, D = x.shape
    splits = np.cumsum(COL_SIZES)[:-1].tolist()
    lb_fwd_all = jnp.cumsum(jax.nn.softmax(hg_lb_fwd.astype(jnp.float32), axis=0), axis=0)
    lb_bwd_all = jnp.cumsum(jax.nn.softmax(hg_lb_bwd.astype(jnp.float32), axis=0), axis=0)
    for i in range(DEPTH):
        z = x @ w_in[i]
        hq, hi, hff, hfb, hg, aq, ak, av, gate_h, gate_a = jnp.split(z, splits, axis=-1)
        y_h = hgrn2_branch(hq, hi, hff, hfb, hg, lb_fwd_all[i], lb_bwd_all[i], hg_norm_g[i])
        y_a = dilated_branch(aq, ak, av)
        merged = (jax.nn.sigmoid(gate_h) * (y_h @ w_branch_hg[i])
                  + jax.nn.sigmoid(gate_a) * (y_a @ w_branch_att[i]))
        x = layer_norm(DN_ALPHA * x + merged @ w_out[i], ln1_g[i], ln1_b[i])
        ffn = moe_ffn(x.reshape(B * L, D), w_router[i], router_bias[i], w_exp_gate[i], w_exp_up[i],
                      w_exp_down[i], w_sh_gate[i], w_sh_up[i], w_sh_down[i]).reshape(B, L, D)
        x = layer_norm(DN_ALPHA * x + ffn, ln2_g[i], ln2_b[i])
        ple = jax.nn.sigmoid(x @ w_ple_gate[i]) * (p[i] @ w_ple_proj[i])
        x = layer_norm(DN_ALPHA * x + ple, ln3_g[i], ln3_b[i])
    return x
```

```cpp
#include <hip/hip_runtime.h>
#include <cstdio>
#include <cstdint>

#ifndef DBG_SLOT_LO
#define DBG_SLOT_LO 0
#define DBG_SLOT_HI 9
#endif
#ifndef DBG_SKIP_YA
#define DBG_SKIP_YA 0
#endif
#ifndef DBG_CHECK
#define DBG_CHECK 0
#endif
#ifndef DBG_PN_LO
#define DBG_PN_LO 0
#endif
#ifndef MK_PER_PHASE
#define MK_PER_PHASE 0
#endif

#define LAS __attribute__((address_space(3)))
typedef unsigned short u16;
typedef short bf16x8 __attribute__((ext_vector_type(8)));
typedef float f32x4 __attribute__((ext_vector_type(4)));
typedef float f32x2 __attribute__((ext_vector_type(2)));
typedef unsigned u32x4 __attribute__((ext_vector_type(4)));
typedef unsigned u32x2 __attribute__((ext_vector_type(2)));
typedef int i32x16 __attribute__((ext_vector_type(16)));

constexpr int T = 65536, D = 1024, SEQ = 2048;
constexpr int NCOL = 6912;
constexpr int NQ = 4, TQ = T / NQ;
constexpr int NEXP = 256, NSLOT = 9;
constexpr int QTILES = 832;
constexpr float ALPHA = 1.189207115002721f;
constexpr float LN_EPS = 1e-5f;
constexpr int NWAVES = 8, NTHR = 512;

constexpr size_t MiB = (size_t)1 << 20;
constexpr size_t WS_CTL = 0, CTL_ZERO_BYTES = 64 * 1024;
constexpr size_t WS_WIN = 1 * MiB, WS_WBH = 15 * MiB, WS_WBA = 16 * MiB, WS_WO = 17 * MiB, WS_WR = 19 * MiB, WS_WPG = 20 * MiB, WS_WPP = 22 * MiB;
constexpr size_t WS_ROT = 22 * MiB + 512 * 1024, WS_LB = 22 * MiB + 768 * 1024;
constexpr size_t WS_HIST = 24 * MiB, WS_TOKE = 25 * MiB, WS_TOKR = 26 * MiB, WS_TOKG = 27 * MiB;
constexpr size_t WS_STOK = 29 * MiB, WS_SGATE = 33 * MiB, WS_SDST = 37 * MiB, WS_TILEE = 41 * MiB, WS_NTILES = 41 * MiB + 512 * 1024;
constexpr size_t WS_XB = 44 * MiB;
constexpr size_t WS_YH = WS_XB, WS_YA = WS_XB + 64 * MiB;
constexpr size_t WS_Z = 172 * MiB;
constexpr size_t Z_QH = WS_Z, Z_VH = WS_Z + 64 * MiB, Z_LFF = WS_Z + 128 * MiB, Z_LFB = WS_Z + 192 * MiB, Z_GS = WS_Z + 256 * MiB;
constexpr size_t Z_AQ = WS_Z + 320 * MiB, Z_AK = WS_Z + 416 * MiB, Z_AV = WS_Z + 512 * MiB, Z_GTH = WS_Z + 608 * MiB, Z_GTA = WS_Z + 736 * MiB;
constexpr size_t WS_X1PRE = WS_Z;
constexpr size_t WS_LOGITS = WS_Z;
constexpr size_t WS_H = WS_Z + 64 * MiB;
constexpr size_t WS_P2 = WS_Z + 168 * MiB;
constexpr size_t WS_X2B = WS_Z + 200 * MiB;
constexpr size_t WS_PB = WS_Z + 232 * MiB;
constexpr size_t WS_WGU = WS_Z + 256 * MiB;
constexpr size_t WS_WD = WS_Z + 513 * MiB;
constexpr size_t WS_YS = WS_Z + 642 * MiB;
constexpr size_t WS_END = WS_Z + 931 * MiB;
constexpr size_t DO_OF = 0, DO_OB = 64 * MiB, DO_MERGED = 0;

constexpr int CW_BAR = 4096;

__device__ __forceinline__ unsigned cvt_pk_bf16(float lo, float hi) { unsigned r; asm volatile("v_cvt_pk_bf16_f32 %0, %1, %2" : "=v"(r) : "v"(lo), "v"(hi)); return r; }
__device__ __forceinline__ float bf_lo(unsigned w) { return __uint_as_float(w << 16); }
__device__ __forceinline__ float bf_hi(unsigned w) { return __uint_as_float(w & 0xffff0000u); }
__device__ __forceinline__ float bf1(u16 b) { return __uint_as_float(((unsigned)b) << 16); }
__device__ __forceinline__ float sigmoidf_(float z) { return __builtin_amdgcn_rcpf(1.0f + __expf(-z)); }
__device__ __forceinline__ unsigned pk_f16(float lo, float hi) { _Float16 a = (_Float16)lo, b = (_Float16)hi; unsigned short ua = __builtin_bit_cast(unsigned short, a), ub = __builtin_bit_cast(unsigned short, b); return (unsigned)ua | ((unsigned)ub << 16); }
__device__ __forceinline__ float f16_lo(unsigned w) { return (float)__builtin_bit_cast(_Float16, (unsigned short)(w & 0xffffu)); }
__device__ __forceinline__ float f16_hi(unsigned w) { return (float)__builtin_bit_cast(_Float16, (unsigned short)(w >> 16)); }
__device__ __forceinline__ float wave_sum(float v) {
#pragma unroll
    for (int o = 1; o < 64; o <<= 1) v += __shfl_xor(v, o);
    return v;
}
__device__ __forceinline__ float wave_max(float v) {
#pragma unroll
    for (int o = 1; o < 64; o <<= 1) v = fmaxf(v, __shfl_xor(v, o));
    return v;
}
#define LDS_WAIT() asm volatile("s_waitcnt lgkmcnt(0)" ::: "memory")
#define VM_WAIT() asm volatile("s_waitcnt vmcnt(0)" ::: "memory")

#define XB_TMO      128
#define XB_XCNT(j)  (256  + 64 * (j))
#define XB_XSUB(j)  (1280 + 64 * (j))
#define XB_XGEN(j)  (2304 + 64 * (j))
#define XB_TOP      3328
#define XB_TOPGEN   3392
#define XCD_BAR_WORDS 3456
#define XB_SPIN_CAP (1u << 22)

__device__ __forceinline__ unsigned xb_ld(unsigned* p)              { return __hip_atomic_load(p, __ATOMIC_RELAXED, __HIP_MEMORY_SCOPE_AGENT); }
__device__ __forceinline__ unsigned xb_add(unsigned* p, unsigned v) { return __hip_atomic_fetch_add(p, v, __ATOMIC_RELAXED, __HIP_MEMORY_SCOPE_AGENT); }
__device__ __forceinline__ unsigned xb_xcc_id() { return (unsigned)__builtin_amdgcn_s_getreg((3 << 11) | 20) & 0xFu; }
#define XB_SPIN(cond, bar) do { unsigned _sp = 0; while (cond) { __builtin_amdgcn_s_sleep(1); \
    if ((++_sp & 255u) == 0u) { if (xb_ld(&(bar)[XB_TMO])) break; if (_sp > XB_SPIN_CAP) { atomicAdd(&(bar)[XB_TMO], 1u); break; } } } } while (0)

struct XcdBarrier { unsigned* bar; unsigned x; volatile LAS unsigned* st; };

__device__ __forceinline__ XcdBarrier xcd_barrier_post(unsigned* bar, volatile LAS unsigned* st) {
    XcdBarrier b; b.bar = bar; b.x = xb_xcc_id(); b.st = st;
    if (threadIdx.x == 0) (void)xb_add(&bar[XB_XCNT(b.x)], 1u);
    return b;
}
__device__ __forceinline__ void xcd_barrier_complete(unsigned* bar, unsigned x, unsigned& nloc, unsigned& nx) {
    const unsigned G = gridDim.x * gridDim.y * gridDim.z;
    unsigned sum, cnt, mine, sp = 0u;
    for (;;) {
        sum = 0u; cnt = 0u; mine = 0u;
#pragma unroll
        for (unsigned j = 0; j < 16; ++j) { const unsigned c = xb_ld(&bar[XB_XCNT(j)]); sum += c; cnt += (c > 0u) ? 1u : 0u; mine = (j == x) ? c : mine; }
        if (sum == G) break;
        __builtin_amdgcn_s_sleep(1);
        if ((++sp & 255u) == 0u) { if (xb_ld(&bar[XB_TMO])) break; if (sp > XB_SPIN_CAP) { atomicAdd(&bar[XB_TMO], 1u); break; } }
    }
    nloc = mine > 0u ? mine : 1u; nx = cnt > 0u ? cnt : 1u;
}
__device__ __forceinline__ void xcd_barrier(const XcdBarrier& b) {
    asm volatile("s_waitcnt vmcnt(0)" ::: "memory");
    __syncthreads();
    if (threadIdx.x == 0) {
        unsigned* bar = b.bar;
        __builtin_amdgcn_s_waitcnt(0);
        unsigned nloc = b.st[0], nx = b.st[1];
        if (nloc == 0u) { xcd_barrier_complete(bar, b.x, nloc, nx); b.st[0] = nloc; b.st[1] = nx; }
        const unsigned old = xb_add(&bar[XB_XSUB(b.x)], 1u);
        const unsigned gen = old / nloc;
        if (old + 1u == (gen + 1u) * nloc) {
            __builtin_amdgcn_fence(__ATOMIC_RELEASE, "agent");
            asm volatile("s_waitcnt vmcnt(0)" ::: "memory");
            const unsigned og = xb_add(&bar[XB_TOP], 1u);
            const unsigned tg = og / nx;
            if (og + 1u == (tg + 1u) * nx) xb_add(&bar[XB_TOPGEN], 1u);
            else XB_SPIN(xb_ld(&bar[XB_TOPGEN]) == tg, bar);
            __builtin_amdgcn_fence(__ATOMIC_ACQUIRE, "agent");
            xb_add(&bar[XB_XGEN(b.x)], 1u);
            asm volatile("s_waitcnt vmcnt(0)" ::: "memory");
        } else {
            XB_SPIN(xb_ld(&bar[XB_XGEN(b.x)]) == gen, bar);
            __builtin_amdgcn_fence(__ATOMIC_ACQUIRE, "agent");
            asm volatile("s_waitcnt vmcnt(0)" ::: "memory");
        }
    }
    __syncthreads();
}

namespace pg8 {
constexpr int BM = 256, BK = 64, HALF = 128, HTB = HALF * BK * 2, STAGE_BYTES = 8 * HTB;
__host__ __device__ __forceinline__ int lds_byte(int r, int c) { const int st = (r >> 4) * 2 + (c >> 5), rr = r & 15, cc = c & 31, ob = rr * 64 + cc * 2; return st * 1024 + (ob ^ (((ob >> 9) & 1) << 5)); }
__host__ __device__ __forceinline__ void stage_rc(int b, int& R, int& C) { const int st = b / 1024, sb = b % 1024, swz = sb ^ (((sb >> 9) & 1) << 5); R = (st >> 1) * 16 + swz / 64; C = (st & 1) * 32 + (swz % 64) / 2; }
__host__ __device__ __forceinline__ int perm32(int rho) { const int n = rho >> 4, i = rho & 15; return 8 * (i >> 2) + 4 * n + (i & 3); }

struct GUnit { const char* A; const char* B; int pm, pn, aux; };

struct DenseOrder {
    static constexpr bool GATHER_ROWS = false;
    const char* A; const char* Bt; int nM, nN, nwg, G, c, K, rev = 0;
    __device__ void init(const void* A_, const void* Bt_, int M, int N, int K_, int G_, int c_) { A = (const char*)A_; Bt = (const char*)Bt_; nM = M / BM; nN = N / BM; nwg = nM * nN; G = G_; c = c_; K = K_; }
    __device__ __forceinline__ bool next(int i, GUnit& u) const {
        if ((long)i * G + c >= nwg) return false; const int nr_ = (nwg + G - 1) / G; const long L = rev ? (long)(nr_ - 1 - i) * G + c : (long)i * G + c; if (L >= nwg) return false;
        int wgid = (int)L; { const int q = nwg / 8, r = nwg % 8, xcd = wgid % 8, off = wgid / 8; wgid = (xcd < r ? xcd * (q + 1) : r * (q + 1) + (xcd - r) * q) + off; }
        const int nig = 8 * nN, gid = wgid / nig, fm = gid * 8, gsz = (nM - fm) < 8 ? (nM - fm) : 8;
        u.pm = fm + ((wgid % nig) % gsz); u.pn = (wgid % nig) / gsz; u.aux = 0;
        u.A = A + (size_t)u.pm * BM * K * 2; u.B = Bt + (size_t)u.pn * BM * K * 2; return true;
    }
    __device__ __forceinline__ unsigned rowoff(const GUnit&, int r0, int sub) const { return (unsigned)(r0 + sub) * (unsigned)K * 2u; }
};
template <int NT, bool GATHER> struct MoeOrder {
    static constexpr bool GATHER_ROWS = GATHER;
    const char* A; const char* W; const int* tile_e; const int* slot_tok; int ntiles, G, vc, K; size_t wstride_e, wstride_pn;
    __device__ __forceinline__ bool next(int i, GUnit& u) const {
        const int v = i * G + vc; const int tile = v / NT; if (tile >= ntiles) return false;
        u.pm = tile; u.pn = v % NT; const int e = __builtin_amdgcn_readfirstlane(tile_e[tile]); u.aux = e;
        u.A = GATHER ? A : A + (size_t)tile * BM * K * 2; u.B = W + (size_t)e * wstride_e + (size_t)u.pn * wstride_pn; return true;
    }
    __device__ __forceinline__ unsigned rowoff(const GUnit& u, int r0, int sub) const {
        if (!GATHER) return (unsigned)(r0 + sub) * (unsigned)K * 2u;
        const int* p = slot_tok + (size_t)u.pm * BM + r0; i32x16 v;
        asm volatile("s_load_dwordx16 %0, %1, 0x0 glc\n\ts_waitcnt lgkmcnt(0)" : "=s"(v) : "s"(p) : "memory");
        int idx = v[0];
#pragma unroll
        for (int j = 1; j < 16; ++j) idx = (sub == j) ? v[j] : idx;
        return (unsigned)idx * (unsigned)K * 2u;
    }
};

template <bool OPAQUE_K = false, class Epi, class Sched>
__device__ __forceinline__ void gemm_phase(LAS unsigned char* lds, const int K_, const Sched& S, const Epi& E) {
    int K = K_; if (OPAQUE_K) asm volatile("" : "+s"(K));
    int tid_ = threadIdx.x; asm volatile("" : "+v"(tid_));
    const int tid = tid_, wid = __builtin_amdgcn_readfirstlane(tid >> 6), lane = tid & 63, wr = wid >> 2, wc = wid & 3, fr = lane & 15, fq = lane >> 4;
    const int nt = K / BK;
    unsigned colb[2], voffB[2]; int r0w[2];
#pragma unroll
    for (int i = 0; i < 2; ++i) { int R, C; stage_rc(tid * 16 + i * 8192, R, C); const int Rb = Epi::PERM ? ((R & ~31) + perm32(R & 31)) : R;
        colb[i] = (unsigned)C * 2u; voffB[i] = (unsigned)(Rb * K + C) * 2u; r0w[i] = 16 * ((wid >> 1) + 4 * i); }
    const int sub = lane >> 2;
    const size_t kstep = (size_t)(BK * 2);
    const size_t hstep = (size_t)HALF * K * 2;
    const unsigned ldsw = (unsigned)wid * 1024u;
    const int aoff = lds_byte(wr * 64 + fr, fq * 8), boff = lds_byte(wc * 32 + fr, fq * 8);
#define PG8_SA(b, h) (((b) * 2 + (h)) * HTB)
#define PG8_SB(b, h) ((4 + (b) * 2 + (h)) * HTB)
#define PG8_STAGE(bufoff, gbase, voff) do { _Pragma("unroll") for (int _i = 0; _i < 2; ++_i) \
        __builtin_amdgcn_global_load_lds((const unsigned*)((const char*)(gbase) + (voff)[_i]), (LAS unsigned*)(lds + (bufoff) + ldsw + _i * 8192), 16, 0, 0); } while (0)
#define PG8_LDA(dst, b, h) do { _Pragma("unroll") for (int m = 0; m < 4; ++m) _Pragma("unroll") for (int k = 0; k < 2; ++k) dst[m][k] = *(const LAS bf16x8*)(lds + PG8_SA(b, h) + aoff + m * 2048 + k * 1024); } while (0)
#define PG8_LDB(dst, b, h) do { _Pragma("unroll") for (int n = 0; n < 2; ++n) _Pragma("unroll") for (int k = 0; k < 2; ++k) dst[n][k] = *(const LAS bf16x8*)(lds + PG8_SB(b, h) + boff + n * 2048 + k * 1024); } while (0)
#define PG8_MMA(ai, bj, At, Bt) do { __builtin_amdgcn_s_setprio(1); _Pragma("unroll") for (int m = 0; m < 4; ++m) _Pragma("unroll") for (int n = 0; n < 2; ++n) _Pragma("unroll") for (int k = 0; k < 2; ++k) \
        acc[ai][bj][m][n] = __builtin_amdgcn_mfma_f32_16x16x32_bf16(Bt[n][k], At[m][k], acc[ai][bj][m][n], 0, 0, 0); __builtin_amdgcn_s_setprio(0); } while (0)
#define PG8_WAIT_V(n) asm volatile("s_waitcnt vmcnt(" #n ")" ::: "memory")
#define PG8_WAIT_L(n) asm volatile("s_waitcnt lgkmcnt(" #n ")" ::: "memory")
#define PG8_BAR __builtin_amdgcn_s_barrier()
#define PG8_SCHED __builtin_amdgcn_sched_barrier(0)
    GUnit cur, nxt; int ui = 0;
    if (!S.next(0, cur)) return;
    f32x4 acc[2][2][4][2];
#pragma unroll
    for (int a = 0; a < 2; ++a)
#pragma unroll
        for (int b = 0; b < 2; ++b)
#pragma unroll
            for (int m = 0; m < 4; ++m)
#pragma unroll
                for (int n = 0; n < 2; ++n) acc[a][b][m][n] = (f32x4){0.f, 0.f, 0.f, 0.f};
    bf16x8 At[4][2], B0[2][2], B1[2][2];
    unsigned oa0[2], oa1[2], na0[2], na1[2];
#pragma unroll
    for (int i = 0; i < 2; ++i) { oa0[i] = S.rowoff(cur, r0w[i], sub) + colb[i]; oa1[i] = S.rowoff(cur, r0w[i] + HALF, sub) + colb[i]; }
    const char* cA = cur.A; const char* cB = cur.B;
    PG8_STAGE(PG8_SB(0, 0), cB, voffB); PG8_STAGE(PG8_SA(0, 0), cA, oa0); PG8_STAGE(PG8_SB(0, 1), cB + hstep, voffB); PG8_STAGE(PG8_SA(0, 1), cA, oa1);
    if (wr == 1) PG8_BAR;
    PG8_WAIT_V(4); PG8_BAR;
    PG8_STAGE(PG8_SB(1, 0), cB + kstep, voffB); PG8_STAGE(PG8_SA(1, 0), cA + kstep, oa0); PG8_STAGE(PG8_SB(1, 1), cB + hstep + kstep, voffB);
    PG8_WAIT_V(6); PG8_BAR;
    for (;;) {
        const bool has_next = S.next(ui + 1, nxt);
        const char* nA = has_next ? nxt.A : cA; const char* nB = has_next ? nxt.B : cB;
        if constexpr (Sched::GATHER_ROWS) {
            if (has_next) {
#pragma unroll
                for (int i = 0; i < 2; ++i) { na0[i] = S.rowoff(nxt, r0w[i], sub) + colb[i]; na1[i] = S.rowoff(nxt, r0w[i] + HALF, sub) + colb[i]; }
            } else {
#pragma unroll
                for (int i = 0; i < 2; ++i) { na0[i] = oa0[i]; na1[i] = oa1[i]; }
            }
        }
        for (int t = 0; t < nt; t += 2) {
            const bool last = (t == nt - 2);
            const char* a1 = cA + (size_t)(t + 1) * kstep;
            const char* a2 = last ? nA : cA + (size_t)(t + 2) * kstep; const char* b2 = last ? nB : cB + (size_t)(t + 2) * kstep;
            const char* a3 = a2 + kstep; const char* b3 = b2 + kstep;
            unsigned x0[2], x1[2];
#pragma unroll
            for (int i = 0; i < 2; ++i) { if constexpr (Sched::GATHER_ROWS) { x0[i] = last ? na0[i] : oa0[i]; x1[i] = last ? na1[i] : oa1[i]; } else { x0[i] = oa0[i]; x1[i] = oa1[i]; } }
            PG8_LDB(B0, 0, 0); PG8_SCHED; PG8_LDA(At, 0, 0); PG8_STAGE(PG8_SA(1, 1), a1, oa1);
            PG8_WAIT_L(8); PG8_BAR; PG8_WAIT_L(0); PG8_MMA(0, 0, At, B0); PG8_BAR; PG8_SCHED;
            PG8_LDB(B1, 0, 1); PG8_STAGE(PG8_SB(0, 0), b2, voffB);
            PG8_BAR; PG8_WAIT_L(0); PG8_MMA(0, 1, At, B1); PG8_BAR;
            PG8_LDA(At, 0, 1); PG8_STAGE(PG8_SA(0, 0), a2, x0);
            PG8_BAR; PG8_WAIT_L(0); PG8_MMA(1, 0, At, B0); PG8_BAR; PG8_SCHED;
            PG8_STAGE(PG8_SB(0, 1), b2 + hstep, voffB);
            PG8_WAIT_V(6); PG8_BAR; PG8_MMA(1, 1, At, B1); PG8_BAR;
            PG8_LDB(B0, 1, 0); PG8_SCHED; PG8_LDA(At, 1, 0); PG8_STAGE(PG8_SA(0, 1), a2, x1);
            PG8_WAIT_L(8); PG8_BAR; PG8_WAIT_L(0); PG8_MMA(0, 0, At, B0); PG8_BAR; PG8_SCHED;
            PG8_LDB(B1, 1, 1); PG8_STAGE(PG8_SB(1, 0), b3, voffB);
            PG8_BAR; PG8_WAIT_L(0); PG8_MMA(0, 1, At, B1); PG8_BAR;
            PG8_LDA(At, 1, 1); PG8_STAGE(PG8_SA(1, 0), a3, x0);
            PG8_BAR; PG8_WAIT_L(0); PG8_MMA(1, 0, At, B0); PG8_BAR; PG8_SCHED;
            PG8_STAGE(PG8_SB(1, 1), b3 + hstep, voffB);
            PG8_WAIT_V(6); PG8_BAR; PG8_MMA(1, 1, At, B1); PG8_BAR;
        }
        E(acc, cur, wr, wc, fr, fq);
        if (!has_next) break;
#pragma unroll
        for (int a = 0; a < 2; ++a)
#pragma unroll
            for (int b = 0; b < 2; ++b)
#pragma unroll
                for (int m = 0; m < 4; ++m)
#pragma unroll
                    for (int n = 0; n < 2; ++n) acc[a][b][m][n] = (f32x4){0.f, 0.f, 0.f, 0.f};
        cur = nxt; cA = nA; cB = nB; ++ui;
#pragma unroll
        for (int i = 0; i < 2; ++i) { if constexpr (Sched::GATHER_ROWS) { oa0[i] = na0[i]; oa1[i] = na1[i]; } }
    }
    PG8_WAIT_V(0);
    if (wr == 0) PG8_BAR;
    PG8_BAR;
#undef PG8_SA
#undef PG8_SB
#undef PG8_STAGE
#undef PG8_LDA
#undef PG8_LDB
#undef PG8_MMA
#undef PG8_WAIT_V
#undef PG8_WAIT_L
#undef PG8_BAR
#undef PG8_SCHED
}

#define EPI_LOOP_ROWS for (int ai = 0; ai < 2; ++ai) _Pragma("unroll") for (int m = 0; m < 4; ++m)

enum { K_SILU = 0, K_ID = 1, K_LOGF = 2, K_ROT = 3, K_SIG = 4 };
struct EpiZ {
    static constexpr bool PERM = true;
    unsigned char* ws; const float* rot; const float* lb;
    template <int KIND> __device__ __forceinline__ void body(const f32x4 (&acc)[2][2][4][2], u16* base, int ld, int pnl, int pm, float scale, const float* lbp, int wr, int wc, int fr, int fq) const {
        const int row0 = pm * BM + wr * 64 + fr, col0 = pnl * BM + wc * 32 + 8 * fq;
        f32x4 l0[2], l1[2];
        if (KIND == K_LOGF) {
#pragma unroll
            for (int bj = 0; bj < 2; ++bj) { l0[bj] = *(const f32x4*)(lbp + col0 + bj * HALF); l1[bj] = *(const f32x4*)(lbp + col0 + bj * HALF + 4); }
        }
        const bool rotl = (KIND == K_ROT) && ((wc & 1) == 0) && (fq < 2);
        const float sgn = (fq == 0) ? -1.f : 1.f;
#pragma unroll
        EPI_LOOP_ROWS {
            const int row = row0 + ai * HALF + m * 16;
            f32x4 cs0, cs1, sn0, sn1;
            if (KIND == K_ROT) { const float* rp = rot + (size_t)(row & (SEQ - 1)) * 16; cs0 = *(const f32x4*)(rp); cs1 = *(const f32x4*)(rp + 4); sn0 = *(const f32x4*)(rp + 8); sn1 = *(const f32x4*)(rp + 12); }
#pragma unroll
            for (int bj = 0; bj < 2; ++bj) {
                f32x4 v0 = acc[ai][bj][m][0], v1 = acc[ai][bj][m][1];
                if (KIND == K_SILU) {
#pragma unroll
                    for (int j = 0; j < 4; ++j) { v0[j] = v0[j] * sigmoidf_(v0[j]); v1[j] = v1[j] * sigmoidf_(v1[j]); }
                } else if (KIND == K_SIG) {
#pragma unroll
                    for (int j = 0; j < 4; ++j) { v0[j] = sigmoidf_(v0[j]); v1[j] = sigmoidf_(v1[j]); }
                } else if (KIND == K_LOGF) {
#pragma unroll
                    for (int j = 0; j < 4; ++j) { v0[j] = __logf(l0[bj][j] + (1.f - l0[bj][j]) * sigmoidf_(v0[j])); v1[j] = __logf(l1[bj][j] + (1.f - l1[bj][j]) * sigmoidf_(v1[j])); }
                } else if (KIND == K_ROT) {
                    f32x4 o0, o1;
#pragma unroll
                    for (int j = 0; j < 4; ++j) { o0[j] = __shfl_xor(v0[j], 16); o1[j] = __shfl_xor(v1[j], 16); }
                    if (rotl) {
#pragma unroll
                        for (int j = 0; j < 4; ++j) { v0[j] = v0[j] * cs0[j] + sgn * o0[j] * sn0[j]; v1[j] = v1[j] * cs1[j] + sgn * o1[j] * sn1[j]; }
                    }
                    v0 = v0 * scale; v1 = v1 * scale;
                }
                u32x4 w;
                if (KIND == K_LOGF) { w.x = pk_f16(v0[0], v0[1]); w.y = pk_f16(v0[2], v0[3]); w.z = pk_f16(v1[0], v1[1]); w.w = pk_f16(v1[2], v1[3]); }
                else { w.x = cvt_pk_bf16(v0[0], v0[1]); w.y = cvt_pk_bf16(v0[2], v0[3]); w.z = cvt_pk_bf16(v1[0], v1[1]); w.w = cvt_pk_bf16(v1[2], v1[3]); }
                *(u32x4*)(base + (size_t)row * ld + col0 + bj * HALF) = w;
            }
        }
    }
    __device__ __forceinline__ void operator()(const f32x4 (&acc)[2][2][4][2], const GUnit& u, int wr, int wc, int fr, int fq) const {
        const int pn = u.pn, pm = u.pm;
        if (pn < DBG_PN_LO) return;
        if (pn < 2)       body<K_SILU>(acc, (u16*)(ws + Z_QH), 512, pn, pm, 1.f, nullptr, wr, wc, fr, fq);
        else if (pn < 4)  body<K_ID>(acc, (u16*)(ws + Z_VH), 512, pn - 2, pm, 1.f, nullptr, wr, wc, fr, fq);
        else if (pn < 6)  body<K_LOGF>(acc, (u16*)(ws + Z_LFF), 512, pn - 4, pm, 1.f, lb, wr, wc, fr, fq);
        else if (pn < 8)  body<K_LOGF>(acc, (u16*)(ws + Z_LFB), 512, pn - 6, pm, 1.f, lb + 512, wr, wc, fr, fq);
        else if (pn < 10) body<K_SILU>(acc, (u16*)(ws + Z_GS), 512, pn - 8, pm, 1.f, nullptr, wr, wc, fr, fq);
        else if (pn < 13) body<K_ROT>(acc, (u16*)(ws + Z_AQ), 768, pn - 10, pm, 0.125f, nullptr, wr, wc, fr, fq);
        else if (pn < 16) body<K_ROT>(acc, (u16*)(ws + Z_AK), 768, pn - 13, pm, 1.f, nullptr, wr, wc, fr, fq);
        else if (pn < 19) body<K_ID>(acc, (u16*)(ws + Z_AV), 768, pn - 16, pm, 1.f, nullptr, wr, wc, fr, fq);
        else if (pn < 23) body<K_ID>(acc, (u16*)(ws + Z_GTH), 1024, pn - 19, pm, 1.f, nullptr, wr, wc, fr, fq);
        else              body<K_ID>(acc, (u16*)(ws + Z_GTA), 1024, pn - 23, pm, 1.f, nullptr, wr, wc, fr, fq);
    }
};

template <bool ADD> struct EpiGated {
    static constexpr bool PERM = true;
    const u16* gate; u16* out; int ld;
    __device__ __forceinline__ void operator()(const f32x4 (&acc)[2][2][4][2], const GUnit& u, int wr, int wc, int fr, int fq) const {
        const int row0 = u.pm * BM + wr * 64 + fr, col0 = u.pn * BM + wc * 32 + 8 * fq;
#pragma unroll
        EPI_LOOP_ROWS {
            const size_t off = (size_t)(row0 + ai * HALF + m * 16) * ld + col0;
#pragma unroll
            for (int bj = 0; bj < 2; ++bj) {
                const u32x4 g = *(const u32x4*)(gate + off + bj * HALF);
                f32x4 v0 = acc[ai][bj][m][0], v1 = acc[ai][bj][m][1];
                v0[0] *= sigmoidf_(bf_lo(g.x)); v0[1] *= sigmoidf_(bf_hi(g.x)); v0[2] *= sigmoidf_(bf_lo(g.y)); v0[3] *= sigmoidf_(bf_hi(g.y));
                v1[0] *= sigmoidf_(bf_lo(g.z)); v1[1] *= sigmoidf_(bf_hi(g.z)); v1[2] *= sigmoidf_(bf_lo(g.w)); v1[3] *= sigmoidf_(bf_hi(g.w));
                if (ADD) { const u32x4 p = *(const u32x4*)(out + off + bj * HALF);
                    v0[0] += bf_lo(p.x); v0[1] += bf_hi(p.x); v0[2] += bf_lo(p.y); v0[3] += bf_hi(p.y);
                    v1[0] += bf_lo(p.z); v1[1] += bf_hi(p.z); v1[2] += bf_lo(p.w); v1[3] += bf_hi(p.w); }
                u32x4 w; w.x = cvt_pk_bf16(v0[0], v0[1]); w.y = cvt_pk_bf16(v0[2], v0[3]); w.z = cvt_pk_bf16(v1[0], v1[1]); w.w = cvt_pk_bf16(v1[2], v1[3]);
                *(u32x4*)(out + off + bj * HALF) = w;
            }
        }
    }
};
struct EpiF32Res {
    static constexpr bool PERM = false;
    float* C; const float* res; int ld; float alpha;
    __device__ __forceinline__ void operator()(const f32x4 (&acc)[2][2][4][2], const GUnit& u, int wr, int wc, int fr, int fq) const {
        const int row0 = u.pm * BM + wr * 64 + fr, col0 = u.pn * BM + wc * 32 + 4 * fq;
#pragma unroll
        EPI_LOOP_ROWS {
            const size_t off = (size_t)(row0 + ai * HALF + m * 16) * ld + col0;
#pragma unroll
            for (int bj = 0; bj < 2; ++bj)
#pragma unroll
                for (int n = 0; n < 2; ++n) { f32x4 v = acc[ai][bj][m][n]; if (res) v = v + alpha * *(const f32x4*)(res + off + bj * HALF + n * 16); *(f32x4*)(C + off + bj * HALF + n * 16) = v; }
        }
    }
};
struct EpiBf16 {
    static constexpr bool PERM = true;
    u16* O; int ld;
    __device__ __forceinline__ void operator()(const f32x4 (&acc)[2][2][4][2], const GUnit& u, int wr, int wc, int fr, int fq) const {
        const int row0 = u.pm * BM + wr * 64 + fr, col0 = u.pn * BM + wc * 32 + 8 * fq;
#pragma unroll
        EPI_LOOP_ROWS {
            u16* rowp = O + (size_t)(row0 + ai * HALF + m * 16) * ld + col0;
#pragma unroll
            for (int bj = 0; bj < 2; ++bj) { const f32x4 v0 = acc[ai][bj][m][0], v1 = acc[ai][bj][m][1];
                u32x4 w; w.x = cvt_pk_bf16(v0[0], v0[1]); w.y = cvt_pk_bf16(v0[2], v0[3]); w.z = cvt_pk_bf16(v1[0], v1[1]); w.w = cvt_pk_bf16(v1[2], v1[3]);
                *(u32x4*)(rowp + bj * HALF) = w; }
        }
    }
};
struct EpiSwiglu {
    static constexpr bool PERM = true;
    u16* H;
    __device__ __forceinline__ void operator()(const f32x4 (&acc)[2][2][4][2], const GUnit& u, int wr, int wc, int fr, int fq) const {
        const int row0 = u.pm * BM + wr * 64 + fr, col0 = u.pn * HALF + wc * 32 + 8 * fq;
#pragma unroll
        EPI_LOOP_ROWS {
            f32x4 g0 = acc[ai][0][m][0], g1 = acc[ai][0][m][1]; const f32x4 u0 = acc[ai][1][m][0], u1 = acc[ai][1][m][1];
#pragma unroll
            for (int j = 0; j < 4; ++j) { g0[j] = g0[j] * sigmoidf_(g0[j]) * u0[j]; g1[j] = g1[j] * sigmoidf_(g1[j]) * u1[j]; }
            u32x4 w; w.x = cvt_pk_bf16(g0[0], g0[1]); w.y = cvt_pk_bf16(g0[2], g0[3]); w.z = cvt_pk_bf16(g1[0], g1[1]); w.w = cvt_pk_bf16(g1[2], g1[3]);
            *(u32x4*)(H + (size_t)(row0 + ai * HALF + m * 16) * 256 + col0) = w;
        }
    }
};
struct EpiDown {
    static constexpr bool PERM = true;
    u16* Y; const int* dst; const float* gate;
    __device__ __forceinline__ void operator()(const f32x4 (&acc)[2][2][4][2], const GUnit& u, int wr, int wc, int fr, int fq) const {
        const int row0 = u.pm * BM + wr * 64 + fr, col0 = u.pn * BM + wc * 32 + 8 * fq;
#pragma unroll
        EPI_LOOP_ROWS {
            const int srow = row0 + ai * HALF + m * 16; const unsigned d = (unsigned)dst[srow]; const float g = gate[srow];
            u16* rowp = Y + (size_t)(d * (unsigned)D + (unsigned)col0);
#pragma unroll
            for (int bj = 0; bj < 2; ++bj) { const f32x4 v0 = acc[ai][bj][m][0] * g, v1 = acc[ai][bj][m][1] * g;
                u32x4 w; w.x = cvt_pk_bf16(v0[0], v0[1]); w.y = cvt_pk_bf16(v0[2], v0[3]); w.z = cvt_pk_bf16(v1[0], v1[1]); w.w = cvt_pk_bf16(v1[2], v1[3]);
                *(u32x4*)(rowp + bj * HALF) = w; }
            asm volatile("" ::: "memory");
        }
    }
};
struct EpiPle {
    static constexpr bool PERM = false;
    float* out; const u16* x2; const u16* p2; int ld;
    __device__ __forceinline__ void operator()(const f32x4 (&acc)[2][2][4][2], const GUnit& u, int wr, int wc, int fr, int fq) const {
        const int row0 = u.pm * BM + wr * 64 + fr, col0 = u.pn * BM + wc * 32 + 4 * fq;
#pragma unroll
        EPI_LOOP_ROWS {
            const size_t off = (size_t)(row0 + ai * HALF + m * 16) * ld + col0;
#pragma unroll
            for (int bj = 0; bj < 2; ++bj)
#pragma unroll
                for (int n = 0; n < 2; ++n) { const size_t o = off + bj * HALF + n * 16; const u32x2 xv = *(const u32x2*)(x2 + o), pv = *(const u32x2*)(p2 + o); const f32x4 a = acc[ai][bj][m][n];
                    f32x4 r; r[0] = ALPHA * bf_lo(xv.x) + sigmoidf_(a[0]) * bf_lo(pv.x); r[1] = ALPHA * bf_hi(xv.x) + sigmoidf_(a[1]) * bf_hi(pv.x);
                    r[2] = ALPHA * bf_lo(xv.y) + sigmoidf_(a[2]) * bf_lo(pv.y); r[3] = ALPHA * bf_hi(xv.y) + sigmoidf_(a[3]) * bf_hi(pv.y);
                    *(f32x4*)(out + o) = r; }
        }
    }
};
}

struct Args { const float* in[25]; float* out; unsigned char* ws; int lo, hi; };
struct Frame {
    LAS unsigned char* lds; int tid, lane, wave, vcu, G; unsigned char* ws; unsigned char* dout;
};

__device__ __forceinline__ void transpose_item(const float* __restrict__ W, int ldw, int k0, int n0, u16* __restrict__ WT, size_t dst_row0, int Kd, LAS float* scr, int lane) {
#pragma unroll 8
    for (int i = 0; i < 32; ++i) { const int kk = 2 * i + (lane >> 5); scr[kk * 33 + (lane & 31)] = W[(size_t)(k0 + kk) * ldw + n0 + (lane & 31)]; }
    LDS_WAIT(); asm volatile("" ::: "memory");
    const int c = lane & 7;
#pragma unroll
    for (int j = 0; j < 4; ++j) { const int n = (lane >> 3) + 8 * j; const LAS float* s = scr + (8 * c) * 33 + n;
        u32x4 o; o.x = cvt_pk_bf16(s[0 * 33], s[1 * 33]); o.y = cvt_pk_bf16(s[2 * 33], s[3 * 33]); o.z = cvt_pk_bf16(s[4 * 33], s[5 * 33]); o.w = cvt_pk_bf16(s[6 * 33], s[7 * 33]);
        *(u32x4*)(WT + (dst_row0 + n) * (size_t)Kd + k0 + 8 * c) = o; }
    LDS_WAIT(); asm volatile("" ::: "memory");
}
__device__ __forceinline__ bool transpose_matrix_item(int& r, const float* W, int K, int N, u16* WT, LAS float* scr, int lane) {
    const int nitems = (K / 64) * (N / 32);
    if (r < nitems) { const int nblk = N / 32, kb = r / nblk, nb = r % nblk; transpose_item(W, N, 64 * kb, 32 * nb, WT, (size_t)32 * nb, K, scr, lane); return true; }
    r -= nitems; return false;
}

template <bool OUT_BF16> __device__ __forceinline__ void ln_row(const float* xrow, const float* g, const float* b, void* orow, int lane) {
    const f32x4* xr = (const f32x4*)xrow + lane;
    f32x4 v[4]; float s = 0.f;
#pragma unroll
    for (int j = 0; j < 4; ++j) { v[j] = xr[64 * j]; s += (v[j].x + v[j].y) + (v[j].z + v[j].w); }
    const float mean = wave_sum(s) * (1.f / D); float s2 = 0.f;
#pragma unroll
    for (int j = 0; j < 4; ++j) { v[j] = v[j] - mean; s2 += (v[j].x * v[j].x + v[j].y * v[j].y) + (v[j].z * v[j].z + v[j].w * v[j].w); }
    const float rstd = 1.f / sqrtf(wave_sum(s2) * (1.f / D) + LN_EPS);
#pragma unroll
    for (int j = 0; j < 4; ++j) { const f32x4 gg = *((const f32x4*)g + lane + 64 * j), bb = *((const f32x4*)b + lane + 64 * j); const f32x4 y = v[j] * rstd * gg + bb;
        if (OUT_BF16) { u32x2 w; w.x = cvt_pk_bf16(y[0], y[1]); w.y = cvt_pk_bf16(y[2], y[3]); *((u32x2*)orow + lane + 64 * j) = w; }
        else *((f32x4*)orow + lane + 64 * j) = y; }
}

__device__ __forceinline__ void phase_prologue(const Frame& F, const Args& a) {
    LAS float* scr = (LAS float*)(F.lds + F.wave * 16384);
    const int gw = F.vcu * NWAVES + F.wave, NGW = F.G * NWAVES;
    constexpr int NITEMS = 16 * 216 + 8 * 32 + 4 * 32 + 16 * 32 + 16 * 8 + 16 * 32 + 4 * 32;
    for (int it = gw; it < NITEMS; it += NGW) {
        int r = it;
        if (transpose_matrix_item(r, a.in[2], 1024, NCOL, (u16*)(F.ws + WS_WIN), scr, F.lane)) continue;
        if (transpose_matrix_item(r, a.in[6], 512, 1024, (u16*)(F.ws + WS_WBH), scr, F.lane)) continue;
        if (transpose_matrix_item(r, a.in[7], 256, 1024, (u16*)(F.ws + WS_WBA), scr, F.lane)) continue;
        if (transpose_matrix_item(r, a.in[8], 1024, 1024, (u16*)(F.ws + WS_WO), scr, F.lane)) continue;
        if (transpose_matrix_item(r, a.in[11], 1024, 256, (u16*)(F.ws + WS_WR), scr, F.lane)) continue;
        if (transpose_matrix_item(r, a.in[21], 1024, 1024, (u16*)(F.ws + WS_WPG), scr, F.lane)) continue;
        transpose_matrix_item(r, a.in[22], 256, 1024, (u16*)(F.ws + WS_WPP), scr, F.lane);
    }
    const size_t gt = (size_t)F.vcu * NTHR + F.tid, NGT = (size_t)F.G * NTHR;
    { const f32x4* x4 = (const f32x4*)a.in[0]; u32x4* o4 = (u32x4*)(F.ws + WS_XB);
      for (size_t i = gt; i < (size_t)T * D / 8; i += NGT) { const f32x4 p = x4[2 * i], q = x4[2 * i + 1]; u32x4 w; w.x = cvt_pk_bf16(p[0], p[1]); w.y = cvt_pk_bf16(p[2], p[3]); w.z = cvt_pk_bf16(q[0], q[1]); w.w = cvt_pk_bf16(q[2], q[3]); o4[i] = w; } }
    { float* rot = (float*)(F.ws + WS_ROT);
      for (size_t i = gt; i < (size_t)SEQ * 8; i += NGT) {
          const int pos = (int)(i >> 3), fi = (int)(i & 7);
          const double invf = fi == 0 ? 1.0 : fi == 1 ? 0.19392274474868576 : fi == 2 ? 0.03760603093086393 : fi == 3 ? 0.007292664737217109 : fi == 4 ? 0.001414213562373095 : fi == 5 ? 0.0002742481756762073 : fi == 6 ? 5.318295896944988e-05 : 1.031338537721246e-05;
          const double ang = (double)pos * invf; const double kq = __builtin_rint(ang * 0.6366197723675814); const double r = ang - kq * 1.5707963267948966; const double r2 = r * r;
          const double sn = r * (1.0 + r2 * (-1.0 / 6 + r2 * (1.0 / 120 + r2 * (-1.0 / 5040 + r2 * (1.0 / 362880 + r2 * (-1.0 / 39916800 + r2 * (1.0 / 6227020800.0)))))));
          const double cs = 1.0 + r2 * (-0.5 + r2 * (1.0 / 24 + r2 * (-1.0 / 720 + r2 * (1.0 / 40320 + r2 * (-1.0 / 3628800 + r2 * (1.0 / 479001600.0))))));
          const int qd = ((int)kq) & 3; const double s_ = qd == 0 ? sn : qd == 1 ? cs : qd == 2 ? -sn : -cs; const double c_ = qd == 0 ? cs : qd == 1 ? -sn : qd == 2 ? -cs : sn;
          rot[pos * 16 + fi] = (float)c_; rot[pos * 16 + 8 + fi] = (float)s_; } }
    { float* lb = (float*)(F.ws + WS_LB);
      for (size_t i = gt; i < 1024; i += NGT) { const int c = (int)(i & 511); const float* src = (i < 512) ? a.in[3] : a.in[4]; lb[i] = 1.0f / (1.0f + expf(src[512 + c] - src[c])); } }
}

__device__ __forceinline__ void hgrn_item(const Frame& F, int item) {
    const int b = item >> 3, h = (item >> 1) & 3, dir = item & 1;
    LAS float* fb = (LAS float*)F.lds; LAS float* kb = fb + 2048; LAS float* qb = kb + 2048; LAS float* vb = qb + 2048; LAS float* op = vb + 2048;
    const int tid = F.tid, v = tid & 127, eg = tid >> 7, ls = tid >> 5, lc = (tid & 31) * 4;
    const u16* QH = (const u16*)(F.ws + Z_QH); const u16* VH = (const u16*)(F.ws + Z_VH); const u16* LF = (const u16*)(F.ws + (dir ? Z_LFB : Z_LFF));
    u16* O = (u16*)(F.dout + (dir ? DO_OB : DO_OF));
    float S[32];
#pragma unroll
    for (int j = 0; j < 32; ++j) S[j] = 0.f;
    const size_t rowbase = (size_t)b * SEQ, colbase = (size_t)h * 128;
    u32x2 rq, rv, rl;
    { const int pos = dir ? (SEQ - 1 - ls) : ls; const size_t o = (rowbase + pos) * 512 + colbase + lc; rq = *(const u32x2*)(QH + o); rv = *(const u32x2*)(VH + o); rl = *(const u32x2*)(LF + o); }
    for (int blk = 0; blk < SEQ / 16; ++blk) {
        { const float l0 = f16_lo(rl.x), l1 = f16_hi(rl.x), l2 = f16_lo(rl.y), l3 = f16_hi(rl.y);
          const f32x4 f = {__expf(l0), __expf(l1), __expf(l2), __expf(l3)}; const f32x4 k = {1.f - f[0], 1.f - f[1], 1.f - f[2], 1.f - f[3]};
          *(LAS f32x4*)(fb + ls * 128 + lc) = f; *(LAS f32x4*)(kb + ls * 128 + lc) = k;
          *(LAS f32x4*)(qb + ls * 128 + lc) = (f32x4){bf_lo(rq.x), bf_hi(rq.x), bf_lo(rq.y), bf_hi(rq.y)};
          *(LAS f32x4*)(vb + ls * 128 + lc) = (f32x4){bf_lo(rv.x), bf_hi(rv.x), bf_lo(rv.y), bf_hi(rv.y)}; }
        __syncthreads();
        if (blk + 1 < SEQ / 16) { const int t = (blk + 1) * 16 + ls; const int pos = dir ? (SEQ - 1 - t) : t; const size_t o = (rowbase + pos) * 512 + colbase + lc; rq = *(const u32x2*)(QH + o); rv = *(const u32x2*)(VH + o); rl = *(const u32x2*)(LF + o); }
#pragma unroll 2
        for (int s = 0; s < 16; ++s) {
            const float vm = vb[s * 128 + v]; float ac = 0.f;
#pragma unroll
            for (int jj = 0; jj < 8; ++jj) {
                const f32x4 f4 = *(const LAS f32x4*)(fb + s * 128 + eg * 32 + 4 * jj), k4 = *(const LAS f32x4*)(kb + s * 128 + eg * 32 + 4 * jj), q4 = *(const LAS f32x4*)(qb + s * 128 + eg * 32 + 4 * jj);
#pragma unroll
                for (int j = 0; j < 4; ++j) { S[4 * jj + j] = f4[j] * S[4 * jj + j] + k4[j] * vm; ac += S[4 * jj + j] * q4[j]; }
            }
            op[(s * 4 + eg) * 128 + v] = ac;
        }
        __syncthreads();
        { const f32x4 o = *(const LAS f32x4*)(op + (ls * 4 + 0) * 128 + lc) + *(const LAS f32x4*)(op + (ls * 4 + 1) * 128 + lc) + *(const LAS f32x4*)(op + (ls * 4 + 2) * 128 + lc) + *(const LAS f32x4*)(op + (ls * 4 + 3) * 128 + lc);
          const int t = blk * 16 + ls; const int pos = dir ? (SEQ - 1 - t) : t; u32x2 w; w.x = cvt_pk_bf16(o[0], o[1]); w.y = cvt_pk_bf16(o[2], o[3]);
          *(u32x2*)(O + (rowbase + pos) * 512 + colbase + lc) = w; }
    }
    __syncthreads();
}

__device__ __forceinline__ void attn_naive(const Frame& F) {
    const int gw = F.vcu * NWAVES + F.wave, NGW = F.G * NWAVES, lane = F.lane;
    const u16* AQ = (const u16*)(F.ws + Z_AQ); const u16* AK = (const u16*)(F.ws + Z_AK); const u16* AV = (const u16*)(F.ws + Z_AV); u16* YA = (u16*)(F.ws + WS_YA);
    for (int wi = gw; wi < T * 4; wi += NGW) {
        const int row = wi >> 2, s = wi & 3, b = row >> 11, p = row & (SEQ - 1);
        float sc[3][3]; int lo_[3], hi_[3];
#pragma unroll
        for (int g = 0; g < 3; ++g) {
            const int sh = 2 * g, mlen = SEQ >> sh, r = p & ((1 << sh) - 1), m = p >> sh; const int lo = m - 64 < 0 ? 0 : m - 64, hi = m + 64 > mlen - 1 ? mlen - 1 : m + 64; lo_[g] = lo; hi_[g] = hi;
            const int hd = g * 4 + s;
            u32x4 qw[8];
            { const u32x4* qp = (const u32x4*)(AQ + (size_t)row * 768 + hd * 64);
#pragma unroll
              for (int c = 0; c < 8; ++c) qw[c] = qp[c]; }
#pragma unroll
            for (int rr = 0; rr < 3; ++rr) {
                const int j = lo + rr * 64 + lane; const bool valid = j <= hi; const int jc = valid ? j : hi;
                const u32x4* kp = (const u32x4*)(AK + ((size_t)b * SEQ + r + ((size_t)jc << sh)) * 768 + hd * 64);
                float d = 0.f;
#pragma unroll
                for (int c = 0; c < 8; ++c) { const u32x4 w = kp[c]; const u32x4 q = qw[c]; d += bf_lo(q.x) * bf_lo(w.x) + bf_hi(q.x) * bf_hi(w.x) + bf_lo(q.y) * bf_lo(w.y) + bf_hi(q.y) * bf_hi(w.y) + bf_lo(q.z) * bf_lo(w.z) + bf_hi(q.z) * bf_hi(w.z) + bf_lo(q.w) * bf_lo(w.w) + bf_hi(q.w) * bf_hi(w.w); }
                sc[g][rr] = valid ? d : -1e30f;
                asm volatile("" : "+v"(sc[g][rr]) :: "memory");
            }
        }
        float mx = -1e30f;
#pragma unroll
        for (int g = 0; g < 3; ++g)
#pragma unroll
            for (int rr = 0; rr < 3; ++rr) mx = fmaxf(mx, sc[g][rr]);
        mx = wave_max(mx);
        float den = 0.f;
#pragma unroll
        for (int g = 0; g < 3; ++g)
#pragma unroll
            for (int rr = 0; rr < 3; ++rr) { sc[g][rr] = sc[g][rr] > -1e29f ? __expf(sc[g][rr] - mx) : 0.f; den += sc[g][rr]; }
        den = wave_sum(den);
        float o = 0.f;
#pragma unroll
        for (int g = 0; g < 3; ++g) {
            const int sh = 2 * g, r = p & ((1 << sh) - 1), hd = g * 4 + s; const u16* vp = AV + ((size_t)b * SEQ + r) * 768 + hd * 64 + lane;
#pragma unroll
            for (int rr = 0; rr < 3; ++rr) {
                const int j0 = lo_[g] + rr * 64; int cnt = hi_[g] - j0 + 1; cnt = cnt > 64 ? 64 : cnt;
                const float e = sc[g][rr];
#pragma unroll 4
                for (int jj = 0; jj < cnt; ++jj) { const float pj = __uint_as_float(__builtin_amdgcn_readlane(__float_as_uint(e), jj)); o += pj * bf1(vp[((size_t)(j0 + jj) << sh) * 768]); }
            }
        }
        o = o / den;
        const float on = __shfl_down(o, 1);
        if ((lane & 1) == 0) *(unsigned*)(YA + (size_t)row * 256 + s * 64 + lane) = cvt_pk_bf16(o, on);
    }
}

__device__ __forceinline__ void phase_hg_combine(const Frame& F, const Args& a) {
    const int gw = F.vcu * NWAVES + F.wave, NGW = F.G * NWAVES, lane = F.lane;
    const u16* OF = (const u16*)(F.dout + DO_OF); const u16* OB = (const u16*)(F.dout + DO_OB); const u16* GS = (const u16*)(F.ws + Z_GS); u16* YH = (u16*)(F.ws + WS_YH);
    const f32x4 ng0 = *(const f32x4*)(a.in[5] + 8 * lane), ng1 = *(const f32x4*)(a.in[5] + 8 * lane + 4);
    for (int row = gw; row < T; row += NGW) {
        const size_t o = (size_t)row * 512 + 8 * lane;
        const u32x4 f = *(const u32x4*)(OF + o), bq = *(const u32x4*)(OB + o), g = *(const u32x4*)(GS + o);
        float v[8] = {bf_lo(f.x) + bf_lo(bq.x), bf_hi(f.x) + bf_hi(bq.x), bf_lo(f.y) + bf_lo(bq.y), bf_hi(f.y) + bf_hi(bq.y), bf_lo(f.z) + bf_lo(bq.z), bf_hi(f.z) + bf_hi(bq.z), bf_lo(f.w) + bf_lo(bq.w), bf_hi(f.w) + bf_hi(bq.w)};
        float ss = 0.f;
#pragma unroll
        for (int j = 0; j < 8; ++j) ss += v[j] * v[j];
        ss += __shfl_xor(ss, 1); ss += __shfl_xor(ss, 2); ss += __shfl_xor(ss, 4); ss += __shfl_xor(ss, 8);
        const float rs = 1.0f / sqrtf(ss * (1.f / 128.f) + LN_EPS);
        const float gg[8] = {bf_lo(g.x), bf_hi(g.x), bf_lo(g.y), bf_hi(g.y), bf_lo(g.z), bf_hi(g.z), bf_lo(g.w), bf_hi(g.w)};
        u32x4 w; w.x = cvt_pk_bf16(v[0] * rs * ng0[0] * gg[0], v[1] * rs * ng0[1] * gg[1]); w.y = cvt_pk_bf16(v[2] * rs * ng0[2] * gg[2], v[3] * rs * ng0[3] * gg[3]);
        w.z = cvt_pk_bf16(v[4] * rs * ng1[0] * gg[4], v[5] * rs * ng1[1] * gg[5]); w.w = cvt_pk_bf16(v[6] * rs * ng1[2] * gg[6], v[7] * rs * ng1[3] * gg[7]);
        *(u32x4*)(YH + o) = w;
    }
}

__device__ __forceinline__ void phase_ln1_convert(const Frame& F, const Args& a) {
    const int gw = F.vcu * NWAVES + F.wave, NGW = F.G * NWAVES;
    const float* X1 = (const float*)(F.ws + WS_X1PRE); u16* X1B = (u16*)(F.ws + WS_XB);
    for (int row = gw; row < T; row += NGW) ln_row<true>(X1 + (size_t)row * D, a.in[9], a.in[10], X1B + (size_t)row * D, F.lane);
    LAS float* scr = (LAS float*)(F.lds + F.wave * 16384);
    u16* WGU = (u16*)(F.ws + WS_WGU); u16* WD = (u16*)(F.ws + WS_WD);
    constexpr int PER_E = 384, NIT = 257 * PER_E;
    for (int it = gw; it < NIT; it += NGW) {
        const int e = it / PER_E, r = it % PER_E; const int which = r >> 7, q = r & 127;
        if (which < 2) { const float* src = (e < 256) ? a.in[13 + which] + (size_t)e * 1024 * 256 : a.in[16 + which]; const int kb = q >> 3, nb = q & 7;
            transpose_item(src, 256, 64 * kb, 32 * nb, WGU, (size_t)e * 512 + (nb >> 2) * 256 + which * 128 + (nb & 3) * 32, 1024, scr, F.lane); }
        else { const float* src = (e < 256) ? a.in[15] + (size_t)e * 256 * 1024 : a.in[18]; const int kb = q >> 5, nb = q & 31;
            transpose_item(src, 1024, 64 * kb, 32 * nb, WD, (size_t)e * 1024 + 32 * nb, 256, scr, F.lane); }
    }
}

__device__ __forceinline__ void phase_topk(const Frame& F, const Args& a) {
    LAS int* hist = (LAS int*)F.lds;
    for (int i = F.tid; i < 8 * 256; i += NTHR) hist[i] = 0;
    __syncthreads();
    const int w = F.vcu, lane = F.lane;
    const float* logits = (const float*)(F.ws + WS_LOGITS); u16* tok_e = (u16*)(F.ws + WS_TOKE); u16* tok_r = (u16*)(F.ws + WS_TOKR); float* tok_g = (float*)(F.ws + WS_TOKG);
    const f32x4 bs = *(const f32x4*)(a.in[12] + 4 * lane);
    for (int i = 0; i < 32; ++i) {
        const int t = w * 256 + F.wave * 32 + i;
        const f32x4 lg = *(const f32x4*)(logits + (size_t)t * 256 + 4 * lane);
        const float s0 = sigmoidf_(lg[0]), s1 = sigmoidf_(lg[1]), s2 = sigmoidf_(lg[2]), s3 = sigmoidf_(lg[3]);
        const float b0 = s0 + bs[0], b1 = s1 + bs[1], b2 = s2 + bs[2], b3 = s3 + bs[3];
        const float h01 = fmaxf(b0, b1), l01 = fminf(b0, b1), h23 = fmaxf(b2, b3), l23 = fminf(b2, b3);
        float m1 = fmaxf(h01, h23), m2 = fmaxf(fminf(h01, h23), fmaxf(l01, l23));
#pragma unroll
        for (int off = 1; off < 8; off <<= 1) { const float p1 = __shfl_xor(m1, off), p2 = __shfl_xor(m2, off); const float n1 = fmaxf(m1, p1), n2 = fmaxf(fminf(m1, p1), fmaxf(m2, p2)); m1 = n1; m2 = n2; }
        const float gs = m1 + m2; const int mygroup = lane >> 3; int rank = 0;
#pragma unroll
        for (int j = 0; j < 8; ++j) { const float gj = __shfl(gs, 8 * j); rank += (gj > gs || (gj == gs && j < mygroup)) ? 1 : 0; }
        const bool sel = rank < 4; const float NINF = -__builtin_inff();
        float v0 = sel ? b0 : NINF, v1 = sel ? b1 : NINF, v2 = sel ? b2 : NINF, v3 = sel ? b3 : NINF;
        int my_e = 0; float my_s = 0.f;
#pragma unroll
        for (int k = 0; k < 8; ++k) {
            float bv = v0; int bi = 4 * lane;
            if (v1 > bv) { bv = v1; bi = 4 * lane + 1; }
            if (v2 > bv) { bv = v2; bi = 4 * lane + 2; }
            if (v3 > bv) { bv = v3; bi = 4 * lane + 3; }
#pragma unroll
            for (int off = 1; off < 64; off <<= 1) { const float ov = __shfl_xor(bv, off); const int oi = __shfl_xor(bi, off); if (ov > bv || (ov == bv && oi < bi)) { bv = ov; bi = oi; } }
            const int owner = bi >> 2, wi = bi & 3;
            const float cand = wi == 0 ? s0 : wi == 1 ? s1 : wi == 2 ? s2 : s3;
            const float sk = __shfl(cand, owner);
            if (lane == owner) { if (wi == 0) v0 = NINF; else if (wi == 1) v1 = NINF; else if (wi == 2) v2 = NINF; else v3 = NINF; }
            if (lane == k) { my_e = bi; my_s = sk; }
        }
        float sum = (lane < 8) ? my_s : 0.f; sum += __shfl_xor(sum, 1); sum += __shfl_xor(sum, 2); sum += __shfl_xor(sum, 4);
        if (lane < 8) { const int rk = hist[F.wave * 256 + my_e]; hist[F.wave * 256 + my_e] = rk + 1;   tok_e[(size_t)t * 8 + lane] = (u16)my_e; tok_r[(size_t)t * 8 + lane] = (u16)rk; tok_g[(size_t)t * 8 + lane] = my_s / sum * 2.5f; }
    }
    __syncthreads();
    if (F.tid < 256) { int run = 0;
#pragma unroll
        for (int wv = 0; wv < 8; ++wv) { const int h = hist[wv * 256 + F.tid]; hist[wv * 256 + F.tid] = run; run += h; }
        ((int*)(F.ws + WS_HIST))[w * 256 + F.tid] = run; }
    __syncthreads();
    for (int i = 0; i < 32; ++i) { const int t = w * 256 + F.wave * 32 + i; if (lane < 8) { const int e = tok_e[(size_t)t * 8 + lane]; tok_r[(size_t)t * 8 + lane] = (u16)(tok_r[(size_t)t * 8 + lane] + hist[F.wave * 256 + e]); } }
    __syncthreads();
}

__device__ __forceinline__ void phase_sort(const Frame& F) {
    LAS int* start = (LAS int*)F.lds; LAS int* base = start + 260; LAS int* tot = base + 260; LAS int* pad = tot + 260;
    const int w = F.vcu, qd = w >> 6, wl = w & 63, tid = F.tid;
    const int* hist = (const int*)(F.ws + WS_HIST);
    int mytot = 0, mypre = 0;
    if (tid < 256) {
        for (int w2 = qd * 64; w2 < qd * 64 + 64; ++w2) { const int h = hist[w2 * 256 + tid]; mytot += h; mypre += (w2 < w) ? h : 0; }
        tot[tid] = mytot; pad[tid] = (mytot + 255) & ~255;
    }
    __syncthreads();
    if (tid == 0) { int s = 0; for (int e = 0; e < 256; ++e) { start[e] = s; s += pad[e]; } start[256] = s; }
    __syncthreads();
    if (tid < 256) base[tid] = start[tid] + mypre;
    __syncthreads();
    int* stok = (int*)(F.ws + WS_STOK) + (size_t)qd * QTILES * 256; float* sgate = (float*)(F.ws + WS_SGATE) + (size_t)qd * QTILES * 256; int* sdst = (int*)(F.ws + WS_SDST) + (size_t)qd * QTILES * 256;
    int* tile_e = (int*)(F.ws + WS_TILEE) + qd * QTILES;
    const u16* tok_e = (const u16*)(F.ws + WS_TOKE); const u16* tok_r = (const u16*)(F.ws + WS_TOKR); const float* tok_g = (const float*)(F.ws + WS_TOKG);
    for (int aidx = tid; aidx < 2048; aidx += NTHR) {
        const int t = w * 256 + (aidx >> 3), k = aidx & 7; const int e = tok_e[(size_t)t * 8 + k], rk = tok_r[(size_t)t * 8 + k];
        const int slot = base[e] + rk; stok[slot] = t; sgate[slot] = tok_g[(size_t)t * 8 + k]; sdst[slot] = (t - qd * TQ) * NSLOT + k;
    }
    const int ssh = start[256];
    if (tid < 256) { const int t = w * 256 + tid; const int slot = ssh + (t - qd * TQ); stok[slot] = t; sgate[slot] = 1.0f; sdst[slot] = (t - qd * TQ) * NSLOT + 8; }
    if (tid < 256 && (tid & 63) == wl) {
        const int e = tid; const int s0 = start[e], n = tot[e], np = pad[e];
        for (int j = n; j < np; ++j) { stok[s0 + j] = qd * TQ; sgate[s0 + j] = 0.f; sdst[s0 + j] = TQ * NSLOT; }
        for (int tl = s0 >> 8; tl < (s0 + np) >> 8; ++tl) tile_e[tl] = e;
    }
    if (wl == 0 && tid < 64) tile_e[(ssh >> 8) + tid] = 256;
    if (wl == 0 && tid == 0) ((int*)(F.ws + WS_NTILES))[qd] = (ssh >> 8) + 64;
    __syncthreads();
}

__device__ __forceinline__ void phase_moe_combine(const Frame& F, const Args& a, int qd) {
    const int gw = F.vcu * NWAVES + F.wave, NGW = F.G * NWAVES, lane = F.lane;
    const u16* X1B = (const u16*)(F.ws + WS_XB) + (size_t)qd * TQ * D; const u16* YS = (const u16*)(F.ws + WS_YS); u16* X2B = (u16*)(F.ws + WS_X2B);
    const float* g = a.in[19]; const float* bta = a.in[20];
    for (int tl = gw; tl < TQ; tl += NGW) {
        float v[16];
#pragma unroll
        for (int c = 0; c < 2; ++c) { const u32x4 x = *(const u32x4*)(X1B + (size_t)tl * D + c * 512 + 8 * lane);
            v[8 * c + 0] = ALPHA * bf_lo(x.x); v[8 * c + 1] = ALPHA * bf_hi(x.x); v[8 * c + 2] = ALPHA * bf_lo(x.y); v[8 * c + 3] = ALPHA * bf_hi(x.y); v[8 * c + 4] = ALPHA * bf_lo(x.z); v[8 * c + 5] = ALPHA * bf_hi(x.z); v[8 * c + 6] = ALPHA * bf_lo(x.w); v[8 * c + 7] = ALPHA * bf_hi(x.w); }
#pragma unroll
        for (int k = DBG_SLOT_LO; k < DBG_SLOT_HI; ++k)
#pragma unroll
            for (int c = 0; c < 2; ++c) { const u32x4 y = *(const u32x4*)(YS + ((size_t)tl * NSLOT + k) * D + c * 512 + 8 * lane);
                v[8 * c + 0] += bf_lo(y.x); v[8 * c + 1] += bf_hi(y.x); v[8 * c + 2] += bf_lo(y.y); v[8 * c + 3] += bf_hi(y.y); v[8 * c + 4] += bf_lo(y.z); v[8 * c + 5] += bf_hi(y.z); v[8 * c + 6] += bf_lo(y.w); v[8 * c + 7] += bf_hi(y.w); }
        float s = 0.f;
#pragma unroll
        for (int j = 0; j < 16; ++j) s += v[j];
        const float mean = wave_sum(s) * (1.f / D); float s2 = 0.f;
#pragma unroll
        for (int j = 0; j < 16; ++j) { v[j] -= mean; s2 += v[j] * v[j]; }
        const float rstd = 1.f / sqrtf(wave_sum(s2) * (1.f / D) + LN_EPS);
#pragma unroll
        for (int c = 0; c < 2; ++c) { const int col = c * 512 + 8 * lane; const f32x4 g0 = *(const f32x4*)(g + col), g1 = *(const f32x4*)(g + col + 4), b0 = *(const f32x4*)(bta + col), b1 = *(const f32x4*)(bta + col + 4);
            u32x4 w; w.x = cvt_pk_bf16(v[8 * c + 0] * rstd * g0[0] + b0[0], v[8 * c + 1] * rstd * g0[1] + b0[1]); w.y = cvt_pk_bf16(v[8 * c + 2] * rstd * g0[2] + b0[2], v[8 * c + 3] * rstd * g0[3] + b0[3]);
            w.z = cvt_pk_bf16(v[8 * c + 4] * rstd * g1[0] + b1[0], v[8 * c + 5] * rstd * g1[1] + b1[1]); w.w = cvt_pk_bf16(v[8 * c + 6] * rstd * g1[2] + b1[2], v[8 * c + 7] * rstd * g1[3] + b1[3]);
            *(u32x4*)(X2B + (size_t)tl * D + col) = w; }
    }
}

constexpr int LDS_BYTES = 147456;
constexpr int MISC_OFF = 131072 + 4096;
constexpr int PH_FIXED = 11, PH_PER_Q = 5, NPHASE = PH_FIXED + NQ * PH_PER_Q;

__global__ void __launch_bounds__(NTHR, 2) fwd_kernel(Args args) {
    extern __shared__ __attribute__((aligned(16))) unsigned char lds_raw[];
#define MKFRAME() Frame F; { int t_ = threadIdx.x; asm volatile("" : "+v"(t_)); F.lds = (LAS unsigned char*)lds_raw; F.tid = t_; F.lane = t_ & 63; F.wave = __builtin_amdgcn_readfirstlane(t_ >> 6); \
        F.G = gridDim.x; const int bx_ = blockIdx.x; F.vcu = (F.G % 8 == 0) ? (bx_ % 8) * (F.G / 8) + bx_ / 8 : bx_; unsigned char* w_ = args.ws; asm volatile("" : "+s"(w_)); F.ws = w_; F.dout = (unsigned char*)args.out; }
    LAS unsigned char* const lds0 = (LAS unsigned char*)lds_raw;
    volatile LAS unsigned* MISC = (volatile LAS unsigned*)(lds0 + MISC_OFF);
    if (threadIdx.x < 64) MISC[threadIdx.x] = 0u;
    __syncthreads();
    unsigned* barw = (unsigned*)(args.ws + WS_CTL) + CW_BAR;
    const int lo = args.lo, hi = args.hi;
    XcdBarrier bar; bar.bar = barw; bar.x = 0; bar.st = nullptr;
    if (hi - lo > 1) bar = xcd_barrier_post(barw, MISC + 8);
#ifndef PHASE_MASK
#define PHASE_MASK 0xFFFFFFFFu
#endif
#define IN(k) (((PHASE_MASK >> (k)) & 1u) && lo <= (k) && (k) < hi)
#define INQ(j) (((PHASE_MASK >> (PH_FIXED + (j))) & 1u) && lo <= (pb + (j)) && (pb + (j)) < hi)
#define SEAMQ(j) do { if (lo <= (pb + (j)) && (pb + (j)) + 1 < hi) xcd_barrier(bar); } while (0)
#define SEAM(k) do { if (lo <= (k) && (k) + 1 < hi) xcd_barrier(bar); } while (0)
    const int G = gridDim.x, c = (int)blockIdx.x;

    if (IN(0)) { MKFRAME(); phase_prologue(F, args); }
    SEAM(0);
    if (IN(1)) {
        MKFRAME(); unsigned char* ws = F.ws;
        pg8::DenseOrder S; S.init(ws + WS_XB, ws + WS_WIN, T, NCOL, 1024, G, c); S.rev = 0;
        pg8::EpiZ E{ws, (const float*)(ws + WS_ROT), (const float*)(ws + WS_LB)};
        pg8::gemm_phase(F.lds, 1024, S, E);
    }
    SEAM(1);
    if (IN(2)) {
        MKFRAME();
#ifndef NO_HGRN
        for (int it = F.vcu; it < 256; it += G) hgrn_item(F, it);
#endif
#ifndef NO_ATTN
        attn_naive(F);
#endif
    }
    SEAM(2);
    if (IN(3)) { MKFRAME(); phase_hg_combine(F, args); }
    SEAM(3);
    if (IN(4)) {
        MKFRAME(); unsigned char* ws = F.ws;
        pg8::DenseOrder S; S.init(ws + WS_YH, ws + WS_WBH, T, D, 512, G, c);
        pg8::EpiGated<false> E{(const u16*)(ws + Z_GTH), (u16*)(F.dout + DO_MERGED), D};
        pg8::gemm_phase(F.lds, 512, S, E);
    }
    SEAM(4);
    if (IN(5) && !DBG_SKIP_YA) {
        MKFRAME(); unsigned char* ws = F.ws;
        pg8::DenseOrder S; S.init(ws + WS_YA, ws + WS_WBA, T, D, 256, G, c);
        pg8::EpiGated<true> E{(const u16*)(ws + Z_GTA), (u16*)(F.dout + DO_MERGED), D};
        pg8::gemm_phase<true>(F.lds, 256, S, E);
    }
    SEAM(5);
    if (IN(6)) {
        MKFRAME(); unsigned char* ws = F.ws;
        pg8::DenseOrder S; S.init(F.dout + DO_MERGED, ws + WS_WO, T, D, 1024, G, c);
        pg8::EpiF32Res E{(float*)(ws + WS_X1PRE), args.in[0], D, ALPHA};
        pg8::gemm_phase(F.lds, 1024, S, E);
    }
    SEAM(6);
    if (IN(7)) { MKFRAME(); phase_ln1_convert(F, args); }
    SEAM(7);
    if (IN(8)) {
        MKFRAME(); unsigned char* ws = F.ws;
        pg8::DenseOrder S; S.init(ws + WS_XB, ws + WS_WR, T, 256, 1024, G, c);
        pg8::EpiF32Res E{(float*)(ws + WS_LOGITS), nullptr, 256, 0.f};
        pg8::gemm_phase(F.lds, 1024, S, E);
    }
    SEAM(8);
    if (IN(9)) { MKFRAME(); phase_topk(F, args); }
    SEAM(9);
    if (IN(10)) { MKFRAME(); phase_sort(F); }
    SEAM(10);
    for (int qd = 0; qd < NQ; ++qd) {
        const int pb = PH_FIXED + qd * PH_PER_Q;
        const size_t lo_off = (size_t)qd * QTILES * 256;
        if (INQ(0)) {
            MKFRAME(); unsigned char* ws = F.ws;
            const int ntiles = __builtin_amdgcn_readfirstlane(((const int*)(ws + WS_NTILES))[qd]);
            pg8::MoeOrder<2, true> S; S.A = (const char*)(ws + WS_XB); S.W = (const char*)(ws + WS_WGU); S.tile_e = (const int*)(ws + WS_TILEE) + qd * QTILES; S.slot_tok = (const int*)(ws + WS_STOK) + lo_off;
            S.ntiles = ntiles; S.G = G; S.vc = F.vcu; S.K = 1024; S.wstride_e = (size_t)512 * 1024 * 2; S.wstride_pn = (size_t)256 * 1024 * 2;
            pg8::EpiSwiglu E{(u16*)(ws + WS_H)};
            pg8::gemm_phase(F.lds, 1024, S, E);
            const size_t gt = (size_t)F.vcu * NTHR + F.tid, NGT = (size_t)G * NTHR;
            const f32x4* p4 = (const f32x4*)(args.in[1] + (size_t)qd * TQ * 256); u32x4* o4 = (u32x4*)(ws + WS_PB);
            for (size_t i = gt; i < (size_t)TQ * 256 / 8; i += NGT) { const f32x4 p = p4[2 * i], q = p4[2 * i + 1]; u32x4 w; w.x = cvt_pk_bf16(p[0], p[1]); w.y = cvt_pk_bf16(p[2], p[3]); w.z = cvt_pk_bf16(q[0], q[1]); w.w = cvt_pk_bf16(q[2], q[3]); o4[i] = w; }
        }
        SEAMQ(0);
        if (INQ(1)) {
            MKFRAME(); unsigned char* ws = F.ws;
            const int ntiles = __builtin_amdgcn_readfirstlane(((const int*)(ws + WS_NTILES))[qd]);
            pg8::MoeOrder<4, false> S; S.A = (const char*)(ws + WS_H); S.W = (const char*)(ws + WS_WD); S.tile_e = (const int*)(ws + WS_TILEE) + qd * QTILES; S.slot_tok = nullptr;
            S.ntiles = ntiles; S.G = G; S.vc = F.vcu; S.K = 256; S.wstride_e = (size_t)1024 * 256 * 2; S.wstride_pn = (size_t)256 * 256 * 2;
#ifndef NO_DOWN
            pg8::EpiDown E{(u16*)(ws + WS_YS), (const int*)(ws + WS_SDST) + lo_off, (const float*)(ws + WS_SGATE) + lo_off};
            pg8::gemm_phase<true>(F.lds, 256, S, E);
#endif
#ifndef NO_P2
            pg8::DenseOrder S2; S2.init(ws + WS_PB, ws + WS_WPP, TQ, D, 256, G, c);
            pg8::EpiBf16 E2{(u16*)(ws + WS_P2), D};
            pg8::gemm_phase<true>(F.lds, 256, S2, E2);
#endif
        }
        SEAMQ(1);
        if (INQ(2)) { MKFRAME(); phase_moe_combine(F, args, qd); }
        SEAMQ(2);
        if (INQ(3)) {
            MKFRAME(); unsigned char* ws = F.ws;
            pg8::DenseOrder S; S.init(ws + WS_X2B, ws + WS_WPG, TQ, D, 1024, G, c);
            pg8::EpiPle E{args.out + (size_t)qd * TQ * D, (const u16*)(ws + WS_X2B), (const u16*)(ws + WS_P2), D};
            pg8::gemm_phase(F.lds, 1024, S, E);
        }
        SEAMQ(3);
        if (INQ(4)) {
            MKFRAME();
            const int gw = F.vcu * NWAVES + F.wave, NGW = G * NWAVES;
            for (int r = gw; r < TQ; r += NGW) { float* rowp = args.out + ((size_t)qd * TQ + r) * D; ln_row<false>(rowp, args.in[23], args.in[24], rowp, F.lane); }
        }
        SEAMQ(4);
    }
#undef IN
#undef SEAM
#undef INQ
#undef SEAMQ
}


#ifndef DBG_CHECK
#define DBG_CHECK 0
#endif
#if DBG_CHECK
constexpr int CHK_WORD0 = 12288;
struct ChkArgs { const float* in[25]; float* out; unsigned char* ws; int mode, qd; };
__device__ __forceinline__ float dotb(const u16* a, const u16* b, int K) { float s = 0.f; for (int k = 0; k < K; k += 8) { const u32x4 x = *(const u32x4*)(a + k), y = *(const u32x4*)(b + k);
    s += bf_lo(x.x) * bf_lo(y.x) + bf_hi(x.x) * bf_hi(y.x) + bf_lo(x.y) * bf_lo(y.y) + bf_hi(x.y) * bf_hi(y.y) + bf_lo(x.z) * bf_lo(y.z) + bf_hi(x.z) * bf_hi(y.z) + bf_lo(x.w) * bf_lo(y.w) + bf_hi(x.w) * bf_hi(y.w); } return s; }
__device__ __forceinline__ float sigm(float z) { return 1.f / (1.f + expf(-z)); }
__device__ __forceinline__ bool badv(float got, float ref, float rel, float ab) { return !(fabsf(got - ref) <= rel * fabsf(ref) + ab); }
__global__ void chk_kernel(ChkArgs a) {
    unsigned char* ws = a.ws; unsigned* res = (unsigned*)(ws + WS_CTL) + CHK_WORD0; const int mode = a.mode, qd = a.qd;
    const size_t gt = (size_t)blockIdx.x * blockDim.x + threadIdx.x, NGT = (size_t)gridDim.x * blockDim.x;
    const u16* XB = (const u16*)(ws + WS_XB); const u16* WIN = (const u16*)(ws + WS_WIN);
    unsigned bad = 0;
    if (mode == 1) { for (size_t i = gt; i < (size_t)T * D; i += NGT) { if (badv(bf1(XB[i]), a.in[0][i], 0.005f, 1e-6f)) ++bad; } }
    else if (mode >= 2 && mode <= 11) {
        const int ty = mode - 2; const int ncol = ty < 5 ? 512 : ty < 8 ? 768 : 1024; const int cbase = ty < 5 ? 512 * ty : ty < 8 ? 2560 + 768 * (ty - 5) : 4864 + 1024 * (ty - 8);
        const size_t zoff[10] = {Z_QH, Z_VH, Z_LFF, Z_LFB, Z_GS, Z_AQ, Z_AK, Z_AV, Z_GTH, Z_GTA}; const u16* Zt = (const u16*)(ws + zoff[ty]); const float* lb = (const float*)(ws + WS_LB); const float* rot = (const float*)(ws + WS_ROT);
        for (size_t i = gt; i < (size_t)(T / 8) * ncol; i += NGT) { const int row = (int)(i / ncol) * 8 + 3, c = (int)(i % ncol);
            float z = dotb(XB + (size_t)row * D, WIN + (size_t)(cbase + c) * D, D), ref, got = bf1(Zt[(size_t)row * ncol + c]);
            if (ty == 0 || ty == 4) ref = z * sigm(z); else if (ty == 1 || ty == 7 || ty == 8 || ty == 9) ref = z;
            else if (ty == 2 || ty == 3) { const float l = lb[(ty - 2) * 512 + c]; ref = logf(l + (1.f - l) * sigm(z)); const unsigned short hb = Zt[(size_t)row * ncol + c]; got = (float)__builtin_bit_cast(_Float16, hb); }
            else { const int d = c & 63; ref = z; if (d < 16) { const int cp = (d < 8) ? c + 8 : c - 8; const float zp = dotb(XB + (size_t)row * D, WIN + (size_t)(cbase + cp) * D, D); const int fi = d & 7, pos = row & (SEQ - 1); const float cs = rot[pos * 16 + fi], sn = rot[pos * 16 + 8 + fi]; ref = (d < 8) ? z * cs - zp * sn : z * cs + zp * sn; } if (ty == 5) ref *= 0.125f; }
            if (badv(got, ref, 0.02f, 0.02f)) { ++bad; if (mode == 10) { atomicAdd(res + 80 + ((c & 255) >> 2), 1u); atomicAdd(res + 160 + ((row & 255) >> 2), 1u); atomicAdd(res + 240 + ((row >> 8) & 255), 1u); if (got > 1.5f || got < -0.5f) atomicAdd(res + 500, 1u); atomicAdd(res + 600 + ((((row >> 8) & 31) >> 3) * 8 + ((row >> 6) & 1) * 4 + ((c >> 5) & 3)), 1u); } } } }
    else if (mode == 12) { const u16* Zt = (const u16*)(ws + Z_GTH); unsigned nm = 0, no = 0; for (size_t i = gt; i < (size_t)2 * T * D; i += NGT) { const u16 h = Zt[i]; if (h == 0x3C3C) ++nm; else { const float g = bf1(h); if (!(g >= 0.f && g <= 1.f)) ++no; } }
        for (int o = 32; o >= 1; o >>= 1) { nm += __shfl_xor(nm, o); no += __shfl_xor(no, o); } if ((threadIdx.x & 63) == 0) { if (nm) atomicAdd(res + 700, nm); if (no) atomicAdd(res + 701, no); } }
    else if (mode == 13) { const u16* YH = (const u16*)(ws + WS_YH); const u16* YA = (const u16*)(ws + WS_YA); const u16* GH = (const u16*)(ws + Z_GTH); const u16* GA = (const u16*)(ws + Z_GTA); const u16* M = (const u16*)((unsigned char*)a.out + DO_MERGED);
        for (size_t i = gt; i < (size_t)(T / 4) * D; i += NGT) { const int row = (int)(i / D) * 4 + 1, c = (int)(i % D);
            const float ref = sigm(bf1(GH[(size_t)row * D + c])) * dotb(YH + (size_t)row * 512, (const u16*)(ws + WS_WBH) + (size_t)c * 512, 512) + sigm(bf1(GA[(size_t)row * D + c])) * dotb(YA + (size_t)row * 256, (const u16*)(ws + WS_WBA) + (size_t)c * 256, 256);
            if (badv(bf1(M[(size_t)row * D + c]), ref, 0.02f, 0.01f)) ++bad; } }
    else if (mode == 14) { const u16* M = (const u16*)((unsigned char*)a.out + DO_MERGED); const float* X1 = (const float*)(ws + WS_X1PRE);
        for (size_t i = gt; i < (size_t)T * D; i += NGT) { const int row = (int)(i / D), c = (int)(i % D);
            const float ref = ALPHA * a.in[0][i] + dotb(M + (size_t)row * D, (const u16*)(ws + WS_WO) + (size_t)c * D, D); if (badv(X1[i], ref, 0.002f, 0.002f)) ++bad; } }
    else if (mode == 15) { const float* X1 = (const float*)(ws + WS_X1PRE);
        for (size_t row = gt; row < T; row += NGT) { float m = 0.f; for (int c = 0; c < D; ++c) m += X1[row * D + c]; m /= D; float v = 0.f; for (int c = 0; c < D; ++c) { const float d = X1[row * D + c] - m; v += d * d; } const float rs = 1.f / sqrtf(v / D + LN_EPS);
            for (int c = 0; c < D; ++c) { const float ref = (X1[row * D + c] - m) * rs * a.in[9][c] + a.in[10][c]; if (badv(bf1(XB[row * D + c]), ref, 0.01f, 0.01f)) ++bad; } } }
    else if (mode == 16) { const float* LG = (const float*)(ws + WS_LOGITS);
        for (size_t i = gt; i < (size_t)T * 256; i += NGT) { const int row = (int)(i / 256), c = (int)(i % 256); if (badv(LG[i], dotb(XB + (size_t)row * D, (const u16*)(ws + WS_WR) + (size_t)c * D, D), 0.002f, 0.002f)) ++bad; } }
    else if (mode == 17) { const float* LG = (const float*)(ws + WS_LOGITS); const u16* te = (const u16*)(ws + WS_TOKE); const float* tg = (const float*)(ws + WS_TOKG);
        for (size_t t = gt; t < T; t += NGT) { float gsc[8]; for (int g = 0; g < 8; ++g) { float m1 = -1e30f, m2 = -1e30f; for (int j = 0; j < 32; ++j) { const float b = sigm(LG[t * 256 + g * 32 + j]) + a.in[12][g * 32 + j]; if (b > m1) { m2 = m1; m1 = b; } else if (b > m2) m2 = b; } gsc[g] = m1 + m2; }
            unsigned gm = 0; for (int g = 0; g < 8; ++g) { int r = 0; for (int j = 0; j < 8; ++j) r += (gsc[j] > gsc[g] || (gsc[j] == gsc[g] && j < g)); if (r < 4) gm |= 1u << g; }
            unsigned long long taken[4] = {0, 0, 0, 0}; float ssum = 0.f; int ok = 1;
            for (int k = 0; k < 8; ++k) { float bv = -1e30f; int bi = -1; for (int e = 0; e < 256; ++e) { if (!((gm >> (e >> 5)) & 1u) || ((taken[e >> 6] >> (e & 63)) & 1ull)) continue; const float b = sigm(LG[t * 256 + e]) + a.in[12][e]; if (b > bv) { bv = b; bi = e; } }
                taken[bi >> 6] |= 1ull << (bi & 63); ssum += sigm(LG[t * 256 + bi]); if (te[t * 8 + k] != bi) ok = 0; }
            for (int k = 0; k < 8 && ok; ++k) { const float ref = sigm(LG[t * 256 + te[t * 8 + k]]) / ssum * 2.5f; if (badv(tg[t * 8 + k], ref, 0.001f, 1e-5f)) ok = 0; }
            if (!ok) ++bad; } }
    else if (mode == 18) { const int* stok = (const int*)(ws + WS_STOK) + (size_t)qd * QTILES * 256; const float* sg = (const float*)(ws + WS_SGATE) + (size_t)qd * QTILES * 256; const int* sd = (const int*)(ws + WS_SDST) + (size_t)qd * QTILES * 256; const int* tle = (const int*)(ws + WS_TILEE) + qd * QTILES;
        const int nt = ((const int*)(ws + WS_NTILES))[qd]; const u16* te = (const u16*)(ws + WS_TOKE); const float* tg = (const float*)(ws + WS_TOKG); unsigned* cnt = res + 64;
        if (nt < 64 || nt > QTILES) { if (gt == 0) ++bad; } else
        for (size_t sl = gt; sl < (size_t)nt * 256; sl += NGT) { const int d = sd[sl], tk = stok[sl], e = tle[sl >> 8]; if (d == TQ * NSLOT) { if (tk != qd * TQ || sg[sl] != 0.f) ++bad; continue; }
            if (d < 0 || d > TQ * NSLOT || tk < qd * TQ || tk >= (qd + 1) * TQ) { ++bad; continue; } const int k = d % NSLOT; if (d / NSLOT != tk - qd * TQ) { ++bad; continue; }
            if (k == 8) { if (e != 256 || sg[sl] != 1.f) ++bad; } else { if (te[(size_t)tk * 8 + k] != e || tg[(size_t)tk * 8 + k] != sg[sl]) ++bad; }
            atomicAdd(cnt, 1u); } }
    else if (mode == 19) { const int* stok = (const int*)(ws + WS_STOK) + (size_t)qd * QTILES * 256; const int* tle = (const int*)(ws + WS_TILEE) + qd * QTILES; const int nt = ((const int*)(ws + WS_NTILES))[qd]; const u16* H = (const u16*)(ws + WS_H); const u16* WGU = (const u16*)(ws + WS_WGU);
        for (size_t i = gt; i < (size_t)nt * 32 * 256; i += NGT) { const int sl = (int)(i / 256) * 8 + 5, j = (int)(i % 256); const int e = tle[sl >> 8], tk = stok[sl]; const u16* xr = XB + (size_t)tk * D;
            const u16* wg = WGU + ((size_t)e * 512 + (j >> 7) * 256 + (j & 127)) * D; const float g = dotb(xr, wg, D), u = dotb(xr, wg + (size_t)128 * D, D); if (badv(bf1(H[(size_t)sl * 256 + j]), g * sigm(g) * u, 0.03f, 0.003f)) ++bad; } }
    else if (mode == 20) { const int* sd = (const int*)(ws + WS_SDST) + (size_t)qd * QTILES * 256; const float* sg = (const float*)(ws + WS_SGATE) + (size_t)qd * QTILES * 256; const int* tle = (const int*)(ws + WS_TILEE) + qd * QTILES; const int nt = ((const int*)(ws + WS_NTILES))[qd]; const u16* H = (const u16*)(ws + WS_H); const u16* WD = (const u16*)(ws + WS_WD); const u16* YS = (const u16*)(ws + WS_YS);
        for (size_t i = gt; i < (size_t)nt * 32 * D; i += NGT) { const int sl = (int)(i / D) * 8 + 2, c = (int)(i % D); const int e = tle[sl >> 8], d = sd[sl]; if (d == TQ * NSLOT) continue;
            const float ref = sg[sl] * dotb(H + (size_t)sl * 256, WD + ((size_t)e * 1024 + c) * 256, 256); if (badv(bf1(YS[(size_t)d * D + c]), ref, 0.02f, 0.002f)) ++bad; } }
    else if (mode == 21) { const u16* PB = (const u16*)(ws + WS_PB); const u16* P2 = (const u16*)(ws + WS_P2); const float* p = a.in[1] + (size_t)qd * TQ * 256;
        for (size_t i = gt; i < (size_t)TQ * D; i += NGT) { const int row = (int)(i / D), c = (int)(i % D); if (badv(bf1(P2[i]), dotb(PB + (size_t)row * 256, (const u16*)(ws + WS_WPP) + (size_t)c * 256, 256), 0.02f, 0.01f)) ++bad; if (c < 256 && badv(bf1(PB[(size_t)row * 256 + c]), p[(size_t)row * 256 + c], 0.005f, 1e-6f)) ++bad; } }
    else if (mode == 22) { const u16* X1 = XB + (size_t)qd * TQ * D; const u16* YS = (const u16*)(ws + WS_YS); const u16* X2 = (const u16*)(ws + WS_X2B);
        for (size_t row = gt; row < TQ; row += NGT) { float m = 0.f, v = 0.f; for (int pass = 0; pass < 3; ++pass) { for (int c = 0; c < D; ++c) { float x = ALPHA * bf1(X1[row * D + c]); for (int k = 0; k < NSLOT; ++k) x += bf1(YS[(row * NSLOT + k) * D + c]);
                    if (pass == 0) m += x; else if (pass == 1) v += (x - m) * (x - m); else { const float ref = (x - m) * v * a.in[19][c] + a.in[20][c]; if (badv(bf1(X2[row * D + c]), ref, 0.01f, 0.01f)) ++bad; } } if (pass == 0) m /= D; else if (pass == 1) v = 1.f / sqrtf(v / D + LN_EPS); } } }
    else if (mode == 23) { const u16* X2 = (const u16*)(ws + WS_X2B); const u16* P2 = (const u16*)(ws + WS_P2); const float* O = a.out + (size_t)qd * TQ * D;
        for (size_t i = gt; i < (size_t)TQ * D; i += NGT) { const int row = (int)(i / D), c = (int)(i % D); const float ref = ALPHA * bf1(X2[i]) + sigm(dotb(X2 + (size_t)row * D, (const u16*)(ws + WS_WPG) + (size_t)c * D, D)) * bf1(P2[i]); if (badv(O[i], ref, 0.002f, 0.002f)) ++bad; } }
    else if (mode == 24) { const float* O = a.out + (size_t)qd * TQ * D;
        for (size_t row = gt; row < TQ; row += NGT) { float m = 0.f, v = 0.f; int nf = 0; for (int c = 0; c < D; ++c) { const float x = (O[row * D + c] - a.in[24][c]) / a.in[23][c]; m += x; v += x * x; nf += !(x - x == 0.f); } m /= D; v = v / D - m * m; if (nf || fabsf(m) > 1e-3f || fabsf(v - 1.f) > 1e-2f) ++bad; } }
    for (int o = 32; o >= 1; o >>= 1) bad += __shfl_xor(bad, o);
    if ((threadIdx.x & 63) == 0 && bad) atomicAdd(res + mode, bad);
}
__global__ void chk_encode(float* out, size_t n, const unsigned* res, int what) {
    unsigned code = 0;
    if (what == 0) { for (int m = 1; m < 64; ++m) if (res[m]) { code = m; break; } }
    else if (what > 0) { const unsigned b = res[what]; code = b ? 1 + (31 - __clz(b)) : 0; }
    else if (what == -1) { code = (res[64] == (unsigned)(4 * TQ * NSLOT)) ? 0 : 7; }
    else if (what == -4) { const unsigned nm = res[700], no = res[701]; code = (nm ? 1 + (31 - __clz(nm)) : 0) + (no ? 40 : 0); }
    else if (what == -2) { const int ms[6] = {11, 13, 14, 15, 16, 17}; for (int i = 0; i < 6; ++i) if (res[ms[i]]) code |= 1u << i; }
    else { const int ms[6] = {18, 19, 20, 21, 22, 23}; for (int i = 0; i < 6; ++i) if (res[ms[i]]) code |= 1u << i; if (res[24]) code += 64; if (code > 98) code = 98; }
    const float c = sqrtf((float)code);
    for (size_t i = (size_t)blockIdx.x * blockDim.x + threadIdx.x; i < n; i += (size_t)gridDim.x * blockDim.x) out[i] = c;
}
#ifndef DBG_WHAT
#define DBG_WHAT 0
#endif
#endif

extern "C" void kernel_launch(void* const* d_in, const int* in_sizes, int n_in, void* d_out, int out_size, void* d_ws, size_t ws_size, hipStream_t stream) {
    static int grid = 0;
    if (grid == 0) {
        if (n_in != 25 || out_size != T * D || ws_size < WS_END) { fprintf(stderr, "kernel_launch: unexpected problem (n_in %d out %d ws %zu)\n", n_in, out_size, ws_size); grid = -1; return; }
        if (hipFuncSetAttribute((const void*)fwd_kernel, hipFuncAttributeMaxDynamicSharedMemorySize, LDS_BYTES) != hipSuccess) { fprintf(stderr, "kernel_launch: hipFuncSetAttribute failed\n"); grid = -1; return; }
        int per_cu = 0; (void)hipOccupancyMaxActiveBlocksPerMultiprocessor(&per_cu, (const void*)fwd_kernel, NTHR, LDS_BYTES); (void)hipGetLastError();
        if (per_cu < 1) fprintf(stderr, "kernel_launch: occupancy query says %d\n", per_cu);
        grid = 256;
    }
    if (grid < 0) return;
    (void)hipMemsetAsync((char*)d_ws + WS_CTL, 0, CTL_ZERO_BYTES, stream);
    Args a{};
    for (int i = 0; i < 25; ++i) a.in[i] = (const float*)d_in[i];
    a.out = (float*)d_out; a.ws = (unsigned char*)d_ws;
#if DBG_CHECK
    ChkArgs ca{}; for (int i = 0; i < 25; ++i) ca.in[i] = (const float*)d_in[i]; ca.out = (float*)d_out; ca.ws = (unsigned char*)d_ws;
#define CHK(m, q) do { ca.mode = (m); ca.qd = (q); hipLaunchKernelGGL(chk_kernel, dim3(2048), dim3(256), 0, stream, ca); } while (0)
    for (int ph = 0; ph < NPHASE; ++ph) { a.lo = ph; a.hi = ph + 1;
        if (ph == 1) (void)hipMemsetAsync((char*)d_ws + Z_GTH, 0x3C, (size_t)256 * MiB, stream);
        hipLaunchKernelGGL(fwd_kernel, dim3(grid), dim3(NTHR), LDS_BYTES, stream, a);
        if (ph == 0) CHK(1, 0);
        if (ph == 1) for (int m = 2; m <= 12; ++m) CHK(m, 0);
        if (ph == 5) CHK(13, 0);
        if (ph == 6) CHK(14, 0);
        if (ph == 7) CHK(15, 0);
        if (ph == 8) CHK(16, 0);
        if (ph == 9) CHK(17, 0);
        if (ph >= PH_FIXED) { const int q = (ph - PH_FIXED) / PH_PER_Q, j = (ph - PH_FIXED) % PH_PER_Q;
            if (j == 0) { CHK(18, q); CHK(19, q); } if (j == 1) { CHK(20, q); CHK(21, q); } if (j == 2) CHK(22, q); if (j == 3) CHK(23, q); if (j == 4) CHK(24, q); } }
    hipLaunchKernelGGL(chk_encode, dim3(2048), dim3(256), 0, stream, (float*)d_out, (size_t)out_size, (const unsigned*)((unsigned char*)d_ws + WS_CTL) + CHK_WORD0, DBG_WHAT);
#elif MK_PER_PHASE
    for (int ph = 0; ph < NPHASE; ++ph) { a.lo = ph; a.hi = ph + 1; hipLaunchKernelGGL(fwd_kernel, dim3(grid), dim3(NTHR), LDS_BYTES, stream, a); }
#else
    a.lo = 0; a.hi = NPHASE;
    hipLaunchKernelGGL(fwd_kernel, dim3(grid), dim3(NTHR), LDS_BYTES, stream, a);
#endif
}
```

```cpp
#include <hip/hip_runtime.h>
#include <cstdio>
#include <cstdint>

#ifndef DBG_SLOT_LO
#define DBG_SLOT_LO 0
#define DBG_SLOT_HI 9
#endif
#ifndef DBG_SKIP_YA
#define DBG_SKIP_YA 0
#endif
#ifndef DBG_CHECK
#define DBG_CHECK 0
#endif
#ifndef DBG_PN_LO
#define DBG_PN_LO 0
#endif
#ifndef DBG_TIME
#define DBG_TIME 0
#endif
#ifndef USE_NAIVE_ATTN
#define USE_NAIVE_ATTN 0
#endif
#ifndef USE_NAIVE_HGRN
#define USE_NAIVE_HGRN 0
#endif
#ifndef DBG_DUP
#define DBG_DUP 0u
#endif
#define DUPN(bit) (((DBG_DUP) >> (bit)) & 1u ? 2 : 1)
#ifndef F8_SCALED
#define F8_SCALED 1
#endif
#ifndef MK_PER_PHASE
#define MK_PER_PHASE 0
#endif

#define LAS __attribute__((address_space(3)))
typedef unsigned short u16;
typedef short bf16x8 __attribute__((ext_vector_type(8)));
typedef float f32x4 __attribute__((ext_vector_type(4)));
typedef float f32x2 __attribute__((ext_vector_type(2)));
typedef unsigned u32x4 __attribute__((ext_vector_type(4)));
typedef unsigned u32x2 __attribute__((ext_vector_type(2)));
typedef int i32x16 __attribute__((ext_vector_type(16)));

constexpr int T = 65536, D = 1024, SEQ = 2048;
constexpr int NCOL = 6912;
constexpr int NQ = 2, TQ = T / NQ;
constexpr int NEXP = 256, NSLOT = 9;
constexpr int QTILES = (TQ * 8 + 256 * 255) / 256 + 1 + TQ / 256;
constexpr int WPC = 256 / NQ;
constexpr float ALPHA = 1.189207115002721f;
constexpr float LN_EPS = 1e-5f;
constexpr int NWAVES = 8, NTHR = 512;
constexpr float Y8_SCALE = 256.f;
constexpr float M8_SCALE = 16.f;
constexpr float H8_SCALE = 32.f;
constexpr float W8_SCALE = 64.f;

constexpr size_t MiB = (size_t)1 << 20;
constexpr size_t WS_CTL = 0, CTL_ZERO_BYTES = 64 * 1024;
constexpr size_t WS_WIN = 1 * MiB, WS_WBH = 15 * MiB, WS_WBA = 16 * MiB, WS_WO = 17 * MiB, WS_WR = 19 * MiB, WS_WPG = 20 * MiB, WS_WPP = 22 * MiB;
constexpr size_t WS_ROT = 22 * MiB + 512 * 1024, WS_LB = 22 * MiB + 768 * 1024;
constexpr size_t WS_HIST = 24 * MiB, WS_TOKE = 25 * MiB, WS_TOKR = 26 * MiB, WS_TOKG = 27 * MiB;
constexpr size_t WS_TOKD = 42 * MiB;
constexpr size_t WS_STOK = 29 * MiB, WS_SGATE = 33 * MiB, WS_SDST = 37 * MiB, WS_TILEE = 41 * MiB, WS_NTILES = 41 * MiB + 512 * 1024;
constexpr size_t WS_XB = 44 * MiB;
constexpr size_t WS_YH = WS_XB, WS_YA = WS_XB + 64 * MiB;
constexpr size_t WS_Z = 172 * MiB;
constexpr size_t Z_QH = WS_Z, Z_VH = WS_Z + 64 * MiB, Z_LFF = WS_Z + 128 * MiB, Z_LFB = WS_Z + 192 * MiB, Z_GS = WS_Z + 256 * MiB;
constexpr size_t Z_AQ = WS_Z + 320 * MiB, Z_AK = WS_Z + 416 * MiB, Z_AV = WS_Z + 512 * MiB, Z_GTH = WS_Z + 608 * MiB, Z_GTA = WS_Z + 736 * MiB;
constexpr size_t WS_X1PRE = WS_Z;
constexpr size_t WS_LOGITS = WS_Z;
constexpr size_t WS_H = WS_Z;
constexpr size_t WS_P2 = WS_Z + 296 * MiB;
constexpr size_t WS_X2B = WS_Z + 104 * MiB;
constexpr size_t WS_PB = WS_Z + 424 * MiB;
constexpr size_t WS_WGU = WS_Z + 296 * MiB;
constexpr size_t WS_WD = WS_Z + 425 * MiB;
constexpr size_t WS_X1F8 = WS_Z + 490 * MiB;
constexpr size_t WS_X3PRE = WS_Z + 802 * MiB;
constexpr size_t WS_X2F8 = WS_Z + 554 * MiB;
constexpr size_t WS_YS = WS_Z + 642 * MiB;
constexpr size_t WS_END = WS_Z + 931 * MiB;
constexpr size_t DO_OF = 0, DO_OB = 64 * MiB, DO_MERGED = 0, DO_MERGED8 = 128 * MiB;

constexpr int CW_BAR = 4096;

__device__ __forceinline__ unsigned cvt_pk_bf16(float lo, float hi) { unsigned r; asm volatile("v_cvt_pk_bf16_f32 %0, %1, %2" : "=v"(r) : "v"(lo), "v"(hi)); return r; }
typedef int i32x8 __attribute__((ext_vector_type(8)));
typedef int i32x4 __attribute__((ext_vector_type(4)));
__device__ __forceinline__ unsigned pk_fp8x4(float a, float b, float c, float d) { int w = 0; w = __builtin_amdgcn_cvt_pk_fp8_f32(a, b, w, false); w = __builtin_amdgcn_cvt_pk_fp8_f32(c, d, w, true); return (unsigned)w; }
typedef float f32x2_t __attribute__((ext_vector_type(2)));
__device__ __forceinline__ void fp8x4_to_f32(unsigned w, float (&o)[4]) { const f32x2_t lo = __builtin_amdgcn_cvt_pk_f32_fp8((int)w, false), hi = __builtin_amdgcn_cvt_pk_f32_fp8((int)w, true); o[0] = lo.x; o[1] = lo.y; o[2] = hi.x; o[3] = hi.y; }
__device__ __forceinline__ float bf_lo(unsigned w) { return __uint_as_float(w << 16); }
__device__ __forceinline__ float bf_hi(unsigned w) { return __uint_as_float(w & 0xffff0000u); }
__device__ __forceinline__ float bf1(u16 b) { return __uint_as_float(((unsigned)b) << 16); }
__device__ __forceinline__ float sigmoidf_(float z) { return __builtin_amdgcn_rcpf(1.0f + __expf(-z)); }
__device__ __forceinline__ unsigned pk_f16(float lo, float hi) { _Float16 a = (_Float16)lo, b = (_Float16)hi; unsigned short ua = __builtin_bit_cast(unsigned short, a), ub = __builtin_bit_cast(unsigned short, b); return (unsigned)ua | ((unsigned)ub << 16); }
__device__ __forceinline__ float f16_lo(unsigned w) { return (float)__builtin_bit_cast(_Float16, (unsigned short)(w & 0xffffu)); }
__device__ __forceinline__ float f16_hi(unsigned w) { return (float)__builtin_bit_cast(_Float16, (unsigned short)(w >> 16)); }
__device__ __forceinline__ float wave_sum(float v) {
    v += __int_as_float(__builtin_amdgcn_update_dpp(0, __float_as_int(v), 0xB1, 0xF, 0xF, true));
    v += __int_as_float(__builtin_amdgcn_update_dpp(0, __float_as_int(v), 0x4E, 0xF, 0xF, true));
    v += __int_as_float(__builtin_amdgcn_update_dpp(0, __float_as_int(v), 0x141, 0xF, 0xF, true));
    v += __int_as_float(__builtin_amdgcn_update_dpp(0, __float_as_int(v), 0x140, 0xF, 0xF, true));
    const int iv = __float_as_int(v);
    return (__int_as_float(__builtin_amdgcn_readlane(iv, 0)) + __int_as_float(__builtin_amdgcn_readlane(iv, 16))) + (__int_as_float(__builtin_amdgcn_readlane(iv, 32)) + __int_as_float(__builtin_amdgcn_readlane(iv, 48)));
}
__device__ __forceinline__ float wave_max(float v) {
#pragma unroll
    for (int o = 1; o < 64; o <<= 1) v = fmaxf(v, __shfl_xor(v, o));
    return v;
}
template <int CTRL> __device__ __forceinline__ float dpp_f(float x) { return __int_as_float(__builtin_amdgcn_update_dpp(0, __float_as_int(x), CTRL, 0xF, 0xF, true)); }
template <int CTRL> __device__ __forceinline__ int dpp_i(int x) { return __builtin_amdgcn_update_dpp(0, x, CTRL, 0xF, 0xF, true); }
__device__ __forceinline__ float rdlane_f(float x, int l) { return __int_as_float(__builtin_amdgcn_readlane(__float_as_int(x), l)); }
#define LDS_WAIT() asm volatile("s_waitcnt lgkmcnt(0)" ::: "memory")
#define VM_WAIT() asm volatile("s_waitcnt vmcnt(0)" ::: "memory")

#define XB_TMO      128
#define XB_XCNT(j)  (256  + 64 * (j))
#define XB_XSUB(j)  (1280 + 64 * (j))
#define XB_XGEN(j)  (2304 + 64 * (j))
#define XB_TOP      3328
#define XB_TOPGEN   3392
#define XCD_BAR_WORDS 3456
#define XB_SPIN_CAP (1u << 22)

__device__ __forceinline__ unsigned xb_ld(unsigned* p)              { return __hip_atomic_load(p, __ATOMIC_RELAXED, __HIP_MEMORY_SCOPE_AGENT); }
__device__ __forceinline__ unsigned xb_add(unsigned* p, unsigned v) { return __hip_atomic_fetch_add(p, v, __ATOMIC_RELAXED, __HIP_MEMORY_SCOPE_AGENT); }
__device__ __forceinline__ unsigned xb_xcc_id() { return (unsigned)__builtin_amdgcn_s_getreg((3 << 11) | 20) & 0xFu; }
#define XB_SPIN(cond, bar) do { unsigned _sp = 0; while (cond) { __builtin_amdgcn_s_sleep(1); \
    if ((++_sp & 255u) == 0u) { if (xb_ld(&(bar)[XB_TMO])) break; if (_sp > XB_SPIN_CAP) { atomicAdd(&(bar)[XB_TMO], 1u); break; } } } } while (0)

struct XcdBarrier { unsigned* bar; unsigned x; volatile LAS unsigned* st; };

__device__ __forceinline__ XcdBarrier xcd_barrier_post(unsigned* bar, volatile LAS unsigned* st) {
    XcdBarrier b; b.bar = bar; b.x = xb_xcc_id(); b.st = st;
    if (threadIdx.x == 0) (void)xb_add(&bar[XB_XCNT(b.x)], 1u);
    return b;
}
__device__ __forceinline__ void xcd_barrier_complete(unsigned* bar, unsigned x, unsigned& nloc, unsigned& nx) {
    const unsigned G = gridDim.x * gridDim.y * gridDim.z;
    unsigned sum, cnt, mine, sp = 0u;
    for (;;) {
        sum = 0u; cnt = 0u; mine = 0u;
#pragma unroll
        for (unsigned j = 0; j < 16; ++j) { const unsigned c = xb_ld(&bar[XB_XCNT(j)]); sum += c; cnt += (c > 0u) ? 1u : 0u; mine = (j == x) ? c : mine; }
        if (sum == G) break;
        __builtin_amdgcn_s_sleep(1);
        if ((++sp & 255u) == 0u) { if (xb_ld(&bar[XB_TMO])) break; if (sp > XB_SPIN_CAP) { atomicAdd(&bar[XB_TMO], 1u); break; } }
    }
    nloc = mine > 0u ? mine : 1u; nx = cnt > 0u ? cnt : 1u;
}
__device__ __forceinline__ void xcd_barrier(const XcdBarrier& b) {
    asm volatile("s_waitcnt vmcnt(0)" ::: "memory");
    __syncthreads();
    if (threadIdx.x == 0) {
        unsigned* bar = b.bar;
        __builtin_amdgcn_s_waitcnt(0);
        unsigned nloc = b.st[0], nx = b.st[1];
        if (nloc == 0u) { xcd_barrier_complete(bar, b.x, nloc, nx); b.st[0] = nloc; b.st[1] = nx; }
        const unsigned old = xb_add(&bar[XB_XSUB(b.x)], 1u);
        const unsigned gen = old / nloc;
        if (old + 1u == (gen + 1u) * nloc) {
            __builtin_amdgcn_fence(__ATOMIC_RELEASE, "agent");
            asm volatile("s_waitcnt vmcnt(0)" ::: "memory");
            const unsigned og = xb_add(&bar[XB_TOP], 1u);
            const unsigned tg = og / nx;
            if (og + 1u == (tg + 1u) * nx) xb_add(&bar[XB_TOPGEN], 1u);
            else XB_SPIN(xb_ld(&bar[XB_TOPGEN]) == tg, bar);
            __builtin_amdgcn_fence(__ATOMIC_ACQUIRE, "agent");
            xb_add(&bar[XB_XGEN(b.x)], 1u);
            asm volatile("s_waitcnt vmcnt(0)" ::: "memory");
        } else {
            XB_SPIN(xb_ld(&bar[XB_XGEN(b.x)]) == gen, bar);
            __builtin_amdgcn_fence(__ATOMIC_ACQUIRE, "agent");
            asm volatile("s_waitcnt vmcnt(0)" ::: "memory");
        }
    }
    __syncthreads();
}

namespace pg8 {
constexpr int BM = 256, BK = 64, HALF = 128, HTB = HALF * BK * 2, STAGE_BYTES = 8 * HTB;
__host__ __device__ __forceinline__ int lds_byte(int r, int c) { const int st = (r >> 4) * 2 + (c >> 5), rr = r & 15, cc = c & 31, ob = rr * 64 + cc * 2; return st * 1024 + (ob ^ (((ob >> 9) & 1) << 5)); }
__host__ __device__ __forceinline__ void stage_rc(int b, int& R, int& C) { const int st = b / 1024, sb = b % 1024, swz = sb ^ (((sb >> 9) & 1) << 5); R = (st >> 1) * 16 + swz / 64; C = (st & 1) * 32 + (swz % 64) / 2; }
__host__ __device__ __forceinline__ int perm32(int rho) { const int n = rho >> 4, i = rho & 15; return 8 * (i >> 2) + 4 * n + (i & 3); }

struct GUnit { const char* A; const char* B; int pm, pn, aux, par, li; };

struct DenseOrder {
    static constexpr bool GATHER_ROWS = false;
    const char* A; const char* Bt; int nM, nN, nwg, G, c, K, rev = 0;
    __device__ void init(const void* A_, const void* Bt_, int M, int N, int K_, int G_, int c_) { A = (const char*)A_; Bt = (const char*)Bt_; nM = M / BM; nN = N / BM; nwg = nM * nN; G = G_; c = c_; K = K_; }
    __device__ __forceinline__ bool next(int i, GUnit& u) const {
        if ((long)i * G + c >= nwg) return false; const int nr_ = (nwg + G - 1) / G; const long L = rev ? (long)(nr_ - 1 - i) * G + c : (long)i * G + c; if (L >= nwg) return false;
        int wgid = (int)L; { const int q = nwg / 8, r = nwg % 8, xcd = wgid % 8, off = wgid / 8; wgid = (xcd < r ? xcd * (q + 1) : r * (q + 1) + (xcd - r) * q) + off; }
        const int nig = 8 * nN, gid = wgid / nig, fm = gid * 8, gsz = (nM - fm) < 8 ? (nM - fm) : 8;
        u.pm = fm + ((wgid % nig) % gsz); u.pn = (wgid % nig) / gsz; u.aux = 0;
        u.A = A + (size_t)u.pm * BM * K * 2; u.B = Bt + (size_t)u.pn * BM * K * 2; return true;
    }
    __device__ __forceinline__ unsigned rowoff(const GUnit&, int r0, int sub) const { return (unsigned)(r0 + sub) * (unsigned)K * 2u; }
    __device__ __forceinline__ void unit_begin(const GUnit&, int, int) const {}
};
struct PanelOrder {
    static constexpr bool GATHER_ROWS = false;
    const char* A; const char* Bt; int pm, nN, K;
    __device__ __forceinline__ bool next(int i, GUnit& u) const { if (i >= nN) return false; u.pm = pm; u.pn = i; u.aux = 0; u.A = A + (size_t)pm * BM * K * 2; u.B = Bt + (size_t)i * BM * K * 2; return true; }
    __device__ __forceinline__ unsigned rowoff(const GUnit&, int r0, int sub) const { return (unsigned)(r0 + sub) * (unsigned)K * 2u; }
    __device__ __forceinline__ void unit_begin(const GUnit&, int, int) const {}
};
constexpr int LDS_SIDE = 131072, LDS_TILEE = 135680, LDS_ROWIDX = LDS_TILEE + ((QTILES * 4 + 255) & ~255), LDS_ROWSLOTS = 16;
template <int NT, bool GATHER> struct MoeOrder {
    static constexpr bool GATHER_ROWS = GATHER;
    const char* A; const char* W; LAS unsigned char* lds; const int* slot_tok; const int* sdst; const float* sgate; int ntiles, G, vc, K; size_t wstride_e, wstride_pn;
    __device__ __forceinline__ void load_table(const int* tile_e, int tid) const {
        for (int i = tid; i < ntiles; i += NTHR) ((LAS int*)(lds + LDS_TILEE))[i] = tile_e[i];
        if (GATHER) { for (int j = tid; j < LDS_ROWSLOTS * 256; j += NTHR) { const int v = (j >> 8) * G + vc, tile = v / NT; if (tile < ntiles) ((LAS int*)(lds + LDS_ROWIDX))[j] = slot_tok[(size_t)tile * BM + (j & 255)]; } }
        asm volatile("s_waitcnt vmcnt(0) lgkmcnt(0)" ::: "memory"); __syncthreads(); }
    __device__ __forceinline__ bool next(int i, GUnit& u) const {
        const int v = i * G + vc; const int tile = v / NT; if (tile >= ntiles) return false;
        u.pm = tile; u.pn = v % NT; u.li = i; const int e = __builtin_amdgcn_readfirstlane(((const LAS int*)(lds + LDS_TILEE))[tile]); u.aux = e;
        u.A = GATHER ? A : A + (size_t)tile * BM * K * 2; u.B = W + (size_t)e * wstride_e + (size_t)u.pn * wstride_pn; return true;
    }
    __device__ __forceinline__ unsigned rowoff(const GUnit& u, int r0, int sub) const {
        if (!GATHER) return (unsigned)(r0 + sub) * (unsigned)K * 2u;
        const int idx = ((const LAS int*)(lds + LDS_ROWIDX))[(u.li & (LDS_ROWSLOTS - 1)) * 256 + r0 + sub];
        return (unsigned)idx * (unsigned)K * 2u;
    }
    __device__ __forceinline__ void unit_begin(const GUnit&, int, int) const {}
};

template <bool OPAQUE_K = false, int F8M = 0  , bool SADDR = true  , class Epi, class Sched>
__device__ __forceinline__ void gemm_phase(LAS unsigned char* lds, const int K_, const Sched& S, const Epi& E) {
    constexpr bool F8 = F8M != 0; constexpr bool F8_SC = F8M == 2;
    int K = K_; if (OPAQUE_K) asm volatile("" : "+s"(K));
    int tid_ = threadIdx.x; asm volatile("" : "+v"(tid_));
    const int tid = tid_, wid = __builtin_amdgcn_readfirstlane(tid >> 6), lane = tid & 63, wr = wid >> 2, wc = wid & 3, fr = lane & 15, fq = lane >> 4;
    const int nt = K / BK;
    unsigned colb[2]; int r0w[2]; unsigned voffB0 = 0, oaS = 0;
#pragma unroll
    for (int i = 0; i < 2; ++i) { int R, C; stage_rc(tid * 16 + i * 8192, R, C); const int Rb = Epi::PERM ? ((R & ~31) + perm32(R & 31)) : R;
        colb[i] = (unsigned)C * 2u; r0w[i] = 16 * ((wid >> 1) + 4 * i); if (i == 0) { voffB0 = (unsigned)(Rb * K + C) * 2u; oaS = (unsigned)(R * K + C) * 2u; } }
    const size_t p64 = (size_t)64 * K * 2; const unsigned K2 = (unsigned)K * 2u, colb0 = colb[0]; const int ridx_lane = (r0w[0] + (lane >> 2)) * 4;
    const int sub = lane >> 2;
    const size_t kstep = (size_t)(BK * 2);
    const size_t hstep = (size_t)HALF * K * 2;
    const unsigned ldsw = (unsigned)wid * 1024u;
    const int aoff = lds_byte(wr * 64 + fr, fq * 8), boff = lds_byte(wc * 32 + fr, fq * 8);
#define PG8_SA(b, h) (((b) * 2 + (h)) * HTB)
#define PG8_SB(b, h) ((4 + (b) * 2 + (h)) * HTB)
#define PG8_STAGE1(ldsaddr, gbase, vo) do { const unsigned long long gb_ = (unsigned long long)(gbase); \
        if constexpr (SADDR) { const unsigned la_ = (unsigned)(size_t)(ldsaddr); \
            asm volatile("s_mov_b32 m0, %2\n\ts_nop 0\n\tglobal_load_lds_dwordx4 %0, %1" :: "v"(vo), "s"(gb_), "s"(la_) : "memory"); }     \
        else { unsigned lo_, hi_; \
            asm volatile("v_add_co_u32 %0, vcc, %2, %4\n\tv_mov_b32 %1, %3\n\tv_addc_co_u32 %1, vcc, 0, %1, vcc" : "=&v"(lo_), "=&v"(hi_) : "s"((unsigned)gb_), "s"((unsigned)(gb_ >> 32)), "v"(vo) : "vcc"); \
            __builtin_amdgcn_global_load_lds((const unsigned*)(((unsigned long long)hi_ << 32) | lo_), (LAS unsigned*)(ldsaddr), 16, 0, 0); } } while (0)
#define PG8_STAGE_B(bufoff, gbase) do { PG8_STAGE1(lds + (bufoff) + ldsw, (const char*)(gbase), voffB0); PG8_STAGE1(lds + (bufoff) + ldsw + 8192, (const char*)(gbase) + p64, voffB0); } while (0)
#define PG8_STAGE_A(bufoff, gbase, h, li_) do { if constexpr (Sched::GATHER_ROWS) { \
            PG8_STAGE1(lds + (bufoff) + ldsw, (const char*)(gbase), (unsigned)gi##h##0 * K2 + colb0); PG8_STAGE1(lds + (bufoff) + ldsw + 8192, (const char*)(gbase), (unsigned)gi##h##1 * K2 + colb0); } \
        else { PG8_STAGE1(lds + (bufoff) + ldsw, (const char*)(gbase) + (h) * hstep, oaS); PG8_STAGE1(lds + (bufoff) + ldsw + 8192, (const char*)(gbase) + (h) * hstep + p64, oaS); } } while (0)
#define PG8_GIDX(h, li_) int gi##h##0 = 0, gi##h##1 = 0; if constexpr (Sched::GATHER_ROWS) { int rl_ = ridx_lane; asm volatile("" : "+v"(rl_));   const LAS unsigned char* gp_ = lds + LDS_ROWIDX + ((li_) & (LDS_ROWSLOTS - 1)) * 1024 + (h) * 512 + rl_; gi##h##0 = *(const LAS int*)gp_; gi##h##1 = *(const LAS int*)(gp_ + 256); }
#define PG8_LDA(dst, b, h) do { _Pragma("unroll") for (int m = 0; m < 4; ++m) _Pragma("unroll") for (int k = 0; k < 2; ++k) dst[m][k] = *(const LAS bf16x8*)(lds + PG8_SA(b, h) + aoff + m * 2048 + k * 1024); } while (0)
#define PG8_LDB(dst, b, h) do { _Pragma("unroll") for (int n = 0; n < 2; ++n) _Pragma("unroll") for (int k = 0; k < 2; ++k) dst[n][k] = *(const LAS bf16x8*)(lds + PG8_SB(b, h) + boff + n * 2048 + k * 1024); } while (0)
#define PG8_MMA(ai, bj, At, Bt) do { __builtin_amdgcn_s_setprio(1); _Pragma("unroll") for (int m = 0; m < 4; ++m) _Pragma("unroll") for (int n = 0; n < 2; ++n) { \
        if constexpr (F8) { \
            if constexpr (F8_SC) { const i32x8 a8_ = __builtin_shufflevector(__builtin_bit_cast(i32x4, At[m][0]), __builtin_bit_cast(i32x4, At[m][1]), 0, 1, 2, 3, 4, 5, 6, 7), b8_ = __builtin_shufflevector(__builtin_bit_cast(i32x4, Bt[n][0]), __builtin_bit_cast(i32x4, Bt[n][1]), 0, 1, 2, 3, 4, 5, 6, 7); \
                acc[ai][bj][m][n] = __builtin_amdgcn_mfma_scale_f32_16x16x128_f8f6f4(b8_, a8_, acc[ai][bj][m][n], 0, 0, 0, sc1_, 0, sc1_); } \
            else { _Pragma("unroll") for (int k = 0; k < 2; ++k) { typedef long l64x2 __attribute__((ext_vector_type(2))); const l64x2 a_ = __builtin_bit_cast(l64x2, At[m][k]), b_ = __builtin_bit_cast(l64x2, Bt[n][k]); \
                acc[ai][bj][m][n] = __builtin_amdgcn_mfma_f32_16x16x32_fp8_fp8(b_[0], a_[0], acc[ai][bj][m][n], 0, 0, 0); acc[ai][bj][m][n] = __builtin_amdgcn_mfma_f32_16x16x32_fp8_fp8(b_[1], a_[1], acc[ai][bj][m][n], 0, 0, 0); } } } \
        else { _Pragma("unroll") for (int k = 0; k < 2; ++k) acc[ai][bj][m][n] = __builtin_amdgcn_mfma_f32_16x16x32_bf16(Bt[n][k], At[m][k], acc[ai][bj][m][n], 0, 0, 0); } } \
        __builtin_amdgcn_s_setprio(0); } while (0)
#define PG8_WAIT_V(n) asm volatile("s_waitcnt vmcnt(" #n ")" ::: "memory")
#define PG8_WAIT_L(n) asm volatile("s_waitcnt lgkmcnt(" #n ")" ::: "memory")
#define PG8_BAR __builtin_amdgcn_s_barrier()
#define PG8_SCHED __builtin_amdgcn_sched_barrier(0)
    int sc1_; asm volatile("s_mov_b32 %0, 0x7f7f7f7f" : "=s"(sc1_));
    GUnit cur, nxt; int ui = 0;
    if (!S.next(0, cur)) return;
    f32x4 acc[2][2][4][2];
#pragma unroll
    for (int a = 0; a < 2; ++a)
#pragma unroll
        for (int b = 0; b < 2; ++b)
#pragma unroll
            for (int m = 0; m < 4; ++m)
#pragma unroll
                for (int n = 0; n < 2; ++n) acc[a][b][m][n] = (f32x4){0.f, 0.f, 0.f, 0.f};
    bf16x8 At[4][2], B0[2][2], B1[2][2];
    const char* cA = cur.A; const char* cB = cur.B;
    { PG8_GIDX(0, cur.li) PG8_GIDX(1, cur.li) PG8_STAGE_B(PG8_SB(0, 0), cB); PG8_STAGE_A(PG8_SA(0, 0), cA, 0, cur.li); PG8_STAGE_B(PG8_SB(0, 1), cB + hstep); PG8_STAGE_A(PG8_SA(0, 1), cA, 1, cur.li); }
    if (wr == 1) PG8_BAR;
    PG8_WAIT_V(4); PG8_BAR;
    { PG8_GIDX(0, cur.li) PG8_STAGE_B(PG8_SB(1, 0), cB + kstep); PG8_STAGE_A(PG8_SA(1, 0), cA + kstep, 0, cur.li); PG8_STAGE_B(PG8_SB(1, 1), cB + hstep + kstep); }
    PG8_WAIT_V(6); PG8_BAR;
    for (;;) {
        cur.par = ui & 1; S.unit_begin(cur, ui & 1, wid);
        const bool has_next = S.next(ui + 1, nxt);
        const char* nA = has_next ? nxt.A : cA; const char* nB = has_next ? nxt.B : cB;
        for (int t = 0; t < nt; t += 2) {
            const bool last = (t == nt - 2);
            const char* a1 = cA + (size_t)(t + 1) * kstep;
            const char* a2 = last ? nA : cA + (size_t)(t + 2) * kstep; const char* b2 = last ? nB : cB + (size_t)(t + 2) * kstep;
            const char* a3 = a2 + kstep; const char* b3 = b2 + kstep;
            const int lis = (last && has_next) ? nxt.li : cur.li;
            { PG8_GIDX(1, cur.li) PG8_LDB(B0, 0, 0); PG8_SCHED; PG8_LDA(At, 0, 0); PG8_STAGE_A(PG8_SA(1, 1), a1, 1, cur.li); }
            PG8_WAIT_L(8); PG8_BAR; PG8_WAIT_L(0); PG8_MMA(0, 0, At, B0); PG8_BAR; PG8_SCHED;
            PG8_LDB(B1, 0, 1); PG8_STAGE_B(PG8_SB(0, 0), b2);
            PG8_BAR; PG8_WAIT_L(0); PG8_MMA(0, 1, At, B1); PG8_BAR;
            { PG8_GIDX(0, lis) PG8_LDA(At, 0, 1); PG8_STAGE_A(PG8_SA(0, 0), a2, 0, lis); }
            PG8_BAR; PG8_WAIT_L(0); PG8_MMA(1, 0, At, B0); PG8_BAR; PG8_SCHED;
            PG8_STAGE_B(PG8_SB(0, 1), b2 + hstep);
            PG8_WAIT_V(6); PG8_BAR; PG8_MMA(1, 1, At, B1); PG8_BAR;
            { PG8_GIDX(1, lis) PG8_LDB(B0, 1, 0); PG8_SCHED; PG8_LDA(At, 1, 0); PG8_STAGE_A(PG8_SA(0, 1), a2, 1, lis); }
            PG8_WAIT_L(8); PG8_BAR; PG8_WAIT_L(0); PG8_MMA(0, 0, At, B0); PG8_BAR; PG8_SCHED;
            PG8_LDB(B1, 1, 1); PG8_STAGE_B(PG8_SB(1, 0), b3);
            PG8_BAR; PG8_WAIT_L(0); PG8_MMA(0, 1, At, B1); PG8_BAR;
            { PG8_GIDX(0, lis) PG8_LDA(At, 1, 1); PG8_STAGE_A(PG8_SA(1, 0), a3, 0, lis); }
            PG8_BAR; PG8_WAIT_L(0); PG8_MMA(1, 0, At, B0); PG8_BAR; PG8_SCHED;
            PG8_STAGE_B(PG8_SB(1, 1), b3 + hstep);
            PG8_WAIT_V(6); PG8_BAR; PG8_MMA(1, 1, At, B1); PG8_BAR;
        }
        { int l_ = threadIdx.x; asm volatile("" : "+v"(l_));
          E(acc, cur, wr, wc, l_ & 15, (l_ & 63) >> 4); }
        if (!has_next) break;
#pragma unroll
        for (int a = 0; a < 2; ++a)
#pragma unroll
            for (int b = 0; b < 2; ++b)
#pragma unroll
                for (int m = 0; m < 4; ++m)
#pragma unroll
                    for (int n = 0; n < 2; ++n) acc[a][b][m][n] = (f32x4){0.f, 0.f, 0.f, 0.f};
        cur = nxt; cA = nA; cB = nB; ++ui;
    }
    PG8_WAIT_V(0);
    if (wr == 0) PG8_BAR;
    PG8_BAR;
#undef PG8_SA
#undef PG8_SB
#undef PG8_STAGE1
#undef PG8_STAGE_A
#undef PG8_GIDX
#undef PG8_STAGE_B
#undef PG8_LDA
#undef PG8_LDB
#undef PG8_MMA
#undef PG8_WAIT_V
#undef PG8_WAIT_L
#undef PG8_BAR
#undef PG8_SCHED
}

#define EPI_LOOP_ROWS for (int ai = 0; ai < 2; ++ai) _Pragma("unroll") for (int m = 0; m < 4; ++m)

__device__ __forceinline__ u32x4 pair16(u32x2 xa, u32x2 xb) {
    const auto lo = __builtin_amdgcn_permlane16_swap(xa.x, xb.x, false, false), hi = __builtin_amdgcn_permlane16_swap(xa.y, xb.y, false, false);
    u32x4 w; w.x = lo[0]; w.y = hi[0]; w.z = lo[1]; w.w = hi[1]; return w; }
enum { K_SILU = 0, K_ID = 1, K_LOGF = 2, K_ROT = 3, K_SIG = 4, K_ID8 = 5   };
struct EpiZ {
    static constexpr bool PERM = true;
    unsigned char* ws; const float* rot; const float* lb; float osc;
    template <int KIND> __device__ __forceinline__ void body(const f32x4 (&acc)[2][2][4][2], u16* base, int ld, int pnl, int pm, float scale, const float* lbp, int wr, int wc, int fr, int fq) const {
        const int row0 = pm * BM + wr * 64 + fr, col0 = pnl * BM + wc * 32 + 8 * fq;
        if constexpr (KIND == K_ID8) {
            unsigned char* bp = (unsigned char*)base + (size_t)(row0 + 16 * (fq & 1)) * ld + col0 - 8 * (fq & 1);
#pragma unroll
            for (int ai = 0; ai < 2; ++ai)
#pragma unroll
                for (int mp = 0; mp < 4; mp += 2)
#pragma unroll
                    for (int bj = 0; bj < 2; ++bj) { u32x2 x[2];
#pragma unroll
                        for (int t = 0; t < 2; ++t) { const f32x4 v0 = acc[ai][bj][mp + t][0] * osc, v1 = acc[ai][bj][mp + t][1] * osc; x[t].x = pk_fp8x4(v0[0], v0[1], v0[2], v0[3]); x[t].y = pk_fp8x4(v1[0], v1[1], v1[2], v1[3]); }
                        *(u32x4*)(bp + (size_t)(ai * HALF + mp * 16) * ld + bj * HALF) = pair16(x[0], x[1]); }
            return;
        }
        f32x4 l0[2], l1[2];
        if (KIND == K_LOGF) {
#pragma unroll
            for (int bj = 0; bj < 2; ++bj) { l0[bj] = *(const f32x4*)(lbp + col0 + bj * HALF); l1[bj] = *(const f32x4*)(lbp + col0 + bj * HALF + 4); }
        }
        const bool rotl = (KIND == K_ROT) && ((wc & 1) == 0) && (fq < 2);
        const float sgn = (fq == 0) ? -1.f : 1.f;
#pragma unroll
        for (int ai = 0; ai < 2; ++ai) {
        f32x4 rt[4][4];
        if (KIND == K_ROT) {
#pragma unroll
            for (int m = 0; m < 4; ++m) { const float* rp = rot + (size_t)((row0 + ai * HALF + m * 16) & (SEQ - 1)) * 16;
#pragma unroll
                for (int k = 0; k < 4; ++k) rt[m][k] = *(const f32x4*)(rp + 4 * k); }
            __builtin_amdgcn_sched_barrier(0);
        }
#pragma unroll
        for (int m = 0; m < 4; ++m) {
            const int row = row0 + ai * HALF + m * 16;
            f32x4 cs0, cs1, sn0, sn1;
            if (KIND == K_ROT) { cs0 = rt[m][0]; cs1 = rt[m][1]; sn0 = rt[m][2]; sn1 = rt[m][3]; }
#pragma unroll
            for (int bj = 0; bj < 2; ++bj) {
                f32x4 v0 = acc[ai][bj][m][0] * osc, v1 = acc[ai][bj][m][1] * osc;
                if (KIND == K_SILU) {
#pragma unroll
                    for (int j = 0; j < 4; ++j) { v0[j] = v0[j] * sigmoidf_(v0[j]); v1[j] = v1[j] * sigmoidf_(v1[j]); }
                } else if (KIND == K_SIG) {
#pragma unroll
                    for (int j = 0; j < 4; ++j) { v0[j] = sigmoidf_(v0[j]); v1[j] = sigmoidf_(v1[j]); }
                } else if (KIND == K_LOGF) {
#pragma unroll
                    for (int j = 0; j < 4; ++j) { v0[j] = __logf(l0[bj][j] + (1.f - l0[bj][j]) * sigmoidf_(v0[j])); v1[j] = __logf(l1[bj][j] + (1.f - l1[bj][j]) * sigmoidf_(v1[j])); }
                } else if (KIND == K_ROT) {
                    f32x4 o0, o1;
#pragma unroll
                    for (int j = 0; j < 4; ++j) { o0[j] = __shfl_xor(v0[j], 16); o1[j] = __shfl_xor(v1[j], 16); }
                    if (rotl) {
#pragma unroll
                        for (int j = 0; j < 4; ++j) { v0[j] = v0[j] * cs0[j] + sgn * o0[j] * sn0[j]; v1[j] = v1[j] * cs1[j] + sgn * o1[j] * sn1[j]; }
                    }
                    v0 = v0 * scale; v1 = v1 * scale;
                }
                if (KIND == K_ID8) { u32x2 w8; w8.x = pk_fp8x4(v0[0], v0[1], v0[2], v0[3]); w8.y = pk_fp8x4(v1[0], v1[1], v1[2], v1[3]);
                    *(u32x2*)((unsigned char*)base + (size_t)row * ld + col0 + bj * HALF) = w8; continue; }
                u32x4 w;
                if (KIND == K_LOGF) { w.x = pk_f16(v0[0], v0[1]); w.y = pk_f16(v0[2], v0[3]); w.z = pk_f16(v1[0], v1[1]); w.w = pk_f16(v1[2], v1[3]); }
                else { w.x = cvt_pk_bf16(v0[0], v0[1]); w.y = cvt_pk_bf16(v0[2], v0[3]); w.z = cvt_pk_bf16(v1[0], v1[1]); w.w = cvt_pk_bf16(v1[2], v1[3]); }
                *(u32x4*)(base + (size_t)row * ld + col0 + bj * HALF) = w;
            }
        }
        }
    }
    __device__ __forceinline__ void operator()(const f32x4 (&acc)[2][2][4][2], const GUnit& u, int wr, int wc, int fr, int fq) const {
        const int pn = u.pn, pm = u.pm;
        if (pn < DBG_PN_LO) return;
        if (pn < 2)       body<K_ID8>(acc, (u16*)(ws + Z_QH), 512, pn, pm, 1.f, nullptr, wr, wc, fr, fq);
        else if (pn < 4)  body<K_ID8>(acc, (u16*)(ws + Z_VH), 512, pn - 2, pm, 1.f, nullptr, wr, wc, fr, fq);
        else if (pn < 6)  body<K_ID>(acc, (u16*)(ws + Z_LFF), 512, pn - 4, pm, 1.f, nullptr, wr, wc, fr, fq);
        else if (pn < 8)  body<K_ID>(acc, (u16*)(ws + Z_LFB), 512, pn - 6, pm, 1.f, nullptr, wr, wc, fr, fq);
        else if (pn < 10) body<K_ID8>(acc, (u16*)(ws + Z_GS), 512, pn - 8, pm, 1.f, nullptr, wr, wc, fr, fq);
        else if (pn < 13) body<K_ROT>(acc, (u16*)(ws + Z_AQ), 768, pn - 10, pm, 0.125f, nullptr, wr, wc, fr, fq);
        else if (pn < 16) body<K_ROT>(acc, (u16*)(ws + Z_AK), 768, pn - 13, pm, 1.f, nullptr, wr, wc, fr, fq);
        else if (pn < 19) body<K_ID>(acc, (u16*)(ws + Z_AV), 768, pn - 16, pm, 1.f, nullptr, wr, wc, fr, fq);
        else if (pn < 23) body<K_ID8>(acc, (u16*)(ws + Z_GTH), 1024, pn - 19, pm, 1.f, nullptr, wr, wc, fr, fq);
        else              body<K_ID8>(acc, (u16*)(ws + Z_GTA), 1024, pn - 23, pm, 1.f, nullptr, wr, wc, fr, fq);
    }
};

template <bool ADD> struct EpiGated {
    static constexpr bool PERM = true;
    const u16* gate; u16* out; unsigned char* out8; int ld;
    __device__ __forceinline__ void operator()(const f32x4 (&acc)[2][2][4][2], const GUnit& u, int wr, int wc, int fr, int fq) const {
        const int row0 = u.pm * BM + wr * 64 + fr, col0 = u.pn * BM + wc * 32 + 8 * fq;
        constexpr float isc = 1.0f / W8_SCALE;
#pragma unroll
        for (int ai = 0; ai < 2; ++ai)
#pragma unroll
        for (int mp = 0; mp < 4; mp += 2) {
            u32x2 gv[4][2]; u32x4 pv[4][2];
#pragma unroll
            for (int m = mp; m < mp + 2; ++m)
#pragma unroll
                for (int bj = 0; bj < 2; ++bj) { const size_t off = (size_t)(row0 + ai * HALF + m * 16) * ld + col0 + bj * HALF; gv[m][bj] = *(const u32x2*)((const unsigned char*)gate + off); if (ADD) pv[m][bj] = *(const u32x4*)(out + off); }
            __builtin_amdgcn_sched_barrier(0);
#pragma unroll
                for (int bj = 0; bj < 2; ++bj) { u32x2 x8[2];
#pragma unroll
                    for (int t = 0; t < 2; ++t) { const int m = mp + t; const size_t off = (size_t)(row0 + ai * HALF + m * 16) * ld + col0 + bj * HALF;
                        const u32x2 g = gv[m][bj]; float g0[4], g1[4]; fp8x4_to_f32(g.x, g0); fp8x4_to_f32(g.y, g1);
                        f32x4 v0 = acc[ai][bj][m][0] * isc, v1 = acc[ai][bj][m][1] * isc;
#pragma unroll
                        for (int j = 0; j < 4; ++j) { v0[j] *= sigmoidf_(g0[j]); v1[j] *= sigmoidf_(g1[j]); }
                        if (ADD) { const u32x4 p = pv[m][bj];
                            v0[0] += bf_lo(p.x); v0[1] += bf_hi(p.x); v0[2] += bf_lo(p.y); v0[3] += bf_hi(p.y);
                            v1[0] += bf_lo(p.z); v1[1] += bf_hi(p.z); v1[2] += bf_lo(p.w); v1[3] += bf_hi(p.w);
                            x8[t].x = pk_fp8x4(v0[0] * M8_SCALE, v0[1] * M8_SCALE, v0[2] * M8_SCALE, v0[3] * M8_SCALE); x8[t].y = pk_fp8x4(v1[0] * M8_SCALE, v1[1] * M8_SCALE, v1[2] * M8_SCALE, v1[3] * M8_SCALE); }
                        else { u32x4 w; w.x = cvt_pk_bf16(v0[0], v0[1]); w.y = cvt_pk_bf16(v0[2], v0[3]); w.z = cvt_pk_bf16(v1[0], v1[1]); w.w = cvt_pk_bf16(v1[2], v1[3]);
                            *(u32x4*)(out + off) = w; }
                    }
                    if (ADD) *(u32x4*)(out8 + (size_t)(row0 + ai * HALF + (mp + (fq & 1)) * 16) * ld + col0 - 8 * (fq & 1) + bj * HALF) = pair16(x8[0], x8[1]);
                }
            __builtin_amdgcn_sched_barrier(0);
        }
    }
};
struct EpiF32Res {
    static constexpr bool PERM = false;
    float* C; const float* res; u16* Cb; int ld; float alpha; float asc;
    __device__ __forceinline__ void operator()(const f32x4 (&acc)[2][2][4][2], const GUnit& u, int wr, int wc, int fr, int fq) const {
        const int row0 = u.pm * BM + wr * 64 + fr, col0 = u.pn * BM + wc * 32 + 4 * fq;
#pragma unroll
        EPI_LOOP_ROWS {
            const size_t off = (size_t)(row0 + ai * HALF + m * 16) * ld + col0;
#pragma unroll
            for (int bj = 0; bj < 2; ++bj)
#pragma unroll
                for (int n = 0; n < 2; ++n) { f32x4 v = acc[ai][bj][m][n] * asc; if (res) v = v + alpha * *(const f32x4*)(res + off + bj * HALF + n * 16);
                    if (Cb) { u32x2 w; w.x = cvt_pk_bf16(v[0], v[1]); w.y = cvt_pk_bf16(v[2], v[3]); *(u32x2*)(Cb + off + bj * HALF + n * 16) = w; } else *(f32x4*)(C + off + bj * HALF + n * 16) = v; }
        }
    }
};
struct EpiBf16Res {
    static constexpr bool PERM = true;
    const float* res; u16* Cb; int ld; float alpha; float asc;
    __device__ __forceinline__ void operator()(const f32x4 (&acc)[2][2][4][2], const GUnit& u, int wr, int wc, int fr, int fq) const {
        const int row0 = u.pm * BM + wr * 64 + fr, col0 = u.pn * BM + wc * 32 + 8 * fq;
#pragma unroll
        for (int ai = 0; ai < 2; ++ai)
#pragma unroll
        for (int mp = 0; mp < 4; mp += 2) {
            f32x4 r[2][2][2];
#pragma unroll
            for (int t = 0; t < 2; ++t)
#pragma unroll
                for (int bj = 0; bj < 2; ++bj) { const float* rp = res + (size_t)(row0 + ai * HALF + (mp + t) * 16) * ld + col0 + bj * HALF; r[t][bj][0] = *(const f32x4*)rp; r[t][bj][1] = *(const f32x4*)(rp + 4); }
            __builtin_amdgcn_sched_barrier(0);
#pragma unroll
            for (int t = 0; t < 2; ++t)
#pragma unroll
                for (int bj = 0; bj < 2; ++bj) { const int m = mp + t; const f32x4 v0 = acc[ai][bj][m][0] * asc + alpha * r[t][bj][0], v1 = acc[ai][bj][m][1] * asc + alpha * r[t][bj][1];
                    u32x4 w; w.x = cvt_pk_bf16(v0[0], v0[1]); w.y = cvt_pk_bf16(v0[2], v0[3]); w.z = cvt_pk_bf16(v1[0], v1[1]); w.w = cvt_pk_bf16(v1[2], v1[3]);
                    *(u32x4*)(Cb + (size_t)(row0 + ai * HALF + m * 16) * ld + col0 + bj * HALF) = w; }
            __builtin_amdgcn_sched_barrier(0);
        }
    }
};
struct EpiBf16 {
    static constexpr bool PERM = true;
    u16* O; int ld;
    __device__ __forceinline__ void operator()(const f32x4 (&acc)[2][2][4][2], const GUnit& u, int wr, int wc, int fr, int fq) const {
        const int row0 = u.pm * BM + wr * 64 + fr, col0 = u.pn * BM + wc * 32 + 8 * fq;
#pragma unroll
        EPI_LOOP_ROWS {
            u16* rowp = O + (size_t)(row0 + ai * HALF + m * 16) * ld + col0;
#pragma unroll
            for (int bj = 0; bj < 2; ++bj) { const f32x4 v0 = acc[ai][bj][m][0], v1 = acc[ai][bj][m][1];
                u32x4 w; w.x = cvt_pk_bf16(v0[0], v0[1]); w.y = cvt_pk_bf16(v0[2], v0[3]); w.z = cvt_pk_bf16(v1[0], v1[1]); w.w = cvt_pk_bf16(v1[2], v1[3]);
                *(u32x4*)(rowp + bj * HALF) = w; }
        }
    }
};
struct EpiSwiglu {
    static constexpr bool PERM = true;
    unsigned char* H;
    __device__ __forceinline__ void operator()(const f32x4 (&acc)[2][2][4][2], const GUnit& u, int wr, int wc, int fr, int fq) const {
        const int row0 = u.pm * BM + wr * 64 + fr, col0 = u.pn * HALF + wc * 32 + 8 * fq;
        constexpr float isc = 1.0f / W8_SCALE;
        unsigned char* hp = H + (size_t)(row0 + 16 * (fq & 1)) * 256 + col0 - 8 * (fq & 1);
#pragma unroll
        for (int ai = 0; ai < 2; ++ai)
#pragma unroll
            for (int mp = 0; mp < 4; mp += 2) { u32x2 x[2];
#pragma unroll
                for (int t = 0; t < 2; ++t) { const int m = mp + t;
                    f32x4 g0 = acc[ai][0][m][0] * isc, g1 = acc[ai][0][m][1] * isc; const f32x4 u0 = acc[ai][1][m][0] * (isc * H8_SCALE), u1 = acc[ai][1][m][1] * (isc * H8_SCALE);
#pragma unroll
                    for (int j = 0; j < 4; ++j) { g0[j] = g0[j] * sigmoidf_(g0[j]) * u0[j]; g1[j] = g1[j] * sigmoidf_(g1[j]) * u1[j]; }
                    x[t].x = pk_fp8x4(g0[0], g0[1], g0[2], g0[3]); x[t].y = pk_fp8x4(g1[0], g1[1], g1[2], g1[3]); }
                *(u32x4*)(hp + (size_t)(ai * HALF + mp * 16) * 256) = pair16(x[0], x[1]); }
    }
};
struct EpiDown {
    static constexpr bool PERM = true;
    unsigned char* Y; LAS unsigned char* lds;
    __device__ __forceinline__ void operator()(const f32x4 (&acc)[2][2][4][2], const GUnit& u, int wr, int wc, int fr, int fq) const {
        const int col0 = u.pn * BM + wc * 32 + 8 * fq;
        const LAS unsigned* side = (const LAS unsigned*)(lds + LDS_SIDE + u.par * 2048);
        unsigned dd[8]; float gg[8];
#pragma unroll
        for (int j = 0; j < 8; ++j) { const int lr = wr * 64 + fr + (j >> 2) * HALF + (j & 3) * 16; dd[j] = side[(lr >> 5) * 64 + (lr & 31)]; gg[j] = __uint_as_float(side[(lr >> 5) * 64 + 32 + (lr & 31)]) * (Y8_SCALE / (W8_SCALE * H8_SCALE)); }
#pragma unroll
        EPI_LOOP_ROWS {
            const unsigned d = dd[ai * 4 + m]; const float g = gg[ai * 4 + m];
            unsigned char* rowp = Y + (size_t)(d * (unsigned)D + (unsigned)col0);
#pragma unroll
            for (int bj = 0; bj < 2; ++bj) { const f32x4 v0 = acc[ai][bj][m][0] * g, v1 = acc[ai][bj][m][1] * g;
                u32x2 w; w.x = pk_fp8x4(v0[0], v0[1], v0[2], v0[3]); w.y = pk_fp8x4(v1[0], v1[1], v1[2], v1[3]);
                *(u32x2*)(rowp + bj * HALF) = w; }
        }
    }
};
struct EpiPle {
    static constexpr bool PERM = true;
    u16* out; const u16* x2; const u16* p2; int ld; float asc;
    __device__ __forceinline__ void operator()(const f32x4 (&acc)[2][2][4][2], const GUnit& u, int wr, int wc, int fr, int fq) const {
        const int row0 = u.pm * BM + wr * 64 + fr, col0 = u.pn * BM + wc * 32 + 8 * fq;
#pragma unroll
        for (int ai = 0; ai < 2; ++ai) {
            u32x4 xv[4][2], pv[4][2];
#pragma unroll
            for (int m = 0; m < 4; ++m)
#pragma unroll
                for (int bj = 0; bj < 2; ++bj) { const size_t o = (size_t)(row0 + ai * HALF + m * 16) * ld + col0 + bj * HALF; xv[m][bj] = *(const u32x4*)(x2 + o); pv[m][bj] = *(const u32x4*)(p2 + o); }
            __builtin_amdgcn_sched_barrier(0);
#pragma unroll
            for (int m = 0; m < 4; ++m)
#pragma unroll
                for (int bj = 0; bj < 2; ++bj) { const size_t o = (size_t)(row0 + ai * HALF + m * 16) * ld + col0 + bj * HALF; const u32x4 x = xv[m][bj], p = pv[m][bj]; const f32x4 a = acc[ai][bj][m][0] * asc, b = acc[ai][bj][m][1] * asc;
                    u32x4 r; r.x = cvt_pk_bf16(ALPHA * bf_lo(x.x) + sigmoidf_(a[0]) * bf_lo(p.x), ALPHA * bf_hi(x.x) + sigmoidf_(a[1]) * bf_hi(p.x));
                    r.y = cvt_pk_bf16(ALPHA * bf_lo(x.y) + sigmoidf_(a[2]) * bf_lo(p.y), ALPHA * bf_hi(x.y) + sigmoidf_(a[3]) * bf_hi(p.y));
                    r.z = cvt_pk_bf16(ALPHA * bf_lo(x.z) + sigmoidf_(b[0]) * bf_lo(p.z), ALPHA * bf_hi(x.z) + sigmoidf_(b[1]) * bf_hi(p.z));
                    r.w = cvt_pk_bf16(ALPHA * bf_lo(x.w) + sigmoidf_(b[2]) * bf_lo(p.w), ALPHA * bf_hi(x.w) + sigmoidf_(b[3]) * bf_hi(p.w));
                    *(u32x4*)(out + o) = r; }
            __builtin_amdgcn_sched_barrier(0);
        }
    }
};
}

struct Args { const float* in[25]; float* out; unsigned char* ws; int lo, hi; };
struct Frame {
    LAS unsigned char* lds; int tid, lane, wave, vcu, G; unsigned char* ws; unsigned char* dout;
};

__device__ __forceinline__ void transpose_item(const float* __restrict__ W, int ldw, int k0, int n0, u16* __restrict__ WT, size_t dst_row0, int Kd, LAS float* scr, int lane) {
#pragma unroll 8
    for (int i = 0; i < 32; ++i) { const int kk = 2 * i + (lane >> 5); scr[kk * 33 + (lane & 31)] = W[(size_t)(k0 + kk) * ldw + n0 + (lane & 31)]; }
    LDS_WAIT(); asm volatile("" ::: "memory");
    const int c = lane & 7;
#pragma unroll
    for (int j = 0; j < 4; ++j) { const int n = (lane >> 3) + 8 * j; const LAS float* s = scr + (8 * c) * 33 + n;
        u32x4 o; o.x = cvt_pk_bf16(s[0 * 33], s[1 * 33]); o.y = cvt_pk_bf16(s[2 * 33], s[3 * 33]); o.z = cvt_pk_bf16(s[4 * 33], s[5 * 33]); o.w = cvt_pk_bf16(s[6 * 33], s[7 * 33]);
        *(u32x4*)(WT + (dst_row0 + n) * (size_t)Kd + k0 + 8 * c) = o; }
    LDS_WAIT(); asm volatile("" ::: "memory");
}

__device__ __forceinline__ void transpose_item_f8(const float* __restrict__ W, int ldw, int k0, int n0, unsigned char* __restrict__ WT, size_t dst_row0, int Kd, float scale, LAS float* scr, int lane) {
    float tv[32];
#pragma unroll
    for (int i = 0; i < 32; ++i) tv[i] = W[(size_t)(k0 + 2 * i + (lane >> 5)) * ldw + n0 + (lane & 31)];
#pragma unroll
    for (int i = 0; i < 32; ++i) scr[(2 * i + (lane >> 5)) * 33 + (lane & 31)] = tv[i];
    LDS_WAIT(); asm volatile("" ::: "memory");
    const int c = lane & 7;
#pragma unroll
    for (int j = 0; j < 4; ++j) { const int n = (lane >> 3) + 8 * j; const LAS float* sp = scr + (8 * c) * 33 + n;
        u32x2 o; o.x = pk_fp8x4(sp[0 * 33] * scale, sp[1 * 33] * scale, sp[2 * 33] * scale, sp[3 * 33] * scale); o.y = pk_fp8x4(sp[4 * 33] * scale, sp[5 * 33] * scale, sp[6 * 33] * scale, sp[7 * 33] * scale);
        *(u32x2*)(WT + (dst_row0 + n) * (size_t)Kd + k0 + 8 * c) = o; }
    LDS_WAIT(); asm volatile("" ::: "memory");
}
__device__ __forceinline__ bool transpose_matrix_item(int& r, const float* W, int K, int N, u16* WT, LAS float* scr, int lane) {
    const int nitems = (K / 64) * (N / 32);
    if (r < nitems) { const int nblk = N / 32, kb = r / nblk, nb = r % nblk; transpose_item(W, N, 64 * kb, 32 * nb, WT, (size_t)32 * nb, K, scr, lane); return true; }
    r -= nitems; return false;
}

template <bool OUT_BF16> __device__ __forceinline__ void ln_row(const float* xrow, const float* g, const float* b, void* orow, int lane, unsigned* o8row = nullptr) {
    const f32x4* xr = (const f32x4*)xrow + lane;
    f32x4 v[4]; float s = 0.f;
#pragma unroll
    for (int j = 0; j < 4; ++j) { v[j] = xr[64 * j]; s += (v[j].x + v[j].y) + (v[j].z + v[j].w); }
    const float mean = wave_sum(s) * (1.f / D); float s2 = 0.f;
#pragma unroll
    for (int j = 0; j < 4; ++j) { v[j] = v[j] - mean; s2 += (v[j].x * v[j].x + v[j].y * v[j].y) + (v[j].z * v[j].z + v[j].w * v[j].w); }
    const float rstd = 1.f / sqrtf(wave_sum(s2) * (1.f / D) + LN_EPS);
#pragma unroll
    for (int j = 0; j < 4; ++j) { const f32x4 gg = *((const f32x4*)g + lane + 64 * j), bb = *((const f32x4*)b + lane + 64 * j); const f32x4 y = v[j] * rstd * gg + bb;
        if (OUT_BF16) { u32x2 w; w.x = cvt_pk_bf16(y[0], y[1]); w.y = cvt_pk_bf16(y[2], y[3]); *((u32x2*)orow + lane + 64 * j) = w; if (o8row) o8row[lane + 64 * j] = pk_fp8x4(y[0], y[1], y[2], y[3]); }
        else *((f32x4*)orow + lane + 64 * j) = y; }
}


template <bool OUT_BF16, int NR, bool IN_BF16 = false> __device__ __forceinline__ void ln_rows(const void* xbase_, size_t r0, size_t rstride, const float* g, const float* b, void* obase, int lane, unsigned char* o8base = nullptr) {
    f32x4 v[NR][4]; float s[NR]; f32x4 gq[4], bq[4];
#pragma unroll
    for (int j = 0; j < 4; ++j) { gq[j] = *((const f32x4*)g + lane + 64 * j); bq[j] = *((const f32x4*)b + lane + 64 * j); }
#pragma unroll
    for (int r = 0; r < NR; ++r) { s[r] = 0.f;
        if (IN_BF16) { const u32x2* xr = (const u32x2*)((const u16*)xbase_ + (r0 + r * rstride) * D) + lane;
#pragma unroll
            for (int j = 0; j < 4; ++j) { const u32x2 w = xr[64 * j]; v[r][j] = (f32x4){bf_lo(w.x), bf_hi(w.x), bf_lo(w.y), bf_hi(w.y)}; } }
        else { const f32x4* xr = (const f32x4*)((const float*)xbase_ + (r0 + r * rstride) * D) + lane;
#pragma unroll
            for (int j = 0; j < 4; ++j) { v[r][j] = xr[64 * j]; } } }
    __builtin_amdgcn_sched_barrier(0);
#pragma unroll
    for (int r = 0; r < NR; ++r)
#pragma unroll
        for (int j = 0; j < 4; ++j) s[r] += (v[r][j].x + v[r][j].y) + (v[r][j].z + v[r][j].w);
#pragma unroll
    for (int r = 0; r < NR; ++r) s[r] = wave_sum(s[r]);
    float s2[NR];
#pragma unroll
    for (int r = 0; r < NR; ++r) { const float mean = s[r] * (1.f / D); s2[r] = 0.f;
#pragma unroll
        for (int j = 0; j < 4; ++j) { v[r][j] = v[r][j] - mean; s2[r] += (v[r][j].x * v[r][j].x + v[r][j].y * v[r][j].y) + (v[r][j].z * v[r][j].z + v[r][j].w * v[r][j].w); } }
#pragma unroll
    for (int r = 0; r < NR; ++r) s2[r] = wave_sum(s2[r]);
#pragma unroll
    for (int j = 0; j < 4; ++j) { const f32x4 gg = gq[j], bb = bq[j];
#pragma unroll
        for (int r = 0; r < NR; ++r) { const float rstd = 1.f / sqrtf(s2[r] * (1.f / D) + LN_EPS); const f32x4 y = v[r][j] * rstd * gg + bb; const size_t row = r0 + r * rstride;
            if (OUT_BF16) { u32x2 w; w.x = cvt_pk_bf16(y[0], y[1]); w.y = cvt_pk_bf16(y[2], y[3]); *((u32x2*)((u16*)obase + row * D) + lane + 64 * j) = w; if (o8base) ((unsigned*)(o8base + row * D))[lane + 64 * j] = pk_fp8x4(y[0], y[1], y[2], y[3]); }
            else *((f32x4*)((float*)obase + row * D) + lane + 64 * j) = y; } }
}

__device__ __forceinline__ void phase_prologue(const Frame& F, const Args& a) {
    LAS float* scr = (LAS float*)(F.lds + F.wave * 16384);
    const int gw = F.vcu * NWAVES + F.wave, NGW = F.G * NWAVES;
    constexpr int NITEMS = 16 * 216 + 8 * 32 + 4 * 32 + 16 * 32 + 16 * 8 + 16 * 32 + 4 * 32;
    for (int it = gw; it < NITEMS; it += NGW) {
        int r = it;
        if (r < 16 * 216) { const int kb = r / 216, nb = r % 216; transpose_item_f8(a.in[2], NCOL, 64 * kb, 32 * nb, F.ws + WS_WIN, (size_t)32 * nb, 1024, W8_SCALE, scr, F.lane); continue; } r -= 16 * 216;
        if (r < 8 * 32) { const int kb = r / 32, nb = r % 32; transpose_item_f8(a.in[6], 1024, 64 * kb, 32 * nb, F.ws + WS_WBH, (size_t)32 * nb, 512, W8_SCALE, scr, F.lane); continue; } r -= 8 * 32;
        if (r < 4 * 32) { const int kb = r / 32, nb = r % 32; transpose_item_f8(a.in[7], 1024, 64 * kb, 32 * nb, F.ws + WS_WBA, (size_t)32 * nb, 256, W8_SCALE, scr, F.lane); continue; } r -= 4 * 32;
        if (r < 16 * 32) { const int kb = r / 32, nb = r % 32; transpose_item_f8(a.in[8], 1024, 64 * kb, 32 * nb, F.ws + WS_WO, (size_t)32 * nb, 1024, W8_SCALE, scr, F.lane); continue; } r -= 16 * 32;
        if (transpose_matrix_item(r, a.in[11], 1024, 256, (u16*)(F.ws + WS_WR), scr, F.lane)) continue;
        if (r < 16 * 32) { const int kb = r / 32, nb = r % 32; transpose_item_f8(a.in[21], 1024, 64 * kb, 32 * nb, F.ws + WS_WPG, (size_t)32 * nb, 1024, W8_SCALE, scr, F.lane); continue; } r -= 16 * 32;
        transpose_matrix_item(r, a.in[22], 256, 1024, (u16*)(F.ws + WS_WPP), scr, F.lane);
    }
    const size_t gt = (size_t)F.vcu * NTHR + F.tid, NGT = (size_t)F.G * NTHR;
    { const f32x4* x4 = (const f32x4*)a.in[0]; u32x4* o4 = (u32x4*)(F.ws + WS_XB);
      static_assert(((size_t)T * D / 16) % ((size_t)256 * NTHR * 4) == 0, "x conversion unroll");
      for (size_t i = gt; i < (size_t)T * D / 16; i += 4 * NGT) { f32x4 p[4][4];
#pragma unroll
          for (int u = 0; u < 4; ++u)
#pragma unroll
              for (int k = 0; k < 4; ++k) p[u][k] = x4[4 * (i + u * NGT) + k];
          __builtin_amdgcn_sched_barrier(0);
#pragma unroll
          for (int u = 0; u < 4; ++u) { u32x4 w; w.x = pk_fp8x4(p[u][0][0], p[u][0][1], p[u][0][2], p[u][0][3]); w.y = pk_fp8x4(p[u][1][0], p[u][1][1], p[u][1][2], p[u][1][3]); w.z = pk_fp8x4(p[u][2][0], p[u][2][1], p[u][2][2], p[u][2][3]); w.w = pk_fp8x4(p[u][3][0], p[u][3][1], p[u][3][2], p[u][3][3]); o4[i + u * NGT] = w; } } }
    { float* rot = (float*)(F.ws + WS_ROT);
      for (size_t i = gt; i < (size_t)SEQ * 8; i += NGT) {
          const int pos = (int)(i >> 3), fi = (int)(i & 7);
          const double invf = fi == 0 ? 1.0 : fi == 1 ? 0.19392274474868576 : fi == 2 ? 0.03760603093086393 : fi == 3 ? 0.007292664737217109 : fi == 4 ? 0.001414213562373095 : fi == 5 ? 0.0002742481756762073 : fi == 6 ? 5.318295896944988e-05 : 1.031338537721246e-05;
          const double ang = (double)pos * invf; const double kq = __builtin_rint(ang * 0.6366197723675814); const double r = ang - kq * 1.5707963267948966; const double r2 = r * r;
          const double sn = r * (1.0 + r2 * (-1.0 / 6 + r2 * (1.0 / 120 + r2 * (-1.0 / 5040 + r2 * (1.0 / 362880 + r2 * (-1.0 / 39916800 + r2 * (1.0 / 6227020800.0)))))));
          const double cs = 1.0 + r2 * (-0.5 + r2 * (1.0 / 24 + r2 * (-1.0 / 720 + r2 * (1.0 / 40320 + r2 * (-1.0 / 3628800 + r2 * (1.0 / 479001600.0))))));
          const int qd = ((int)kq) & 3; const double s_ = qd == 0 ? sn : qd == 1 ? cs : qd == 2 ? -sn : -cs; const double c_ = qd == 0 ? cs : qd == 1 ? -sn : qd == 2 ? -cs : sn;
          rot[pos * 16 + fi] = (float)c_; rot[pos * 16 + 8 + fi] = (float)s_; } }
    { float* lb = (float*)(F.ws + WS_LB);
      for (size_t i = gt; i < 1024; i += NGT) { const int c = (int)(i & 511); const float* src = (i < 512) ? a.in[3] : a.in[4]; lb[i] = 1.0f / (1.0f + expf(src[512 + c] - src[c])); } }
}

__device__ __forceinline__ void hgrn_item(const Frame& F, int item) {
    const int b = item >> 3, h = (item >> 1) & 3, dir = item & 1;
    LAS float* fb = (LAS float*)F.lds; LAS float* kb = fb + 2048; LAS float* qb = kb + 2048; LAS float* vb = qb + 2048; LAS float* op = vb + 2048;
    const int tid = F.tid, v = tid & 127, eg = tid >> 7, ls = tid >> 5, lc = (tid & 31) * 4;
    const u16* QH = (const u16*)(F.ws + Z_QH); const u16* VH = (const u16*)(F.ws + Z_VH); const u16* LF = (const u16*)(F.ws + (dir ? Z_LFB : Z_LFF));
#if DBG_CHECK && !USE_NAIVE_HGRN
    u16* O = (u16*)(F.ws + WS_XB + (dir ? 64 * MiB : 0));
#else
    u16* O = (u16*)(F.dout + (dir ? DO_OB : DO_OF));
#endif
    float S[32];
#pragma unroll
    for (int j = 0; j < 32; ++j) S[j] = 0.f;
    const size_t rowbase = (size_t)b * SEQ, colbase = (size_t)h * 128;
    u32x2 rq, rv, rl;
    { const int pos = dir ? (SEQ - 1 - ls) : ls; const size_t o = (rowbase + pos) * 512 + colbase + lc; rq = *(const u32x2*)(QH + o); rv = *(const u32x2*)(VH + o); rl = *(const u32x2*)(LF + o); }
    for (int blk = 0; blk < SEQ / 16; ++blk) {
        { const f32x4 lb4 = *(const f32x4*)((const float*)(F.ws + WS_LB) + dir * 512 + h * 128 + lc);
          const f32x4 f = {lb4[0] + (1.f - lb4[0]) * sigmoidf_(bf_lo(rl.x)), lb4[1] + (1.f - lb4[1]) * sigmoidf_(bf_hi(rl.x)), lb4[2] + (1.f - lb4[2]) * sigmoidf_(bf_lo(rl.y)), lb4[3] + (1.f - lb4[3]) * sigmoidf_(bf_hi(rl.y))}; const f32x4 k = {1.f - f[0], 1.f - f[1], 1.f - f[2], 1.f - f[3]};
          *(LAS f32x4*)(fb + ls * 128 + lc) = f; *(LAS f32x4*)(kb + ls * 128 + lc) = k;
          { f32x4 qq = {bf_lo(rq.x), bf_hi(rq.x), bf_lo(rq.y), bf_hi(rq.y)};
#pragma unroll
            for (int j = 0; j < 4; ++j) qq[j] *= sigmoidf_(qq[j]);
            *(LAS f32x4*)(qb + ls * 128 + lc) = qq; }
          *(LAS f32x4*)(vb + ls * 128 + lc) = (f32x4){bf_lo(rv.x), bf_hi(rv.x), bf_lo(rv.y), bf_hi(rv.y)}; }
        __syncthreads();
        if (blk + 1 < SEQ / 16) { const int t = (blk + 1) * 16 + ls; const int pos = dir ? (SEQ - 1 - t) : t; const size_t o = (rowbase + pos) * 512 + colbase + lc; rq = *(const u32x2*)(QH + o); rv = *(const u32x2*)(VH + o); rl = *(const u32x2*)(LF + o); }
#pragma unroll 2
        for (int s = 0; s < 16; ++s) {
            const float vm = vb[s * 128 + v]; float ac = 0.f;
#pragma unroll
            for (int jj = 0; jj < 8; ++jj) {
                const f32x4 f4 = *(const LAS f32x4*)(fb + s * 128 + eg * 32 + 4 * jj), k4 = *(const LAS f32x4*)(kb + s * 128 + eg * 32 + 4 * jj), q4 = *(const LAS f32x4*)(qb + s * 128 + eg * 32 + 4 * jj);
#pragma unroll
                for (int j = 0; j < 4; ++j) { S[4 * jj + j] = f4[j] * S[4 * jj + j] + k4[j] * vm; ac += S[4 * jj + j] * q4[j]; }
            }
            op[(s * 4 + eg) * 128 + v] = ac;
        }
        __syncthreads();
        { const f32x4 o = *(const LAS f32x4*)(op + (ls * 4 + 0) * 128 + lc) + *(const LAS f32x4*)(op + (ls * 4 + 1) * 128 + lc) + *(const LAS f32x4*)(op + (ls * 4 + 2) * 128 + lc) + *(const LAS f32x4*)(op + (ls * 4 + 3) * 128 + lc);
          const int t = blk * 16 + ls; const int pos = dir ? (SEQ - 1 - t) : t; u32x2 w; w.x = cvt_pk_bf16(o[0], o[1]); w.y = cvt_pk_bf16(o[2], o[3]);
          *(u32x2*)(O + (rowbase + pos) * 512 + colbase + lc) = w; }
    }
    __syncthreads();
}

__device__ __forceinline__ void attn_naive(const Frame& F) {
    const int gw = F.vcu * NWAVES + F.wave, NGW = F.G * NWAVES, lane = F.lane;
    const u16* AQ = (const u16*)(F.ws + Z_AQ); const u16* AK = (const u16*)(F.ws + Z_AK); const u16* AV = (const u16*)(F.ws + Z_AV); u16* YA = (u16*)(F.ws + WS_YA);
    for (int wi = gw; wi < T * 4; wi += NGW) {
        const int row = wi >> 2, s = wi & 3, b = row >> 11, p = row & (SEQ - 1);
        float sc[3][3]; int lo_[3], hi_[3];
#pragma unroll
        for (int g = 0; g < 3; ++g) {
            const int sh = 2 * g, mlen = SEQ >> sh, r = p & ((1 << sh) - 1), m = p >> sh; const int lo = m - 64 < 0 ? 0 : m - 64, hi = m + 64 > mlen - 1 ? mlen - 1 : m + 64; lo_[g] = lo; hi_[g] = hi;
            const int hd = g * 4 + s;
            u32x4 qw[8];
            { const u32x4* qp = (const u32x4*)(AQ + (size_t)row * 768 + hd * 64);
#pragma unroll
              for (int c = 0; c < 8; ++c) qw[c] = qp[c]; }
#pragma unroll
            for (int rr = 0; rr < 3; ++rr) {
                const int j = lo + rr * 64 + lane; const bool valid = j <= hi; const int jc = valid ? j : hi;
                const u32x4* kp = (const u32x4*)(AK + ((size_t)b * SEQ + r + ((size_t)jc << sh)) * 768 + hd * 64);
                float d = 0.f;
#pragma unroll
                for (int c = 0; c < 8; ++c) { const u32x4 w = kp[c]; const u32x4 q = qw[c]; d += bf_lo(q.x) * bf_lo(w.x) + bf_hi(q.x) * bf_hi(w.x) + bf_lo(q.y) * bf_lo(w.y) + bf_hi(q.y) * bf_hi(w.y) + bf_lo(q.z) * bf_lo(w.z) + bf_hi(q.z) * bf_hi(w.z) + bf_lo(q.w) * bf_lo(w.w) + bf_hi(q.w) * bf_hi(w.w); }
                sc[g][rr] = valid ? d : -1e30f;
                asm volatile("" : "+v"(sc[g][rr]) :: "memory");
            }
        }
        float mx = -1e30f;
#pragma unroll
        for (int g = 0; g < 3; ++g)
#pragma unroll
            for (int rr = 0; rr < 3; ++rr) mx = fmaxf(mx, sc[g][rr]);
        mx = wave_max(mx);
        float den = 0.f;
#pragma unroll
        for (int g = 0; g < 3; ++g)
#pragma unroll
            for (int rr = 0; rr < 3; ++rr) { sc[g][rr] = sc[g][rr] > -1e29f ? __expf(sc[g][rr] - mx) : 0.f; den += sc[g][rr]; }
        den = wave_sum(den);
        float o = 0.f;
#pragma unroll
        for (int g = 0; g < 3; ++g) {
            const int sh = 2 * g, r = p & ((1 << sh) - 1), hd = g * 4 + s; const u16* vp = AV + ((size_t)b * SEQ + r) * 768 + hd * 64 + lane;
#pragma unroll
            for (int rr = 0; rr < 3; ++rr) {
                const int j0 = lo_[g] + rr * 64; int cnt = hi_[g] - j0 + 1; cnt = cnt > 64 ? 64 : cnt;
                const float e = sc[g][rr];
#pragma unroll 4
                for (int jj = 0; jj < cnt; ++jj) { const float pj = __uint_as_float(__builtin_amdgcn_readlane(__float_as_uint(e), jj)); o += pj * bf1(vp[((size_t)(j0 + jj) << sh) * 768]); }
            }
        }
        o = o / den;
        const float on = __shfl_down(o, 1);
        if ((lane & 1) == 0) *(unsigned*)(YA + (size_t)row * 256 + s * 64 + lane) = cvt_pk_bf16(o, on);
    }
}


typedef float f32x16 __attribute__((ext_vector_type(16)));
constexpr size_t DO_OP = 128 * MiB, DO_ML = 224 * MiB;
__device__ __forceinline__ bf16x8 pack_pt(const f32x16& x, const int s) {
    u32x4 p;
    asm volatile("v_cvt_pk_bf16_f32 %0, %4, %5\n\tv_cvt_pk_bf16_f32 %1, %6, %7\n\tv_cvt_pk_bf16_f32 %2, %8, %9\n\tv_cvt_pk_bf16_f32 %3, %10, %11\n\ts_nop 1"
                 : "=&v"(p[0]), "=&v"(p[1]), "=&v"(p[2]), "=&v"(p[3])
                 : "v"(x[8 * s]), "v"(x[8 * s + 1]), "v"(x[8 * s + 2]), "v"(x[8 * s + 3]), "v"(x[8 * s + 4]), "v"(x[8 * s + 5]), "v"(x[8 * s + 6]), "v"(x[8 * s + 7]));
    return __builtin_bit_cast(bf16x8, p);
}
__device__ __forceinline__ void attn_mfma(const Frame& F) {
    const int lane = F.lane, c = lane & 31, h = lane >> 5;
    LAS unsigned char* vbuf = F.lds + F.wave * 4608;
    const unsigned vb_addr = (unsigned)(size_t)vbuf;
    const u16* AQ = (const u16*)(F.ws + Z_AQ); const u16* AK = (const u16*)(F.ws + Z_AK); const u16* AV = (const u16*)(F.ws + Z_AV);
    u16* OP = (u16*)(F.dout + DO_OP); float* ML = (float*)(F.dout + DO_ML);
    const int gw = F.vcu * NWAVES + F.wave, NGW = F.G * NWAVES;
    const int blk = (lane >> 4) & 1, q4 = (lane & 15) >> 2, p4 = lane & 3;
    for (int it = gw; it < 32 * 12 * 64; it += NGW) {
        const int x = it & 63, bh = it >> 6, hd = bh % 12, b = bh / 12, g = hd >> 2, sh = 2 * g;
        const int nqb = 64 >> sh, r = x >> (6 - sh), qb = x & (nqb - 1), mlen = SEQ >> sh, m0 = qb * 32;
        const size_t rowb = (size_t)b * SEQ + r;
        const size_t qrow = rowb + ((size_t)(m0 + c) << sh);
        bf16x8 qf[4];
#pragma unroll
        for (int s = 0; s < 4; ++s) qf[s] = *(const bf16x8*)(AQ + qrow * 768 + hd * 64 + 16 * s + 8 * h);
        f32x16 st[5];
        bf16x8 kf[5][4];
#pragma unroll
        for (int kb = 0; kb < 5; ++kb) {
            int mk = m0 - 64 + 32 * kb + c; mk = mk < 0 ? 0 : (mk > mlen - 1 ? mlen - 1 : mk);
            const u16* kp = AK + (rowb + ((size_t)mk << sh)) * 768 + hd * 64 + 8 * h;
#pragma unroll
            for (int s = 0; s < 4; ++s) kf[kb][s] = *(const bf16x8*)(kp + 16 * s);
        }
        __builtin_amdgcn_sched_barrier(0);
#pragma unroll
        for (int kb = 0; kb < 5; ++kb) {
            f32x16 acc;
#pragma unroll
            for (int i = 0; i < 16; ++i) acc[i] = 0.f;
#pragma unroll
            for (int s = 0; s < 4; ++s) acc = __builtin_amdgcn_mfma_f32_32x32x16_bf16(kf[kb][s], qf[s], acc, 0, 0, 0);
            st[kb] = acc;
        }
        float mx = -1e30f;
#pragma unroll
        for (int kb = 0; kb < 5; ++kb)
#pragma unroll
            for (int i = 0; i < 16; ++i) { const int rel = 32 * kb - 64 + ((i & 3) + 8 * (i >> 2) + 4 * h) - c; const int key = m0 + c + rel; const bool valid = (key >= 0) && (key < mlen) && (rel >= -64) && (rel <= 64);
                const float v = valid ? st[kb][i] : -1e30f; st[kb][i] = v; mx = fmaxf(mx, v); }
        mx = fmaxf(mx, __shfl_xor(mx, 32));
        float l = 0.f;
#pragma unroll
        for (int kb = 0; kb < 5; ++kb)
#pragma unroll
            for (int i = 0; i < 16; ++i) { const float p = st[kb][i] > -1e29f ? __expf(st[kb][i] - mx) : 0.f; st[kb][i] = p; l += p; }
        l += __shfl_xor(l, 32);
        f32x16 y0, y1;
#pragma unroll
        for (int i = 0; i < 16; ++i) { y0[i] = 0.f; y1[i] = 0.f; }
        u32x4 vr[4];
#define LOADV(kb_) _Pragma("unroll") for (int i4 = 0; i4 < 4; ++i4) { const int row = (lane >> 3) + 8 * i4; int mk = m0 - 64 + 32 * (kb_) + row; mk = mk < 0 ? 0 : (mk > mlen - 1 ? mlen - 1 : mk); \
            vr[i4] = *(const u32x4*)(AV + (rowb + ((size_t)mk << sh)) * 768 + hd * 64 + (lane & 7) * 8); }
        LOADV(0)
#pragma unroll
        for (int kb = 0; kb < 5; ++kb) {
#pragma unroll
            for (int i4 = 0; i4 < 4; ++i4) { const int row = (lane >> 3) + 8 * i4; *(LAS u32x4*)(vbuf + row * 144 + (lane & 7) * 16) = vr[i4]; }
            if (kb < 4) { LOADV(kb + 1) }
            asm volatile("s_waitcnt lgkmcnt(0)" ::: "memory");
            u32x2 tq[2][4];
#pragma unroll
            for (int s = 0; s < 2; ++s) {
                const unsigned a0 = vb_addr + 144u * (unsigned)(16 * s + 4 * h + q4) + 2u * (unsigned)(16 * blk + 4 * p4);
                asm volatile("ds_read_b64_tr_b16 %0, %4\n\tds_read_b64_tr_b16 %1, %4 offset:1152\n\tds_read_b64_tr_b16 %2, %4 offset:64\n\tds_read_b64_tr_b16 %3, %4 offset:1216"
                             : "=&v"(tq[s][0]), "=&v"(tq[s][1]), "=&v"(tq[s][2]), "=&v"(tq[s][3]) : "v"(a0) : "memory");
            }
            asm volatile("s_waitcnt lgkmcnt(0)" : "+v"(tq[0][0]), "+v"(tq[0][1]), "+v"(tq[0][2]), "+v"(tq[0][3]), "+v"(tq[1][0]), "+v"(tq[1][1]), "+v"(tq[1][2]), "+v"(tq[1][3]) :: "memory");
#pragma unroll
            for (int s = 0; s < 2; ++s) {
                const bf16x8 xs = pack_pt(st[kb], s);
                u32x4 vv0, vv1; vv0.x = tq[s][0].x; vv0.y = tq[s][0].y; vv0.z = tq[s][1].x; vv0.w = tq[s][1].y; vv1.x = tq[s][2].x; vv1.y = tq[s][2].y; vv1.z = tq[s][3].x; vv1.w = tq[s][3].y;
                y0 = __builtin_amdgcn_mfma_f32_32x32x16_bf16(__builtin_bit_cast(bf16x8, vv0), xs, y0, 0, 0, 0);
                y1 = __builtin_amdgcn_mfma_f32_32x32x16_bf16(__builtin_bit_cast(bf16x8, vv1), xs, y1, 0, 0, 0);
            }
        }
#undef LOADV
        const float inv = 1.0f / l;
        u16* op = OP + qrow * 768 + hd * 64 + 4 * h;
#pragma unroll
        for (int gq = 0; gq < 4; ++gq) {
            u32x2 w0, w1; w0.x = cvt_pk_bf16(y0[4 * gq] * inv, y0[4 * gq + 1] * inv); w0.y = cvt_pk_bf16(y0[4 * gq + 2] * inv, y0[4 * gq + 3] * inv);
            w1.x = cvt_pk_bf16(y1[4 * gq] * inv, y1[4 * gq + 1] * inv); w1.y = cvt_pk_bf16(y1[4 * gq + 2] * inv, y1[4 * gq + 3] * inv);
            *(u32x2*)(op + 8 * gq) = w0; *(u32x2*)(op + 32 + 8 * gq) = w1; }
        if (h == 0) ML[qrow * 12 + hd] = mx + __logf(l);
    }
}


constexpr int HT_STRIDE = 272, HT_BYTES = 64 * HT_STRIDE;
constexpr int HL_QS = 0, HL_KS = HT_BYTES, HL_QIN = 2 * HT_BYTES, HL_KOUT = 3 * HT_BYTES, HL_V = 4 * HT_BYTES, HL_PSUM = 5 * HT_BYTES, HL_D = HL_PSUM + 4096;
#define TR2(dst0, dst1, addr, off1) asm volatile("ds_read_b64_tr_b16 %0, %2\n\tds_read_b64_tr_b16 %1, %2 offset:" #off1 "\n\ts_waitcnt lgkmcnt(0)" : "=&v"(dst0), "=&v"(dst1) : "v"(addr) : "memory")
#define TR2N(dst0, dst1, addr, off1) asm volatile("ds_read_b64_tr_b16 %0, %2\n\tds_read_b64_tr_b16 %1, %2 offset:" #off1 : "=&v"(dst0), "=&v"(dst1) : "v"(addr) : "memory")
#define TRW8(a0, a1, a2, a3, a4, a5, a6, a7) asm volatile("s_waitcnt lgkmcnt(0)" : "+v"(a0), "+v"(a1), "+v"(a2), "+v"(a3), "+v"(a4), "+v"(a5), "+v"(a6), "+v"(a7) :: "memory")
#define TRW4(a0, a1, a2, a3) asm volatile("s_waitcnt lgkmcnt(0)" : "+v"(a0), "+v"(a1), "+v"(a2), "+v"(a3) :: "memory")
__device__ __forceinline__ void hgrn_mfma_item(const Frame& F, int item, u16* OFp, u16* OBp) {
    const int b = item >> 3, hh = (item >> 1) & 3, dir = item & 1;
    const int tid = F.tid, lane = F.lane, wave = F.wave, vj = wave & 3, ci = wave >> 2, c = lane & 31, h = lane >> 5;
    const int blk = (lane >> 4) & 1, q4 = (lane & 15) >> 2, p4 = lane & 3;
    LAS unsigned char* L = F.lds; const unsigned Lb = (unsigned)(size_t)L;
    const int e2 = 2 * (tid & 63), part = tid >> 6;
    const u16* QH = (const u16*)(F.ws + Z_QH); const u16* VH = (const u16*)(F.ws + Z_VH); const u16* LF = (const u16*)(F.ws + (dir ? Z_LFB : Z_LFF));
    u16* O = dir ? OBp : OFp;
    const size_t rowbase = (size_t)b * SEQ, colbase = (size_t)hh * 128;
    f32x16 S[4];
#pragma unroll
    for (int et = 0; et < 4; ++et)
#pragma unroll
        for (int i = 0; i < 16; ++i) S[et][i] = 0.f;
    const f32x2 lbv = *(const f32x2*)((const float*)(F.ws + WS_LB) + dir * 512 + hh * 128 + e2);
    unsigned rq[8], rv[8], rl[8];
#pragma unroll
    for (int j = 0; j < 8; ++j) { const int tt = part * 8 + j; const int pos = dir ? (SEQ - 1 - tt) : tt; const size_t o = (rowbase + pos) * 512 + colbase + e2; rq[j] = *(const u16*)((const unsigned char*)QH + o); rv[j] = *(const u16*)((const unsigned char*)VH + o); rl[j] = *(const unsigned*)(LF + o); }
    for (int chunk = 0; chunk < SEQ / 64; ++chunk) {
        float bl0[8], bl1[8], fk0[8], fk1[8]; float r0 = 0.f, r1 = 0.f;
#pragma unroll
        for (int j = 0; j < 8; ++j) { const float f0 = lbv.x + (1.f - lbv.x) * sigmoidf_(bf_lo(rl[j])), f1 = lbv.y + (1.f - lbv.y) * sigmoidf_(bf_hi(rl[j])); fk0[j] = 1.f - f0; fk1[j] = 1.f - f1; r0 += __logf(f0); r1 += __logf(f1); bl0[j] = r0; bl1[j] = r1; }
        *(LAS f32x2*)(L + HL_PSUM + (part * 128 + e2) * 4) = (f32x2){r0, r1};
        __syncthreads();
        float offs0 = 0.f, offs1 = 0.f, bref0 = 0.f, bref1 = 0.f, blast0 = 0.f, blast1 = 0.f;
#pragma unroll
        for (int pp = 0; pp < 8; ++pp) { const f32x2 t = *(const LAS f32x2*)(L + HL_PSUM + (pp * 128 + e2) * 4); if (pp < part) { offs0 += t.x; offs1 += t.y; } if (pp < 4) { bref0 += t.x; bref1 += t.y; } blast0 += t.x; blast1 += t.y; }
        const float Cr0 = __expf(bref0), Cr1 = __expf(bref1), Cl0 = __expf(blast0 - bref0), Cl1 = __expf(blast1 - bref1);
        if (part == 0) *(LAS f32x2*)(L + HL_D + e2 * 4) = (f32x2){__expf(blast0), __expf(blast1)};
#pragma unroll
        for (int j = 0; j < 8; ++j) {
            const int t = part * 8 + j; const unsigned a = (unsigned)(t * HT_STRIDE + e2 * 2);
            const float E0 = __expf(offs0 + bl0[j] - bref0), E1 = __expf(offs1 + bl1[j] - bref1); const float R0 = __builtin_amdgcn_rcpf(E0), R1 = __builtin_amdgcn_rcpf(E1);
            const f32x2_t qq_ = __builtin_amdgcn_cvt_pk_f32_fp8((int)rq[j], false), vv_ = __builtin_amdgcn_cvt_pk_f32_fp8((int)rv[j], false);
            float q0 = qq_.x, q1 = qq_.y; q0 *= sigmoidf_(q0); q1 *= sigmoidf_(q1); const float k0 = fk0[j], k1 = fk1[j];
            *(LAS unsigned*)(L + HL_QS + a) = cvt_pk_bf16(q0 * E0, q1 * E1);
            *(LAS unsigned*)(L + HL_KS + a) = cvt_pk_bf16(k0 * R0, k1 * R1);
            *(LAS unsigned*)(L + HL_QIN + a) = cvt_pk_bf16(q0 * E0 * Cr0, q1 * E1 * Cr1);
            *(LAS unsigned*)(L + HL_KOUT + a) = cvt_pk_bf16(k0 * R0 * Cl0, k1 * R1 * Cl1);
            *(LAS unsigned*)(L + HL_V + a) = cvt_pk_bf16(vv_.x, vv_.y);
        }
        __syncthreads();
        if (chunk + 1 < SEQ / 64) {
#pragma unroll
            for (int j = 0; j < 8; ++j) { const int tt = (chunk + 1) * 64 + part * 8 + j; const int pos = dir ? (SEQ - 1 - tt) : tt; const size_t o = (rowbase + pos) * 512 + colbase + e2; rq[j] = *(const u16*)((const unsigned char*)QH + o); rv[j] = *(const u16*)((const unsigned char*)VH + o); rl[j] = *(const unsigned*)(LF + o); }
        }
        f32x16 z;
#pragma unroll
        for (int i = 0; i < 16; ++i) z[i] = 0.f;
        { u32x4 qb[4][2];
#pragma unroll
          for (int et = 0; et < 4; ++et)
#pragma unroll
            for (int st = 0; st < 2; ++st) { const LAS unsigned char* qp = L + HL_QIN + (32 * ci + c) * HT_STRIDE + (32 * et + 16 * st + 4 * h) * 2;
                const u32x2 lo = *(const LAS u32x2*)qp, hi = *(const LAS u32x2*)(qp + 16); qb[et][st].x = lo.x; qb[et][st].y = lo.y; qb[et][st].z = hi.x; qb[et][st].w = hi.y; }
          __builtin_amdgcn_sched_barrier(0);
#pragma unroll
          for (int et = 0; et < 4; ++et)
#pragma unroll
            for (int st = 0; st < 2; ++st) { const bf16x8 A = pack_pt(S[et], st); z = __builtin_amdgcn_mfma_f32_32x32x16_bf16(A, __builtin_bit_cast(bf16x8, qb[et][st]), z, 0, 0, 0); } }
#pragma unroll
        for (int stile = 0; stile < 2; ++stile) {
            if (stile <= ci) {
                f32x16 pt;
#pragma unroll
                for (int i = 0; i < 16; ++i) pt[i] = 0.f;
#pragma unroll
                for (int e4 = 0; e4 < 8; e4 += 4) { bf16x8 Af[4], Bf[4];
#pragma unroll
                    for (int k = 0; k < 4; ++k) { Af[k] = *(const LAS bf16x8*)(L + HL_KS + (32 * stile + c) * HT_STRIDE + (16 * (e4 + k) + 8 * h) * 2);
                        Bf[k] = *(const LAS bf16x8*)(L + HL_QS + (32 * ci + c) * HT_STRIDE + (16 * (e4 + k) + 8 * h) * 2); }
                    __builtin_amdgcn_sched_barrier(0);
#pragma unroll
                    for (int k = 0; k < 4; ++k) pt = __builtin_amdgcn_mfma_f32_32x32x16_bf16(Af[k], Bf[k], pt, 0, 0, 0);
                }
#pragma unroll
                for (int i = 0; i < 16; ++i) { const int srow = 32 * stile + (i & 3) + 8 * (i >> 2) + 4 * h; pt[i] = (srow <= 32 * ci + c) ? pt[i] : 0.f; }
                { u32x2 t0[2], t1[2];
#pragma unroll
                  for (int st = 0; st < 2; ++st) { const unsigned a0 = Lb + HL_V + (unsigned)((32 * stile + 16 * st + 4 * h + q4) * HT_STRIDE + (32 * vj + 16 * blk + 4 * p4) * 2);
                      TR2N(t0[st], t1[st], a0, 2176); }
                  TRW4(t0[0], t1[0], t0[1], t1[1]);
#pragma unroll
                  for (int st = 0; st < 2; ++st) { const bf16x8 Bp = pack_pt(pt, st);
                      u32x4 av; av.x = t0[st].x; av.y = t0[st].y; av.z = t1[st].x; av.w = t1[st].y;
                      z = __builtin_amdgcn_mfma_f32_32x32x16_bf16(__builtin_bit_cast(bf16x8, av), Bp, z, 0, 0, 0); } }
            }
        }
        { const int tt = chunk * 64 + 32 * ci + c; const int pos = dir ? (SEQ - 1 - tt) : tt; u16* op = O + (rowbase + pos) * 512 + colbase + 32 * vj + 4 * h;
#pragma unroll
          for (int gq = 0; gq < 4; ++gq) { u32x2 w; w.x = cvt_pk_bf16(z[4 * gq], z[4 * gq + 1]); w.y = cvt_pk_bf16(z[4 * gq + 2], z[4 * gq + 3]); *(u32x2*)(op + 8 * gq) = w; } }
        bf16x8 Vb[4];
        { u32x2 t0[4], t1[4];
#pragma unroll
          for (int tk = 0; tk < 4; ++tk) { const unsigned a0 = Lb + HL_V + (unsigned)((16 * tk + 8 * h + q4) * HT_STRIDE + (32 * vj + 16 * blk + 4 * p4) * 2);
              TR2N(t0[tk], t1[tk], a0, 1088); }
          TRW8(t0[0], t1[0], t0[1], t1[1], t0[2], t1[2], t0[3], t1[3]);
#pragma unroll
          for (int tk = 0; tk < 4; ++tk) { u32x4 bv; bv.x = t0[tk].x; bv.y = t0[tk].y; bv.z = t1[tk].x; bv.w = t1[tk].y; Vb[tk] = __builtin_bit_cast(bf16x8, bv); } }
#pragma unroll
        for (int et = 0; et < 4; ++et) {
#pragma unroll
            for (int gq = 0; gq < 4; ++gq) { const f32x4 dv = *(const LAS f32x4*)(L + HL_D + (32 * et + 8 * gq + 4 * h) * 4);
#pragma unroll
                for (int e = 0; e < 4; ++e) S[et][4 * gq + e] *= dv[e]; }
            { u32x2 t0[4], t1[4];
#pragma unroll
              for (int tk = 0; tk < 4; ++tk) { const unsigned a0 = Lb + HL_KOUT + (unsigned)((16 * tk + 8 * h + q4) * HT_STRIDE + (32 * et + 16 * blk + 4 * p4) * 2);
                  TR2N(t0[tk], t1[tk], a0, 1088); }
              TRW8(t0[0], t1[0], t0[1], t1[1], t0[2], t1[2], t0[3], t1[3]);
#pragma unroll
              for (int tk = 0; tk < 4; ++tk) { u32x4 ak; ak.x = t0[tk].x; ak.y = t0[tk].y; ak.z = t1[tk].x; ak.w = t1[tk].y;
                  S[et] = __builtin_amdgcn_mfma_f32_32x32x16_bf16(__builtin_bit_cast(bf16x8, ak), Vb[tk], S[et], 0, 0, 0); } }
        }
    }
    __syncthreads();
}

__device__ __forceinline__ void phase_hg_combine(const Frame& F, const Args& a) {
    const int gw = F.vcu * NWAVES + F.wave, NGW = F.G * NWAVES, lane = F.lane;
    const u16* OF = (const u16*)(F.dout + DO_OF); const u16* OB = (const u16*)(F.dout + DO_OB); const u16* GS = (const u16*)(F.ws + Z_GS); u16* YH = (u16*)(F.ws + WS_YH);
    const u16* OP = (const u16*)(F.dout + DO_OP); const float* ML = (const float*)(F.dout + DO_ML); u16* YA = (u16*)(F.ws + WS_YA);
    const f32x4 ng0 = *(const f32x4*)(a.in[5] + 8 * lane), ng1 = *(const f32x4*)(a.in[5] + 8 * lane + 4);
    const int sl = lane >> 4, dd = (4 * lane) & 63;
    constexpr int NR = 4;
    for (int row0 = gw; row0 < T; row0 += NR * NGW) {
        u32x4 fv[NR], bv[NR]; u32x2 gv[NR], av[NR][3]; float lv[NR][3];
#pragma unroll
        for (int r = 0; r < NR; ++r) { const int row = row0 + r * NGW; const size_t o = (size_t)row * 512 + 8 * lane;
            fv[r] = *(const u32x4*)(OF + o); bv[r] = *(const u32x4*)(OB + o); gv[r] = *(const u32x2*)((const unsigned char*)GS + o);
#pragma unroll
            for (int k = 0; k < 3; ++k) { lv[r][k] = ML[(size_t)row * 12 + 4 * k + sl]; av[r][k] = *(const u32x2*)(OP + (size_t)row * 768 + (4 * k + sl) * 64 + dd); } }
        __builtin_amdgcn_sched_barrier(0);
#pragma unroll
        for (int r = 0; r < NR; ++r) { const int row = row0 + r * NGW; const size_t o = (size_t)row * 512 + 8 * lane;
            const u32x4 f = fv[r], bq = bv[r]; const u32x2 g = gv[r];
            float v[8] = {bf_lo(f.x) + bf_lo(bq.x), bf_hi(f.x) + bf_hi(bq.x), bf_lo(f.y) + bf_lo(bq.y), bf_hi(f.y) + bf_hi(bq.y), bf_lo(f.z) + bf_lo(bq.z), bf_hi(f.z) + bf_hi(bq.z), bf_lo(f.w) + bf_lo(bq.w), bf_hi(f.w) + bf_hi(bq.w)};
            float ss = 0.f;
#pragma unroll
            for (int j = 0; j < 8; ++j) ss += v[j] * v[j];
            ss += __int_as_float(__builtin_amdgcn_update_dpp(0, __float_as_int(ss), 0xB1, 0xF, 0xF, true)); ss += __int_as_float(__builtin_amdgcn_update_dpp(0, __float_as_int(ss), 0x4E, 0xF, 0xF, true));
            ss += __int_as_float(__builtin_amdgcn_update_dpp(0, __float_as_int(ss), 0x141, 0xF, 0xF, true)); ss += __int_as_float(__builtin_amdgcn_update_dpp(0, __float_as_int(ss), 0x140, 0xF, 0xF, true));
            const float rs = 1.0f / sqrtf(ss * (1.f / 128.f) + LN_EPS);
            float gg[8]; { float t0[4], t1[4]; fp8x4_to_f32(g.x, t0); fp8x4_to_f32(g.y, t1);
#pragma unroll
              for (int j = 0; j < 4; ++j) { gg[j] = t0[j]; gg[4 + j] = t1[j]; } }
#pragma unroll
            for (int j = 0; j < 8; ++j) gg[j] *= sigmoidf_(gg[j]);
            u32x2 w; w.x = pk_fp8x4(v[0] * rs * ng0[0] * gg[0], v[1] * rs * ng0[1] * gg[1], v[2] * rs * ng0[2] * gg[2], v[3] * rs * ng0[3] * gg[3]);
            w.y = pk_fp8x4(v[4] * rs * ng1[0] * gg[4], v[5] * rs * ng1[1] * gg[5], v[6] * rs * ng1[2] * gg[6], v[7] * rs * ng1[3] * gg[7]);
            *(u32x2*)((unsigned char*)YH + o) = w;
            const float l0 = lv[r][0], l1 = lv[r][1], l2 = lv[r][2];
            const float lm = fmaxf(l0, fmaxf(l1, l2)); float w0 = __expf(l0 - lm), w1 = __expf(l1 - lm), w2 = __expf(l2 - lm); const float ws_ = 1.0f / (w0 + w1 + w2); w0 *= ws_; w1 *= ws_; w2 *= ws_;
            const u32x2 a0 = av[r][0], a1 = av[r][1], a2 = av[r][2];
            const unsigned wv = pk_fp8x4(w0 * bf_lo(a0.x) + w1 * bf_lo(a1.x) + w2 * bf_lo(a2.x), w0 * bf_hi(a0.x) + w1 * bf_hi(a1.x) + w2 * bf_hi(a2.x), w0 * bf_lo(a0.y) + w1 * bf_lo(a1.y) + w2 * bf_lo(a2.y), w0 * bf_hi(a0.y) + w1 * bf_hi(a1.y) + w2 * bf_hi(a2.y));
            *(unsigned*)((unsigned char*)YA + (size_t)row * 256 + 4 * lane) = wv;
        }
    }
}

template <bool DO_LN, bool DO_CONV> __device__ __forceinline__ void phase_ln1_convert(const Frame& F, const Args& a, int part = 0, int nparts = 1) {
    const int gw = F.vcu * NWAVES + F.wave, NGW = F.G * NWAVES;
    const float* X1 = (const float*)(F.ws + WS_X1PRE); u16* X1B = (u16*)(F.ws + WS_XB);
    if constexpr (DO_LN)
    for (int row = gw; row < T; row += 4 * NGW) ln_rows<true, 4, true>(X1, (size_t)row, (size_t)NGW, a.in[9], a.in[10], X1B, F.lane, F.ws + WS_X1F8);
    if constexpr (!DO_CONV) return;
    LAS float* scr = (LAS float*)(F.lds + F.wave * 16384);
    unsigned char* WGU = F.ws + WS_WGU; unsigned char* WD = F.ws + WS_WD;
    constexpr int PER_E = 384, NIT = 257 * PER_E;
    const int lane = F.lane;
#define CV_DECODE(it_, sp_, ldw_, dp_, kd_) { const int e = (it_) / PER_E, r = (it_) % PER_E; const int which = r >> 7, q = r & 127; \
        if (which < 2) { const float* src = (e < 256) ? a.in[13 + which] + (size_t)e * 1024 * 256 : a.in[16 + which]; const int kb = q >> 3, nb = q & 7; ldw_ = 256; kd_ = 1024; \
            sp_ = src + (size_t)(64 * kb + (lane >> 5)) * 256 + 32 * nb + (lane & 31); dp_ = WGU + ((size_t)e * 512 + (nb >> 2) * 256 + which * 128 + (nb & 3) * 32) * 1024 + 64 * kb; } \
        else { const float* src = (e < 256) ? a.in[15] + (size_t)e * 256 * 1024 : a.in[18]; const int kb = q >> 5, nb = q & 31; ldw_ = 1024; kd_ = 256; \
            sp_ = src + (size_t)(64 * kb + (lane >> 5)) * 1024 + 32 * nb + (lane & 31); dp_ = WD + ((size_t)e * 1024 + 32 * nb) * 256 + 64 * kb; } }
#define CV_LOAD(tv_, sp_, ldw_) { _Pragma("unroll") for (int i = 0; i < 32; ++i) tv_[i] = sp_[(size_t)(2 * i) * ldw_]; }
#define CV_FINISH(tv_, dp_, kd_) { _Pragma("unroll") for (int i = 0; i < 32; ++i) scr[(2 * i + (lane >> 5)) * 33 + (lane & 31)] = tv_[i]; \
        LDS_WAIT(); asm volatile("" ::: "memory"); const int c = lane & 7; \
        _Pragma("unroll") for (int j = 0; j < 4; ++j) { const int n = (lane >> 3) + 8 * j; const LAS float* sp = scr + (8 * c) * 33 + n; \
            u32x2 o; o.x = pk_fp8x4(sp[0 * 33] * W8_SCALE, sp[1 * 33] * W8_SCALE, sp[2 * 33] * W8_SCALE, sp[3 * 33] * W8_SCALE); o.y = pk_fp8x4(sp[4 * 33] * W8_SCALE, sp[5 * 33] * W8_SCALE, sp[6 * 33] * W8_SCALE, sp[7 * 33] * W8_SCALE); \
            *(u32x2*)(dp_ + (size_t)n * kd_ + 8 * c) = o; } \
        LDS_WAIT(); asm volatile("" ::: "memory"); }
    float tva[32], tvb[32]; const float* spa = nullptr; const float* spb = nullptr; unsigned char* dpa = nullptr; unsigned char* dpb = nullptr; int lda = 0, ldb = 0, kda = 0, kdb = 0;
    const int step = nparts * NGW; int it = gw + part * NGW;
    if (it < NIT) { CV_DECODE(it, spa, lda, dpa, kda) CV_LOAD(tva, spa, lda) }
    for (; it < NIT; it += 2 * step) {
        const bool hb = it + step < NIT, ha = it + 2 * step < NIT;
        if (hb) { CV_DECODE(it + step, spb, ldb, dpb, kdb) CV_LOAD(tvb, spb, ldb) }
        CV_FINISH(tva, dpa, kda)
        if (ha) { CV_DECODE(it + 2 * step, spa, lda, dpa, kda) CV_LOAD(tva, spa, lda) }
        if (hb) CV_FINISH(tvb, dpb, kdb)
    }
#undef CV_DECODE
#undef CV_LOAD
#undef CV_FINISH
}

__device__ __forceinline__ void phase_topk(const Frame& F, const Args& a) {
    LAS int* hist = (LAS int*)F.lds;
    for (int i = F.tid; i < 8 * 256; i += NTHR) hist[i] = 0;
    __syncthreads();
    const int w = F.vcu, lane = F.lane;
    const float* logits = (const float*)(F.ws + WS_LOGITS); u16* tok_e = (u16*)(F.ws + WS_TOKE); u16* tok_r = (u16*)(F.ws + WS_TOKR); float* tok_g = (float*)(F.ws + WS_TOKG);
    const f32x4 bs = *(const f32x4*)(a.in[12] + 4 * lane);
    constexpr int TB = 4;
    for (int i0 = 0; i0 < 32; i0 += TB) {
        float s0[TB], s1[TB], s2[TB], s3[TB], v0[TB], v1[TB], v2[TB], v3[TB], my_s[TB]; int my_e[TB];
        const float NINF = -__builtin_inff();
        { float b0[TB], b1[TB], b2[TB], b3[TB], m1[TB], m2[TB], gs[TB]; int rank[TB];
#pragma unroll
          for (int u = 0; u < TB; ++u) { const int t = w * 256 + F.wave * 32 + i0 + u; const f32x4 lg = *(const f32x4*)(logits + (size_t)t * 256 + 4 * lane);
              s0[u] = sigmoidf_(lg[0]); s1[u] = sigmoidf_(lg[1]); s2[u] = sigmoidf_(lg[2]); s3[u] = sigmoidf_(lg[3]);
              b0[u] = s0[u] + bs[0]; b1[u] = s1[u] + bs[1]; b2[u] = s2[u] + bs[2]; b3[u] = s3[u] + bs[3];
              const float h01 = fmaxf(b0[u], b1[u]), l01 = fminf(b0[u], b1[u]), h23 = fmaxf(b2[u], b3[u]), l23 = fminf(b2[u], b3[u]);
              m1[u] = fmaxf(h01, h23); m2[u] = fmaxf(fminf(h01, h23), fmaxf(l01, l23)); }
#define TOP2_STEP(CTRL) _Pragma("unroll") for (int u = 0; u < TB; ++u) { const float p1 = dpp_f<CTRL>(m1[u]), p2 = dpp_f<CTRL>(m2[u]); const float n1 = fmaxf(m1[u], p1), n2 = fmaxf(fminf(m1[u], p1), fmaxf(m2[u], p2)); m1[u] = n1; m2[u] = n2; }
          TOP2_STEP(0xB1) TOP2_STEP(0x4E) TOP2_STEP(0x141)
#undef TOP2_STEP
          const int mygroup = lane >> 3;
#pragma unroll
          for (int u = 0; u < TB; ++u) { gs[u] = m1[u] + m2[u]; rank[u] = 0; }
#pragma unroll
          for (int j = 0; j < 8; ++j)
#pragma unroll
              for (int u = 0; u < TB; ++u) { const float gj = rdlane_f(gs[u], 8 * j); rank[u] += (gj > gs[u] || (gj == gs[u] && j < mygroup)) ? 1 : 0; }
#pragma unroll
          for (int u = 0; u < TB; ++u) { const bool sel = rank[u] < 4; v0[u] = sel ? b0[u] : NINF; v1[u] = sel ? b1[u] : NINF; v2[u] = sel ? b2[u] : NINF; v3[u] = sel ? b3[u] : NINF; my_e[u] = 0; my_s[u] = 0.f; } }
#pragma unroll
        for (int k = 0; k < 8; ++k) {
            float bv[TB]; int bi[TB];
#pragma unroll
            for (int u = 0; u < TB; ++u) { bv[u] = v0[u]; bi[u] = 4 * lane;
                if (v1[u] > bv[u]) { bv[u] = v1[u]; bi[u] = 4 * lane + 1; }
                if (v2[u] > bv[u]) { bv[u] = v2[u]; bi[u] = 4 * lane + 2; }
                if (v3[u] > bv[u]) { bv[u] = v3[u]; bi[u] = 4 * lane + 3; } }
#define AMX_STEP(CTRL) _Pragma("unroll") for (int u = 0; u < TB; ++u) { const float ov = dpp_f<CTRL>(bv[u]); const int oi = dpp_i<CTRL>(bi[u]); if (ov > bv[u] || (ov == bv[u] && oi < bi[u])) { bv[u] = ov; bi[u] = oi; } }
            AMX_STEP(0xB1) AMX_STEP(0x4E) AMX_STEP(0x141) AMX_STEP(0x140)
#undef AMX_STEP
#pragma unroll
            for (int u = 0; u < TB; ++u) { float fv = rdlane_f(bv[u], 0); int fi = __builtin_amdgcn_readlane(bi[u], 0);
#pragma unroll
                for (int rw = 1; rw < 4; ++rw) { const float ov = rdlane_f(bv[u], 16 * rw); const int oi = __builtin_amdgcn_readlane(bi[u], 16 * rw); if (ov > fv || (ov == fv && oi < fi)) { fv = ov; fi = oi; } }
                bv[u] = fv; bi[u] = fi; }
#pragma unroll
            for (int u = 0; u < TB; ++u) { const int owner = bi[u] >> 2, wi = bi[u] & 3;
                const float cand = wi == 0 ? s0[u] : wi == 1 ? s1[u] : wi == 2 ? s2[u] : s3[u];
                const float sk = rdlane_f(cand, owner);
                if (lane == owner) { if (wi == 0) v0[u] = NINF; else if (wi == 1) v1[u] = NINF; else if (wi == 2) v2[u] = NINF; else v3[u] = NINF; }
                if (lane == k) { my_e[u] = bi[u]; my_s[u] = sk; } }
        }
#pragma unroll
        for (int u = 0; u < TB; ++u) { const int t = w * 256 + F.wave * 32 + i0 + u;
            float sum = (lane < 8) ? my_s[u] : 0.f; sum += dpp_f<0xB1>(sum); sum += dpp_f<0x4E>(sum); sum += dpp_f<0x141>(sum);
            if (lane < 8) { const int rk = hist[F.wave * 256 + my_e[u]]; hist[F.wave * 256 + my_e[u]] = rk + 1; tok_e[(size_t)t * 8 + lane] = (u16)my_e[u]; tok_r[(size_t)t * 8 + lane] = (u16)rk; tok_g[(size_t)t * 8 + lane] = my_s[u] / sum * 2.5f; } }
    }
    __syncthreads();
    if (F.tid < 256) { int run = 0;
#pragma unroll
        for (int wv = 0; wv < 8; ++wv) { const int h = hist[wv * 256 + F.tid]; hist[wv * 256 + F.tid] = run; run += h; }
        ((int*)(F.ws + WS_HIST))[w * 256 + F.tid] = run; }
    __syncthreads();
    for (int i = 0; i < 32; ++i) { const int t = w * 256 + F.wave * 32 + i; if (lane < 8) { const int e = tok_e[(size_t)t * 8 + lane]; tok_r[(size_t)t * 8 + lane] = (u16)(tok_r[(size_t)t * 8 + lane] + hist[F.wave * 256 + e]); } }
    __syncthreads();
}

__device__ __forceinline__ void phase_sort(const Frame& F) {
    LAS int* start = (LAS int*)F.lds; LAS int* base = start + 260; LAS int* tot = base + 260; LAS int* pad = tot + 260; LAS int* dbase = pad + 260;
    const int w = F.vcu, qd = w / WPC, wl = w % WPC, tid = F.tid;
    const int* hist = (const int*)(F.ws + WS_HIST);
    int mytot = 0, mypre = 0;
    if (tid < 256) {
        for (int w2 = qd * WPC; w2 < qd * WPC + WPC; ++w2) { const int h = hist[w2 * 256 + tid]; mytot += h; mypre += (w2 < w) ? h : 0; }
        tot[tid] = mytot; pad[tid] = (mytot + 255) & ~255;
    }
    __syncthreads();
    if (tid == 0) { int s = 0, d = 0; for (int e = 0; e < 256; ++e) { start[e] = s; s += pad[e]; dbase[e] = d; d += tot[e]; } start[256] = s; }
    __syncthreads();
    if (tid < 256) { base[tid] = start[tid] + mypre; dbase[tid] += mypre; }
    __syncthreads();
    int* stok = (int*)(F.ws + WS_STOK) + (size_t)qd * QTILES * 256; float* sgate = (float*)(F.ws + WS_SGATE) + (size_t)qd * QTILES * 256; int* sdst = (int*)(F.ws + WS_SDST) + (size_t)qd * QTILES * 256;
    int* tile_e = (int*)(F.ws + WS_TILEE) + qd * QTILES;
    const u16* tok_e = (const u16*)(F.ws + WS_TOKE); const u16* tok_r = (const u16*)(F.ws + WS_TOKR); const float* tok_g = (const float*)(F.ws + WS_TOKG);
    for (int aidx = tid; aidx < 2048; aidx += NTHR) {
        const int t = w * 256 + (aidx >> 3), k = aidx & 7; const int e = tok_e[(size_t)t * 8 + k], rk = tok_r[(size_t)t * 8 + k];
        const int slot = base[e] + rk, dn = dbase[e] + rk; stok[slot] = t; sgate[slot] = tok_g[(size_t)t * 8 + k]; sdst[slot] = dn; ((int*)(F.ws + WS_TOKD))[(size_t)t * 8 + k] = dn;
    }
    const int ssh = start[256];
    if (tid < 256) { const int t = w * 256 + tid; const int slot = ssh + (t - qd * TQ); stok[slot] = t; sgate[slot] = 1.0f; sdst[slot] = TQ * 8 + (t - qd * TQ); }
    if (tid < 256 && (tid % WPC) == wl) {
        const int e = tid; const int s0 = start[e], n = tot[e], np = pad[e];
        for (int j = n; j < np; ++j) { stok[s0 + j] = qd * TQ; sgate[s0 + j] = 0.f; sdst[s0 + j] = TQ * NSLOT; }
        for (int tl = s0 >> 8; tl < (s0 + np) >> 8; ++tl) tile_e[tl] = e;
    }
    if (wl == 0 && tid < TQ / 256) tile_e[(ssh >> 8) + tid] = 256;
    if (wl == 0 && tid == 0) ((int*)(F.ws + WS_NTILES))[qd] = (ssh >> 8) + TQ / 256;
    __syncthreads();
}


constexpr int DN_ROWP = 80, DN_PLANE = 256 * DN_ROWP;
__device__ __forceinline__ void moe_down_phase(const Frame& F, int qd) {
    unsigned char* ws = F.ws; LAS unsigned char* L = F.lds; const int tid = F.tid, lane = F.lane, wave = F.wave, i16 = lane & 15, q = lane >> 4;
    const int ntiles = __builtin_amdgcn_readfirstlane(((const int*)(ws + WS_NTILES))[qd]);
    const int* tile_e = (const int*)(ws + WS_TILEE) + qd * QTILES;
    LAS int* estart = (LAS int*)(L + 4 * DN_PLANE);
    LAS int* te = estart + 512;
    for (int i = tid; i < ntiles; i += NTHR) te[i] = tile_e[i];
    __syncthreads();
    if (tid < 258) { int lo = 0, hi = ntiles; while (lo < hi) { const int mid = (lo + hi) >> 1; if (te[mid] < tid) lo = mid + 1; else hi = mid; } estart[tid] = lo; }
    __syncthreads();
    const long U = (long)ntiles * 4; const int u0 = (int)((long)F.vcu * U / F.G), u1 = (int)((long)(F.vcu + 1) * U / F.G);
    const unsigned char* H8 = ws + WS_H; const unsigned char* WD8 = ws + WS_WD; unsigned char* YS = ws + WS_YS;
    const int* sdst = (const int*)(ws + WS_SDST) + (size_t)qd * QTILES * 256; const float* sgate = (const float*)(ws + WS_SGATE) + (size_t)qd * QTILES * 256;
    int sc1; asm volatile("v_mov_b32 %0, 0x7f7f7f7f" : "=v"(sc1));
    int cur_key = -1, e = 0;
#define DN_DECODE(u_, e_, pn_, tile_) { while (4 * estart[e_ + 1] <= (u_)) ++e_; const int ts_ = estart[e_], nte_ = estart[e_ + 1] - ts_, r_ = (u_) - 4 * ts_; pn_ = r_ / nte_; tile_ = ts_ + r_ % nte_; }
#define DN_LOADA(dst, tile_) { const size_t row0_ = (size_t)(tile_) * 256 + wave * 32; \
        _Pragma("unroll") for (int rg = 0; rg < 2; ++rg) { _Pragma("unroll") for (int ks = 0; ks < 2; ++ks) { const unsigned char* ap = H8 + (row0_ + 16 * rg + i16) * 256 + 128 * ks + 32 * q; const i32x4 lo = *(const i32x4*)ap, hi = *(const i32x4*)(ap + 16); dst[rg][ks] = __builtin_shufflevector(lo, hi, 0, 1, 2, 3, 4, 5, 6, 7); } \
            } }
#define DN_LOADN(tile_) { const size_t row0_ = (size_t)(tile_) * 256 + wave * 32; \
        _Pragma("unroll") for (int rg = 0; rg < 2; ++rg) { _Pragma("unroll") for (int ks = 0; ks < 2; ++ks) { const unsigned char* ap = H8 + (row0_ + 16 * rg + i16) * 256 + 128 * ks + 32 * q; \
            asm volatile("global_load_dwordx4 %0, %2, off\n\tglobal_load_dwordx4 %1, %2, off offset:16" : "=&v"(nl[rg][ks]), "=&v"(nh[rg][ks]) : "v"(ap) : "memory"); } \
            { const size_t rr_ = row0_ + 16 * rg + i16; const int* dp_ = sdst + rr_; const float* gp_ = sgate + rr_; \
              asm volatile("global_load_dword %0, %2, off\n\tglobal_load_dword %1, %3, off" : "=&v"(ndd[rg]), "=&v"(ngg[rg]) : "v"(dp_), "v"(gp_) : "memory"); } } }
    i32x8 af[2][2]; i32x4 nl[2][2] = {}, nh[2][2] = {}; unsigned ndd[2] = {0u, 0u}; float ngg[2] = {0.f, 0.f};
    unsigned dd[2] = {0u, 0u}; float gg[2] = {0.f, 0.f};
    int pn = 0, tile = 0, en = 0, pnn = 0, tilen = 0;
    if (u0 < u1) { DN_DECODE(u0, e, pn, tile) DN_LOADA(af, tile) en = e;
#pragma unroll
        for (int rg = 0; rg < 2; ++rg) { const size_t rr = (size_t)tile * 256 + wave * 32 + 16 * rg + i16; dd[rg] = (unsigned)sdst[rr]; gg[rg] = sgate[rr] * (Y8_SCALE / (W8_SCALE * H8_SCALE)); }
        asm volatile("" : "+v"(af[0][0]), "+v"(af[0][1]), "+v"(af[1][0]), "+v"(af[1][1]), "+v"(dd[0]), "+v"(dd[1]), "+v"(gg[0]), "+v"(gg[1]));
    }
    for (int u = u0; u < u1; ++u) {
        const int key = e * 4 + pn;
        if (key != cur_key) {
            __syncthreads();
            const unsigned char* src = WD8 + ((size_t)e * 1024 + (size_t)pn * 256) * 256;
#pragma unroll
            for (int j = 0; j < 8; ++j) { const int p = tid + NTHR * j, rho = p >> 4, c = p & 15; const int n = (rho & ~63) + 16 * ((rho & 15) >> 2) + 4 * ((rho >> 4) & 3) + (rho & 3);
                *(LAS u32x4*)(L + ((c >> 1) & 3) * DN_PLANE + rho * DN_ROWP + (c >> 3) * 32 + (c & 1) * 16) = *(const u32x4*)(src + (size_t)n * 256 + 16 * c); }
            __syncthreads();
            cur_key = key;
        }
        const bool more = u + 1 < u1;
        if (more) { DN_DECODE(u + 1, en, pnn, tilen) DN_LOADN(tilen) }
        int vb = q * DN_PLANE + i16 * DN_ROWP; asm volatile("" : "+v"(vb));
        unsigned char* yp0 = YS + (size_t)dd[0] * D + pn * 256 + 16 * q; unsigned char* yp1 = YS + (size_t)dd[1] * D + pn * 256 + 16 * q; const float g0 = gg[0], g1 = gg[1];
#define DN_LDB(s_) ({ const LAS unsigned char* bp_ = L + vb + ((s_) >> 1) * (16 * DN_ROWP) + ((s_) & 1) * 32; const i32x4 lo_ = *(const LAS i32x4*)bp_, hi_ = *(const LAS i32x4*)(bp_ + 16); __builtin_shufflevector(lo_, hi_, 0, 1, 2, 3, 4, 5, 6, 7); })
        i32x8 bq[3]; bq[0] = DN_LDB(0); bq[1] = DN_LDB(1);
#pragma unroll
        for (int hb = 0; hb < 2; ++hb) {
            f32x4 acc[2][8];
#pragma unroll
            for (int rg = 0; rg < 2; ++rg)
#pragma unroll
                for (int ng = 0; ng < 8; ++ng) acc[rg][ng] = (f32x4){0.f, 0.f, 0.f, 0.f};
#pragma unroll
            for (int s2 = 0; s2 < 16; ++s2) { const int st = 16 * hb + s2;
                if (st + 2 < 32) bq[(st + 2) % 3] = DN_LDB(st + 2);
#pragma unroll
                for (int rg = 0; rg < 2; ++rg) acc[rg][s2 >> 1] = __builtin_amdgcn_mfma_scale_f32_16x16x128_f8f6f4(bq[st % 3], af[rg][st & 1], acc[rg][s2 >> 1], 0, 0, 0, sc1, 0, sc1);
                __builtin_amdgcn_sched_barrier(0);
            }
            if (hb == 1) {
                asm volatile("s_waitcnt vmcnt(0)" : "+v"(nl[0][0]), "+v"(nl[0][1]), "+v"(nl[1][0]), "+v"(nl[1][1]), "+v"(nh[0][0]), "+v"(nh[0][1]), "+v"(nh[1][0]), "+v"(nh[1][1]), "+v"(ndd[0]), "+v"(ndd[1]), "+v"(ngg[0]), "+v"(ngg[1]) :: "memory");
                dd[0] = ndd[0]; dd[1] = ndd[1]; gg[0] = ngg[0] * (Y8_SCALE / (W8_SCALE * H8_SCALE)); gg[1] = ngg[1] * (Y8_SCALE / (W8_SCALE * H8_SCALE));
#pragma unroll
                for (int rg = 0; rg < 2; ++rg) { af[rg][0] = __builtin_shufflevector(nl[rg][0], nh[rg][0], 0, 1, 2, 3, 4, 5, 6, 7); af[rg][1] = __builtin_shufflevector(nl[rg][1], nh[rg][1], 0, 1, 2, 3, 4, 5, 6, 7); }
            }
#pragma unroll
            for (int rg = 0; rg < 2; ++rg) { unsigned char* yp = (rg ? yp1 : yp0) + 128 * hb; const float g = rg ? g1 : g0;
#pragma unroll
                for (int cb = 0; cb < 2; ++cb) { u32x4 w;
#pragma unroll
                    for (int k = 0; k < 4; ++k) { const f32x4 v = acc[rg][4 * cb + k] * g; w[k] = pk_fp8x4(v[0], v[1], v[2], v[3]); }
                    *(u32x4*)(yp + 64 * cb) = w; } }
        }
#undef DN_LDB
        e = en; pn = pnn; tile = tilen;
    }
#undef DN_DECODE
#undef DN_LOADA
#undef DN_LOADN
    __syncthreads();
}

__device__ __forceinline__ void phase_moe_combine(const Frame& F, const Args& a, int qd) {
    const int gw = F.vcu * NWAVES + F.wave, NGW = F.G * NWAVES, lane = F.lane;
    const u16* X1B = (const u16*)(F.ws + WS_XB) + (size_t)qd * TQ * D; const unsigned char* YS = F.ws + WS_YS; u16* X2B = (u16*)(F.ws + WS_X2B) + (size_t)qd * TQ * D;
    typedef float f32x2v __attribute__((ext_vector_type(2)));
    constexpr int NT = 2;
    f32x4 gq[4], bq[4];
#pragma unroll
    for (int k = 0; k < 4; ++k) { gq[k] = *(const f32x4*)(a.in[19] + 16 * lane + 4 * k); bq[k] = *(const f32x4*)(a.in[20] + 16 * lane + 4 * k); }
    for (int tl0 = gw; tl0 < TQ; tl0 += NT * NGW) {
        int mydn[NT]; u32x4 yy[NT][NSLOT], xx[NT][2];
#pragma unroll
        for (int t = 0; t < NT; ++t) { const int tl = tl0 + t * NGW; mydn[t] = (lane < 8) ? ((const int*)(F.ws + WS_TOKD))[((size_t)qd * TQ + tl) * 8 + lane] : 0; }
#pragma unroll
        for (int t = 0; t < NT; ++t) { const int tl = tl0 + t * NGW;
#pragma unroll
            for (int c = 0; c < 2; ++c) xx[t][c] = *(const u32x4*)(X1B + (size_t)tl * D + 16 * lane + 8 * c);
#pragma unroll
            for (int k = 0; k < NSLOT; ++k) { const int dn = (k < 8) ? __builtin_amdgcn_readlane(mydn[t], k) : TQ * 8 + tl; yy[t][k] = *(const u32x4*)(YS + (size_t)dn * D + 16 * lane); } }
        __builtin_amdgcn_sched_barrier(0);
#pragma unroll
        for (int t = 0; t < NT; ++t) { const int tl = tl0 + t * NGW;
            float v[16];
#pragma unroll
            for (int c = 0; c < 2; ++c) { const u32x4 x = xx[t][c];
                v[8 * c + 0] = ALPHA * bf_lo(x.x); v[8 * c + 1] = ALPHA * bf_hi(x.x); v[8 * c + 2] = ALPHA * bf_lo(x.y); v[8 * c + 3] = ALPHA * bf_hi(x.y); v[8 * c + 4] = ALPHA * bf_lo(x.z); v[8 * c + 5] = ALPHA * bf_hi(x.z); v[8 * c + 6] = ALPHA * bf_lo(x.w); v[8 * c + 7] = ALPHA * bf_hi(x.w); }
            float ys[16];
#pragma unroll
            for (int j = 0; j < 16; ++j) ys[j] = 0.f;
#pragma unroll
            for (int k = 0; k < NSLOT; ++k)
#pragma unroll
                for (int q = 0; q < 4; ++q) { const int wv = (int)yy[t][k][q]; const f32x2v lo = __builtin_amdgcn_cvt_pk_f32_fp8(wv, false), hi = __builtin_amdgcn_cvt_pk_f32_fp8(wv, true);
                    ys[4 * q + 0] += lo.x; ys[4 * q + 1] += lo.y; ys[4 * q + 2] += hi.x; ys[4 * q + 3] += hi.y; }
#pragma unroll
            for (int j = 0; j < 16; ++j) v[j] += ys[j] * (1.0f / Y8_SCALE);
            float s = 0.f;
#pragma unroll
            for (int j = 0; j < 16; ++j) s += v[j];
            const float mean = wave_sum(s) * (1.f / D); float s2 = 0.f;
#pragma unroll
            for (int j = 0; j < 16; ++j) { v[j] -= mean; s2 += v[j] * v[j]; }
            const float rstd = 1.f / sqrtf(wave_sum(s2) * (1.f / D) + LN_EPS);
            u32x4 w8;
#pragma unroll
            for (int c = 0; c < 2; ++c) { const int col = 16 * lane + 8 * c; const f32x4 g0 = gq[2 * c], g1 = gq[2 * c + 1], b0 = bq[2 * c], b1 = bq[2 * c + 1];
                u32x4 w; w.x = cvt_pk_bf16(v[8 * c + 0] * rstd * g0[0] + b0[0], v[8 * c + 1] * rstd * g0[1] + b0[1]); w.y = cvt_pk_bf16(v[8 * c + 2] * rstd * g0[2] + b0[2], v[8 * c + 3] * rstd * g0[3] + b0[3]);
                w.z = cvt_pk_bf16(v[8 * c + 4] * rstd * g1[0] + b1[0], v[8 * c + 5] * rstd * g1[1] + b1[1]); w.w = cvt_pk_bf16(v[8 * c + 6] * rstd * g1[2] + b1[2], v[8 * c + 7] * rstd * g1[3] + b1[3]);
                *(u32x4*)(X2B + (size_t)tl * D + col) = w;
                w8[2 * c] = pk_fp8x4(bf_lo(w.x), bf_hi(w.x), bf_lo(w.y), bf_hi(w.y)); w8[2 * c + 1] = pk_fp8x4(bf_lo(w.z), bf_hi(w.z), bf_lo(w.w), bf_hi(w.w)); }
            *(u32x4*)(F.ws + WS_X2F8 + ((size_t)qd * TQ + tl) * D + 16 * lane) = w8;
        }
    }
}

constexpr int LDS_BYTES = 163840;
static_assert(pg8::LDS_ROWIDX + pg8::LDS_ROWSLOTS * 1024 <= LDS_BYTES && (QTILES * 2 + 255) / 256 <= pg8::LDS_ROWSLOTS, "LDS side tables");
constexpr int MISC_OFF = 131072 + 4096;
constexpr int PH_FIXED = 11, PH_PER_Q = 2, PH_TAIL0 = PH_FIXED + NQ * PH_PER_Q, NPHASE = PH_TAIL0 + 2;

__global__ void __launch_bounds__(NTHR, 2) fwd_kernel(Args args) {
    extern __shared__ __attribute__((aligned(16))) unsigned char lds_raw[];
#define MKFRAME() Frame F; { int t_ = threadIdx.x; asm volatile("" : "+v"(t_)); F.lds = (LAS unsigned char*)lds_raw; F.tid = t_; F.lane = t_ & 63; F.wave = __builtin_amdgcn_readfirstlane(t_ >> 6); \
        F.G = gridDim.x; const int bx_ = blockIdx.x; F.vcu = (F.G % 8 == 0) ? (bx_ % 8) * (F.G / 8) + bx_ / 8 : bx_; size_t z_ = 0; asm volatile("" : "+s"(z_)); F.ws = args.ws + z_;     F.dout = (unsigned char*)args.out; }
    LAS unsigned char* const lds0 = (LAS unsigned char*)lds_raw;
    volatile LAS unsigned* MISC = (volatile LAS unsigned*)(lds0 + MISC_OFF);
    if (threadIdx.x < 64) MISC[threadIdx.x] = 0u;
    __syncthreads();
    unsigned* barw = (unsigned*)(args.ws + WS_CTL) + CW_BAR;
    const int lo = args.lo, hi = args.hi;
    XcdBarrier bar; bar.bar = barw; bar.x = 0; bar.st = nullptr;
    if (hi - lo > 1) bar = xcd_barrier_post(barw, MISC + 8);
#ifndef PHASE_MASK
#define PHASE_MASK 0xFFFFFFFFu
#endif
#define IN(k) (((PHASE_MASK >> (k)) & 1u) && lo <= (k) && (k) < hi)
#define INQ(j) (((PHASE_MASK >> (PH_FIXED + (j))) & 1u) && lo <= (pb + (j)) && (pb + (j)) < hi)
#define SEAMQ(j) do { if (lo <= (pb + (j)) && (pb + (j)) + 1 < hi) xcd_barrier(bar); STAMP(pb + (j) + 1); } while (0)
#if DBG_TIME
#define STAMP(i) do { if (blockIdx.x == 0 && threadIdx.x == 0) ((unsigned long long*)(args.ws + WS_CTL + 60 * 1024))[i] = __builtin_amdgcn_s_memrealtime(); } while (0)
#else
#define STAMP(i) do { } while (0)
#endif
    STAMP(0);
#define SEAM(k) do { if (lo <= (k) && (k) + 1 < hi) xcd_barrier(bar); STAMP((k) + 1); } while (0)
    const int G = gridDim.x, c = (int)blockIdx.x;
    const bool wg_odd_t = ((blockIdx.x >> 3) & 1) != 0;

    if (IN(0)) { MKFRAME(); phase_prologue(F, args); }
    SEAM(0);
    if (IN(1)) {
        MKFRAME(); unsigned char* ws = F.ws;
        pg8::DenseOrder S; S.init(ws + WS_XB, ws + WS_WIN, T, NCOL, 512, G, c);
        pg8::EpiZ E{ws, (const float*)(ws + WS_ROT), (const float*)(ws + WS_LB), 1.0f / W8_SCALE};
        for (int rep = 0; rep < DUPN(7); ++rep) pg8::gemm_phase<false, 2>(F.lds, 512, S, E);
    }
    SEAM(1);
    if (IN(2)) {
        MKFRAME();
#ifndef NO_HGRN
#if USE_NAIVE_HGRN
        for (int it = F.vcu; it < 256; it += G) hgrn_item(F, it);
#else
        for (int it = F.vcu; it < 256; it += G) hgrn_mfma_item(F, it, (u16*)(F.dout + DO_OF), (u16*)(F.dout + DO_OB));
#if DBG_CHECK
        for (int it = F.vcu; it < 256; it += G) hgrn_item(F, it);
#endif
#endif
#endif
        STAMP(40);
#if USE_NAIVE_ATTN
        attn_naive(F);
#else
        for (int rep2 = 0; rep2 < DUPN(15); ++rep2) attn_mfma(F);
#endif
    }
    SEAM(2);
    if (IN(3)) { MKFRAME(); for (int rep = 0; rep < DUPN(8); ++rep) phase_hg_combine(F, args); }
    SEAM(3);
    if (IN(4)) {
        MKFRAME(); unsigned char* ws = F.ws;
        pg8::DenseOrder S; S.init(ws + WS_YH, ws + WS_WBH, T, D, 256, G, c);
        pg8::EpiGated<false> E{(const u16*)(ws + Z_GTH), (u16*)(F.dout + DO_MERGED), nullptr, D};
        pg8::gemm_phase<false, 2, false>(F.lds, 256, S, E);
    }
    SEAM(4);
    if (IN(5) && !DBG_SKIP_YA) {
        MKFRAME(); unsigned char* ws = F.ws;
        pg8::DenseOrder S; S.init(ws + WS_YA, ws + WS_WBA, T, D, 128, G, c);
        pg8::EpiGated<true> E{(const u16*)(ws + Z_GTA), (u16*)(F.dout + DO_MERGED), F.dout + DO_MERGED8, D};
        pg8::gemm_phase<true, 2, false>(F.lds, 128, S, E);
    }
    SEAM(5);
    if (IN(6)) {
        MKFRAME(); unsigned char* ws = F.ws;
        pg8::DenseOrder S; S.init(F.dout + DO_MERGED8, ws + WS_WO, T, D, 512, G, c);
        pg8::EpiBf16Res E{args.in[0], (u16*)(ws + WS_X1PRE), D, ALPHA, 1.0f / (W8_SCALE * M8_SCALE)};
        pg8::gemm_phase<false, 2>(F.lds, 512, S, E);
    }
    SEAM(6);
    if (IN(7)) { MKFRAME(); phase_ln1_convert<true, false>(F, args); }
    SEAM(7);
    if (IN(8) && !wg_odd_t) { { MKFRAME(); phase_ln1_convert<false, true>(F, args, 0, 3); } VM_WAIT(); __syncthreads(); }
    if (IN(8)) {
        MKFRAME(); unsigned char* ws = F.ws;
        pg8::DenseOrder S; S.init(ws + WS_XB, ws + WS_WR, T, 256, 1024, G, c);
        pg8::EpiF32Res E{(float*)(ws + WS_LOGITS), nullptr, nullptr, 256, 0.f, 1.f};
        for (int rep = 0; rep < DUPN(11); ++rep) pg8::gemm_phase(F.lds, 1024, S, E);
    }
    if (IN(8) && wg_odd_t) { VM_WAIT(); __syncthreads(); MKFRAME(); phase_ln1_convert<false, true>(F, args, 0, 3); }
    SEAM(8);
    if (IN(9) && !wg_odd_t) { { MKFRAME(); phase_ln1_convert<false, true>(F, args, 1, 3); } VM_WAIT(); __syncthreads(); }
    if (IN(9)) { MKFRAME(); phase_topk(F, args); }
    if (IN(9) && wg_odd_t) { VM_WAIT(); __syncthreads(); MKFRAME(); phase_ln1_convert<false, true>(F, args, 1, 3); }
    SEAM(9);
    if (IN(10) && !wg_odd_t) { { MKFRAME(); phase_ln1_convert<false, true>(F, args, 2, 3); } VM_WAIT(); __syncthreads(); }
    if (IN(10)) { MKFRAME(); phase_sort(F); }
    if (IN(10) && wg_odd_t) { VM_WAIT(); __syncthreads(); MKFRAME(); phase_ln1_convert<false, true>(F, args, 2, 3); }
    SEAM(10);
    for (int qd = 0; qd < NQ; ++qd) {
        const int pb = PH_FIXED + qd * PH_PER_Q;
        const size_t lo_off = (size_t)qd * QTILES * 256;
        const bool wg_odd = ((blockIdx.x >> 3) & 1) != 0;
        if (INQ(0) && qd > 0 && !wg_odd) { MKFRAME(); phase_moe_combine(F, args, qd - 1); }
        if (INQ(0)) {
            MKFRAME(); unsigned char* ws = F.ws;
            const int ntiles = __builtin_amdgcn_readfirstlane(((const int*)(ws + WS_NTILES))[qd]);
            pg8::MoeOrder<2, true> S; S.A = (const char*)(ws + WS_X1F8); S.W = (const char*)(ws + WS_WGU); S.lds = F.lds; S.slot_tok = (const int*)(ws + WS_STOK) + lo_off; S.sdst = nullptr; S.sgate = nullptr;
            S.ntiles = ntiles; S.G = G; S.vc = F.vcu; S.K = 512; S.wstride_e = (size_t)512 * 1024; S.wstride_pn = (size_t)256 * 1024;
            S.load_table((const int*)(ws + WS_TILEE) + qd * QTILES, F.tid);
            pg8::EpiSwiglu E{ws + WS_H};
            for (int rep = 0; rep < DUPN(0); ++rep) pg8::gemm_phase<false, 2>(F.lds, 512, S, E);
        }
        if (INQ(0) && qd > 0 && wg_odd) { __syncthreads(); MKFRAME(); phase_moe_combine(F, args, qd - 1); }
        SEAMQ(0);
        if (INQ(1)) { MKFRAME(); moe_down_phase(F, qd); }
        SEAMQ(1);
    }
    if (IN(PH_TAIL0) && !wg_odd_t) { MKFRAME(); phase_moe_combine(F, args, NQ - 1); }
    if (IN(PH_TAIL0)) {
        { MKFRAME(); unsigned char* ws = F.ws; const int pm = F.vcu;
          const f32x4* p4 = (const f32x4*)(args.in[1] + (size_t)pm * 256 * 256); u32x4* o4 = (u32x4*)(ws + WS_PB + (size_t)pm * 256 * 256 * 2);
          for (int i = F.tid; i < 256 * 256 / 8; i += NTHR) { const f32x4 p = p4[2 * i], q = p4[2 * i + 1]; u32x4 w; w.x = cvt_pk_bf16(p[0], p[1]); w.y = cvt_pk_bf16(p[2], p[3]); w.z = cvt_pk_bf16(q[0], q[1]); w.w = cvt_pk_bf16(q[2], q[3]); o4[i] = w; } }
        VM_WAIT(); __syncthreads(); __builtin_amdgcn_fence(__ATOMIC_ACQUIRE, "agent"); VM_WAIT();
        { MKFRAME(); unsigned char* ws = F.ws; pg8::PanelOrder S; S.A = (const char*)(ws + WS_PB); S.Bt = (const char*)(ws + WS_WPP); S.pm = F.vcu; S.nN = 4; S.K = 256;
          pg8::EpiBf16 E{(u16*)(ws + WS_P2), D};
          pg8::gemm_phase<true>(F.lds, 256, S, E); }
        VM_WAIT(); __syncthreads();
    }
    if (IN(PH_TAIL0) && wg_odd_t) { MKFRAME(); phase_moe_combine(F, args, NQ - 1); }
    SEAM(PH_TAIL0);
    if (IN(PH_TAIL0 + 1)) {
        { MKFRAME(); unsigned char* ws = F.ws; pg8::PanelOrder S; S.A = (const char*)(ws + WS_X2F8); S.Bt = (const char*)(ws + WS_WPG); S.pm = F.vcu; S.nN = 4; S.K = 512;
          pg8::EpiPle E{(u16*)(ws + WS_X3PRE), (const u16*)(ws + WS_X2B), (const u16*)(ws + WS_P2), D, 1.0f / W8_SCALE};
          pg8::gemm_phase<false, 2>(F.lds, 512, S, E); }
        VM_WAIT(); __syncthreads(); __builtin_amdgcn_fence(__ATOMIC_ACQUIRE, "agent"); VM_WAIT();
        { MKFRAME(); unsigned char* ws = F.ws; const int pm = F.vcu;
          for (int r = F.wave; r < 256; r += 4 * NWAVES) ln_rows<false, 4, true>((const u16*)(ws + WS_X3PRE), (size_t)pm * 256 + r, (size_t)NWAVES, args.in[23], args.in[24], args.out, F.lane); }
    }
#undef IN
#undef SEAM
#undef INQ
#undef SEAMQ
}


#ifndef DBG_CHECK
#define DBG_CHECK 0
#endif
#if DBG_CHECK
constexpr int CHK_WORD0 = 12288;
struct ChkArgs { const float* in[25]; float* out; unsigned char* ws; int mode, qd; };
__device__ __forceinline__ float dotb(const u16* a, const u16* b, int K) { float s = 0.f; for (int k = 0; k < K; k += 8) { const u32x4 x = *(const u32x4*)(a + k), y = *(const u32x4*)(b + k);
    s += bf_lo(x.x) * bf_lo(y.x) + bf_hi(x.x) * bf_hi(y.x) + bf_lo(x.y) * bf_lo(y.y) + bf_hi(x.y) * bf_hi(y.y) + bf_lo(x.z) * bf_lo(y.z) + bf_hi(x.z) * bf_hi(y.z) + bf_lo(x.w) * bf_lo(y.w) + bf_hi(x.w) * bf_hi(y.w); } return s; }
__device__ __forceinline__ float sigm(float z) { return 1.f / (1.f + expf(-z)); }
__device__ __forceinline__ bool badv(float got, float ref, float rel, float ab) { return !(fabsf(got - ref) <= rel * fabsf(ref) + ab); }
__global__ void chk_kernel(ChkArgs a) {
    unsigned char* ws = a.ws; unsigned* res = (unsigned*)(ws + WS_CTL) + CHK_WORD0; const int mode = a.mode, qd = a.qd;
    const size_t gt = (size_t)blockIdx.x * blockDim.x + threadIdx.x, NGT = (size_t)gridDim.x * blockDim.x;
    const u16* XB = (const u16*)(ws + WS_XB); const u16* WIN = (const u16*)(ws + WS_WIN);
    unsigned bad = 0;
    if (mode == 1) { for (size_t i = gt; i < (size_t)T * D; i += NGT) { if (badv(bf1(XB[i]), a.in[0][i], 0.005f, 1e-6f)) ++bad; } }
    else if (mode >= 2 && mode <= 11) {
        const int ty = mode - 2; const int ncol = ty < 5 ? 512 : ty < 8 ? 768 : 1024; const int cbase = ty < 5 ? 512 * ty : ty < 8 ? 2560 + 768 * (ty - 5) : 4864 + 1024 * (ty - 8);
        const size_t zoff[10] = {Z_QH, Z_VH, Z_LFF, Z_LFB, Z_GS, Z_AQ, Z_AK, Z_AV, Z_GTH, Z_GTA}; const u16* Zt = (const u16*)(ws + zoff[ty]); const float* lb = (const float*)(ws + WS_LB); const float* rot = (const float*)(ws + WS_ROT);
        for (size_t i = gt; i < (size_t)(T / 8) * ncol; i += NGT) { const int row = (int)(i / ncol) * 8 + 3, c = (int)(i % ncol);
            float z = dotb(XB + (size_t)row * D, WIN + (size_t)(cbase + c) * D, D), ref, got = bf1(Zt[(size_t)row * ncol + c]);
            if (ty <= 4 || ty == 7 || ty == 8 || ty == 9) ref = z;
            else { const int d = c & 63; ref = z; if (d < 16) { const int cp = (d < 8) ? c + 8 : c - 8; const float zp = dotb(XB + (size_t)row * D, WIN + (size_t)(cbase + cp) * D, D); const int fi = d & 7, pos = row & (SEQ - 1); const float cs = rot[pos * 16 + fi], sn = rot[pos * 16 + 8 + fi]; ref = (d < 8) ? z * cs - zp * sn : z * cs + zp * sn; } if (ty == 5) ref *= 0.125f; }
            if (badv(got, ref, 0.02f, 0.02f)) { ++bad; if (mode == 10) { atomicAdd(res + 80 + ((c & 255) >> 2), 1u); atomicAdd(res + 160 + ((row & 255) >> 2), 1u); atomicAdd(res + 240 + ((row >> 8) & 255), 1u); if (got > 1.5f || got < -0.5f) atomicAdd(res + 500, 1u); atomicAdd(res + 600 + ((((row >> 8) & 31) >> 3) * 8 + ((row >> 6) & 1) * 4 + ((c >> 5) & 3)), 1u); } } } }
    else if (mode == 12) { const u16* Zt = (const u16*)(ws + Z_GTH); unsigned nm = 0, no = 0; for (size_t i = gt; i < (size_t)2 * T * D; i += NGT) { const u16 h = Zt[i]; if (h == 0x3C3C) ++nm; else { const float g = bf1(h); if (!(g >= 0.f && g <= 1.f)) ++no; } }
        for (int o = 32; o >= 1; o >>= 1) { nm += __shfl_xor(nm, o); no += __shfl_xor(no, o); } if ((threadIdx.x & 63) == 0) { if (nm) atomicAdd(res + 700, nm); if (no) atomicAdd(res + 701, no); } }
    else if (mode == 25) { const u16* AQ = (const u16*)(ws + Z_AQ); const u16* AK = (const u16*)(ws + Z_AK); const u16* AV = (const u16*)(ws + Z_AV); const u16* YA = (const u16*)(ws + WS_YA);
        for (size_t i = gt; i < (size_t)(T / 64) * 256; i += NGT) { const int row = (int)(i / 256) * 64 + 7, sl = (int)((i % 256) / 64), d = (int)(i % 64); const int b = row >> 11, p = row & (SEQ - 1);
            float mx = -1e30f; for (int pass = 0; pass < 2; ++pass) { float den = 0.f, o = 0.f; for (int g = 0; g < 3; ++g) { const int sh = 2 * g, mlen = SEQ >> sh, r = p & ((1 << sh) - 1), m = p >> sh, hd = g * 4 + sl; const int lo = m - 64 < 0 ? 0 : m - 64, hi = m + 64 > mlen - 1 ? mlen - 1 : m + 64;
                    for (int j = lo; j <= hi; ++j) { const size_t kr = (size_t)b * SEQ + r + ((size_t)j << sh); const float sc = dotb(AQ + (size_t)row * 768 + hd * 64, AK + kr * 768 + hd * 64, 64); if (pass == 0) mx = fmaxf(mx, sc); else { const float e = expf(sc - mx); den += e; o += e * bf1(AV[kr * 768 + hd * 64 + d]); } } }
                if (pass == 1) { if (badv(bf1(YA[(size_t)row * 256 + sl * 64 + d]), o / den, 0.03f, 0.004f)) ++bad; } } } }
    else if (mode == 26) { const u16* A0 = (const u16*)((unsigned char*)a.out + DO_OF); const u16* R0 = (const u16*)(ws + WS_XB);
        for (size_t i = gt; i < (size_t)2 * T * 512; i += NGT) { if (badv(bf1(A0[i]), bf1(R0[i]), 0.03f, 0.03f)) ++bad; } }
    else if (mode == 13) { const u16* YH = (const u16*)(ws + WS_YH); const u16* YA = (const u16*)(ws + WS_YA); const u16* GH = (const u16*)(ws + Z_GTH); const u16* GA = (const u16*)(ws + Z_GTA); const u16* M = (const u16*)((unsigned char*)a.out + DO_MERGED);
        for (size_t i = gt; i < (size_t)(T / 4) * D; i += NGT) { const int row = (int)(i / D) * 4 + 1, c = (int)(i % D);
            const float ref = sigm(bf1(GH[(size_t)row * D + c])) * dotb(YH + (size_t)row * 512, (const u16*)(ws + WS_WBH) + (size_t)c * 512, 512) + sigm(bf1(GA[(size_t)row * D + c])) * dotb(YA + (size_t)row * 256, (const u16*)(ws + WS_WBA) + (size_t)c * 256, 256);
            if (badv(bf1(M[(size_t)row * D + c]), ref, 0.02f, 0.01f)) ++bad; } }
    else if (mode == 14) { const u16* M = (const u16*)((unsigned char*)a.out + DO_MERGED); const float* X1 = (const float*)(ws + WS_X1PRE);
        for (size_t i = gt; i < (size_t)T * D; i += NGT) { const int row = (int)(i / D), c = (int)(i % D);
            const float ref = ALPHA * a.in[0][i] + dotb(M + (size_t)row * D, (const u16*)(ws + WS_WO) + (size_t)c * D, D); if (badv(X1[i], ref, 0.002f, 0.002f)) ++bad; } }
    else if (mode == 15) { const float* X1 = (const float*)(ws + WS_X1PRE);
        for (size_t row = gt; row < T; row += NGT) { float m = 0.f; for (int c = 0; c < D; ++c) m += X1[row * D + c]; m /= D; float v = 0.f; for (int c = 0; c < D; ++c) { const float d = X1[row * D + c] - m; v += d * d; } const float rs = 1.f / sqrtf(v / D + LN_EPS);
            for (int c = 0; c < D; ++c) { const float ref = (X1[row * D + c] - m) * rs * a.in[9][c] + a.in[10][c]; if (badv(bf1(XB[row * D + c]), ref, 0.01f, 0.01f)) ++bad; } } }
    else if (mode == 16) { const float* LG = (const float*)(ws + WS_LOGITS);
        for (size_t i = gt; i < (size_t)T * 256; i += NGT) { const int row = (int)(i / 256), c = (int)(i % 256); if (badv(LG[i], dotb(XB + (size_t)row * D, (const u16*)(ws + WS_WR) + (size_t)c * D, D), 0.002f, 0.002f)) ++bad; } }
    else if (mode == 17) { const float* LG = (const float*)(ws + WS_LOGITS); const u16* te = (const u16*)(ws + WS_TOKE); const float* tg = (const float*)(ws + WS_TOKG);
        for (size_t t = gt; t < T; t += NGT) { float gsc[8]; for (int g = 0; g < 8; ++g) { float m1 = -1e30f, m2 = -1e30f; for (int j = 0; j < 32; ++j) { const float b = sigm(LG[t * 256 + g * 32 + j]) + a.in[12][g * 32 + j]; if (b > m1) { m2 = m1; m1 = b; } else if (b > m2) m2 = b; } gsc[g] = m1 + m2; }
            unsigned gm = 0; for (int g = 0; g < 8; ++g) { int r = 0; for (int j = 0; j < 8; ++j) r += (gsc[j] > gsc[g] || (gsc[j] == gsc[g] && j < g)); if (r < 4) gm |= 1u << g; }
            unsigned long long taken[4] = {0, 0, 0, 0}; float ssum = 0.f; int ok = 1;
            for (int k = 0; k < 8; ++k) { float bv = -1e30f; int bi = -1; for (int e = 0; e < 256; ++e) { if (!((gm >> (e >> 5)) & 1u) || ((taken[e >> 6] >> (e & 63)) & 1ull)) continue; const float b = sigm(LG[t * 256 + e]) + a.in[12][e]; if (b > bv) { bv = b; bi = e; } }
                taken[bi >> 6] |= 1ull << (bi & 63); ssum += sigm(LG[t * 256 + bi]); if (te[t * 8 + k] != bi) ok = 0; }
            for (int k = 0; k < 8 && ok; ++k) { const float ref = sigm(LG[t * 256 + te[t * 8 + k]]) / ssum * 2.5f; if (badv(tg[t * 8 + k], ref, 0.001f, 1e-5f)) ok = 0; }
            if (!ok) ++bad; } }
    else if (mode == 18) { const int* stok = (const int*)(ws + WS_STOK) + (size_t)qd * QTILES * 256; const float* sg = (const float*)(ws + WS_SGATE) + (size_t)qd * QTILES * 256; const int* sd = (const int*)(ws + WS_SDST) + (size_t)qd * QTILES * 256; const int* tle = (const int*)(ws + WS_TILEE) + qd * QTILES;
        const int nt = ((const int*)(ws + WS_NTILES))[qd]; const u16* te = (const u16*)(ws + WS_TOKE); const float* tg = (const float*)(ws + WS_TOKG); unsigned* cnt = res + 64;
        if (nt < 64 || nt > QTILES) { if (gt == 0) ++bad; } else
        for (size_t sl = gt; sl < (size_t)nt * 256; sl += NGT) { const int d = sd[sl], tk = stok[sl], e = tle[sl >> 8]; if (d == TQ * NSLOT) { if (tk != qd * TQ || sg[sl] != 0.f) ++bad; continue; }
            if (d < 0 || d > TQ * NSLOT || tk < qd * TQ || tk >= (qd + 1) * TQ) { ++bad; continue; } const int k = d % NSLOT; if (d / NSLOT != tk - qd * TQ) { ++bad; continue; }
            if (k == 8) { if (e != 256 || sg[sl] != 1.f) ++bad; } else { if (te[(size_t)tk * 8 + k] != e || tg[(size_t)tk * 8 + k] != sg[sl]) ++bad; }
            atomicAdd(cnt, 1u); } }
    else if (mode == 19) { const int* stok = (const int*)(ws + WS_STOK) + (size_t)qd * QTILES * 256; const int* tle = (const int*)(ws + WS_TILEE) + qd * QTILES; const int nt = ((const int*)(ws + WS_NTILES))[qd]; const u16* H = (const u16*)(ws + WS_H); const u16* WGU = (const u16*)(ws + WS_WGU);
        for (size_t i = gt; i < (size_t)nt * 32 * 256; i += NGT) { const int sl = (int)(i / 256) * 8 + 5, j = (int)(i % 256); const int e = tle[sl >> 8], tk = stok[sl]; const u16* xr = XB + (size_t)tk * D;
            const u16* wg = WGU + ((size_t)e * 512 + (j >> 7) * 256 + (j & 127)) * D; const float g = dotb(xr, wg, D), u = dotb(xr, wg + (size_t)128 * D, D); if (badv(bf1(H[(size_t)sl * 256 + j]), g * sigm(g) * u, 0.03f, 0.003f)) ++bad; } }
    else if (mode == 20) { const int* sd = (const int*)(ws + WS_SDST) + (size_t)qd * QTILES * 256; const float* sg = (const float*)(ws + WS_SGATE) + (size_t)qd * QTILES * 256; const int* tle = (const int*)(ws + WS_TILEE) + qd * QTILES; const int nt = ((const int*)(ws + WS_NTILES))[qd]; const u16* H = (const u16*)(ws + WS_H); const u16* WD = (const u16*)(ws + WS_WD); const u16* YS = (const u16*)(ws + WS_YS);
        for (size_t i = gt; i < (size_t)nt * 32 * D; i += NGT) { const int sl = (int)(i / D) * 8 + 2, c = (int)(i % D); const int e = tle[sl >> 8], d = sd[sl]; if (d == TQ * NSLOT) continue;
            const float ref = sg[sl] * dotb(H + (size_t)sl * 256, WD + ((size_t)e * 1024 + c) * 256, 256); if (badv(bf1(YS[(size_t)d * D + c]), ref, 0.02f, 0.002f)) ++bad; } }
    else if (mode == 21) { const u16* PB = (const u16*)(ws + WS_PB) + (size_t)qd * TQ * 256; const u16* P2 = (const u16*)(ws + WS_P2) + (size_t)qd * TQ * D; const float* p = a.in[1] + (size_t)qd * TQ * 256;
        for (size_t i = gt; i < (size_t)TQ * D; i += NGT) { const int row = (int)(i / D), c = (int)(i % D); if (badv(bf1(P2[i]), dotb(PB + (size_t)row * 256, (const u16*)(ws + WS_WPP) + (size_t)c * 256, 256), 0.02f, 0.01f)) ++bad; if (c < 256 && badv(bf1(PB[(size_t)row * 256 + c]), p[(size_t)row * 256 + c], 0.005f, 1e-6f)) ++bad; } }
    else if (mode == 22) { const u16* X1 = XB + (size_t)qd * TQ * D; const u16* YS = (const u16*)(ws + WS_YS); const u16* X2 = (const u16*)(ws + WS_X2B) + (size_t)qd * TQ * D;
        for (size_t row = gt; row < TQ; row += NGT) { float m = 0.f, v = 0.f; for (int pass = 0; pass < 3; ++pass) { for (int c = 0; c < D; ++c) { float x = ALPHA * bf1(X1[row * D + c]); for (int k = 0; k < NSLOT; ++k) x += bf1(YS[(row * NSLOT + k) * D + c]);
                    if (pass == 0) m += x; else if (pass == 1) v += (x - m) * (x - m); else { const float ref = (x - m) * v * a.in[19][c] + a.in[20][c]; if (badv(bf1(X2[row * D + c]), ref, 0.01f, 0.01f)) ++bad; } } if (pass == 0) m /= D; else if (pass == 1) v = 1.f / sqrtf(v / D + LN_EPS); } } }
    else if (mode == 23) { const u16* X2 = (const u16*)(ws + WS_X2B); const u16* P2 = (const u16*)(ws + WS_P2); const float* O = a.out + (size_t)qd * TQ * D;
        for (size_t i = gt; i < (size_t)TQ * D; i += NGT) { const int row = (int)(i / D), c = (int)(i % D); const float ref = ALPHA * bf1(X2[i]) + sigm(dotb(X2 + (size_t)row * D, (const u16*)(ws + WS_WPG) + (size_t)c * D, D)) * bf1(P2[i]); if (badv(O[i], ref, 0.002f, 0.002f)) ++bad; } }
    else if (mode == 24) { const float* O = a.out + (size_t)qd * TQ * D;
        for (size_t row = gt; row < TQ; row += NGT) { float m = 0.f, v = 0.f; int nf = 0; for (int c = 0; c < D; ++c) { const float x = (O[row * D + c] - a.in[24][c]) / a.in[23][c]; m += x; v += x * x; nf += !(x - x == 0.f); } m /= D; v = v / D - m * m; if (nf || fabsf(m) > 1e-3f || fabsf(v - 1.f) > 1e-2f) ++bad; } }
    for (int o = 32; o >= 1; o >>= 1) bad += __shfl_xor(bad, o);
    if ((threadIdx.x & 63) == 0 && bad) atomicAdd(res + mode, bad);
}
__global__ void chk_encode(float* out, size_t n, const unsigned* res, int what) {
    unsigned code = 0;
    if (what == 0) { for (int m = 1; m < 64; ++m) if (res[m]) { code = m; break; } }
    else if (what > 0) { const unsigned b = res[what]; code = b ? 1 + (31 - __clz(b)) : 0; }
    else if (what == -1) { code = (res[64] == (unsigned)(4 * TQ * NSLOT)) ? 0 : 7; }
    else if (what == -4) { const unsigned nm = res[700], no = res[701]; code = (nm ? 1 + (31 - __clz(nm)) : 0) + (no ? 40 : 0); }
    else if (what == -2) { const int ms[6] = {11, 13, 14, 15, 16, 17}; for (int i = 0; i < 6; ++i) if (res[ms[i]]) code |= 1u << i; }
    else { const int ms[6] = {18, 19, 20, 21, 22, 23}; for (int i = 0; i < 6; ++i) if (res[ms[i]]) code |= 1u << i; if (res[24]) code += 64; if (code > 98) code = 98; }
    const float c = sqrtf((float)code);
    for (size_t i = (size_t)blockIdx.x * blockDim.x + threadIdx.x; i < n; i += (size_t)gridDim.x * blockDim.x) out[i] = c;
}
#ifndef DBG_WHAT
#define DBG_WHAT 0
#endif
#endif


#if DBG_TIME
__global__ void time_encode(float* out, size_t n, const unsigned long long* ts) {
    auto ms = [&](int a, int b) { return (float)(ts[b] - ts[a]) * 1e-5f; };
    (void)ms; unsigned code = DBG_TIME_EXPR; if (code > 98) code = 98;
    const float c = sqrtf((float)code);
    for (size_t i = (size_t)blockIdx.x * blockDim.x + threadIdx.x; i < n; i += (size_t)gridDim.x * blockDim.x) out[i] = c;
}
#endif

extern "C" void kernel_launch(void* const* d_in, const int* in_sizes, int n_in, void* d_out, int out_size, void* d_ws, size_t ws_size, hipStream_t stream) {
    static int grid = 0;
    if (grid == 0) {
        if (n_in != 25 || out_size != T * D || ws_size < WS_END) { fprintf(stderr, "kernel_launch: unexpected problem (n_in %d out %d ws %zu)\n", n_in, out_size, ws_size); grid = -1; return; }
        if (hipFuncSetAttribute((const void*)fwd_kernel, hipFuncAttributeMaxDynamicSharedMemorySize, LDS_BYTES) != hipSuccess) { fprintf(stderr, "kernel_launch: hipFuncSetAttribute failed\n"); grid = -1; return; }
        int per_cu = 0; (void)hipOccupancyMaxActiveBlocksPerMultiprocessor(&per_cu, (const void*)fwd_kernel, NTHR, LDS_BYTES); (void)hipGetLastError();
        if (per_cu < 1) fprintf(stderr, "kernel_launch: occupancy query says %d\n", per_cu);
        grid = 256;
    }
    if (grid < 0) return;
    (void)hipMemsetAsync((char*)d_ws + WS_CTL, 0, CTL_ZERO_BYTES, stream);
    Args a{};
    for (int i = 0; i < 25; ++i) a.in[i] = (const float*)d_in[i];
    a.out = (float*)d_out; a.ws = (unsigned char*)d_ws;
#if DBG_CHECK
    ChkArgs ca{}; for (int i = 0; i < 25; ++i) ca.in[i] = (const float*)d_in[i]; ca.out = (float*)d_out; ca.ws = (unsigned char*)d_ws;
#define CHK(m, q) do { ca.mode = (m); ca.qd = (q); hipLaunchKernelGGL(chk_kernel, dim3(2048), dim3(256), 0, stream, ca); } while (0)
    for (int ph = 0; ph < NPHASE; ++ph) { a.lo = ph; a.hi = ph + 1;
        if (ph == 1) (void)hipMemsetAsync((char*)d_ws + Z_GTH, 0x3C, (size_t)256 * MiB, stream);
        hipLaunchKernelGGL(fwd_kernel, dim3(grid), dim3(NTHR), LDS_BYTES, stream, a);
        if (ph == 0) CHK(1, 0);
        if (ph == 1) for (int m = 2; m <= 12; ++m) CHK(m, 0);
        if (ph == 2) CHK(26, 0);
        if (ph == 3) CHK(25, 0);
        if (ph == 5) CHK(13, 0);
        if (ph == 6) CHK(14, 0);
        if (ph == 7) CHK(15, 0);
        if (ph == 8) CHK(16, 0);
        if (ph == 9) CHK(17, 0);
        if (ph >= PH_FIXED && ph < PH_TAIL0) { const int q = (ph - PH_FIXED) / PH_PER_Q, j = (ph - PH_FIXED) % PH_PER_Q;
            if (j == 0) { CHK(18, q); CHK(19, q); if (q > 0) CHK(22, q - 1); } if (j == 1) CHK(20, q); }
        if (ph == PH_TAIL0) CHK(22, NQ - 1);
        if (ph == PH_TAIL0 + 1) for (int q = 0; q < NQ; ++q) { CHK(21, q); CHK(24, q); } }
    hipLaunchKernelGGL(chk_encode, dim3(2048), dim3(256), 0, stream, (float*)d_out, (size_t)out_size, (const unsigned*)((unsigned char*)d_ws + WS_CTL) + CHK_WORD0, DBG_WHAT);
#elif MK_PER_PHASE
    for (int ph = 0; ph < NPHASE; ++ph) { a.lo = ph; a.hi = ph + 1; hipLaunchKernelGGL(fwd_kernel, dim3(grid), dim3(NTHR), LDS_BYTES, stream, a); }
#else
    a.lo = 0; a.hi = NPHASE;
    hipLaunchKernelGGL(fwd_kernel, dim3(grid), dim3(NTHR), LDS_BYTES, stream, a);
#if DBG_TIME
    hipLaunchKernelGGL(time_encode, dim3(2048), dim3(256), 0, stream, (float*)d_out, (size_t)out_size, (const unsigned long long*)((unsigned char*)d_ws + WS_CTL + 60 * 1024));
#endif
#endif
}
```

```cpp
#include <hip/hip_runtime.h>
#include <cstdio>
#include <cstdint>

#ifndef DBG_SLOT_LO
#define DBG_SLOT_LO 0
#define DBG_SLOT_HI 9
#endif
#ifndef DBG_SKIP_YA
#define DBG_SKIP_YA 0
#endif
#ifndef DBG_CHECK
#define DBG_CHECK 0
#endif
#ifndef DBG_PN_LO
#define DBG_PN_LO 0
#endif
#ifndef DBG_TIME
#define DBG_TIME 0
#endif
#ifndef USE_NAIVE_ATTN
#define USE_NAIVE_ATTN 0
#endif
#ifndef USE_NAIVE_HGRN
#define USE_NAIVE_HGRN 0
#endif
#ifndef DBG_DUP
#define DBG_DUP 0u
#endif
#define DUPN(bit) (((DBG_DUP) >> (bit)) & 1u ? 2 : 1)
#ifndef F8_SCALED
#define F8_SCALED 1
#endif
#ifndef MK_PER_PHASE
#define MK_PER_PHASE 0
#endif

#define LAS __attribute__((address_space(3)))
typedef unsigned short u16;
typedef short bf16x8 __attribute__((ext_vector_type(8)));
typedef float f32x4 __attribute__((ext_vector_type(4)));
typedef float f32x2 __attribute__((ext_vector_type(2)));
typedef unsigned u32x4 __attribute__((ext_vector_type(4)));
typedef unsigned u32x2 __attribute__((ext_vector_type(2)));
typedef int i32x16 __attribute__((ext_vector_type(16)));

constexpr int T = 65536, D = 1024, SEQ = 2048;
constexpr int NCOL = 6912;
constexpr int NQ = 2, TQ = T / NQ;
constexpr int NEXP = 256, NSLOT = 9;
constexpr int QTILES = (TQ * 8 + 256 * 255) / 256 + 1 + TQ / 256;
constexpr int WPC = 256 / NQ;
constexpr float ALPHA = 1.189207115002721f;
constexpr float LN_EPS = 1e-5f;
constexpr int NWAVES = 8, NTHR = 512;
constexpr float Y8_SCALE = 256.f;
constexpr float M8_SCALE = 16.f;
constexpr float H8_SCALE = 32.f;
constexpr float W8_SCALE = 64.f;

constexpr size_t MiB = (size_t)1 << 20;
constexpr size_t WS_CTL = 0, CTL_ZERO_BYTES = 64 * 1024;
constexpr size_t WS_WIN = 1 * MiB, WS_WBH = 15 * MiB, WS_WBA = 16 * MiB, WS_WO = 17 * MiB, WS_WR = 19 * MiB, WS_WPG = 20 * MiB, WS_WPP = 22 * MiB;
constexpr size_t WS_ROT = 22 * MiB + 512 * 1024, WS_LB = 22 * MiB + 768 * 1024;
constexpr size_t WS_HIST = 24 * MiB, WS_TOKE = 25 * MiB, WS_TOKR = 26 * MiB, WS_TOKG = 27 * MiB;
constexpr size_t WS_TOKD = 42 * MiB;
constexpr size_t WS_STOK = 29 * MiB, WS_SGATE = 33 * MiB, WS_SDST = 37 * MiB, WS_TILEE = 41 * MiB, WS_NTILES = 41 * MiB + 512 * 1024;
constexpr size_t WS_XB = 44 * MiB;
constexpr size_t WS_YH = WS_XB, WS_YA = WS_XB + 64 * MiB;
constexpr size_t WS_Z = 172 * MiB;
constexpr size_t Z_QH = WS_Z, Z_VH = WS_Z + 64 * MiB, Z_LFF = WS_Z + 128 * MiB, Z_LFB = WS_Z + 192 * MiB, Z_GS = WS_Z + 256 * MiB;
constexpr size_t Z_AQ = WS_Z + 320 * MiB, Z_AK = WS_Z + 416 * MiB, Z_AV = WS_Z + 512 * MiB, Z_GTH = WS_Z + 608 * MiB, Z_GTA = WS_Z + 736 * MiB;
constexpr size_t WS_X1PRE = WS_Z;
constexpr size_t WS_LOGITS = WS_Z;
constexpr size_t WS_H = WS_Z;
constexpr size_t WS_P2 = WS_Z + 296 * MiB;
constexpr size_t WS_X2B = WS_Z + 104 * MiB;
constexpr size_t WS_PB = WS_Z + 424 * MiB;
constexpr size_t WS_WGU = WS_Z + 296 * MiB;
constexpr size_t WS_WD = WS_Z + 425 * MiB;
constexpr size_t WS_X1F8 = WS_Z + 490 * MiB;
constexpr size_t WS_X3PRE = WS_Z + 802 * MiB;
constexpr size_t WS_X2F8 = WS_Z + 554 * MiB;
constexpr size_t WS_YS = WS_Z + 642 * MiB;
constexpr size_t WS_END = WS_Z + 931 * MiB;
constexpr size_t DO_OF = 0, DO_OB = 64 * MiB, DO_MERGED = 0, DO_MERGED8 = 128 * MiB;

constexpr int CW_BAR = 4096;

__device__ __forceinline__ unsigned cvt_pk_bf16(float lo, float hi) { unsigned r; asm volatile("v_cvt_pk_bf16_f32 %0, %1, %2" : "=v"(r) : "v"(lo), "v"(hi)); return r; }
typedef int i32x8 __attribute__((ext_vector_type(8)));
typedef int i32x4 __attribute__((ext_vector_type(4)));
__device__ __forceinline__ unsigned pk_fp8x4(float a, float b, float c, float d) { int w = 0; w = __builtin_amdgcn_cvt_pk_fp8_f32(a, b, w, false); w = __builtin_amdgcn_cvt_pk_fp8_f32(c, d, w, true); return (unsigned)w; }
typedef float f32x2_t __attribute__((ext_vector_type(2)));
__device__ __forceinline__ void fp8x4_to_f32(unsigned w, float (&o)[4]) { const f32x2_t lo = __builtin_amdgcn_cvt_pk_f32_fp8((int)w, false), hi = __builtin_amdgcn_cvt_pk_f32_fp8((int)w, true); o[0] = lo.x; o[1] = lo.y; o[2] = hi.x; o[3] = hi.y; }
__device__ __forceinline__ float bf_lo(unsigned w) { return __uint_as_float(w << 16); }
__device__ __forceinline__ float bf_hi(unsigned w) { return __uint_as_float(w & 0xffff0000u); }
__device__ __forceinline__ float bf1(u16 b) { return __uint_as_float(((unsigned)b) << 16); }
__device__ __forceinline__ float sigmoidf_(float z) { return __builtin_amdgcn_rcpf(1.0f + __expf(-z)); }
__device__ __forceinline__ unsigned pk_f16(float lo, float hi) { _Float16 a = (_Float16)lo, b = (_Float16)hi; unsigned short ua = __builtin_bit_cast(unsigned short, a), ub = __builtin_bit_cast(unsigned short, b); return (unsigned)ua | ((unsigned)ub << 16); }
__device__ __forceinline__ float f16_lo(unsigned w) { return (float)__builtin_bit_cast(_Float16, (unsigned short)(w & 0xffffu)); }
__device__ __forceinline__ float f16_hi(unsigned w) { return (float)__builtin_bit_cast(_Float16, (unsigned short)(w >> 16)); }
__device__ __forceinline__ float wave_sum(float v) {
    v += __int_as_float(__builtin_amdgcn_update_dpp(0, __float_as_int(v), 0xB1, 0xF, 0xF, true));
    v += __int_as_float(__builtin_amdgcn_update_dpp(0, __float_as_int(v), 0x4E, 0xF, 0xF, true));
    v += __int_as_float(__builtin_amdgcn_update_dpp(0, __float_as_int(v), 0x141, 0xF, 0xF, true));
    v += __int_as_float(__builtin_amdgcn_update_dpp(0, __float_as_int(v), 0x140, 0xF, 0xF, true));
    const int iv = __float_as_int(v);
    return (__int_as_float(__builtin_amdgcn_readlane(iv, 0)) + __int_as_float(__builtin_amdgcn_readlane(iv, 16))) + (__int_as_float(__builtin_amdgcn_readlane(iv, 32)) + __int_as_float(__builtin_amdgcn_readlane(iv, 48)));
}
__device__ __forceinline__ float wave_max(float v) {
#pragma unroll
    for (int o = 1; o < 64; o <<= 1) v = fmaxf(v, __shfl_xor(v, o));
    return v;
}
template <int CTRL> __device__ __forceinline__ float dpp_f(float x) { return __int_as_float(__builtin_amdgcn_update_dpp(0, __float_as_int(x), CTRL, 0xF, 0xF, true)); }
template <int CTRL> __device__ __forceinline__ int dpp_i(int x) { return __builtin_amdgcn_update_dpp(0, x, CTRL, 0xF, 0xF, true); }
__device__ __forceinline__ float rdlane_f(float x, int l) { return __int_as_float(__builtin_amdgcn_readlane(__float_as_int(x), l)); }
#define LDS_WAIT() asm volatile("s_waitcnt lgkmcnt(0)" ::: "memory")
#define VM_WAIT() asm volatile("s_waitcnt vmcnt(0)" ::: "memory")

#define XB_TMO      128
#define XB_XCNT(j)  (256  + 64 * (j))
#define XB_XSUB(j)  (1280 + 64 * (j))
#define XB_XGEN(j)  (2304 + 64 * (j))
#define XB_TOP      3328
#define XB_TOPGEN   3392
#define XCD_BAR_WORDS 3456
#define XB_SPIN_CAP (1u << 22)

__device__ __forceinline__ unsigned xb_ld(unsigned* p)              { return __hip_atomic_load(p, __ATOMIC_RELAXED, __HIP_MEMORY_SCOPE_AGENT); }
__device__ __forceinline__ unsigned xb_add(unsigned* p, unsigned v) { return __hip_atomic_fetch_add(p, v, __ATOMIC_RELAXED, __HIP_MEMORY_SCOPE_AGENT); }
__device__ __forceinline__ unsigned xb_xcc_id() { return (unsigned)__builtin_amdgcn_s_getreg((3 << 11) | 20) & 0xFu; }
#define XB_SPIN(cond, bar) do { unsigned _sp = 0; while (cond) { __builtin_amdgcn_s_sleep(1); \
    if ((++_sp & 255u) == 0u) { if (xb_ld(&(bar)[XB_TMO])) break; if (_sp > XB_SPIN_CAP) { atomicAdd(&(bar)[XB_TMO], 1u); break; } } } } while (0)

struct XcdBarrier { unsigned* bar; unsigned x; volatile LAS unsigned* st; };

__device__ __forceinline__ XcdBarrier xcd_barrier_post(unsigned* bar, volatile LAS unsigned* st) {
    XcdBarrier b; b.bar = bar; b.x = xb_xcc_id(); b.st = st;
    if (threadIdx.x == 0) (void)xb_add(&bar[XB_XCNT(b.x)], 1u);
    return b;
}
__device__ __forceinline__ void xcd_barrier_complete(unsigned* bar, unsigned x, unsigned& nloc, unsigned& nx) {
    const unsigned G = gridDim.x * gridDim.y * gridDim.z;
    unsigned sum, cnt, mine, sp = 0u;
    for (;;) {
        sum = 0u; cnt = 0u; mine = 0u;
#pragma unroll
        for (unsigned j = 0; j < 16; ++j) { const unsigned c = xb_ld(&bar[XB_XCNT(j)]); sum += c; cnt += (c > 0u) ? 1u : 0u; mine = (j == x) ? c : mine; }
        if (sum == G) break;
        __builtin_amdgcn_s_sleep(1);
        if ((++sp & 255u) == 0u) { if (xb_ld(&bar[XB_TMO])) break; if (sp > XB_SPIN_CAP) { atomicAdd(&bar[XB_TMO], 1u); break; } }
    }
    nloc = mine > 0u ? mine : 1u; nx = cnt > 0u ? cnt : 1u;
}
__device__ __forceinline__ void xcd_barrier(const XcdBarrier& b) {
    asm volatile("s_waitcnt vmcnt(0)" ::: "memory");
    __syncthreads();
    if (threadIdx.x == 0) {
        unsigned* bar = b.bar;
        __builtin_amdgcn_s_waitcnt(0);
        unsigned nloc = b.st[0], nx = b.st[1];
        if (nloc == 0u) { xcd_barrier_complete(bar, b.x, nloc, nx); b.st[0] = nloc; b.st[1] = nx; }
        const unsigned old = xb_add(&bar[XB_XSUB(b.x)], 1u);
        const unsigned gen = old / nloc;
        if (old + 1u == (gen + 1u) * nloc) {
            __builtin_amdgcn_fence(__ATOMIC_RELEASE, "agent");
            asm volatile("s_waitcnt vmcnt(0)" ::: "memory");
            const unsigned og = xb_add(&bar[XB_TOP], 1u);
            const unsigned tg = og / nx;
            if (og + 1u == (tg + 1u) * nx) xb_add(&bar[XB_TOPGEN], 1u);
            else XB_SPIN(xb_ld(&bar[XB_TOPGEN]) == tg, bar);
            __builtin_amdgcn_fence(__ATOMIC_ACQUIRE, "agent");
            xb_add(&bar[XB_XGEN(b.x)], 1u);
            asm volatile("s_waitcnt vmcnt(0)" ::: "memory");
        } else {
            XB_SPIN(xb_ld(&bar[XB_XGEN(b.x)]) == gen, bar);
            __builtin_amdgcn_fence(__ATOMIC_ACQUIRE, "agent");
            asm volatile("s_waitcnt vmcnt(0)" ::: "memory");
        }
    }
    __syncthreads();
}

namespace pg8 {
constexpr int BM = 256, BK = 64, HALF = 128, HTB = HALF * BK * 2, STAGE_BYTES = 8 * HTB;
__host__ __device__ __forceinline__ int lds_byte(int r, int c) { const int st = (r >> 4) * 2 + (c >> 5), rr = r & 15, cc = c & 31, ob = rr * 64 + cc * 2; return st * 1024 + (ob ^ (((ob >> 9) & 1) << 5)); }
__host__ __device__ __forceinline__ void stage_rc(int b, int& R, int& C) { const int st = b / 1024, sb = b % 1024, swz = sb ^ (((sb >> 9) & 1) << 5); R = (st >> 1) * 16 + swz / 64; C = (st & 1) * 32 + (swz % 64) / 2; }
__host__ __device__ __forceinline__ int perm32(int rho) { const int n = rho >> 4, i = rho & 15; return 8 * (i >> 2) + 4 * n + (i & 3); }

struct GUnit { const char* A; const char* B; int pm, pn, aux, par, li; };

struct DenseOrder {
    static constexpr bool GATHER_ROWS = false;
    const char* A; const char* Bt; int nM, nN, nwg, G, c, K, rev = 0;
    __device__ void init(const void* A_, const void* Bt_, int M, int N, int K_, int G_, int c_) { A = (const char*)A_; Bt = (const char*)Bt_; nM = M / BM; nN = N / BM; nwg = nM * nN; G = G_; c = c_; K = K_; }
    __device__ __forceinline__ bool next(int i, GUnit& u) const {
        if ((long)i * G + c >= nwg) return false; const int nr_ = (nwg + G - 1) / G; const long L = rev ? (long)(nr_ - 1 - i) * G + c : (long)i * G + c; if (L >= nwg) return false;
        int wgid = (int)L; { const int q = nwg / 8, r = nwg % 8, xcd = wgid % 8, off = wgid / 8; wgid = (xcd < r ? xcd * (q + 1) : r * (q + 1) + (xcd - r) * q) + off; }
        const int nig = 8 * nN, gid = wgid / nig, fm = gid * 8, gsz = (nM - fm) < 8 ? (nM - fm) : 8;
        u.pm = fm + ((wgid % nig) % gsz); u.pn = (wgid % nig) / gsz; u.aux = 0;
        u.A = A + (size_t)u.pm * BM * K * 2; u.B = Bt + (size_t)u.pn * BM * K * 2; return true;
    }
    __device__ __forceinline__ unsigned rowoff(const GUnit&, int r0, int sub) const { return (unsigned)(r0 + sub) * (unsigned)K * 2u; }
    __device__ __forceinline__ void unit_begin(const GUnit&, int, int) const {}
};
struct PanelOrder {
    static constexpr bool GATHER_ROWS = false;
    const char* A; const char* Bt; int pm, nN, K;
    __device__ __forceinline__ bool next(int i, GUnit& u) const { if (i >= nN) return false; u.pm = pm; u.pn = i; u.aux = 0; u.A = A + (size_t)pm * BM * K * 2; u.B = Bt + (size_t)i * BM * K * 2; return true; }
    __device__ __forceinline__ unsigned rowoff(const GUnit&, int r0, int sub) const { return (unsigned)(r0 + sub) * (unsigned)K * 2u; }
    __device__ __forceinline__ void unit_begin(const GUnit&, int, int) const {}
};
constexpr int LDS_SIDE = 131072, LDS_TILEE = 135680, LDS_ROWIDX = LDS_TILEE + ((QTILES * 4 + 255) & ~255), LDS_ROWSLOTS = 16;
template <int NT, bool GATHER> struct MoeOrder {
    static constexpr bool GATHER_ROWS = GATHER;
    const char* A; const char* W; LAS unsigned char* lds; const int* slot_tok; const int* sdst; const float* sgate; int ntiles, G, vc, K; size_t wstride_e, wstride_pn;
    __device__ __forceinline__ void load_table(const int* tile_e, int tid) const {
        for (int i = tid; i < ntiles; i += NTHR) ((LAS int*)(lds + LDS_TILEE))[i] = tile_e[i];
        if (GATHER) { for (int j = tid; j < LDS_ROWSLOTS * 256; j += NTHR) { const int v = (j >> 8) * G + vc, tile = v / NT; if (tile < ntiles) ((LAS int*)(lds + LDS_ROWIDX))[j] = slot_tok[(size_t)tile * BM + (j & 255)]; } }
        asm volatile("s_waitcnt vmcnt(0) lgkmcnt(0)" ::: "memory"); __syncthreads(); }
    __device__ __forceinline__ bool next(int i, GUnit& u) const {
        const int v = i * G + vc; const int tile = v / NT; if (tile >= ntiles) return false;
        u.pm = tile; u.pn = v % NT; u.li = i; const int e = __builtin_amdgcn_readfirstlane(((const LAS int*)(lds + LDS_TILEE))[tile]); u.aux = e;
        u.A = GATHER ? A : A + (size_t)tile * BM * K * 2; u.B = W + (size_t)e * wstride_e + (size_t)u.pn * wstride_pn; return true;
    }
    __device__ __forceinline__ unsigned rowoff(const GUnit& u, int r0, int sub) const {
        if (!GATHER) return (unsigned)(r0 + sub) * (unsigned)K * 2u;
        const int idx = ((const LAS int*)(lds + LDS_ROWIDX))[(u.li & (LDS_ROWSLOTS - 1)) * 256 + r0 + sub];
        return (unsigned)idx * (unsigned)K * 2u;
    }
    __device__ __forceinline__ void unit_begin(const GUnit&, int, int) const {}
};

template <bool OPAQUE_K = false, int F8M = 0  , bool SADDR = true  , class Epi, class Sched>
__device__ __forceinline__ void gemm_phase(LAS unsigned char* lds, const int K_, const Sched& S, const Epi& E) {
    constexpr bool F8 = F8M != 0; constexpr bool F8_SC = F8M == 2;
    int K = K_; if (OPAQUE_K) asm volatile("" : "+s"(K));
    int tid_ = threadIdx.x; asm volatile("" : "+v"(tid_));
    const int tid = tid_, wid = __builtin_amdgcn_readfirstlane(tid >> 6), lane = tid & 63, wr = wid >> 2, wc = wid & 3, fr = lane & 15, fq = lane >> 4;
    const int nt = K / BK;
    unsigned colb[2]; int r0w[2]; unsigned voffB0 = 0, oaS = 0;
#pragma unroll
    for (int i = 0; i < 2; ++i) { int R, C; stage_rc(tid * 16 + i * 8192, R, C); const int Rb = Epi::PERM ? ((R & ~31) + perm32(R & 31)) : R;
        colb[i] = (unsigned)C * 2u; r0w[i] = 16 * ((wid >> 1) + 4 * i); if (i == 0) { voffB0 = (unsigned)(Rb * K + C) * 2u; oaS = (unsigned)(R * K + C) * 2u; } }
    const size_t p64 = (size_t)64 * K * 2; const unsigned K2 = (unsigned)K * 2u, colb0 = colb[0]; const int ridx_lane = (r0w[0] + (lane >> 2)) * 4;
    const int sub = lane >> 2;
    const size_t kstep = (size_t)(BK * 2);
    const size_t hstep = (size_t)HALF * K * 2;
    const unsigned ldsw = (unsigned)wid * 1024u;
    const int aoff = lds_byte(wr * 64 + fr, fq * 8), boff = lds_byte(wc * 32 + fr, fq * 8);
#define PG8_SA(b, h) (((b) * 2 + (h)) * HTB)
#define PG8_SB(b, h) ((4 + (b) * 2 + (h)) * HTB)
#define PG8_STAGE1(ldsaddr, gbase, vo) do { const unsigned long long gb_ = (unsigned long long)(gbase); \
        if constexpr (SADDR) { const unsigned la_ = (unsigned)(size_t)(ldsaddr); \
            asm volatile("s_mov_b32 m0, %2\n\ts_nop 0\n\tglobal_load_lds_dwordx4 %0, %1" :: "v"(vo), "s"(gb_), "s"(la_) : "memory"); }     \
        else { unsigned lo_, hi_; \
            asm volatile("v_add_co_u32 %0, vcc, %2, %4\n\tv_mov_b32 %1, %3\n\tv_addc_co_u32 %1, vcc, 0, %1, vcc" : "=&v"(lo_), "=&v"(hi_) : "s"((unsigned)gb_), "s"((unsigned)(gb_ >> 32)), "v"(vo) : "vcc"); \
            __builtin_amdgcn_global_load_lds((const unsigned*)(((unsigned long long)hi_ << 32) | lo_), (LAS unsigned*)(ldsaddr), 16, 0, 0); } } while (0)
#define PG8_STAGE_B(bufoff, gbase) do { PG8_STAGE1(lds + (bufoff) + ldsw, (const char*)(gbase), voffB0); PG8_STAGE1(lds + (bufoff) + ldsw + 8192, (const char*)(gbase) + p64, voffB0); } while (0)
#define PG8_STAGE_A(bufoff, gbase, h, li_) do { if constexpr (Sched::GATHER_ROWS) { \
            PG8_STAGE1(lds + (bufoff) + ldsw, (const char*)(gbase), (unsigned)gi##h##0 * K2 + colb0); PG8_STAGE1(lds + (bufoff) + ldsw + 8192, (const char*)(gbase), (unsigned)gi##h##1 * K2 + colb0); } \
        else { PG8_STAGE1(lds + (bufoff) + ldsw, (const char*)(gbase) + (h) * hstep, oaS); PG8_STAGE1(lds + (bufoff) + ldsw + 8192, (const char*)(gbase) + (h) * hstep + p64, oaS); } } while (0)
#define PG8_GIDX(h, li_) int gi##h##0 = 0, gi##h##1 = 0; if constexpr (Sched::GATHER_ROWS) { int rl_ = ridx_lane; asm volatile("" : "+v"(rl_));   const LAS unsigned char* gp_ = lds + LDS_ROWIDX + ((li_) & (LDS_ROWSLOTS - 1)) * 1024 + (h) * 512 + rl_; gi##h##0 = *(const LAS int*)gp_; gi##h##1 = *(const LAS int*)(gp_ + 256); }
#define PG8_LDA(dst, b, h) do { _Pragma("unroll") for (int m = 0; m < 4; ++m) _Pragma("unroll") for (int k = 0; k < 2; ++k) dst[m][k] = *(const LAS bf16x8*)(lds + PG8_SA(b, h) + aoff + m * 2048 + k * 1024); } while (0)
#define PG8_LDB(dst, b, h) do { _Pragma("unroll") for (int n = 0; n < 2; ++n) _Pragma("unroll") for (int k = 0; k < 2; ++k) dst[n][k] = *(const LAS bf16x8*)(lds + PG8_SB(b, h) + boff + n * 2048 + k * 1024); } while (0)
#define PG8_MMA(ai, bj, At, Bt) do { __builtin_amdgcn_s_setprio(1); _Pragma("unroll") for (int m = 0; m < 4; ++m) _Pragma("unroll") for (int n = 0; n < 2; ++n) { \
        if constexpr (F8) { \
            if constexpr (F8_SC) { const i32x8 a8_ = __builtin_shufflevector(__builtin_bit_cast(i32x4, At[m][0]), __builtin_bit_cast(i32x4, At[m][1]), 0, 1, 2, 3, 4, 5, 6, 7), b8_ = __builtin_shufflevector(__builtin_bit_cast(i32x4, Bt[n][0]), __builtin_bit_cast(i32x4, Bt[n][1]), 0, 1, 2, 3, 4, 5, 6, 7); \
                acc[ai][bj][m][n] = __builtin_amdgcn_mfma_scale_f32_16x16x128_f8f6f4(b8_, a8_, acc[ai][bj][m][n], 0, 0, 0, sc1_, 0, sc1_); } \
            else { _Pragma("unroll") for (int k = 0; k < 2; ++k) { typedef long l64x2 __attribute__((ext_vector_type(2))); const l64x2 a_ = __builtin_bit_cast(l64x2, At[m][k]), b_ = __builtin_bit_cast(l64x2, Bt[n][k]); \
                acc[ai][bj][m][n] = __builtin_amdgcn_mfma_f32_16x16x32_fp8_fp8(b_[0], a_[0], acc[ai][bj][m][n], 0, 0, 0); acc[ai][bj][m][n] = __builtin_amdgcn_mfma_f32_16x16x32_fp8_fp8(b_[1], a_[1], acc[ai][bj][m][n], 0, 0, 0); } } } \
        else { _Pragma("unroll") for (int k = 0; k < 2; ++k) acc[ai][bj][m][n] = __builtin_amdgcn_mfma_f32_16x16x32_bf16(Bt[n][k], At[m][k], acc[ai][bj][m][n], 0, 0, 0); } } \
        __builtin_amdgcn_s_setprio(0); } while (0)
#define PG8_WAIT_V(n) asm volatile("s_waitcnt vmcnt(" #n ")" ::: "memory")
#define PG8_WAIT_L(n) asm volatile("s_waitcnt lgkmcnt(" #n ")" ::: "memory")
#define PG8_BAR __builtin_amdgcn_s_barrier()
#define PG8_SCHED __builtin_amdgcn_sched_barrier(0)
    int sc1_; asm volatile("s_mov_b32 %0, 0x7f7f7f7f" : "=s"(sc1_));
    GUnit cur, nxt; int ui = 0;
    if (!S.next(0, cur)) return;
    f32x4 acc[2][2][4][2];
#pragma unroll
    for (int a = 0; a < 2; ++a)
#pragma unroll
        for (int b = 0; b < 2; ++b)
#pragma unroll
            for (int m = 0; m < 4; ++m)
#pragma unroll
                for (int n = 0; n < 2; ++n) acc[a][b][m][n] = (f32x4){0.f, 0.f, 0.f, 0.f};
    bf16x8 At[4][2], B0[2][2], B1[2][2];
    const char* cA = cur.A; const char* cB = cur.B;
    { PG8_GIDX(0, cur.li) PG8_GIDX(1, cur.li) PG8_STAGE_B(PG8_SB(0, 0), cB); PG8_STAGE_A(PG8_SA(0, 0), cA, 0, cur.li); PG8_STAGE_B(PG8_SB(0, 1), cB + hstep); PG8_STAGE_A(PG8_SA(0, 1), cA, 1, cur.li); }
    if (wr == 1) PG8_BAR;
    PG8_WAIT_V(4); PG8_BAR;
    { PG8_GIDX(0, cur.li) PG8_STAGE_B(PG8_SB(1, 0), cB + kstep); PG8_STAGE_A(PG8_SA(1, 0), cA + kstep, 0, cur.li); PG8_STAGE_B(PG8_SB(1, 1), cB + hstep + kstep); }
    PG8_WAIT_V(6); PG8_BAR;
    for (;;) {
        cur.par = ui & 1; S.unit_begin(cur, ui & 1, wid);
        const bool has_next = S.next(ui + 1, nxt);
        const char* nA = has_next ? nxt.A : cA; const char* nB = has_next ? nxt.B : cB;
        for (int t = 0; t < nt; t += 2) {
            const bool last = (t == nt - 2);
            const char* a1 = cA + (size_t)(t + 1) * kstep;
            const char* a2 = last ? nA : cA + (size_t)(t + 2) * kstep; const char* b2 = last ? nB : cB + (size_t)(t + 2) * kstep;
            const char* a3 = a2 + kstep; const char* b3 = b2 + kstep;
            const int lis = (last && has_next) ? nxt.li : cur.li;
            { PG8_GIDX(1, cur.li) PG8_LDB(B0, 0, 0); PG8_SCHED; PG8_LDA(At, 0, 0); PG8_STAGE_A(PG8_SA(1, 1), a1, 1, cur.li); }
            PG8_WAIT_L(8); PG8_BAR; PG8_WAIT_L(0); PG8_MMA(0, 0, At, B0); PG8_BAR; PG8_SCHED;
            PG8_LDB(B1, 0, 1); PG8_STAGE_B(PG8_SB(0, 0), b2);
            PG8_BAR; PG8_WAIT_L(0); PG8_MMA(0, 1, At, B1); PG8_BAR;
            { PG8_GIDX(0, lis) PG8_LDA(At, 0, 1); PG8_STAGE_A(PG8_SA(0, 0), a2, 0, lis); }
            PG8_BAR; PG8_WAIT_L(0); PG8_MMA(1, 0, At, B0); PG8_BAR; PG8_SCHED;
            PG8_STAGE_B(PG8_SB(0, 1), b2 + hstep);
            PG8_WAIT_V(6); PG8_BAR; PG8_MMA(1, 1, At, B1); PG8_BAR;
            { PG8_GIDX(1, lis) PG8_LDB(B0, 1, 0); PG8_SCHED; PG8_LDA(At, 1, 0); PG8_STAGE_A(PG8_SA(0, 1), a2, 1, lis); }
            PG8_WAIT_L(8); PG8_BAR; PG8_WAIT_L(0); PG8_MMA(0, 0, At, B0); PG8_BAR; PG8_SCHED;
            PG8_LDB(B1, 1, 1); PG8_STAGE_B(PG8_SB(1, 0), b3);
            PG8_BAR; PG8_WAIT_L(0); PG8_MMA(0, 1, At, B1); PG8_BAR;
            { PG8_GIDX(0, lis) PG8_LDA(At, 1, 1); PG8_STAGE_A(PG8_SA(1, 0), a3, 0, lis); }
            PG8_BAR; PG8_WAIT_L(0); PG8_MMA(1, 0, At, B0); PG8_BAR; PG8_SCHED;
            PG8_STAGE_B(PG8_SB(1, 1), b3 + hstep);
            PG8_WAIT_V(6); PG8_BAR; PG8_MMA(1, 1, At, B1); PG8_BAR;
        }
        { int l_ = threadIdx.x; asm volatile("" : "+v"(l_));
          E(acc, cur, wr, wc, l_ & 15, (l_ & 63) >> 4); }
        if (!has_next) break;
#pragma unroll
        for (int a = 0; a < 2; ++a)
#pragma unroll
            for (int b = 0; b < 2; ++b)
#pragma unroll
                for (int m = 0; m < 4; ++m)
#pragma unroll
                    for (int n = 0; n < 2; ++n) acc[a][b][m][n] = (f32x4){0.f, 0.f, 0.f, 0.f};
        cur = nxt; cA = nA; cB = nB; ++ui;
    }
    PG8_WAIT_V(0);
    if (wr == 0) PG8_BAR;
    PG8_BAR;
#undef PG8_SA
#undef PG8_SB
#undef PG8_STAGE1
#undef PG8_STAGE_A
#undef PG8_GIDX
#undef PG8_STAGE_B
#undef PG8_LDA
#undef PG8_LDB
#undef PG8_MMA
#undef PG8_WAIT_V
#undef PG8_WAIT_L
#undef PG8_BAR
#undef PG8_SCHED
}

#define EPI_LOOP_ROWS for (int ai = 0; ai < 2; ++ai) _Pragma("unroll") for (int m = 0; m < 4; ++m)

__device__ __forceinline__ u32x4 pair16(u32x2 xa, u32x2 xb) {
    const auto lo = __builtin_amdgcn_permlane16_swap(xa.x, xb.x, false, false), hi = __builtin_amdgcn_permlane16_swap(xa.y, xb.y, false, false);
    u32x4 w; w.x = lo[0]; w.y = hi[0]; w.z = lo[1]; w.w = hi[1]; return w; }
enum { K_SILU = 0, K_ID = 1, K_LOGF = 2, K_ROT = 3, K_SIG = 4, K_ID8 = 5   };
struct EpiZ {
    static constexpr bool PERM = true;
    unsigned char* ws; const float* rot; const float* lb; float osc;
    template <int KIND> __device__ __forceinline__ void body(const f32x4 (&acc)[2][2][4][2], u16* base, int ld, int pnl, int pm, float scale, const float* lbp, int wr, int wc, int fr, int fq) const {
        const int row0 = pm * BM + wr * 64 + fr, col0 = pnl * BM + wc * 32 + 8 * fq;
        if constexpr (KIND == K_ID8) {
            unsigned char* bp = (unsigned char*)base + (size_t)(row0 + 16 * (fq & 1)) * ld + col0 - 8 * (fq & 1);
#pragma unroll
            for (int ai = 0; ai < 2; ++ai)
#pragma unroll
                for (int mp = 0; mp < 4; mp += 2)
#pragma unroll
                    for (int bj = 0; bj < 2; ++bj) { u32x2 x[2];
#pragma unroll
                        for (int t = 0; t < 2; ++t) { const f32x4 v0 = acc[ai][bj][mp + t][0] * osc, v1 = acc[ai][bj][mp + t][1] * osc; x[t].x = pk_fp8x4(v0[0], v0[1], v0[2], v0[3]); x[t].y = pk_fp8x4(v1[0], v1[1], v1[2], v1[3]); }
                        *(u32x4*)(bp + (size_t)(ai * HALF + mp * 16) * ld + bj * HALF) = pair16(x[0], x[1]); }
            return;
        }
        f32x4 l0[2], l1[2];
        if (KIND == K_LOGF) {
#pragma unroll
            for (int bj = 0; bj < 2; ++bj) { l0[bj] = *(const f32x4*)(lbp + col0 + bj * HALF); l1[bj] = *(const f32x4*)(lbp + col0 + bj * HALF + 4); }
        }
        const bool rotl = (KIND == K_ROT) && ((wc & 1) == 0) && (fq < 2);
        const float sgn = (fq == 0) ? -1.f : 1.f;
#pragma unroll
        for (int ai = 0; ai < 2; ++ai) {
        f32x4 rt[4][4];
        if (KIND == K_ROT) {
#pragma unroll
            for (int m = 0; m < 4; ++m) { const float* rp = rot + (size_t)((row0 + ai * HALF + m * 16) & (SEQ - 1)) * 16;
#pragma unroll
                for (int k = 0; k < 4; ++k) rt[m][k] = *(const f32x4*)(rp + 4 * k); }
            __builtin_amdgcn_sched_barrier(0);
        }
#pragma unroll
        for (int m = 0; m < 4; ++m) {
            const int row = row0 + ai * HALF + m * 16;
            f32x4 cs0, cs1, sn0, sn1;
            if (KIND == K_ROT) { cs0 = rt[m][0]; cs1 = rt[m][1]; sn0 = rt[m][2]; sn1 = rt[m][3]; }
#pragma unroll
            for (int bj = 0; bj < 2; ++bj) {
                f32x4 v0 = acc[ai][bj][m][0] * osc, v1 = acc[ai][bj][m][1] * osc;
                if (KIND == K_SILU) {
#pragma unroll
                    for (int j = 0; j < 4; ++j) { v0[j] = v0[j] * sigmoidf_(v0[j]); v1[j] = v1[j] * sigmoidf_(v1[j]); }
                } else if (KIND == K_SIG) {
#pragma unroll
                    for (int j = 0; j < 4; ++j) { v0[j] = sigmoidf_(v0[j]); v1[j] = sigmoidf_(v1[j]); }
                } else if (KIND == K_LOGF) {
#pragma unroll
                    for (int j = 0; j < 4; ++j) { v0[j] = __logf(l0[bj][j] + (1.f - l0[bj][j]) * sigmoidf_(v0[j])); v1[j] = __logf(l1[bj][j] + (1.f - l1[bj][j]) * sigmoidf_(v1[j])); }
                } else if (KIND == K_ROT) {
                    f32x4 o0, o1;
#pragma unroll
                    for (int j = 0; j < 4; ++j) { o0[j] = __shfl_xor(v0[j], 16); o1[j] = __shfl_xor(v1[j], 16); }
                    if (rotl) {
#pragma unroll
                        for (int j = 0; j < 4; ++j) { v0[j] = v0[j] * cs0[j] + sgn * o0[j] * sn0[j]; v1[j] = v1[j] * cs1[j] + sgn * o1[j] * sn1[j]; }
                    }
                    v0 = v0 * scale; v1 = v1 * scale;
                }
                if (KIND == K_ID8) { u32x2 w8; w8.x = pk_fp8x4(v0[0], v0[1], v0[2], v0[3]); w8.y = pk_fp8x4(v1[0], v1[1], v1[2], v1[3]);
                    *(u32x2*)((unsigned char*)base + (size_t)row * ld + col0 + bj * HALF) = w8; continue; }
                u32x4 w;
                if (KIND == K_LOGF) { w.x = pk_f16(v0[0], v0[1]); w.y = pk_f16(v0[2], v0[3]); w.z = pk_f16(v1[0], v1[1]); w.w = pk_f16(v1[2], v1[3]); }
                else { w.x = cvt_pk_bf16(v0[0], v0[1]); w.y = cvt_pk_bf16(v0[2], v0[3]); w.z = cvt_pk_bf16(v1[0], v1[1]); w.w = cvt_pk_bf16(v1[2], v1[3]); }
                *(u32x4*)(base + (size_t)row * ld + col0 + bj * HALF) = w;
            }
        }
        }
    }
    __device__ __forceinline__ void operator()(const f32x4 (&acc)[2][2][4][2], const GUnit& u, int wr, int wc, int fr, int fq) const {
        const int pn = u.pn, pm = u.pm;
        if (pn < DBG_PN_LO) return;
        if (pn < 2)       body<K_ID8>(acc, (u16*)(ws + Z_QH), 512, pn, pm, 1.f, nullptr, wr, wc, fr, fq);
        else if (pn < 4)  body<K_ID8>(acc, (u16*)(ws + Z_VH), 512, pn - 2, pm, 1.f, nullptr, wr, wc, fr, fq);
        else if (pn < 6)  body<K_ID>(acc, (u16*)(ws + Z_LFF), 512, pn - 4, pm, 1.f, nullptr, wr, wc, fr, fq);
        else if (pn < 8)  body<K_ID>(acc, (u16*)(ws + Z_LFB), 512, pn - 6, pm, 1.f, nullptr, wr, wc, fr, fq);
        else if (pn < 10) body<K_ID8>(acc, (u16*)(ws + Z_GS), 512, pn - 8, pm, 1.f, nullptr, wr, wc, fr, fq);
        else if (pn < 13) body<K_ROT>(acc, (u16*)(ws + Z_AQ), 768, pn - 10, pm, 0.125f, nullptr, wr, wc, fr, fq);
        else if (pn < 16) body<K_ROT>(acc, (u16*)(ws + Z_AK), 768, pn - 13, pm, 1.f, nullptr, wr, wc, fr, fq);
        else if (pn < 19) body<K_ID>(acc, (u16*)(ws + Z_AV), 768, pn - 16, pm, 1.f, nullptr, wr, wc, fr, fq);
        else if (pn < 23) body<K_ID8>(acc, (u16*)(ws + Z_GTH), 1024, pn - 19, pm, 1.f, nullptr, wr, wc, fr, fq);
        else              body<K_ID8>(acc, (u16*)(ws + Z_GTA), 1024, pn - 23, pm, 1.f, nullptr, wr, wc, fr, fq);
    }
};

template <bool ADD> struct EpiGated {
    static constexpr bool PERM = true;
    const u16* gate; u16* out; unsigned char* out8; int ld;
    __device__ __forceinline__ void operator()(const f32x4 (&acc)[2][2][4][2], const GUnit& u, int wr, int wc, int fr, int fq) const {
        const int row0 = u.pm * BM + wr * 64 + fr, col0 = u.pn * BM + wc * 32 + 8 * fq;
        constexpr float isc = 1.0f / W8_SCALE;
#pragma unroll
        for (int ai = 0; ai < 2; ++ai)
#pragma unroll
        for (int mp = 0; mp < 4; mp += 2) {
            u32x2 gv[4][2]; u32x4 pv[4][2];
#pragma unroll
            for (int m = mp; m < mp + 2; ++m)
#pragma unroll
                for (int bj = 0; bj < 2; ++bj) { const size_t off = (size_t)(row0 + ai * HALF + m * 16) * ld + col0 + bj * HALF; gv[m][bj] = *(const u32x2*)((const unsigned char*)gate + off); if (ADD) pv[m][bj] = *(const u32x4*)(out + off); }
            __builtin_amdgcn_sched_barrier(0);
#pragma unroll
                for (int bj = 0; bj < 2; ++bj) { u32x2 x8[2];
#pragma unroll
                    for (int t = 0; t < 2; ++t) { const int m = mp + t; const size_t off = (size_t)(row0 + ai * HALF + m * 16) * ld + col0 + bj * HALF;
                        const u32x2 g = gv[m][bj]; float g0[4], g1[4]; fp8x4_to_f32(g.x, g0); fp8x4_to_f32(g.y, g1);
                        f32x4 v0 = acc[ai][bj][m][0] * isc, v1 = acc[ai][bj][m][1] * isc;
#pragma unroll
                        for (int j = 0; j < 4; ++j) { v0[j] *= sigmoidf_(g0[j]); v1[j] *= sigmoidf_(g1[j]); }
                        if (ADD) { const u32x4 p = pv[m][bj];
                            v0[0] += bf_lo(p.x); v0[1] += bf_hi(p.x); v0[2] += bf_lo(p.y); v0[3] += bf_hi(p.y);
                            v1[0] += bf_lo(p.z); v1[1] += bf_hi(p.z); v1[2] += bf_lo(p.w); v1[3] += bf_hi(p.w);
                            x8[t].x = pk_fp8x4(v0[0] * M8_SCALE, v0[1] * M8_SCALE, v0[2] * M8_SCALE, v0[3] * M8_SCALE); x8[t].y = pk_fp8x4(v1[0] * M8_SCALE, v1[1] * M8_SCALE, v1[2] * M8_SCALE, v1[3] * M8_SCALE); }
                        else { u32x4 w; w.x = cvt_pk_bf16(v0[0], v0[1]); w.y = cvt_pk_bf16(v0[2], v0[3]); w.z = cvt_pk_bf16(v1[0], v1[1]); w.w = cvt_pk_bf16(v1[2], v1[3]);
                            *(u32x4*)(out + off) = w; }
                    }
                    if (ADD) *(u32x4*)(out8 + (size_t)(row0 + ai * HALF + (mp + (fq & 1)) * 16) * ld + col0 - 8 * (fq & 1) + bj * HALF) = pair16(x8[0], x8[1]);
                }
            __builtin_amdgcn_sched_barrier(0);
        }
    }
};
struct EpiF32Res {
    static constexpr bool PERM = false;
    float* C; const float* res; u16* Cb; int ld; float alpha; float asc;
    __device__ __forceinline__ void operator()(const f32x4 (&acc)[2][2][4][2], const GUnit& u, int wr, int wc, int fr, int fq) const {
        const int row0 = u.pm * BM + wr * 64 + fr, col0 = u.pn * BM + wc * 32 + 4 * fq;
#pragma unroll
        EPI_LOOP_ROWS {
            const size_t off = (size_t)(row0 + ai * HALF + m * 16) * ld + col0;
#pragma unroll
            for (int bj = 0; bj < 2; ++bj)
#pragma unroll
                for (int n = 0; n < 2; ++n) { f32x4 v = acc[ai][bj][m][n] * asc; if (res) v = v + alpha * *(const f32x4*)(res + off + bj * HALF + n * 16);
                    if (Cb) { u32x2 w; w.x = cvt_pk_bf16(v[0], v[1]); w.y = cvt_pk_bf16(v[2], v[3]); *(u32x2*)(Cb + off + bj * HALF + n * 16) = w; } else *(f32x4*)(C + off + bj * HALF + n * 16) = v; }
        }
    }
};
struct EpiBf16Res {
    static constexpr bool PERM = true;
    const float* res; u16* Cb; int ld; float alpha; float asc;
    __device__ __forceinline__ void operator()(const f32x4 (&acc)[2][2][4][2], const GUnit& u, int wr, int wc, int fr, int fq) const {
        const int row0 = u.pm * BM + wr * 64 + fr, col0 = u.pn * BM + wc * 32 + 8 * fq;
#pragma unroll
        for (int ai = 0; ai < 2; ++ai)
#pragma unroll
        for (int mp = 0; mp < 4; mp += 2) {
            f32x4 r[2][2][2];
#pragma unroll
            for (int t = 0; t < 2; ++t)
#pragma unroll
                for (int bj = 0; bj < 2; ++bj) { const float* rp = res + (size_t)(row0 + ai * HALF + (mp + t) * 16) * ld + col0 + bj * HALF; r[t][bj][0] = *(const f32x4*)rp; r[t][bj][1] = *(const f32x4*)(rp + 4); }
            __builtin_amdgcn_sched_barrier(0);
#pragma unroll
            for (int t = 0; t < 2; ++t)
#pragma unroll
                for (int bj = 0; bj < 2; ++bj) { const int m = mp + t; const f32x4 v0 = acc[ai][bj][m][0] * asc + alpha * r[t][bj][0], v1 = acc[ai][bj][m][1] * asc + alpha * r[t][bj][1];
                    u32x4 w; w.x = cvt_pk_bf16(v0[0], v0[1]); w.y = cvt_pk_bf16(v0[2], v0[3]); w.z = cvt_pk_bf16(v1[0], v1[1]); w.w = cvt_pk_bf16(v1[2], v1[3]);
                    *(u32x4*)(Cb + (size_t)(row0 + ai * HALF + m * 16) * ld + col0 + bj * HALF) = w; }
            __builtin_amdgcn_sched_barrier(0);
        }
    }
};
struct EpiBf16 {
    static constexpr bool PERM = true;
    u16* O; int ld;
    __device__ __forceinline__ void operator()(const f32x4 (&acc)[2][2][4][2], const GUnit& u, int wr, int wc, int fr, int fq) const {
        const int row0 = u.pm * BM + wr * 64 + fr, col0 = u.pn * BM + wc * 32 + 8 * fq;
#pragma unroll
        EPI_LOOP_ROWS {
            u16* rowp = O + (size_t)(row0 + ai * HALF + m * 16) * ld + col0;
#pragma unroll
            for (int bj = 0; bj < 2; ++bj) { const f32x4 v0 = acc[ai][bj][m][0], v1 = acc[ai][bj][m][1];
                u32x4 w; w.x = cvt_pk_bf16(v0[0], v0[1]); w.y = cvt_pk_bf16(v0[2], v0[3]); w.z = cvt_pk_bf16(v1[0], v1[1]); w.w = cvt_pk_bf16(v1[2], v1[3]);
                *(u32x4*)(rowp + bj * HALF) = w; }
        }
    }
};
struct EpiSwiglu {
    static constexpr bool PERM = true;
    unsigned char* H;
    __device__ __forceinline__ void operator()(const f32x4 (&acc)[2][2][4][2], const GUnit& u, int wr, int wc, int fr, int fq) const {
        const int row0 = u.pm * BM + wr * 64 + fr, col0 = u.pn * HALF + wc * 32 + 8 * fq;
        constexpr float isc = 1.0f / W8_SCALE;
        unsigned char* hp = H + (size_t)(row0 + 16 * (fq & 1)) * 256 + col0 - 8 * (fq & 1);
#pragma unroll
        for (int ai = 0; ai < 2; ++ai)
#pragma unroll
            for (int mp = 0; mp < 4; mp += 2) { u32x2 x[2];
#pragma unroll
                for (int t = 0; t < 2; ++t) { const int m = mp + t;
                    f32x4 g0 = acc[ai][0][m][0] * isc, g1 = acc[ai][0][m][1] * isc; const f32x4 u0 = acc[ai][1][m][0] * (isc * H8_SCALE), u1 = acc[ai][1][m][1] * (isc * H8_SCALE);
#pragma unroll
                    for (int j = 0; j < 4; ++j) { g0[j] = g0[j] * sigmoidf_(g0[j]) * u0[j]; g1[j] = g1[j] * sigmoidf_(g1[j]) * u1[j]; }
                    x[t].x = pk_fp8x4(g0[0], g0[1], g0[2], g0[3]); x[t].y = pk_fp8x4(g1[0], g1[1], g1[2], g1[3]); }
                *(u32x4*)(hp + (size_t)(ai * HALF + mp * 16) * 256) = pair16(x[0], x[1]); }
    }
};
struct EpiDown {
    static constexpr bool PERM = true;
    unsigned char* Y; LAS unsigned char* lds;
    __device__ __forceinline__ void operator()(const f32x4 (&acc)[2][2][4][2], const GUnit& u, int wr, int wc, int fr, int fq) const {
        const int col0 = u.pn * BM + wc * 32 + 8 * fq;
        const LAS unsigned* side = (const LAS unsigned*)(lds + LDS_SIDE + u.par * 2048);
        unsigned dd[8]; float gg[8];
#pragma unroll
        for (int j = 0; j < 8; ++j) { const int lr = wr * 64 + fr + (j >> 2) * HALF + (j & 3) * 16; dd[j] = side[(lr >> 5) * 64 + (lr & 31)]; gg[j] = __uint_as_float(side[(lr >> 5) * 64 + 32 + (lr & 31)]) * (Y8_SCALE / (W8_SCALE * H8_SCALE)); }
#pragma unroll
        EPI_LOOP_ROWS {
            const unsigned d = dd[ai * 4 + m]; const float g = gg[ai * 4 + m];
            unsigned char* rowp = Y + (size_t)(d * (unsigned)D + (unsigned)col0);
#pragma unroll
            for (int bj = 0; bj < 2; ++bj) { const f32x4 v0 = acc[ai][bj][m][0] * g, v1 = acc[ai][bj][m][1] * g;
                u32x2 w; w.x = pk_fp8x4(v0[0], v0[1], v0[2], v0[3]); w.y = pk_fp8x4(v1[0], v1[1], v1[2], v1[3]);
                *(u32x2*)(rowp + bj * HALF) = w; }
        }
    }
};
struct EpiPle {
    static constexpr bool PERM = true;
    u16* out; const u16* x2; const u16* p2; int ld; float asc;
    __device__ __forceinline__ void operator()(const f32x4 (&acc)[2][2][4][2], const GUnit& u, int wr, int wc, int fr, int fq) const {
        const int row0 = u.pm * BM + wr * 64 + fr, col0 = u.pn * BM + wc * 32 + 8 * fq;
#pragma unroll
        for (int ai = 0; ai < 2; ++ai) {
            u32x4 xv[4][2], pv[4][2];
#pragma unroll
            for (int m = 0; m < 4; ++m)
#pragma unroll
                for (int bj = 0; bj < 2; ++bj) { const size_t o = (size_t)(row0 + ai * HALF + m * 16) * ld + col0 + bj * HALF; xv[m][bj] = *(const u32x4*)(x2 + o); pv[m][bj] = *(const u32x4*)(p2 + o); }
            __builtin_amdgcn_sched_barrier(0);
#pragma unroll
            for (int m = 0; m < 4; ++m)
#pragma unroll
                for (int bj = 0; bj < 2; ++bj) { const size_t o = (size_t)(row0 + ai * HALF + m * 16) * ld + col0 + bj * HALF; const u32x4 x = xv[m][bj], p = pv[m][bj]; const f32x4 a = acc[ai][bj][m][0] * asc, b = acc[ai][bj][m][1] * asc;
                    u32x4 r; r.x = cvt_pk_bf16(ALPHA * bf_lo(x.x) + sigmoidf_(a[0]) * bf_lo(p.x), ALPHA * bf_hi(x.x) + sigmoidf_(a[1]) * bf_hi(p.x));
                    r.y = cvt_pk_bf16(ALPHA * bf_lo(x.y) + sigmoidf_(a[2]) * bf_lo(p.y), ALPHA * bf_hi(x.y) + sigmoidf_(a[3]) * bf_hi(p.y));
                    r.z = cvt_pk_bf16(ALPHA * bf_lo(x.z) + sigmoidf_(b[0]) * bf_lo(p.z), ALPHA * bf_hi(x.z) + sigmoidf_(b[1]) * bf_hi(p.z));
                    r.w = cvt_pk_bf16(ALPHA * bf_lo(x.w) + sigmoidf_(b[2]) * bf_lo(p.w), ALPHA * bf_hi(x.w) + sigmoidf_(b[3]) * bf_hi(p.w));
                    *(u32x4*)(out + o) = r; }
            __builtin_amdgcn_sched_barrier(0);
        }
    }
};
}

struct Args { const float* in[25]; float* out; unsigned char* ws; int lo, hi; };
struct Frame {
    LAS unsigned char* lds; int tid, lane, wave, vcu, G; unsigned char* ws; unsigned char* dout;
};

__device__ __forceinline__ void transpose_item(const float* __restrict__ W, int ldw, int k0, int n0, u16* __restrict__ WT, size_t dst_row0, int Kd, LAS float* scr, int lane) {
#pragma unroll 8
    for (int i = 0; i < 32; ++i) { const int kk = 2 * i + (lane >> 5); scr[kk * 33 + (lane & 31)] = W[(size_t)(k0 + kk) * ldw + n0 + (lane & 31)]; }
    LDS_WAIT(); asm volatile("" ::: "memory");
    const int c = lane & 7;
#pragma unroll
    for (int j = 0; j < 4; ++j) { const int n = (lane >> 3) + 8 * j; const LAS float* s = scr + (8 * c) * 33 + n;
        u32x4 o; o.x = cvt_pk_bf16(s[0 * 33], s[1 * 33]); o.y = cvt_pk_bf16(s[2 * 33], s[3 * 33]); o.z = cvt_pk_bf16(s[4 * 33], s[5 * 33]); o.w = cvt_pk_bf16(s[6 * 33], s[7 * 33]);
        *(u32x4*)(WT + (dst_row0 + n) * (size_t)Kd + k0 + 8 * c) = o; }
    LDS_WAIT(); asm volatile("" ::: "memory");
}

__device__ __forceinline__ void transpose_item_f8(const float* __restrict__ W, int ldw, int k0, int n0, unsigned char* __restrict__ WT, size_t dst_row0, int Kd, float scale, LAS float* scr, int lane) {
    float tv[32];
#pragma unroll
    for (int i = 0; i < 32; ++i) tv[i] = W[(size_t)(k0 + 2 * i + (lane >> 5)) * ldw + n0 + (lane & 31)];
#pragma unroll
    for (int i = 0; i < 32; ++i) scr[(2 * i + (lane >> 5)) * 33 + (lane & 31)] = tv[i];
    LDS_WAIT(); asm volatile("" ::: "memory");
    const int c = lane & 7;
#pragma unroll
    for (int j = 0; j < 4; ++j) { const int n = (lane >> 3) + 8 * j; const LAS float* sp = scr + (8 * c) * 33 + n;
        u32x2 o; o.x = pk_fp8x4(sp[0 * 33] * scale, sp[1 * 33] * scale, sp[2 * 33] * scale, sp[3 * 33] * scale); o.y = pk_fp8x4(sp[4 * 33] * scale, sp[5 * 33] * scale, sp[6 * 33] * scale, sp[7 * 33] * scale);
        *(u32x2*)(WT + (dst_row0 + n) * (size_t)Kd + k0 + 8 * c) = o; }
    LDS_WAIT(); asm volatile("" ::: "memory");
}
__device__ __forceinline__ bool transpose_matrix_item(int& r, const float* W, int K, int N, u16* WT, LAS float* scr, int lane) {
    const int nitems = (K / 64) * (N / 32);
    if (r < nitems) { const int nblk = N / 32, kb = r / nblk, nb = r % nblk; transpose_item(W, N, 64 * kb, 32 * nb, WT, (size_t)32 * nb, K, scr, lane); return true; }
    r -= nitems; return false;
}

template <bool OUT_BF16> __device__ __forceinline__ void ln_row(const float* xrow, const float* g, const float* b, void* orow, int lane, unsigned* o8row = nullptr) {
    const f32x4* xr = (const f32x4*)xrow + lane;
    f32x4 v[4]; float s = 0.f;
#pragma unroll
    for (int j = 0; j < 4; ++j) { v[j] = xr[64 * j]; s += (v[j].x + v[j].y) + (v[j].z + v[j].w); }
    const float mean = wave_sum(s) * (1.f / D); float s2 = 0.f;
#pragma unroll
    for (int j = 0; j < 4; ++j) { v[j] = v[j] - mean; s2 += (v[j].x * v[j].x + v[j].y * v[j].y) + (v[j].z * v[j].z + v[j].w * v[j].w); }
    const float rstd = 1.f / sqrtf(wave_sum(s2) * (1.f / D) + LN_EPS);
#pragma unroll
    for (int j = 0; j < 4; ++j) { const f32x4 gg = *((const f32x4*)g + lane + 64 * j), bb = *((const f32x4*)b + lane + 64 * j); const f32x4 y = v[j] * rstd * gg + bb;
        if (OUT_BF16) { u32x2 w; w.x = cvt_pk_bf16(y[0], y[1]); w.y = cvt_pk_bf16(y[2], y[3]); *((u32x2*)orow + lane + 64 * j) = w; if (o8row) o8row[lane + 64 * j] = pk_fp8x4(y[0], y[1], y[2], y[3]); }
        else *((f32x4*)orow + lane + 64 * j) = y; }
}


template <bool OUT_BF16, int NR, bool IN_BF16 = false> __device__ __forceinline__ void ln_rows(const void* xbase_, size_t r0, size_t rstride, const float* g, const float* b, void* obase, int lane, unsigned char* o8base = nullptr) {
    f32x4 v[NR][4]; float s[NR]; f32x4 gq[4], bq[4];
#pragma unroll
    for (int j = 0; j < 4; ++j) { gq[j] = *((const f32x4*)g + lane + 64 * j); bq[j] = *((const f32x4*)b + lane + 64 * j); }
#pragma unroll
    for (int r = 0; r < NR; ++r) { s[r] = 0.f;
        if (IN_BF16) { const u32x2* xr = (const u32x2*)((const u16*)xbase_ + (r0 + r * rstride) * D) + lane;
#pragma unroll
            for (int j = 0; j < 4; ++j) { const u32x2 w = xr[64 * j]; v[r][j] = (f32x4){bf_lo(w.x), bf_hi(w.x), bf_lo(w.y), bf_hi(w.y)}; } }
        else { const f32x4* xr = (const f32x4*)((const float*)xbase_ + (r0 + r * rstride) * D) + lane;
#pragma unroll
            for (int j = 0; j < 4; ++j) { v[r][j] = xr[64 * j]; } } }
    __builtin_amdgcn_sched_barrier(0);
#pragma unroll
    for (int r = 0; r < NR; ++r)
#pragma unroll
        for (int j = 0; j < 4; ++j) s[r] += (v[r][j].x + v[r][j].y) + (v[r][j].z + v[r][j].w);
#pragma unroll
    for (int r = 0; r < NR; ++r) s[r] = wave_sum(s[r]);
    float s2[NR];
#pragma unroll
    for (int r = 0; r < NR; ++r) { const float mean = s[r] * (1.f / D); s2[r] = 0.f;
#pragma unroll
        for (int j = 0; j < 4; ++j) { v[r][j] = v[r][j] - mean; s2[r] += (v[r][j].x * v[r][j].x + v[r][j].y * v[r][j].y) + (v[r][j].z * v[r][j].z + v[r][j].w * v[r][j].w); } }
#pragma unroll
    for (int r = 0; r < NR; ++r) s2[r] = wave_sum(s2[r]);
#pragma unroll
    for (int j = 0; j < 4; ++j) { const f32x4 gg = gq[j], bb = bq[j];
#pragma unroll
        for (int r = 0; r < NR; ++r) { const float rstd = 1.f / sqrtf(s2[r] * (1.f / D) + LN_EPS); const f32x4 y = v[r][j] * rstd * gg + bb; const size_t row = r0 + r * rstride;
            if (OUT_BF16) { u32x2 w; w.x = cvt_pk_bf16(y[0], y[1]); w.y = cvt_pk_bf16(y[2], y[3]); *((u32x2*)((u16*)obase + row * D) + lane + 64 * j) = w; if (o8base) ((unsigned*)(o8base + row * D))[lane + 64 * j] = pk_fp8x4(y[0], y[1], y[2], y[3]); }
            else *((f32x4*)((float*)obase + row * D) + lane + 64 * j) = y; } }
}

__device__ __forceinline__ void phase_prologue(const Frame& F, const Args& a) {
    LAS float* scr = (LAS float*)(F.lds + F.wave * 16384);
    const int gw = F.vcu * NWAVES + F.wave, NGW = F.G * NWAVES;
    constexpr int NITEMS = 16 * 216 + 8 * 32 + 4 * 32 + 16 * 32 + 16 * 8 + 16 * 32 + 4 * 32;
    for (int it = gw; it < NITEMS; it += NGW) {
        int r = it;
        if (r < 16 * 216) { const int kb = r / 216, nb = r % 216; transpose_item_f8(a.in[2], NCOL, 64 * kb, 32 * nb, F.ws + WS_WIN, (size_t)32 * nb, 1024, W8_SCALE, scr, F.lane); continue; } r -= 16 * 216;
        if (r < 8 * 32) { const int kb = r / 32, nb = r % 32; transpose_item_f8(a.in[6], 1024, 64 * kb, 32 * nb, F.ws + WS_WBH, (size_t)32 * nb, 512, W8_SCALE, scr, F.lane); continue; } r -= 8 * 32;
        if (r < 4 * 32) { const int kb = r / 32, nb = r % 32; transpose_item_f8(a.in[7], 1024, 64 * kb, 32 * nb, F.ws + WS_WBA, (size_t)32 * nb, 256, W8_SCALE, scr, F.lane); continue; } r -= 4 * 32;
        if (r < 16 * 32) { const int kb = r / 32, nb = r % 32; transpose_item_f8(a.in[8], 1024, 64 * kb, 32 * nb, F.ws + WS_WO, (size_t)32 * nb, 1024, W8_SCALE, scr, F.lane); continue; } r -= 16 * 32;
        if (transpose_matrix_item(r, a.in[11], 1024, 256, (u16*)(F.ws + WS_WR), scr, F.lane)) continue;
        if (r < 16 * 32) { const int kb = r / 32, nb = r % 32; transpose_item_f8(a.in[21], 1024, 64 * kb, 32 * nb, F.ws + WS_WPG, (size_t)32 * nb, 1024, W8_SCALE, scr, F.lane); continue; } r -= 16 * 32;
        transpose_matrix_item(r, a.in[22], 256, 1024, (u16*)(F.ws + WS_WPP), scr, F.lane);
    }
    const size_t gt = (size_t)F.vcu * NTHR + F.tid, NGT = (size_t)F.G * NTHR;
    { const f32x4* x4 = (const f32x4*)a.in[0]; u32x4* o4 = (u32x4*)(F.ws + WS_XB);
      static_assert(((size_t)T * D / 16) % ((size_t)256 * NTHR * 4) == 0, "x conversion unroll");
      for (size_t i = gt; i < (size_t)T * D / 16; i += 4 * NGT) { f32x4 p[4][4];
#pragma unroll
          for (int u = 0; u < 4; ++u)
#pragma unroll
              for (int k = 0; k < 4; ++k) p[u][k] = x4[4 * (i + u * NGT) + k];
          __builtin_amdgcn_sched_barrier(0);
#pragma unroll
          for (int u = 0; u < 4; ++u) { u32x4 w; w.x = pk_fp8x4(p[u][0][0], p[u][0][1], p[u][0][2], p[u][0][3]); w.y = pk_fp8x4(p[u][1][0], p[u][1][1], p[u][1][2], p[u][1][3]); w.z = pk_fp8x4(p[u][2][0], p[u][2][1], p[u][2][2], p[u][2][3]); w.w = pk_fp8x4(p[u][3][0], p[u][3][1], p[u][3][2], p[u][3][3]); o4[i + u * NGT] = w; } } }
    { float* rot = (float*)(F.ws + WS_ROT);
      for (size_t i = gt; i < (size_t)SEQ * 8; i += NGT) {
          const int pos = (int)(i >> 3), fi = (int)(i & 7);
          const double invf = fi == 0 ? 1.0 : fi == 1 ? 0.19392274474868576 : fi == 2 ? 0.03760603093086393 : fi == 3 ? 0.007292664737217109 : fi == 4 ? 0.001414213562373095 : fi == 5 ? 0.0002742481756762073 : fi == 6 ? 5.318295896944988e-05 : 1.031338537721246e-05;
          const double ang = (double)pos * invf; const double kq = __builtin_rint(ang * 0.6366197723675814); const double r = ang - kq * 1.5707963267948966; const double r2 = r * r;
          const double sn = r * (1.0 + r2 * (-1.0 / 6 + r2 * (1.0 / 120 + r2 * (-1.0 / 5040 + r2 * (1.0 / 362880 + r2 * (-1.0 / 39916800 + r2 * (1.0 / 6227020800.0)))))));
          const double cs = 1.0 + r2 * (-0.5 + r2 * (1.0 / 24 + r2 * (-1.0 / 720 + r2 * (1.0 / 40320 + r2 * (-1.0 / 3628800 + r2 * (1.0 / 479001600.0))))));
          const int qd = ((int)kq) & 3; const double s_ = qd == 0 ? sn : qd == 1 ? cs : qd == 2 ? -sn : -cs; const double c_ = qd == 0 ? cs : qd == 1 ? -sn : qd == 2 ? -cs : sn;
          rot[pos * 16 + fi] = (float)c_; rot[pos * 16 + 8 + fi] = (float)s_; } }
    { float* lb = (float*)(F.ws + WS_LB);
      for (size_t i = gt; i < 1024; i += NGT) { const int c = (int)(i & 511); const float* src = (i < 512) ? a.in[3] : a.in[4]; lb[i] = 1.0f / (1.0f + expf(src[512 + c] - src[c])); } }
}

__device__ __forceinline__ void hgrn_item(const Frame& F, int item) {
    const int b = item >> 3, h = (item >> 1) & 3, dir = item & 1;
    LAS float* fb = (LAS float*)F.lds; LAS float* kb = fb + 2048; LAS float* qb = kb + 2048; LAS float* vb = qb + 2048; LAS float* op = vb + 2048;
    const int tid = F.tid, v = tid & 127, eg = tid >> 7, ls = tid >> 5, lc = (tid & 31) * 4;
    const u16* QH = (const u16*)(F.ws + Z_QH); const u16* VH = (const u16*)(F.ws + Z_VH); const u16* LF = (const u16*)(F.ws + (dir ? Z_LFB : Z_LFF));
#if DBG_CHECK && !USE_NAIVE_HGRN
    u16* O = (u16*)(F.ws + WS_XB + (dir ? 64 * MiB : 0));
#else
    u16* O = (u16*)(F.dout + (dir ? DO_OB : DO_OF));
#endif
    float S[32];
#pragma unroll
    for (int j = 0; j < 32; ++j) S[j] = 0.f;
    const size_t rowbase = (size_t)b * SEQ, colbase = (size_t)h * 128;
    u32x2 rq, rv, rl;
    { const int pos = dir ? (SEQ - 1 - ls) : ls; const size_t o = (rowbase + pos) * 512 + colbase + lc; rq = *(const u32x2*)(QH + o); rv = *(const u32x2*)(VH + o); rl = *(const u32x2*)(LF + o); }
    for (int blk = 0; blk < SEQ / 16; ++blk) {
        { const f32x4 lb4 = *(const f32x4*)((const float*)(F.ws + WS_LB) + dir * 512 + h * 128 + lc);
          const f32x4 f = {lb4[0] + (1.f - lb4[0]) * sigmoidf_(bf_lo(rl.x)), lb4[1] + (1.f - lb4[1]) * sigmoidf_(bf_hi(rl.x)), lb4[2] + (1.f - lb4[2]) * sigmoidf_(bf_lo(rl.y)), lb4[3] + (1.f - lb4[3]) * sigmoidf_(bf_hi(rl.y))}; const f32x4 k = {1.f - f[0], 1.f - f[1], 1.f - f[2], 1.f - f[3]};
          *(LAS f32x4*)(fb + ls * 128 + lc) = f; *(LAS f32x4*)(kb + ls * 128 + lc) = k;
          { f32x4 qq = {bf_lo(rq.x), bf_hi(rq.x), bf_lo(rq.y), bf_hi(rq.y)};
#pragma unroll
            for (int j = 0; j < 4; ++j) qq[j] *= sigmoidf_(qq[j]);
            *(LAS f32x4*)(qb + ls * 128 + lc) = qq; }
          *(LAS f32x4*)(vb + ls * 128 + lc) = (f32x4){bf_lo(rv.x), bf_hi(rv.x), bf_lo(rv.y), bf_hi(rv.y)}; }
        __syncthreads();
        if (blk + 1 < SEQ / 16) { const int t = (blk + 1) * 16 + ls; const int pos = dir ? (SEQ - 1 - t) : t; const size_t o = (rowbase + pos) * 512 + colbase + lc; rq = *(const u32x2*)(QH + o); rv = *(const u32x2*)(VH + o); rl = *(const u32x2*)(LF + o); }
#pragma unroll 2
        for (int s = 0; s < 16; ++s) {
            const float vm = vb[s * 128 + v]; float ac = 0.f;
#pragma unroll
            for (int jj = 0; jj < 8; ++jj) {
                const f32x4 f4 = *(const LAS f32x4*)(fb + s * 128 + eg * 32 + 4 * jj), k4 = *(const LAS f32x4*)(kb + s * 128 + eg * 32 + 4 * jj), q4 = *(const LAS f32x4*)(qb + s * 128 + eg * 32 + 4 * jj);
#pragma unroll
                for (int j = 0; j < 4; ++j) { S[4 * jj + j] = f4[j] * S[4 * jj + j] + k4[j] * vm; ac += S[4 * jj + j] * q4[j]; }
            }
            op[(s * 4 + eg) * 128 + v] = ac;
        }
        __syncthreads();
        { const f32x4 o = *(const LAS f32x4*)(op + (ls * 4 + 0) * 128 + lc) + *(const LAS f32x4*)(op + (ls * 4 + 1) * 128 + lc) + *(const LAS f32x4*)(op + (ls * 4 + 2) * 128 + lc) + *(const LAS f32x4*)(op + (ls * 4 + 3) * 128 + lc);
          const int t = blk * 16 + ls; const int pos = dir ? (SEQ - 1 - t) : t; u32x2 w; w.x = cvt_pk_bf16(o[0], o[1]); w.y = cvt_pk_bf16(o[2], o[3]);
          *(u32x2*)(O + (rowbase + pos) * 512 + colbase + lc) = w; }
    }
    __syncthreads();
}

__device__ __forceinline__ void attn_naive(const Frame& F) {
    const int gw = F.vcu * NWAVES + F.wave, NGW = F.G * NWAVES, lane = F.lane;
    const u16* AQ = (const u16*)(F.ws + Z_AQ); const u16* AK = (const u16*)(F.ws + Z_AK); const u16* AV = (const u16*)(F.ws + Z_AV); u16* YA = (u16*)(F.ws + WS_YA);
    for (int wi = gw; wi < T * 4; wi += NGW) {
        const int row = wi >> 2, s = wi & 3, b = row >> 11, p = row & (SEQ - 1);
        float sc[3][3]; int lo_[3], hi_[3];
#pragma unroll
        for (int g = 0; g < 3; ++g) {
            const int sh = 2 * g, mlen = SEQ >> sh, r = p & ((1 << sh) - 1), m = p >> sh; const int lo = m - 64 < 0 ? 0 : m - 64, hi = m + 64 > mlen - 1 ? mlen - 1 : m + 64; lo_[g] = lo; hi_[g] = hi;
            const int hd = g * 4 + s;
            u32x4 qw[8];
            { const u32x4* qp = (const u32x4*)(AQ + (size_t)row * 768 + hd * 64);
#pragma unroll
              for (int c = 0; c < 8; ++c) qw[c] = qp[c]; }
#pragma unroll
            for (int rr = 0; rr < 3; ++rr) {
                const int j = lo + rr * 64 + lane; const bool valid = j <= hi; const int jc = valid ? j : hi;
                const u32x4* kp = (const u32x4*)(AK + ((size_t)b * SEQ + r + ((size_t)jc << sh)) * 768 + hd * 64);
                float d = 0.f;
#pragma unroll
                for (int c = 0; c < 8; ++c) { const u32x4 w = kp[c]; const u32x4 q = qw[c]; d += bf_lo(q.x) * bf_lo(w.x) + bf_hi(q.x) * bf_hi(w.x) + bf_lo(q.y) * bf_lo(w.y) + bf_hi(q.y) * bf_hi(w.y) + bf_lo(q.z) * bf_lo(w.z) + bf_hi(q.z) * bf_hi(w.z) + bf_lo(q.w) * bf_lo(w.w) + bf_hi(q.w) * bf_hi(w.w); }
                sc[g][rr] = valid ? d : -1e30f;
                asm volatile("" : "+v"(sc[g][rr]) :: "memory");
            }
        }
        float mx = -1e30f;
#pragma unroll
        for (int g = 0; g < 3; ++g)
#pragma unroll
            for (int rr = 0; rr < 3; ++rr) mx = fmaxf(mx, sc[g][rr]);
        mx = wave_max(mx);
        float den = 0.f;
#pragma unroll
        for (int g = 0; g < 3; ++g)
#pragma unroll
            for (int rr = 0; rr < 3; ++rr) { sc[g][rr] = sc[g][rr] > -1e29f ? __expf(sc[g][rr] - mx) : 0.f; den += sc[g][rr]; }
        den = wave_sum(den);
        float o = 0.f;
#pragma unroll
        for (int g = 0; g < 3; ++g) {
            const int sh = 2 * g, r = p & ((1 << sh) - 1), hd = g * 4 + s; const u16* vp = AV + ((size_t)b * SEQ + r) * 768 + hd * 64 + lane;
#pragma unroll
            for (int rr = 0; rr < 3; ++rr) {
                const int j0 = lo_[g] + rr * 64; int cnt = hi_[g] - j0 + 1; cnt = cnt > 64 ? 64 : cnt;
                const float e = sc[g][rr];
#pragma unroll 4
                for (int jj = 0; jj < cnt; ++jj) { const float pj = __uint_as_float(__builtin_amdgcn_readlane(__float_as_uint(e), jj)); o += pj * bf1(vp[((size_t)(j0 + jj) << sh) * 768]); }
            }
        }
        o = o / den;
        const float on = __shfl_down(o, 1);
        if ((lane & 1) == 0) *(unsigned*)(YA + (size_t)row * 256 + s * 64 + lane) = cvt_pk_bf16(o, on);
    }
}


typedef float f32x16 __attribute__((ext_vector_type(16)));
constexpr size_t DO_OP = 128 * MiB, DO_ML = 224 * MiB;
__device__ __forceinline__ bf16x8 pack_pt(const f32x16& x, const int s) {
    u32x4 p;
    asm volatile("v_cvt_pk_bf16_f32 %0, %4, %5\n\tv_cvt_pk_bf16_f32 %1, %6, %7\n\tv_cvt_pk_bf16_f32 %2, %8, %9\n\tv_cvt_pk_bf16_f32 %3, %10, %11\n\ts_nop 1"
                 : "=&v"(p[0]), "=&v"(p[1]), "=&v"(p[2]), "=&v"(p[3])
                 : "v"(x[8 * s]), "v"(x[8 * s + 1]), "v"(x[8 * s + 2]), "v"(x[8 * s + 3]), "v"(x[8 * s + 4]), "v"(x[8 * s + 5]), "v"(x[8 * s + 6]), "v"(x[8 * s + 7]));
    return __builtin_bit_cast(bf16x8, p);
}
__device__ __forceinline__ void attn_mfma(const Frame& F) {
    const int lane = F.lane, c = lane & 31, h = lane >> 5;
    LAS unsigned char* vbuf = F.lds + F.wave * 4608;
    const unsigned vb_addr = (unsigned)(size_t)vbuf;
    const u16* AQ = (const u16*)(F.ws + Z_AQ); const u16* AK = (const u16*)(F.ws + Z_AK); const u16* AV = (const u16*)(F.ws + Z_AV);
    u16* OP = (u16*)(F.dout + DO_OP); float* ML = (float*)(F.dout + DO_ML);
    const int gw = F.vcu * NWAVES + F.wave, NGW = F.G * NWAVES;
    const int blk = (lane >> 4) & 1, q4 = (lane & 15) >> 2, p4 = lane & 3;
    for (int it = gw; it < 32 * 12 * 64; it += NGW) {
        const int x = it & 63, bh = it >> 6, hd = bh % 12, b = bh / 12, g = hd >> 2, sh = 2 * g;
        const int nqb = 64 >> sh, r = x >> (6 - sh), qb = x & (nqb - 1), mlen = SEQ >> sh, m0 = qb * 32;
        const size_t rowb = (size_t)b * SEQ + r;
        const size_t qrow = rowb + ((size_t)(m0 + c) << sh);
        bf16x8 qf[4];
#pragma unroll
        for (int s = 0; s < 4; ++s) qf[s] = *(const bf16x8*)(AQ + qrow * 768 + hd * 64 + 16 * s + 8 * h);
        f32x16 st[5];
        bf16x8 kf[5][4];
#pragma unroll
        for (int kb = 0; kb < 5; ++kb) {
            int mk = m0 - 64 + 32 * kb + c; mk = mk < 0 ? 0 : (mk > mlen - 1 ? mlen - 1 : mk);
            const u16* kp = AK + (rowb + ((size_t)mk << sh)) * 768 + hd * 64 + 8 * h;
#pragma unroll
            for (int s = 0; s < 4; ++s) kf[kb][s] = *(const bf16x8*)(kp + 16 * s);
        }
        __builtin_amdgcn_sched_barrier(0);
#pragma unroll
        for (int kb = 0; kb < 5; ++kb) {
            f32x16 acc;
#pragma unroll
            for (int i = 0; i < 16; ++i) acc[i] = 0.f;
#pragma unroll
            for (int s = 0; s < 4; ++s) acc = __builtin_amdgcn_mfma_f32_32x32x16_bf16(kf[kb][s], qf[s], acc, 0, 0, 0);
            st[kb] = acc;
        }
        float mx = -1e30f;
#pragma unroll
        for (int kb = 0; kb < 5; ++kb)
#pragma unroll
            for (int i = 0; i < 16; ++i) { const int rel = 32 * kb - 64 + ((i & 3) + 8 * (i >> 2) + 4 * h) - c; const int key = m0 + c + rel; const bool valid = (key >= 0) && (key < mlen) && (rel >= -64) && (rel <= 64);
                const float v = valid ? st[kb][i] : -1e30f; st[kb][i] = v; mx = fmaxf(mx, v); }
        mx = fmaxf(mx, __shfl_xor(mx, 32));
        float l = 0.f;
#pragma unroll
        for (int kb = 0; kb < 5; ++kb)
#pragma unroll
            for (int i = 0; i < 16; ++i) { const float p = st[kb][i] > -1e29f ? __expf(st[kb][i] - mx) : 0.f; st[kb][i] = p; l += p; }
        l += __shfl_xor(l, 32);
        f32x16 y0, y1;
#pragma unroll
        for (int i = 0; i < 16; ++i) { y0[i] = 0.f; y1[i] = 0.f; }
        u32x4 vr[4];
#define LOADV(kb_) _Pragma("unroll") for (int i4 = 0; i4 < 4; ++i4) { const int row = (lane >> 3) + 8 * i4; int mk = m0 - 64 + 32 * (kb_) + row; mk = mk < 0 ? 0 : (mk > mlen - 1 ? mlen - 1 : mk); \
            vr[i4] = *(const u32x4*)(AV + (rowb + ((size_t)mk << sh)) * 768 + hd * 64 + (lane & 7) * 8); }
        LOADV(0)
#pragma unroll
        for (int kb = 0; kb < 5; ++kb) {
#pragma unroll
            for (int i4 = 0; i4 < 4; ++i4) { const int row = (lane >> 3) + 8 * i4; *(LAS u32x4*)(vbuf + row * 144 + (lane & 7) * 16) = vr[i4]; }
            if (kb < 4) { LOADV(kb + 1) }
            asm volatile("s_waitcnt lgkmcnt(0)" ::: "memory");
            u32x2 tq[2][4];
#pragma unroll
            for (int s = 0; s < 2; ++s) {
                const unsigned a0 = vb_addr + 144u * (unsigned)(16 * s + 4 * h + q4) + 2u * (unsigned)(16 * blk + 4 * p4);
                asm volatile("ds_read_b64_tr_b16 %0, %4\n\tds_read_b64_tr_b16 %1, %4 offset:1152\n\tds_read_b64_tr_b16 %2, %4 offset:64\n\tds_read_b64_tr_b16 %3, %4 offset:1216"
                             : "=&v"(tq[s][0]), "=&v"(tq[s][1]), "=&v"(tq[s][2]), "=&v"(tq[s][3]) : "v"(a0) : "memory");
            }
            asm volatile("s_waitcnt lgkmcnt(0)" : "+v"(tq[0][0]), "+v"(tq[0][1]), "+v"(tq[0][2]), "+v"(tq[0][3]), "+v"(tq[1][0]), "+v"(tq[1][1]), "+v"(tq[1][2]), "+v"(tq[1][3]) :: "memory");
#pragma unroll
            for (int s = 0; s < 2; ++s) {
                const bf16x8 xs = pack_pt(st[kb], s);
                u32x4 vv0, vv1; vv0.x = tq[s][0].x; vv0.y = tq[s][0].y; vv0.z = tq[s][1].x; vv0.w = tq[s][1].y; vv1.x = tq[s][2].x; vv1.y = tq[s][2].y; vv1.z = tq[s][3].x; vv1.w = tq[s][3].y;
                y0 = __builtin_amdgcn_mfma_f32_32x32x16_bf16(__builtin_bit_cast(bf16x8, vv0), xs, y0, 0, 0, 0);
                y1 = __builtin_amdgcn_mfma_f32_32x32x16_bf16(__builtin_bit_cast(bf16x8, vv1), xs, y1, 0, 0, 0);
            }
        }
#undef LOADV
        const float inv = 1.0f / l;
        u16* op = OP + qrow * 768 + hd * 64 + 4 * h;
#pragma unroll
        for (int gq = 0; gq < 4; ++gq) {
            u32x2 w0, w1; w0.x = cvt_pk_bf16(y0[4 * gq] * inv, y0[4 * gq + 1] * inv); w0.y = cvt_pk_bf16(y0[4 * gq + 2] * inv, y0[4 * gq + 3] * inv);
            w1.x = cvt_pk_bf16(y1[4 * gq] * inv, y1[4 * gq + 1] * inv); w1.y = cvt_pk_bf16(y1[4 * gq + 2] * inv, y1[4 * gq + 3] * inv);
            *(u32x2*)(op + 8 * gq) = w0; *(u32x2*)(op + 32 + 8 * gq) = w1; }
        if (h == 0) ML[qrow * 12 + hd] = mx + __logf(l);
    }
}


constexpr int HT_STRIDE = 272, HT_BYTES = 64 * HT_STRIDE;
constexpr int HL_QS = 0, HL_KS = HT_BYTES, HL_QIN = 2 * HT_BYTES, HL_KOUT = 3 * HT_BYTES, HL_V = 4 * HT_BYTES, HL_PSUM = 5 * HT_BYTES, HL_D = HL_PSUM + 4096;
#define TR2(dst0, dst1, addr, off1) asm volatile("ds_read_b64_tr_b16 %0, %2\n\tds_read_b64_tr_b16 %1, %2 offset:" #off1 "\n\ts_waitcnt lgkmcnt(0)" : "=&v"(dst0), "=&v"(dst1) : "v"(addr) : "memory")
__device__ __forceinline__ void hgrn_mfma_item(const Frame& F, int item, u16* OFp, u16* OBp) {
    const int b = item >> 3, hh = (item >> 1) & 3, dir = item & 1;
    const int tid = F.tid, lane = F.lane, wave = F.wave, vj = wave & 3, ci = wave >> 2, c = lane & 31, h = lane >> 5;
    const int blk = (lane >> 4) & 1, q4 = (lane & 15) >> 2, p4 = lane & 3;
    LAS unsigned char* L = F.lds; const unsigned Lb = (unsigned)(size_t)L;
    const int e2 = 2 * (tid & 63), part = tid >> 6;
    const u16* QH = (const u16*)(F.ws + Z_QH); const u16* VH = (const u16*)(F.ws + Z_VH); const u16* LF = (const u16*)(F.ws + (dir ? Z_LFB : Z_LFF));
    u16* O = dir ? OBp : OFp;
    const size_t rowbase = (size_t)b * SEQ, colbase = (size_t)hh * 128;
    f32x16 S[4];
#pragma unroll
    for (int et = 0; et < 4; ++et)
#pragma unroll
        for (int i = 0; i < 16; ++i) S[et][i] = 0.f;
    const f32x2 lbv = *(const f32x2*)((const float*)(F.ws + WS_LB) + dir * 512 + hh * 128 + e2);
    unsigned rq[8], rv[8], rl[8];
#pragma unroll
    for (int j = 0; j < 8; ++j) { const int tt = part * 8 + j; const int pos = dir ? (SEQ - 1 - tt) : tt; const size_t o = (rowbase + pos) * 512 + colbase + e2; rq[j] = *(const u16*)((const unsigned char*)QH + o); rv[j] = *(const u16*)((const unsigned char*)VH + o); rl[j] = *(const unsigned*)(LF + o); }
    for (int chunk = 0; chunk < SEQ / 64; ++chunk) {
        float bl0[8], bl1[8], fk0[8], fk1[8]; float r0 = 0.f, r1 = 0.f;
#pragma unroll
        for (int j = 0; j < 8; ++j) { const float f0 = lbv.x + (1.f - lbv.x) * sigmoidf_(bf_lo(rl[j])), f1 = lbv.y + (1.f - lbv.y) * sigmoidf_(bf_hi(rl[j])); fk0[j] = 1.f - f0; fk1[j] = 1.f - f1; r0 += __logf(f0); r1 += __logf(f1); bl0[j] = r0; bl1[j] = r1; }
        *(LAS f32x2*)(L + HL_PSUM + (part * 128 + e2) * 4) = (f32x2){r0, r1};
        __syncthreads();
        float offs0 = 0.f, offs1 = 0.f, bref0 = 0.f, bref1 = 0.f, blast0 = 0.f, blast1 = 0.f;
#pragma unroll
        for (int pp = 0; pp < 8; ++pp) { const f32x2 t = *(const LAS f32x2*)(L + HL_PSUM + (pp * 128 + e2) * 4); if (pp < part) { offs0 += t.x; offs1 += t.y; } if (pp < 4) { bref0 += t.x; bref1 += t.y; } blast0 += t.x; blast1 += t.y; }
        const float Cr0 = __expf(bref0), Cr1 = __expf(bref1), Cl0 = __expf(blast0 - bref0), Cl1 = __expf(blast1 - bref1);
        if (part == 0) *(LAS f32x2*)(L + HL_D + e2 * 4) = (f32x2){__expf(blast0), __expf(blast1)};
#pragma unroll
        for (int j = 0; j < 8; ++j) {
            const int t = part * 8 + j; const unsigned a = (unsigned)(t * HT_STRIDE + e2 * 2);
            const float E0 = __expf(offs0 + bl0[j] - bref0), E1 = __expf(offs1 + bl1[j] - bref1); const float R0 = __builtin_amdgcn_rcpf(E0), R1 = __builtin_amdgcn_rcpf(E1);
            const f32x2_t qq_ = __builtin_amdgcn_cvt_pk_f32_fp8((int)rq[j], false), vv_ = __builtin_amdgcn_cvt_pk_f32_fp8((int)rv[j], false);
            float q0 = qq_.x, q1 = qq_.y; q0 *= sigmoidf_(q0); q1 *= sigmoidf_(q1); const float k0 = fk0[j], k1 = fk1[j];
            *(LAS unsigned*)(L + HL_QS + a) = cvt_pk_bf16(q0 * E0, q1 * E1);
            *(LAS unsigned*)(L + HL_KS + a) = cvt_pk_bf16(k0 * R0, k1 * R1);
            *(LAS unsigned*)(L + HL_QIN + a) = cvt_pk_bf16(q0 * E0 * Cr0, q1 * E1 * Cr1);
            *(LAS unsigned*)(L + HL_KOUT + a) = cvt_pk_bf16(k0 * R0 * Cl0, k1 * R1 * Cl1);
            *(LAS unsigned*)(L + HL_V + a) = cvt_pk_bf16(vv_.x, vv_.y);
        }
        __syncthreads();
        if (chunk + 1 < SEQ / 64) {
#pragma unroll
            for (int j = 0; j < 8; ++j) { const int tt = (chunk + 1) * 64 + part * 8 + j; const int pos = dir ? (SEQ - 1 - tt) : tt; const size_t o = (rowbase + pos) * 512 + colbase + e2; rq[j] = *(const u16*)((const unsigned char*)QH + o); rv[j] = *(const u16*)((const unsigned char*)VH + o); rl[j] = *(const unsigned*)(LF + o); }
        }
        f32x16 z;
#pragma unroll
        for (int i = 0; i < 16; ++i) z[i] = 0.f;
#pragma unroll
        for (int et = 0; et < 4; ++et)
#pragma unroll
            for (int st = 0; st < 2; ++st) {
                const bf16x8 A = pack_pt(S[et], st);
                const LAS unsigned char* qp = L + HL_QIN + (32 * ci + c) * HT_STRIDE + (32 * et + 16 * st + 4 * h) * 2;
                const u32x2 lo = *(const LAS u32x2*)qp, hi = *(const LAS u32x2*)(qp + 16);
                u32x4 bb; bb.x = lo.x; bb.y = lo.y; bb.z = hi.x; bb.w = hi.y;
                z = __builtin_amdgcn_mfma_f32_32x32x16_bf16(A, __builtin_bit_cast(bf16x8, bb), z, 0, 0, 0);
            }
#pragma unroll
        for (int stile = 0; stile < 2; ++stile) {
            if (stile <= ci) {
                f32x16 pt;
#pragma unroll
                for (int i = 0; i < 16; ++i) pt[i] = 0.f;
#pragma unroll
                for (int ek = 0; ek < 8; ++ek) {
                    const bf16x8 A = *(const LAS bf16x8*)(L + HL_KS + (32 * stile + c) * HT_STRIDE + (16 * ek + 8 * h) * 2);
                    const bf16x8 B = *(const LAS bf16x8*)(L + HL_QS + (32 * ci + c) * HT_STRIDE + (16 * ek + 8 * h) * 2);
                    pt = __builtin_amdgcn_mfma_f32_32x32x16_bf16(A, B, pt, 0, 0, 0);
                }
#pragma unroll
                for (int i = 0; i < 16; ++i) { const int srow = 32 * stile + (i & 3) + 8 * (i >> 2) + 4 * h; pt[i] = (srow <= 32 * ci + c) ? pt[i] : 0.f; }
#pragma unroll
                for (int st = 0; st < 2; ++st) {
                    const bf16x8 Bp = pack_pt(pt, st);
                    u32x2 t0, t1; const unsigned a0 = Lb + HL_V + (unsigned)((32 * stile + 16 * st + 4 * h + q4) * HT_STRIDE + (32 * vj + 16 * blk + 4 * p4) * 2);
                    TR2(t0, t1, a0, 2176);
                    u32x4 av; av.x = t0.x; av.y = t0.y; av.z = t1.x; av.w = t1.y;
                    z = __builtin_amdgcn_mfma_f32_32x32x16_bf16(__builtin_bit_cast(bf16x8, av), Bp, z, 0, 0, 0);
                }
            }
        }
        { const int tt = chunk * 64 + 32 * ci + c; const int pos = dir ? (SEQ - 1 - tt) : tt; u16* op = O + (rowbase + pos) * 512 + colbase + 32 * vj + 4 * h;
#pragma unroll
          for (int gq = 0; gq < 4; ++gq) { u32x2 w; w.x = cvt_pk_bf16(z[4 * gq], z[4 * gq + 1]); w.y = cvt_pk_bf16(z[4 * gq + 2], z[4 * gq + 3]); *(u32x2*)(op + 8 * gq) = w; } }
        bf16x8 Vb[4];
#pragma unroll
        for (int tk = 0; tk < 4; ++tk) { u32x2 t0, t1; const unsigned a0 = Lb + HL_V + (unsigned)((16 * tk + 8 * h + q4) * HT_STRIDE + (32 * vj + 16 * blk + 4 * p4) * 2);
            TR2(t0, t1, a0, 1088);
            u32x4 bv; bv.x = t0.x; bv.y = t0.y; bv.z = t1.x; bv.w = t1.y; Vb[tk] = __builtin_bit_cast(bf16x8, bv); }
#pragma unroll
        for (int et = 0; et < 4; ++et) {
#pragma unroll
            for (int gq = 0; gq < 4; ++gq) { const f32x4 dv = *(const LAS f32x4*)(L + HL_D + (32 * et + 8 * gq + 4 * h) * 4);
#pragma unroll
                for (int e = 0; e < 4; ++e) S[et][4 * gq + e] *= dv[e]; }
#pragma unroll
            for (int tk = 0; tk < 4; ++tk) { u32x2 t0, t1; const unsigned a0 = Lb + HL_KOUT + (unsigned)((16 * tk + 8 * h + q4) * HT_STRIDE + (32 * et + 16 * blk + 4 * p4) * 2);
                TR2(t0, t1, a0, 1088);
                u32x4 ak; ak.x = t0.x; ak.y = t0.y; ak.z = t1.x; ak.w = t1.y;
                S[et] = __builtin_amdgcn_mfma_f32_32x32x16_bf16(__builtin_bit_cast(bf16x8, ak), Vb[tk], S[et], 0, 0, 0); }
        }
    }
    __syncthreads();
}

__device__ __forceinline__ void phase_hg_combine(const Frame& F, const Args& a) {
    const int gw = F.vcu * NWAVES + F.wave, NGW = F.G * NWAVES, lane = F.lane;
    const u16* OF = (const u16*)(F.dout + DO_OF); const u16* OB = (const u16*)(F.dout + DO_OB); const u16* GS = (const u16*)(F.ws + Z_GS); u16* YH = (u16*)(F.ws + WS_YH);
    const u16* OP = (const u16*)(F.dout + DO_OP); const float* ML = (const float*)(F.dout + DO_ML); u16* YA = (u16*)(F.ws + WS_YA);
    const f32x4 ng0 = *(const f32x4*)(a.in[5] + 8 * lane), ng1 = *(const f32x4*)(a.in[5] + 8 * lane + 4);
    const int sl = lane >> 4, dd = (4 * lane) & 63;
    constexpr int NR = 4;
    for (int row0 = gw; row0 < T; row0 += NR * NGW) {
        u32x4 fv[NR], bv[NR]; u32x2 gv[NR], av[NR][3]; float lv[NR][3];
#pragma unroll
        for (int r = 0; r < NR; ++r) { const int row = row0 + r * NGW; const size_t o = (size_t)row * 512 + 8 * lane;
            fv[r] = *(const u32x4*)(OF + o); bv[r] = *(const u32x4*)(OB + o); gv[r] = *(const u32x2*)((const unsigned char*)GS + o);
#pragma unroll
            for (int k = 0; k < 3; ++k) { lv[r][k] = ML[(size_t)row * 12 + 4 * k + sl]; av[r][k] = *(const u32x2*)(OP + (size_t)row * 768 + (4 * k + sl) * 64 + dd); } }
        __builtin_amdgcn_sched_barrier(0);
#pragma unroll
        for (int r = 0; r < NR; ++r) { const int row = row0 + r * NGW; const size_t o = (size_t)row * 512 + 8 * lane;
            const u32x4 f = fv[r], bq = bv[r]; const u32x2 g = gv[r];
            float v[8] = {bf_lo(f.x) + bf_lo(bq.x), bf_hi(f.x) + bf_hi(bq.x), bf_lo(f.y) + bf_lo(bq.y), bf_hi(f.y) + bf_hi(bq.y), bf_lo(f.z) + bf_lo(bq.z), bf_hi(f.z) + bf_hi(bq.z), bf_lo(f.w) + bf_lo(bq.w), bf_hi(f.w) + bf_hi(bq.w)};
            float ss = 0.f;
#pragma unroll
            for (int j = 0; j < 8; ++j) ss += v[j] * v[j];
            ss += __int_as_float(__builtin_amdgcn_update_dpp(0, __float_as_int(ss), 0xB1, 0xF, 0xF, true)); ss += __int_as_float(__builtin_amdgcn_update_dpp(0, __float_as_int(ss), 0x4E, 0xF, 0xF, true));
            ss += __int_as_float(__builtin_amdgcn_update_dpp(0, __float_as_int(ss), 0x141, 0xF, 0xF, true)); ss += __int_as_float(__builtin_amdgcn_update_dpp(0, __float_as_int(ss), 0x140, 0xF, 0xF, true));
            const float rs = 1.0f / sqrtf(ss * (1.f / 128.f) + LN_EPS);
            float gg[8]; { float t0[4], t1[4]; fp8x4_to_f32(g.x, t0); fp8x4_to_f32(g.y, t1);
#pragma unroll
              for (int j = 0; j < 4; ++j) { gg[j] = t0[j]; gg[4 + j] = t1[j]; } }
#pragma unroll
            for (int j = 0; j < 8; ++j) gg[j] *= sigmoidf_(gg[j]);
            u32x2 w; w.x = pk_fp8x4(v[0] * rs * ng0[0] * gg[0], v[1] * rs * ng0[1] * gg[1], v[2] * rs * ng0[2] * gg[2], v[3] * rs * ng0[3] * gg[3]);
            w.y = pk_fp8x4(v[4] * rs * ng1[0] * gg[4], v[5] * rs * ng1[1] * gg[5], v[6] * rs * ng1[2] * gg[6], v[7] * rs * ng1[3] * gg[7]);
            *(u32x2*)((unsigned char*)YH + o) = w;
            const float l0 = lv[r][0], l1 = lv[r][1], l2 = lv[r][2];
            const float lm = fmaxf(l0, fmaxf(l1, l2)); float w0 = __expf(l0 - lm), w1 = __expf(l1 - lm), w2 = __expf(l2 - lm); const float ws_ = 1.0f / (w0 + w1 + w2); w0 *= ws_; w1 *= ws_; w2 *= ws_;
            const u32x2 a0 = av[r][0], a1 = av[r][1], a2 = av[r][2];
            const unsigned wv = pk_fp8x4(w0 * bf_lo(a0.x) + w1 * bf_lo(a1.x) + w2 * bf_lo(a2.x), w0 * bf_hi(a0.x) + w1 * bf_hi(a1.x) + w2 * bf_hi(a2.x), w0 * bf_lo(a0.y) + w1 * bf_lo(a1.y) + w2 * bf_lo(a2.y), w0 * bf_hi(a0.y) + w1 * bf_hi(a1.y) + w2 * bf_hi(a2.y));
            *(unsigned*)((unsigned char*)YA + (size_t)row * 256 + 4 * lane) = wv;
        }
    }
}

template <bool DO_LN, bool DO_CONV> __device__ __forceinline__ void phase_ln1_convert(const Frame& F, const Args& a, int part = 0, int nparts = 1) {
    const int gw = F.vcu * NWAVES + F.wave, NGW = F.G * NWAVES;
    const float* X1 = (const float*)(F.ws + WS_X1PRE); u16* X1B = (u16*)(F.ws + WS_XB);
    if constexpr (DO_LN)
    for (int row = gw; row < T; row += 4 * NGW) ln_rows<true, 4, true>(X1, (size_t)row, (size_t)NGW, a.in[9], a.in[10], X1B, F.lane, F.ws + WS_X1F8);
    if constexpr (!DO_CONV) return;
    LAS float* scr = (LAS float*)(F.lds + F.wave * 16384);
    unsigned char* WGU = F.ws + WS_WGU; unsigned char* WD = F.ws + WS_WD;
    constexpr int PER_E = 384, NIT = 257 * PER_E;
    const int lane = F.lane;
#define CV_DECODE(it_, sp_, ldw_, dp_, kd_) { const int e = (it_) / PER_E, r = (it_) % PER_E; const int which = r >> 7, q = r & 127; \
        if (which < 2) { const float* src = (e < 256) ? a.in[13 + which] + (size_t)e * 1024 * 256 : a.in[16 + which]; const int kb = q >> 3, nb = q & 7; ldw_ = 256; kd_ = 1024; \
            sp_ = src + (size_t)(64 * kb + (lane >> 5)) * 256 + 32 * nb + (lane & 31); dp_ = WGU + ((size_t)e * 512 + (nb >> 2) * 256 + which * 128 + (nb & 3) * 32) * 1024 + 64 * kb; } \
        else { const float* src = (e < 256) ? a.in[15] + (size_t)e * 256 * 1024 : a.in[18]; const int kb = q >> 5, nb = q & 31; ldw_ = 1024; kd_ = 256; \
            sp_ = src + (size_t)(64 * kb + (lane >> 5)) * 1024 + 32 * nb + (lane & 31); dp_ = WD + ((size_t)e * 1024 + 32 * nb) * 256 + 64 * kb; } }
#define CV_LOAD(tv_, sp_, ldw_) { _Pragma("unroll") for (int i = 0; i < 32; ++i) tv_[i] = sp_[(size_t)(2 * i) * ldw_]; }
#define CV_FINISH(tv_, dp_, kd_) { _Pragma("unroll") for (int i = 0; i < 32; ++i) scr[(2 * i + (lane >> 5)) * 33 + (lane & 31)] = tv_[i]; \
        LDS_WAIT(); asm volatile("" ::: "memory"); const int c = lane & 7; \
        _Pragma("unroll") for (int j = 0; j < 4; ++j) { const int n = (lane >> 3) + 8 * j; const LAS float* sp = scr + (8 * c) * 33 + n; \
            u32x2 o; o.x = pk_fp8x4(sp[0 * 33] * W8_SCALE, sp[1 * 33] * W8_SCALE, sp[2 * 33] * W8_SCALE, sp[3 * 33] * W8_SCALE); o.y = pk_fp8x4(sp[4 * 33] * W8_SCALE, sp[5 * 33] * W8_SCALE, sp[6 * 33] * W8_SCALE, sp[7 * 33] * W8_SCALE); \
            *(u32x2*)(dp_ + (size_t)n * kd_ + 8 * c) = o; } \
        LDS_WAIT(); asm volatile("" ::: "memory"); }
    float tva[32], tvb[32]; const float* spa = nullptr; const float* spb = nullptr; unsigned char* dpa = nullptr; unsigned char* dpb = nullptr; int lda = 0, ldb = 0, kda = 0, kdb = 0;
    const int step = nparts * NGW; int it = gw + part * NGW;
    if (it < NIT) { CV_DECODE(it, spa, lda, dpa, kda) CV_LOAD(tva, spa, lda) }
    for (; it < NIT; it += 2 * step) {
        const bool hb = it + step < NIT, ha = it + 2 * step < NIT;
        if (hb) { CV_DECODE(it + step, spb, ldb, dpb, kdb) CV_LOAD(tvb, spb, ldb) }
        CV_FINISH(tva, dpa, kda)
        if (ha) { CV_DECODE(it + 2 * step, spa, lda, dpa, kda) CV_LOAD(tva, spa, lda) }
        if (hb) CV_FINISH(tvb, dpb, kdb)
    }
#undef CV_DECODE
#undef CV_LOAD
#undef CV_FINISH
}

__device__ __forceinline__ void phase_topk(const Frame& F, const Args& a) {
    LAS int* hist = (LAS int*)F.lds;
    for (int i = F.tid; i < 8 * 256; i += NTHR) hist[i] = 0;
    __syncthreads();
    const int w = F.vcu, lane = F.lane;
    const float* logits = (const float*)(F.ws + WS_LOGITS); u16* tok_e = (u16*)(F.ws + WS_TOKE); u16* tok_r = (u16*)(F.ws + WS_TOKR); float* tok_g = (float*)(F.ws + WS_TOKG);
    const f32x4 bs = *(const f32x4*)(a.in[12] + 4 * lane);
    constexpr int TB = 4;
    for (int i0 = 0; i0 < 32; i0 += TB) {
        float s0[TB], s1[TB], s2[TB], s3[TB], v0[TB], v1[TB], v2[TB], v3[TB], my_s[TB]; int my_e[TB];
        const float NINF = -__builtin_inff();
        { float b0[TB], b1[TB], b2[TB], b3[TB], m1[TB], m2[TB], gs[TB]; int rank[TB];
#pragma unroll
          for (int u = 0; u < TB; ++u) { const int t = w * 256 + F.wave * 32 + i0 + u; const f32x4 lg = *(const f32x4*)(logits + (size_t)t * 256 + 4 * lane);
              s0[u] = sigmoidf_(lg[0]); s1[u] = sigmoidf_(lg[1]); s2[u] = sigmoidf_(lg[2]); s3[u] = sigmoidf_(lg[3]);
              b0[u] = s0[u] + bs[0]; b1[u] = s1[u] + bs[1]; b2[u] = s2[u] + bs[2]; b3[u] = s3[u] + bs[3];
              const float h01 = fmaxf(b0[u], b1[u]), l01 = fminf(b0[u], b1[u]), h23 = fmaxf(b2[u], b3[u]), l23 = fminf(b2[u], b3[u]);
              m1[u] = fmaxf(h01, h23); m2[u] = fmaxf(fminf(h01, h23), fmaxf(l01, l23)); }
#define TOP2_STEP(CTRL) _Pragma("unroll") for (int u = 0; u < TB; ++u) { const float p1 = dpp_f<CTRL>(m1[u]), p2 = dpp_f<CTRL>(m2[u]); const float n1 = fmaxf(m1[u], p1), n2 = fmaxf(fminf(m1[u], p1), fmaxf(m2[u], p2)); m1[u] = n1; m2[u] = n2; }
          TOP2_STEP(0xB1) TOP2_STEP(0x4E) TOP2_STEP(0x141)
#undef TOP2_STEP
          const int mygroup = lane >> 3;
#pragma unroll
          for (int u = 0; u < TB; ++u) { gs[u] = m1[u] + m2[u]; rank[u] = 0; }
#pragma unroll
          for (int j = 0; j < 8; ++j)
#pragma unroll
              for (int u = 0; u < TB; ++u) { const float gj = rdlane_f(gs[u], 8 * j); rank[u] += (gj > gs[u] || (gj == gs[u] && j < mygroup)) ? 1 : 0; }
#pragma unroll
          for (int u = 0; u < TB; ++u) { const bool sel = rank[u] < 4; v0[u] = sel ? b0[u] : NINF; v1[u] = sel ? b1[u] : NINF; v2[u] = sel ? b2[u] : NINF; v3[u] = sel ? b3[u] : NINF; my_e[u] = 0; my_s[u] = 0.f; } }
#pragma unroll
        for (int k = 0; k < 8; ++k) {
            float bv[TB]; int bi[TB];
#pragma unroll
            for (int u = 0; u < TB; ++u) { bv[u] = v0[u]; bi[u] = 4 * lane;
                if (v1[u] > bv[u]) { bv[u] = v1[u]; bi[u] = 4 * lane + 1; }
                if (v2[u] > bv[u]) { bv[u] = v2[u]; bi[u] = 4 * lane + 2; }
                if (v3[u] > bv[u]) { bv[u] = v3[u]; bi[u] = 4 * lane + 3; } }
#define AMX_STEP(CTRL) _Pragma("unroll") for (int u = 0; u < TB; ++u) { const float ov = dpp_f<CTRL>(bv[u]); const int oi = dpp_i<CTRL>(bi[u]); if (ov > bv[u] || (ov == bv[u] && oi < bi[u])) { bv[u] = ov; bi[u] = oi; } }
            AMX_STEP(0xB1) AMX_STEP(0x4E) AMX_STEP(0x141) AMX_STEP(0x140)
#undef AMX_STEP
#pragma unroll
            for (int u = 0; u < TB; ++u) { float fv = rdlane_f(bv[u], 0); int fi = __builtin_amdgcn_readlane(bi[u], 0);
#pragma unroll
                for (int rw = 1; rw < 4; ++rw) { const float ov = rdlane_f(bv[u], 16 * rw); const int oi = __builtin_amdgcn_readlane(bi[u], 16 * rw); if (ov > fv || (ov == fv && oi < fi)) { fv = ov; fi = oi; } }
                bv[u] = fv; bi[u] = fi; }
#pragma unroll
            for (int u = 0; u < TB; ++u) { const int owner = bi[u] >> 2, wi = bi[u] & 3;
                const float cand = wi == 0 ? s0[u] : wi == 1 ? s1[u] : wi == 2 ? s2[u] : s3[u];
                const float sk = rdlane_f(cand, owner);
                if (lane == owner) { if (wi == 0) v0[u] = NINF; else if (wi == 1) v1[u] = NINF; else if (wi == 2) v2[u] = NINF; else v3[u] = NINF; }
                if (lane == k) { my_e[u] = bi[u]; my_s[u] = sk; } }
        }
#pragma unroll
        for (int u = 0; u < TB; ++u) { const int t = w * 256 + F.wave * 32 + i0 + u;
            float sum = (lane < 8) ? my_s[u] : 0.f; sum += dpp_f<0xB1>(sum); sum += dpp_f<0x4E>(sum); sum += dpp_f<0x141>(sum);
            if (lane < 8) { const int rk = hist[F.wave * 256 + my_e[u]]; hist[F.wave * 256 + my_e[u]] = rk + 1; tok_e[(size_t)t * 8 + lane] = (u16)my_e[u]; tok_r[(size_t)t * 8 + lane] = (u16)rk; tok_g[(size_t)t * 8 + lane] = my_s[u] / sum * 2.5f; } }
    }
    __syncthreads();
    if (F.tid < 256) { int run = 0;
#pragma unroll
        for (int wv = 0; wv < 8; ++wv) { const int h = hist[wv * 256 + F.tid]; hist[wv * 256 + F.tid] = run; run += h; }
        ((int*)(F.ws + WS_HIST))[w * 256 + F.tid] = run; }
    __syncthreads();
    for (int i = 0; i < 32; ++i) { const int t = w * 256 + F.wave * 32 + i; if (lane < 8) { const int e = tok_e[(size_t)t * 8 + lane]; tok_r[(size_t)t * 8 + lane] = (u16)(tok_r[(size_t)t * 8 + lane] + hist[F.wave * 256 + e]); } }
    __syncthreads();
}

__device__ __forceinline__ void phase_sort(const Frame& F) {
    LAS int* start = (LAS int*)F.lds; LAS int* base = start + 260; LAS int* tot = base + 260; LAS int* pad = tot + 260; LAS int* dbase = pad + 260;
    const int w = F.vcu, qd = w / WPC, wl = w % WPC, tid = F.tid;
    const int* hist = (const int*)(F.ws + WS_HIST);
    int mytot = 0, mypre = 0;
    if (tid < 256) {
        for (int w2 = qd * WPC; w2 < qd * WPC + WPC; ++w2) { const int h = hist[w2 * 256 + tid]; mytot += h; mypre += (w2 < w) ? h : 0; }
        tot[tid] = mytot; pad[tid] = (mytot + 255) & ~255;
    }
    __syncthreads();
    if (tid == 0) { int s = 0, d = 0; for (int e = 0; e < 256; ++e) { start[e] = s; s += pad[e]; dbase[e] = d; d += tot[e]; } start[256] = s; }
    __syncthreads();
    if (tid < 256) { base[tid] = start[tid] + mypre; dbase[tid] += mypre; }
    __syncthreads();
    int* stok = (int*)(F.ws + WS_STOK) + (size_t)qd * QTILES * 256; float* sgate = (float*)(F.ws + WS_SGATE) + (size_t)qd * QTILES * 256; int* sdst = (int*)(F.ws + WS_SDST) + (size_t)qd * QTILES * 256;
    int* tile_e = (int*)(F.ws + WS_TILEE) + qd * QTILES;
    const u16* tok_e = (const u16*)(F.ws + WS_TOKE); const u16* tok_r = (const u16*)(F.ws + WS_TOKR); const float* tok_g = (const float*)(F.ws + WS_TOKG);
    for (int aidx = tid; aidx < 2048; aidx += NTHR) {
        const int t = w * 256 + (aidx >> 3), k = aidx & 7; const int e = tok_e[(size_t)t * 8 + k], rk = tok_r[(size_t)t * 8 + k];
        const int slot = base[e] + rk, dn = dbase[e] + rk; stok[slot] = t; sgate[slot] = tok_g[(size_t)t * 8 + k]; sdst[slot] = dn; ((int*)(F.ws + WS_TOKD))[(size_t)t * 8 + k] = dn;
    }
    const int ssh = start[256];
    if (tid < 256) { const int t = w * 256 + tid; const int slot = ssh + (t - qd * TQ); stok[slot] = t; sgate[slot] = 1.0f; sdst[slot] = TQ * 8 + (t - qd * TQ); }
    if (tid < 256 && (tid % WPC) == wl) {
        const int e = tid; const int s0 = start[e], n = tot[e], np = pad[e];
        for (int j = n; j < np; ++j) { stok[s0 + j] = qd * TQ; sgate[s0 + j] = 0.f; sdst[s0 + j] = TQ * NSLOT; }
        for (int tl = s0 >> 8; tl < (s0 + np) >> 8; ++tl) tile_e[tl] = e;
    }
    if (wl == 0 && tid < TQ / 256) tile_e[(ssh >> 8) + tid] = 256;
    if (wl == 0 && tid == 0) ((int*)(F.ws + WS_NTILES))[qd] = (ssh >> 8) + TQ / 256;
    __syncthreads();
}


constexpr int DN_ROWP = 80, DN_PLANE = 256 * DN_ROWP;
__device__ __forceinline__ void moe_down_phase(const Frame& F, int qd) {
    unsigned char* ws = F.ws; LAS unsigned char* L = F.lds; const int tid = F.tid, lane = F.lane, wave = F.wave, i16 = lane & 15, q = lane >> 4;
    const int ntiles = __builtin_amdgcn_readfirstlane(((const int*)(ws + WS_NTILES))[qd]);
    const int* tile_e = (const int*)(ws + WS_TILEE) + qd * QTILES;
    LAS int* estart = (LAS int*)(L + 4 * DN_PLANE);
    LAS int* te = estart + 512;
    for (int i = tid; i < ntiles; i += NTHR) te[i] = tile_e[i];
    __syncthreads();
    if (tid < 258) { int lo = 0, hi = ntiles; while (lo < hi) { const int mid = (lo + hi) >> 1; if (te[mid] < tid) lo = mid + 1; else hi = mid; } estart[tid] = lo; }
    __syncthreads();
    const long U = (long)ntiles * 4; const int u0 = (int)((long)F.vcu * U / F.G), u1 = (int)((long)(F.vcu + 1) * U / F.G);
    const unsigned char* H8 = ws + WS_H; const unsigned char* WD8 = ws + WS_WD; unsigned char* YS = ws + WS_YS;
    const int* sdst = (const int*)(ws + WS_SDST) + (size_t)qd * QTILES * 256; const float* sgate = (const float*)(ws + WS_SGATE) + (size_t)qd * QTILES * 256;
    int sc1; asm volatile("v_mov_b32 %0, 0x7f7f7f7f" : "=v"(sc1));
    int cur_key = -1, e = 0;
#define DN_DECODE(u_, e_, pn_, tile_) { while (4 * estart[e_ + 1] <= (u_)) ++e_; const int ts_ = estart[e_], nte_ = estart[e_ + 1] - ts_, r_ = (u_) - 4 * ts_; pn_ = r_ / nte_; tile_ = ts_ + r_ % nte_; }
#define DN_LOADA(dst, tile_) { const size_t row0_ = (size_t)(tile_) * 256 + wave * 32; \
        _Pragma("unroll") for (int rg = 0; rg < 2; ++rg) { _Pragma("unroll") for (int ks = 0; ks < 2; ++ks) { const unsigned char* ap = H8 + (row0_ + 16 * rg + i16) * 256 + 128 * ks + 32 * q; const i32x4 lo = *(const i32x4*)ap, hi = *(const i32x4*)(ap + 16); dst[rg][ks] = __builtin_shufflevector(lo, hi, 0, 1, 2, 3, 4, 5, 6, 7); } \
            } }
#define DN_LOADN(tile_) { const size_t row0_ = (size_t)(tile_) * 256 + wave * 32; \
        _Pragma("unroll") for (int rg = 0; rg < 2; ++rg) { _Pragma("unroll") for (int ks = 0; ks < 2; ++ks) { const unsigned char* ap = H8 + (row0_ + 16 * rg + i16) * 256 + 128 * ks + 32 * q; \
            asm volatile("global_load_dwordx4 %0, %2, off\n\tglobal_load_dwordx4 %1, %2, off offset:16" : "=&v"(nl[rg][ks]), "=&v"(nh[rg][ks]) : "v"(ap) : "memory"); } \
            { const size_t rr_ = row0_ + 16 * rg + i16; const int* dp_ = sdst + rr_; const float* gp_ = sgate + rr_; \
              asm volatile("global_load_dword %0, %2, off\n\tglobal_load_dword %1, %3, off" : "=&v"(ndd[rg]), "=&v"(ngg[rg]) : "v"(dp_), "v"(gp_) : "memory"); } } }
    i32x8 af[2][2]; i32x4 nl[2][2] = {}, nh[2][2] = {}; unsigned ndd[2] = {0u, 0u}; float ngg[2] = {0.f, 0.f};
    unsigned dd[2] = {0u, 0u}; float gg[2] = {0.f, 0.f};
    int pn = 0, tile = 0, en = 0, pnn = 0, tilen = 0;
    if (u0 < u1) { DN_DECODE(u0, e, pn, tile) DN_LOADA(af, tile) en = e;
#pragma unroll
        for (int rg = 0; rg < 2; ++rg) { const size_t rr = (size_t)tile * 256 + wave * 32 + 16 * rg + i16; dd[rg] = (unsigned)sdst[rr]; gg[rg] = sgate[rr] * (Y8_SCALE / (W8_SCALE * H8_SCALE)); }
        asm volatile("" : "+v"(af[0][0]), "+v"(af[0][1]), "+v"(af[1][0]), "+v"(af[1][1]), "+v"(dd[0]), "+v"(dd[1]), "+v"(gg[0]), "+v"(gg[1]));
    }
    for (int u = u0; u < u1; ++u) {
        const int key = e * 4 + pn;
        if (key != cur_key) {
            __syncthreads();
            const unsigned char* src = WD8 + ((size_t)e * 1024 + (size_t)pn * 256) * 256;
#pragma unroll
            for (int j = 0; j < 8; ++j) { const int p = tid + NTHR * j, rho = p >> 4, c = p & 15; const int n = (rho & ~63) + 16 * ((rho & 15) >> 2) + 4 * ((rho >> 4) & 3) + (rho & 3);
                *(LAS u32x4*)(L + ((c >> 1) & 3) * DN_PLANE + rho * DN_ROWP + (c >> 3) * 32 + (c & 1) * 16) = *(const u32x4*)(src + (size_t)n * 256 + 16 * c); }
            __syncthreads();
            cur_key = key;
        }
        const bool more = u + 1 < u1;
        if (more) { DN_DECODE(u + 1, en, pnn, tilen) DN_LOADN(tilen) }
        int vb = q * DN_PLANE + i16 * DN_ROWP; asm volatile("" : "+v"(vb));
        unsigned char* yp0 = YS + (size_t)dd[0] * D + pn * 256 + 16 * q; unsigned char* yp1 = YS + (size_t)dd[1] * D + pn * 256 + 16 * q; const float g0 = gg[0], g1 = gg[1];
#define DN_LDB(s_) ({ const LAS unsigned char* bp_ = L + vb + ((s_) >> 1) * (16 * DN_ROWP) + ((s_) & 1) * 32; const i32x4 lo_ = *(const LAS i32x4*)bp_, hi_ = *(const LAS i32x4*)(bp_ + 16); __builtin_shufflevector(lo_, hi_, 0, 1, 2, 3, 4, 5, 6, 7); })
        i32x8 bq[3]; bq[0] = DN_LDB(0); bq[1] = DN_LDB(1);
#pragma unroll
        for (int hb = 0; hb < 2; ++hb) {
            f32x4 acc[2][8];
#pragma unroll
            for (int rg = 0; rg < 2; ++rg)
#pragma unroll
                for (int ng = 0; ng < 8; ++ng) acc[rg][ng] = (f32x4){0.f, 0.f, 0.f, 0.f};
#pragma unroll
            for (int s2 = 0; s2 < 16; ++s2) { const int st = 16 * hb + s2;
                if (st + 2 < 32) bq[(st + 2) % 3] = DN_LDB(st + 2);
#pragma unroll
                for (int rg = 0; rg < 2; ++rg) acc[rg][s2 >> 1] = __builtin_amdgcn_mfma_scale_f32_16x16x128_f8f6f4(bq[st % 3], af[rg][st & 1], acc[rg][s2 >> 1], 0, 0, 0, sc1, 0, sc1);
                __builtin_amdgcn_sched_barrier(0);
            }
            if (hb == 1) {
                asm volatile("s_waitcnt vmcnt(0)" : "+v"(nl[0][0]), "+v"(nl[0][1]), "+v"(nl[1][0]), "+v"(nl[1][1]), "+v"(nh[0][0]), "+v"(nh[0][1]), "+v"(nh[1][0]), "+v"(nh[1][1]), "+v"(ndd[0]), "+v"(ndd[1]), "+v"(ngg[0]), "+v"(ngg[1]) :: "memory");
                dd[0] = ndd[0]; dd[1] = ndd[1]; gg[0] = ngg[0] * (Y8_SCALE / (W8_SCALE * H8_SCALE)); gg[1] = ngg[1] * (Y8_SCALE / (W8_SCALE * H8_SCALE));
#pragma unroll
                for (int rg = 0; rg < 2; ++rg) { af[rg][0] = __builtin_shufflevector(nl[rg][0], nh[rg][0], 0, 1, 2, 3, 4, 5, 6, 7); af[rg][1] = __builtin_shufflevector(nl[rg][1], nh[rg][1], 0, 1, 2, 3, 4, 5, 6, 7); }
            }
#pragma unroll
            for (int rg = 0; rg < 2; ++rg) { unsigned char* yp = (rg ? yp1 : yp0) + 128 * hb; const float g = rg ? g1 : g0;
#pragma unroll
                for (int cb = 0; cb < 2; ++cb) { u32x4 w;
#pragma unroll
                    for (int k = 0; k < 4; ++k) { const f32x4 v = acc[rg][4 * cb + k] * g; w[k] = pk_fp8x4(v[0], v[1], v[2], v[3]); }
                    *(u32x4*)(yp + 64 * cb) = w; } }
        }
#undef DN_LDB
        e = en; pn = pnn; tile = tilen;
    }
#undef DN_DECODE
#undef DN_LOADA
#undef DN_LOADN
    __syncthreads();
}

__device__ __forceinline__ void phase_moe_combine(const Frame& F, const Args& a, int qd) {
    const int gw = F.vcu * NWAVES + F.wave, NGW = F.G * NWAVES, lane = F.lane;
    const u16* X1B = (const u16*)(F.ws + WS_XB) + (size_t)qd * TQ * D; const unsigned char* YS = F.ws + WS_YS; u16* X2B = (u16*)(F.ws + WS_X2B) + (size_t)qd * TQ * D;
    typedef float f32x2v __attribute__((ext_vector_type(2)));
    constexpr int NT = 2;
    f32x4 gq[4], bq[4];
#pragma unroll
    for (int k = 0; k < 4; ++k) { gq[k] = *(const f32x4*)(a.in[19] + 16 * lane + 4 * k); bq[k] = *(const f32x4*)(a.in[20] + 16 * lane + 4 * k); }
    for (int tl0 = gw; tl0 < TQ; tl0 += NT * NGW) {
        int mydn[NT]; u32x4 yy[NT][NSLOT], xx[NT][2];
#pragma unroll
        for (int t = 0; t < NT; ++t) { const int tl = tl0 + t * NGW; mydn[t] = (lane < 8) ? ((const int*)(F.ws + WS_TOKD))[((size_t)qd * TQ + tl) * 8 + lane] : 0; }
#pragma unroll
        for (int t = 0; t < NT; ++t) { const int tl = tl0 + t * NGW;
#pragma unroll
            for (int c = 0; c < 2; ++c) xx[t][c] = *(const u32x4*)(X1B + (size_t)tl * D + 16 * lane + 8 * c);
#pragma unroll
            for (int k = 0; k < NSLOT; ++k) { const int dn = (k < 8) ? __builtin_amdgcn_readlane(mydn[t], k) : TQ * 8 + tl; yy[t][k] = *(const u32x4*)(YS + (size_t)dn * D + 16 * lane); } }
        __builtin_amdgcn_sched_barrier(0);
#pragma unroll
        for (int t = 0; t < NT; ++t) { const int tl = tl0 + t * NGW;
            float v[16];
#pragma unroll
            for (int c = 0; c < 2; ++c) { const u32x4 x = xx[t][c];
                v[8 * c + 0] = ALPHA * bf_lo(x.x); v[8 * c + 1] = ALPHA * bf_hi(x.x); v[8 * c + 2] = ALPHA * bf_lo(x.y); v[8 * c + 3] = ALPHA * bf_hi(x.y); v[8 * c + 4] = ALPHA * bf_lo(x.z); v[8 * c + 5] = ALPHA * bf_hi(x.z); v[8 * c + 6] = ALPHA * bf_lo(x.w); v[8 * c + 7] = ALPHA * bf_hi(x.w); }
            float ys[16];
#pragma unroll
            for (int j = 0; j < 16; ++j) ys[j] = 0.f;
#pragma unroll
            for (int k = 0; k < NSLOT; ++k)
#pragma unroll
                for (int q = 0; q < 4; ++q) { const int wv = (int)yy[t][k][q]; const f32x2v lo = __builtin_amdgcn_cvt_pk_f32_fp8(wv, false), hi = __builtin_amdgcn_cvt_pk_f32_fp8(wv, true);
                    ys[4 * q + 0] += lo.x; ys[4 * q + 1] += lo.y; ys[4 * q + 2] += hi.x; ys[4 * q + 3] += hi.y; }
#pragma unroll
            for (int j = 0; j < 16; ++j) v[j] += ys[j] * (1.0f / Y8_SCALE);
            float s = 0.f;
#pragma unroll
            for (int j = 0; j < 16; ++j) s += v[j];
            const float mean = wave_sum(s) * (1.f / D); float s2 = 0.f;
#pragma unroll
            for (int j = 0; j < 16; ++j) { v[j] -= mean; s2 += v[j] * v[j]; }
            const float rstd = 1.f / sqrtf(wave_sum(s2) * (1.f / D) + LN_EPS);
            u32x4 w8;
#pragma unroll
            for (int c = 0; c < 2; ++c) { const int col = 16 * lane + 8 * c; const f32x4 g0 = gq[2 * c], g1 = gq[2 * c + 1], b0 = bq[2 * c], b1 = bq[2 * c + 1];
                u32x4 w; w.x = cvt_pk_bf16(v[8 * c + 0] * rstd * g0[0] + b0[0], v[8 * c + 1] * rstd * g0[1] + b0[1]); w.y = cvt_pk_bf16(v[8 * c + 2] * rstd * g0[2] + b0[2], v[8 * c + 3] * rstd * g0[3] + b0[3]);
                w.z = cvt_pk_bf16(v[8 * c + 4] * rstd * g1[0] + b1[0], v[8 * c + 5] * rstd * g1[1] + b1[1]); w.w = cvt_pk_bf16(v[8 * c + 6] * rstd * g1[2] + b1[2], v[8 * c + 7] * rstd * g1[3] + b1[3]);
                *(u32x4*)(X2B + (size_t)tl * D + col) = w;
                w8[2 * c] = pk_fp8x4(bf_lo(w.x), bf_hi(w.x), bf_lo(w.y), bf_hi(w.y)); w8[2 * c + 1] = pk_fp8x4(bf_lo(w.z), bf_hi(w.z), bf_lo(w.w), bf_hi(w.w)); }
            *(u32x4*)(F.ws + WS_X2F8 + ((size_t)qd * TQ + tl) * D + 16 * lane) = w8;
        }
    }
}

constexpr int LDS_BYTES = 163840;
static_assert(pg8::LDS_ROWIDX + pg8::LDS_ROWSLOTS * 1024 <= LDS_BYTES && (QTILES * 2 + 255) / 256 <= pg8::LDS_ROWSLOTS, "LDS side tables");
constexpr int MISC_OFF = 131072 + 4096;
constexpr int PH_FIXED = 11, PH_PER_Q = 2, PH_TAIL0 = PH_FIXED + NQ * PH_PER_Q, NPHASE = PH_TAIL0 + 2;

__global__ void __launch_bounds__(NTHR, 2) fwd_kernel(Args args) {
    extern __shared__ __attribute__((aligned(16))) unsigned char lds_raw[];
#define MKFRAME() Frame F; { int t_ = threadIdx.x; asm volatile("" : "+v"(t_)); F.lds = (LAS unsigned char*)lds_raw; F.tid = t_; F.lane = t_ & 63; F.wave = __builtin_amdgcn_readfirstlane(t_ >> 6); \
        F.G = gridDim.x; const int bx_ = blockIdx.x; F.vcu = (F.G % 8 == 0) ? (bx_ % 8) * (F.G / 8) + bx_ / 8 : bx_; size_t z_ = 0; asm volatile("" : "+s"(z_)); F.ws = args.ws + z_;     F.dout = (unsigned char*)args.out; }
    LAS unsigned char* const lds0 = (LAS unsigned char*)lds_raw;
    volatile LAS unsigned* MISC = (volatile LAS unsigned*)(lds0 + MISC_OFF);
    if (threadIdx.x < 64) MISC[threadIdx.x] = 0u;
    __syncthreads();
    unsigned* barw = (unsigned*)(args.ws + WS_CTL) + CW_BAR;
    const int lo = args.lo, hi = args.hi;
    XcdBarrier bar; bar.bar = barw; bar.x = 0; bar.st = nullptr;
    if (hi - lo > 1) bar = xcd_barrier_post(barw, MISC + 8);
#ifndef PHASE_MASK
#define PHASE_MASK 0xFFFFFFFFu
#endif
#define IN(k) (((PHASE_MASK >> (k)) & 1u) && lo <= (k) && (k) < hi)
#define INQ(j) (((PHASE_MASK >> (PH_FIXED + (j))) & 1u) && lo <= (pb + (j)) && (pb + (j)) < hi)
#define SEAMQ(j) do { if (lo <= (pb + (j)) && (pb + (j)) + 1 < hi) xcd_barrier(bar); STAMP(pb + (j) + 1); } while (0)
#if DBG_TIME
#define STAMP(i) do { if (blockIdx.x == 0 && threadIdx.x == 0) ((unsigned long long*)(args.ws + WS_CTL + 60 * 1024))[i] = __builtin_amdgcn_s_memrealtime(); } while (0)
#else
#define STAMP(i) do { } while (0)
#endif
    STAMP(0);
#define SEAM(k) do { if (lo <= (k) && (k) + 1 < hi) xcd_barrier(bar); STAMP((k) + 1); } while (0)
    const int G = gridDim.x, c = (int)blockIdx.x;
    const bool wg_odd_t = ((blockIdx.x >> 2) & 1) != 0  ;

    if (IN(0)) { MKFRAME(); phase_prologue(F, args); }
    SEAM(0);
    if (IN(1)) {
        MKFRAME(); unsigned char* ws = F.ws;
        pg8::DenseOrder S; S.init(ws + WS_XB, ws + WS_WIN, T, NCOL, 512, G, c);
        pg8::EpiZ E{ws, (const float*)(ws + WS_ROT), (const float*)(ws + WS_LB), 1.0f / W8_SCALE};
        for (int rep = 0; rep < DUPN(7); ++rep) pg8::gemm_phase<false, 2>(F.lds, 512, S, E);
    }
    SEAM(1);
    if (IN(2)) {
        MKFRAME();
#ifndef NO_HGRN
#if USE_NAIVE_HGRN
        for (int it = F.vcu; it < 256; it += G) hgrn_item(F, it);
#else
        for (int it = F.vcu; it < 256; it += G) hgrn_mfma_item(F, it, (u16*)(F.dout + DO_OF), (u16*)(F.dout + DO_OB));
#if DBG_CHECK
        for (int it = F.vcu; it < 256; it += G) hgrn_item(F, it);
#endif
#endif
#endif
        STAMP(40);
#if USE_NAIVE_ATTN
        attn_naive(F);
#else
        for (int rep2 = 0; rep2 < DUPN(15); ++rep2) attn_mfma(F);
#endif
    }
    SEAM(2);
    if (IN(3)) { MKFRAME(); for (int rep = 0; rep < DUPN(8); ++rep) phase_hg_combine(F, args); }
    SEAM(3);
    if (IN(4)) {
        MKFRAME(); unsigned char* ws = F.ws;
        pg8::DenseOrder S; S.init(ws + WS_YH, ws + WS_WBH, T, D, 256, G, c);
        pg8::EpiGated<false> E{(const u16*)(ws + Z_GTH), (u16*)(F.dout + DO_MERGED), nullptr, D};
        pg8::gemm_phase<false, 2, false>(F.lds, 256, S, E);
    }
    SEAM(4);
    if (IN(5) && !DBG_SKIP_YA) {
        MKFRAME(); unsigned char* ws = F.ws;
        pg8::DenseOrder S; S.init(ws + WS_YA, ws + WS_WBA, T, D, 128, G, c);
        pg8::EpiGated<true> E{(const u16*)(ws + Z_GTA), (u16*)(F.dout + DO_MERGED), F.dout + DO_MERGED8, D};
        pg8::gemm_phase<true, 2, false>(F.lds, 128, S, E);
    }
    SEAM(5);
    if (IN(6)) {
        MKFRAME(); unsigned char* ws = F.ws;
        pg8::DenseOrder S; S.init(F.dout + DO_MERGED8, ws + WS_WO, T, D, 512, G, c);
        pg8::EpiBf16Res E{args.in[0], (u16*)(ws + WS_X1PRE), D, ALPHA, 1.0f / (W8_SCALE * M8_SCALE)};
        pg8::gemm_phase<false, 2>(F.lds, 512, S, E);
    }
    SEAM(6);
    if (IN(7)) { MKFRAME(); phase_ln1_convert<true, false>(F, args); }
    SEAM(7);
    if (IN(8) && !wg_odd_t) { { MKFRAME(); phase_ln1_convert<false, true>(F, args, 0, 3); } VM_WAIT(); __syncthreads(); }
    if (IN(8)) {
        MKFRAME(); unsigned char* ws = F.ws;
        pg8::DenseOrder S; S.init(ws + WS_XB, ws + WS_WR, T, 256, 1024, G, c);
        pg8::EpiF32Res E{(float*)(ws + WS_LOGITS), nullptr, nullptr, 256, 0.f, 1.f};
        for (int rep = 0; rep < DUPN(11); ++rep) pg8::gemm_phase(F.lds, 1024, S, E);
    }
    if (IN(8) && wg_odd_t) { VM_WAIT(); __syncthreads(); MKFRAME(); phase_ln1_convert<false, true>(F, args, 0, 3); }
    SEAM(8);
    if (IN(9) && !wg_odd_t) { { MKFRAME(); phase_ln1_convert<false, true>(F, args, 1, 3); } VM_WAIT(); __syncthreads(); }
    if (IN(9)) { MKFRAME(); phase_topk(F, args); }
    if (IN(9) && wg_odd_t) { VM_WAIT(); __syncthreads(); MKFRAME(); phase_ln1_convert<false, true>(F, args, 1, 3); }
    SEAM(9);
    if (IN(10) && !wg_odd_t) { { MKFRAME(); phase_ln1_convert<false, true>(F, args, 2, 3); } VM_WAIT(); __syncthreads(); }
    if (IN(10)) { MKFRAME(); phase_sort(F); }
    if (IN(10) && wg_odd_t) { VM_WAIT(); __syncthreads(); MKFRAME(); phase_ln1_convert<false, true>(F, args, 2, 3); }
    SEAM(10);
    for (int qd = 0; qd < NQ; ++qd) {
        const int pb = PH_FIXED + qd * PH_PER_Q;
        const size_t lo_off = (size_t)qd * QTILES * 256;
        const bool wg_odd = ((blockIdx.x >> 2) & 1) != 0  ;
        if (INQ(0) && qd > 0 && !wg_odd) { MKFRAME(); phase_moe_combine(F, args, qd - 1); }
        if (INQ(0)) {
            MKFRAME(); unsigned char* ws = F.ws;
            const int ntiles = __builtin_amdgcn_readfirstlane(((const int*)(ws + WS_NTILES))[qd]);
            pg8::MoeOrder<2, true> S; S.A = (const char*)(ws + WS_X1F8); S.W = (const char*)(ws + WS_WGU); S.lds = F.lds; S.slot_tok = (const int*)(ws + WS_STOK) + lo_off; S.sdst = nullptr; S.sgate = nullptr;
            S.ntiles = ntiles; S.G = G; S.vc = F.vcu; S.K = 512; S.wstride_e = (size_t)512 * 1024; S.wstride_pn = (size_t)256 * 1024;
            S.load_table((const int*)(ws + WS_TILEE) + qd * QTILES, F.tid);
            pg8::EpiSwiglu E{ws + WS_H};
            for (int rep = 0; rep < DUPN(0); ++rep) pg8::gemm_phase<false, 2>(F.lds, 512, S, E);
        }
        if (INQ(0) && qd > 0 && wg_odd) { __syncthreads(); MKFRAME(); phase_moe_combine(F, args, qd - 1); }
        SEAMQ(0);
        if (INQ(1)) { MKFRAME(); moe_down_phase(F, qd); }
        SEAMQ(1);
    }
    if (IN(PH_TAIL0) && !wg_odd_t) { MKFRAME(); phase_moe_combine(F, args, NQ - 1); }
    if (IN(PH_TAIL0)) {
        { MKFRAME(); unsigned char* ws = F.ws; const int pm = F.vcu;
          const f32x4* p4 = (const f32x4*)(args.in[1] + (size_t)pm * 256 * 256); u32x4* o4 = (u32x4*)(ws + WS_PB + (size_t)pm * 256 * 256 * 2);
          for (int i = F.tid; i < 256 * 256 / 8; i += NTHR) { const f32x4 p = p4[2 * i], q = p4[2 * i + 1]; u32x4 w; w.x = cvt_pk_bf16(p[0], p[1]); w.y = cvt_pk_bf16(p[2], p[3]); w.z = cvt_pk_bf16(q[0], q[1]); w.w = cvt_pk_bf16(q[2], q[3]); o4[i] = w; } }
        VM_WAIT(); __syncthreads(); __builtin_amdgcn_fence(__ATOMIC_ACQUIRE, "agent"); VM_WAIT();
        { MKFRAME(); unsigned char* ws = F.ws; pg8::PanelOrder S; S.A = (const char*)(ws + WS_PB); S.Bt = (const char*)(ws + WS_WPP); S.pm = F.vcu; S.nN = 4; S.K = 256;
          pg8::EpiBf16 E{(u16*)(ws + WS_P2), D};
          pg8::gemm_phase<true>(F.lds, 256, S, E); }
        VM_WAIT(); __syncthreads();
    }
    if (IN(PH_TAIL0) && wg_odd_t) { MKFRAME(); phase_moe_combine(F, args, NQ - 1); }
    SEAM(PH_TAIL0);
    if (IN(PH_TAIL0 + 1)) {
        { MKFRAME(); unsigned char* ws = F.ws; pg8::PanelOrder S; S.A = (const char*)(ws + WS_X2F8); S.Bt = (const char*)(ws + WS_WPG); S.pm = F.vcu; S.nN = 4; S.K = 512;
          pg8::EpiPle E{(u16*)(ws + WS_X3PRE), (const u16*)(ws + WS_X2B), (const u16*)(ws + WS_P2), D, 1.0f / W8_SCALE};
          pg8::gemm_phase<false, 2>(F.lds, 512, S, E); }
        VM_WAIT(); __syncthreads(); __builtin_amdgcn_fence(__ATOMIC_ACQUIRE, "agent"); VM_WAIT();
        { MKFRAME(); unsigned char* ws = F.ws; const int pm = F.vcu;
          for (int r = F.wave; r < 256; r += 4 * NWAVES) ln_rows<false, 4, true>((const u16*)(ws + WS_X3PRE), (size_t)pm * 256 + r, (size_t)NWAVES, args.in[23], args.in[24], args.out, F.lane); }
    }
#undef IN
#undef SEAM
#undef INQ
#undef SEAMQ
}


#ifndef DBG_CHECK
#define DBG_CHECK 0
#endif
#if DBG_CHECK
constexpr int CHK_WORD0 = 12288;
struct ChkArgs { const float* in[25]; float* out; unsigned char* ws; int mode, qd; };
__device__ __forceinline__ float dotb(const u16* a, const u16* b, int K) { float s = 0.f; for (int k = 0; k < K; k += 8) { const u32x4 x = *(const u32x4*)(a + k), y = *(const u32x4*)(b + k);
    s += bf_lo(x.x) * bf_lo(y.x) + bf_hi(x.x) * bf_hi(y.x) + bf_lo(x.y) * bf_lo(y.y) + bf_hi(x.y) * bf_hi(y.y) + bf_lo(x.z) * bf_lo(y.z) + bf_hi(x.z) * bf_hi(y.z) + bf_lo(x.w) * bf_lo(y.w) + bf_hi(x.w) * bf_hi(y.w); } return s; }
__device__ __forceinline__ float sigm(float z) { return 1.f / (1.f + expf(-z)); }
__device__ __forceinline__ bool badv(float got, float ref, float rel, float ab) { return !(fabsf(got - ref) <= rel * fabsf(ref) + ab); }
__global__ void chk_kernel(ChkArgs a) {
    unsigned char* ws = a.ws; unsigned* res = (unsigned*)(ws + WS_CTL) + CHK_WORD0; const int mode = a.mode, qd = a.qd;
    const size_t gt = (size_t)blockIdx.x * blockDim.x + threadIdx.x, NGT = (size_t)gridDim.x * blockDim.x;
    const u16* XB = (const u16*)(ws + WS_XB); const u16* WIN = (const u16*)(ws + WS_WIN);
    unsigned bad = 0;
    if (mode == 1) { for (size_t i = gt; i < (size_t)T * D; i += NGT) { if (badv(bf1(XB[i]), a.in[0][i], 0.005f, 1e-6f)) ++bad; } }
    else if (mode >= 2 && mode <= 11) {
        const int ty = mode - 2; const int ncol = ty < 5 ? 512 : ty < 8 ? 768 : 1024; const int cbase = ty < 5 ? 512 * ty : ty < 8 ? 2560 + 768 * (ty - 5) : 4864 + 1024 * (ty - 8);
        const size_t zoff[10] = {Z_QH, Z_VH, Z_LFF, Z_LFB, Z_GS, Z_AQ, Z_AK, Z_AV, Z_GTH, Z_GTA}; const u16* Zt = (const u16*)(ws + zoff[ty]); const float* lb = (const float*)(ws + WS_LB); const float* rot = (const float*)(ws + WS_ROT);
        for (size_t i = gt; i < (size_t)(T / 8) * ncol; i += NGT) { const int row = (int)(i / ncol) * 8 + 3, c = (int)(i % ncol);
            float z = dotb(XB + (size_t)row * D, WIN + (size_t)(cbase + c) * D, D), ref, got = bf1(Zt[(size_t)row * ncol + c]);
            if (ty <= 4 || ty == 7 || ty == 8 || ty == 9) ref = z;
            else { const int d = c & 63; ref = z; if (d < 16) { const int cp = (d < 8) ? c + 8 : c - 8; const float zp = dotb(XB + (size_t)row * D, WIN + (size_t)(cbase + cp) * D, D); const int fi = d & 7, pos = row & (SEQ - 1); const float cs = rot[pos * 16 + fi], sn = rot[pos * 16 + 8 + fi]; ref = (d < 8) ? z * cs - zp * sn : z * cs + zp * sn; } if (ty == 5) ref *= 0.125f; }
            if (badv(got, ref, 0.02f, 0.02f)) { ++bad; if (mode == 10) { atomicAdd(res + 80 + ((c & 255) >> 2), 1u); atomicAdd(res + 160 + ((row & 255) >> 2), 1u); atomicAdd(res + 240 + ((row >> 8) & 255), 1u); if (got > 1.5f || got < -0.5f) atomicAdd(res + 500, 1u); atomicAdd(res + 600 + ((((row >> 8) & 31) >> 3) * 8 + ((row >> 6) & 1) * 4 + ((c >> 5) & 3)), 1u); } } } }
    else if (mode == 12) { const u16* Zt = (const u16*)(ws + Z_GTH); unsigned nm = 0, no = 0; for (size_t i = gt; i < (size_t)2 * T * D; i += NGT) { const u16 h = Zt[i]; if (h == 0x3C3C) ++nm; else { const float g = bf1(h); if (!(g >= 0.f && g <= 1.f)) ++no; } }
        for (int o = 32; o >= 1; o >>= 1) { nm += __shfl_xor(nm, o); no += __shfl_xor(no, o); } if ((threadIdx.x & 63) == 0) { if (nm) atomicAdd(res + 700, nm); if (no) atomicAdd(res + 701, no); } }
    else if (mode == 25) { const u16* AQ = (const u16*)(ws + Z_AQ); const u16* AK = (const u16*)(ws + Z_AK); const u16* AV = (const u16*)(ws + Z_AV); const u16* YA = (const u16*)(ws + WS_YA);
        for (size_t i = gt; i < (size_t)(T / 64) * 256; i += NGT) { const int row = (int)(i / 256) * 64 + 7, sl = (int)((i % 256) / 64), d = (int)(i % 64); const int b = row >> 11, p = row & (SEQ - 1);
            float mx = -1e30f; for (int pass = 0; pass < 2; ++pass) { float den = 0.f, o = 0.f; for (int g = 0; g < 3; ++g) { const int sh = 2 * g, mlen = SEQ >> sh, r = p & ((1 << sh) - 1), m = p >> sh, hd = g * 4 + sl; const int lo = m - 64 < 0 ? 0 : m - 64, hi = m + 64 > mlen - 1 ? mlen - 1 : m + 64;
                    for (int j = lo; j <= hi; ++j) { const size_t kr = (size_t)b * SEQ + r + ((size_t)j << sh); const float sc = dotb(AQ + (size_t)row * 768 + hd * 64, AK + kr * 768 + hd * 64, 64); if (pass == 0) mx = fmaxf(mx, sc); else { const float e = expf(sc - mx); den += e; o += e * bf1(AV[kr * 768 + hd * 64 + d]); } } }
                if (pass == 1) { if (badv(bf1(YA[(size_t)row * 256 + sl * 64 + d]), o / den, 0.03f, 0.004f)) ++bad; } } } }
    else if (mode == 26) { const u16* A0 = (const u16*)((unsigned char*)a.out + DO_OF); const u16* R0 = (const u16*)(ws + WS_XB);
        for (size_t i = gt; i < (size_t)2 * T * 512; i += NGT) { if (badv(bf1(A0[i]), bf1(R0[i]), 0.03f, 0.03f)) ++bad; } }
    else if (mode == 13) { const u16* YH = (const u16*)(ws + WS_YH); const u16* YA = (const u16*)(ws + WS_YA); const u16* GH = (const u16*)(ws + Z_GTH); const u16* GA = (const u16*)(ws + Z_GTA); const u16* M = (const u16*)((unsigned char*)a.out + DO_MERGED);
        for (size_t i = gt; i < (size_t)(T / 4) * D; i += NGT) { const int row = (int)(i / D) * 4 + 1, c = (int)(i % D);
            const float ref = sigm(bf1(GH[(size_t)row * D + c])) * dotb(YH + (size_t)row * 512, (const u16*)(ws + WS_WBH) + (size_t)c * 512, 512) + sigm(bf1(GA[(size_t)row * D + c])) * dotb(YA + (size_t)row * 256, (const u16*)(ws + WS_WBA) + (size_t)c * 256, 256);
            if (badv(bf1(M[(size_t)row * D + c]), ref, 0.02f, 0.01f)) ++bad; } }
    else if (mode == 14) { const u16* M = (const u16*)((unsigned char*)a.out + DO_MERGED); const float* X1 = (const float*)(ws + WS_X1PRE);
        for (size_t i = gt; i < (size_t)T * D; i += NGT) { const int row = (int)(i / D), c = (int)(i % D);
            const float ref = ALPHA * a.in[0][i] + dotb(M + (size_t)row * D, (const u16*)(ws + WS_WO) + (size_t)c * D, D); if (badv(X1[i], ref, 0.002f, 0.002f)) ++bad; } }
    else if (mode == 15) { const float* X1 = (const float*)(ws + WS_X1PRE);
        for (size_t row = gt; row < T; row += NGT) { float m = 0.f; for (int c = 0; c < D; ++c) m += X1[row * D + c]; m /= D; float v = 0.f; for (int c = 0; c < D; ++c) { const float d = X1[row * D + c] - m; v += d * d; } const float rs = 1.f / sqrtf(v / D + LN_EPS);
            for (int c = 0; c < D; ++c) { const float ref = (X1[row * D + c] - m) * rs * a.in[9][c] + a.in[10][c]; if (badv(bf1(XB[row * D + c]), ref, 0.01f, 0.01f)) ++bad; } } }
    else if (mode == 16) { const float* LG = (const float*)(ws + WS_LOGITS);
        for (size_t i = gt; i < (size_t)T * 256; i += NGT) { const int row = (int)(i / 256), c = (int)(i % 256); if (badv(LG[i], dotb(XB + (size_t)row * D, (const u16*)(ws + WS_WR) + (size_t)c * D, D), 0.002f, 0.002f)) ++bad; } }
    else if (mode == 17) { const float* LG = (const float*)(ws + WS_LOGITS); const u16* te = (const u16*)(ws + WS_TOKE); const float* tg = (const float*)(ws + WS_TOKG);
        for (size_t t = gt; t < T; t += NGT) { float gsc[8]; for (int g = 0; g < 8; ++g) { float m1 = -1e30f, m2 = -1e30f; for (int j = 0; j < 32; ++j) { const float b = sigm(LG[t * 256 + g * 32 + j]) + a.in[12][g * 32 + j]; if (b > m1) { m2 = m1; m1 = b; } else if (b > m2) m2 = b; } gsc[g] = m1 + m2; }
            unsigned gm = 0; for (int g = 0; g < 8; ++g) { int r = 0; for (int j = 0; j < 8; ++j) r += (gsc[j] > gsc[g] || (gsc[j] == gsc[g] && j < g)); if (r < 4) gm |= 1u << g; }
            unsigned long long taken[4] = {0, 0, 0, 0}; float ssum = 0.f; int ok = 1;
            for (int k = 0; k < 8; ++k) { float bv = -1e30f; int bi = -1; for (int e = 0; e < 256; ++e) { if (!((gm >> (e >> 5)) & 1u) || ((taken[e >> 6] >> (e & 63)) & 1ull)) continue; const float b = sigm(LG[t * 256 + e]) + a.in[12][e]; if (b > bv) { bv = b; bi = e; } }
                taken[bi >> 6] |= 1ull << (bi & 63); ssum += sigm(LG[t * 256 + bi]); if (te[t * 8 + k] != bi) ok = 0; }
            for (int k = 0; k < 8 && ok; ++k) { const float ref = sigm(LG[t * 256 + te[t * 8 + k]]) / ssum * 2.5f; if (badv(tg[t * 8 + k], ref, 0.001f, 1e-5f)) ok = 0; }
            if (!ok) ++bad; } }
    else if (mode == 18) { const int* stok = (const int*)(ws + WS_STOK) + (size_t)qd * QTILES * 256; const float* sg = (const float*)(ws + WS_SGATE) + (size_t)qd * QTILES * 256; const int* sd = (const int*)(ws + WS_SDST) + (size_t)qd * QTILES * 256; const int* tle = (const int*)(ws + WS_TILEE) + qd * QTILES;
        const int nt = ((const int*)(ws + WS_NTILES))[qd]; const u16* te = (const u16*)(ws + WS_TOKE); const float* tg = (const float*)(ws + WS_TOKG); unsigned* cnt = res + 64;
        if (nt < 64 || nt > QTILES) { if (gt == 0) ++bad; } else
        for (size_t sl = gt; sl < (size_t)nt * 256; sl += NGT) { const int d = sd[sl], tk = stok[sl], e = tle[sl >> 8]; if (d == TQ * NSLOT) { if (tk != qd * TQ || sg[sl] != 0.f) ++bad; continue; }
            if (d < 0 || d > TQ * NSLOT || tk < qd * TQ || tk >= (qd + 1) * TQ) { ++bad; continue; } const int k = d % NSLOT; if (d / NSLOT != tk - qd * TQ) { ++bad; continue; }
            if (k == 8) { if (e != 256 || sg[sl] != 1.f) ++bad; } else { if (te[(size_t)tk * 8 + k] != e || tg[(size_t)tk * 8 + k] != sg[sl]) ++bad; }
            atomicAdd(cnt, 1u); } }
    else if (mode == 19) { const int* stok = (const int*)(ws + WS_STOK) + (size_t)qd * QTILES * 256; const int* tle = (const int*)(ws + WS_TILEE) + qd * QTILES; const int nt = ((const int*)(ws + WS_NTILES))[qd]; const u16* H = (const u16*)(ws + WS_H); const u16* WGU = (const u16*)(ws + WS_WGU);
        for (size_t i = gt; i < (size_t)nt * 32 * 256; i += NGT) { const int sl = (int)(i / 256) * 8 + 5, j = (int)(i % 256); const int e = tle[sl >> 8], tk = stok[sl]; const u16* xr = XB + (size_t)tk * D;
            const u16* wg = WGU + ((size_t)e * 512 + (j >> 7) * 256 + (j & 127)) * D; const float g = dotb(xr, wg, D), u = dotb(xr, wg + (size_t)128 * D, D); if (badv(bf1(H[(size_t)sl * 256 + j]), g * sigm(g) * u, 0.03f, 0.003f)) ++bad; } }
    else if (mode == 20) { const int* sd = (const int*)(ws + WS_SDST) + (size_t)qd * QTILES * 256; const float* sg = (const float*)(ws + WS_SGATE) + (size_t)qd * QTILES * 256; const int* tle = (const int*)(ws + WS_TILEE) + qd * QTILES; const int nt = ((const int*)(ws + WS_NTILES))[qd]; const u16* H = (const u16*)(ws + WS_H); const u16* WD = (const u16*)(ws + WS_WD); const u16* YS = (const u16*)(ws + WS_YS);
        for (size_t i = gt; i < (size_t)nt * 32 * D; i += NGT) { const int sl = (int)(i / D) * 8 + 2, c = (int)(i % D); const int e = tle[sl >> 8], d = sd[sl]; if (d == TQ * NSLOT) continue;
            const float ref = sg[sl] * dotb(H + (size_t)sl * 256, WD + ((size_t)e * 1024 + c) * 256, 256); if (badv(bf1(YS[(size_t)d * D + c]), ref, 0.02f, 0.002f)) ++bad; } }
    else if (mode == 21) { const u16* PB = (const u16*)(ws + WS_PB) + (size_t)qd * TQ * 256; const u16* P2 = (const u16*)(ws + WS_P2) + (size_t)qd * TQ * D; const float* p = a.in[1] + (size_t)qd * TQ * 256;
        for (size_t i = gt; i < (size_t)TQ * D; i += NGT) { const int row = (int)(i / D), c = (int)(i % D); if (badv(bf1(P2[i]), dotb(PB + (size_t)row * 256, (const u16*)(ws + WS_WPP) + (size_t)c * 256, 256), 0.02f, 0.01f)) ++bad; if (c < 256 && badv(bf1(PB[(size_t)row * 256 + c]), p[(size_t)row * 256 + c], 0.005f, 1e-6f)) ++bad; } }
    else if (mode == 22) { const u16* X1 = XB + (size_t)qd * TQ * D; const u16* YS = (const u16*)(ws + WS_YS); const u16* X2 = (const u16*)(ws + WS_X2B) + (size_t)qd * TQ * D;
        for (size_t row = gt; row < TQ; row += NGT) { float m = 0.f, v = 0.f; for (int pass = 0; pass < 3; ++pass) { for (int c = 0; c < D; ++c) { float x = ALPHA * bf1(X1[row * D + c]); for (int k = 0; k < NSLOT; ++k) x += bf1(YS[(row * NSLOT + k) * D + c]);
                    if (pass == 0) m += x; else if (pass == 1) v += (x - m) * (x - m); else { const float ref = (x - m) * v * a.in[19][c] + a.in[20][c]; if (badv(bf1(X2[row * D + c]), ref, 0.01f, 0.01f)) ++bad; } } if (pass == 0) m /= D; else if (pass == 1) v = 1.f / sqrtf(v / D + LN_EPS); } } }
    else if (mode == 23) { const u16* X2 = (const u16*)(ws + WS_X2B); const u16* P2 = (const u16*)(ws + WS_P2); const float* O = a.out + (size_t)qd * TQ * D;
        for (size_t i = gt; i < (size_t)TQ * D; i += NGT) { const int row = (int)(i / D), c = (int)(i % D); const float ref = ALPHA * bf1(X2[i]) + sigm(dotb(X2 + (size_t)row * D, (const u16*)(ws + WS_WPG) + (size_t)c * D, D)) * bf1(P2[i]); if (badv(O[i], ref, 0.002f, 0.002f)) ++bad; } }
    else if (mode == 24) { const float* O = a.out + (size_t)qd * TQ * D;
        for (size_t row = gt; row < TQ; row += NGT) { float m = 0.f, v = 0.f; int nf = 0; for (int c = 0; c < D; ++c) { const float x = (O[row * D + c] - a.in[24][c]) / a.in[23][c]; m += x; v += x * x; nf += !(x - x == 0.f); } m /= D; v = v / D - m * m; if (nf || fabsf(m) > 1e-3f || fabsf(v - 1.f) > 1e-2f) ++bad; } }
    for (int o = 32; o >= 1; o >>= 1) bad += __shfl_xor(bad, o);
    if ((threadIdx.x & 63) == 0 && bad) atomicAdd(res + mode, bad);
}
__global__ void chk_encode(float* out, size_t n, const unsigned* res, int what) {
    unsigned code = 0;
    if (what == 0) { for (int m = 1; m < 64; ++m) if (res[m]) { code = m; break; } }
    else if (what > 0) { const unsigned b = res[what]; code = b ? 1 + (31 - __clz(b)) : 0; }
    else if (what == -1) { code = (res[64] == (unsigned)(4 * TQ * NSLOT)) ? 0 : 7; }
    else if (what == -4) { const unsigned nm = res[700], no = res[701]; code = (nm ? 1 + (31 - __clz(nm)) : 0) + (no ? 40 : 0); }
    else if (what == -2) { const int ms[6] = {11, 13, 14, 15, 16, 17}; for (int i = 0; i < 6; ++i) if (res[ms[i]]) code |= 1u << i; }
    else { const int ms[6] = {18, 19, 20, 21, 22, 23}; for (int i = 0; i < 6; ++i) if (res[ms[i]]) code |= 1u << i; if (res[24]) code += 64; if (code > 98) code = 98; }
    const float c = sqrtf((float)code);
    for (size_t i = (size_t)blockIdx.x * blockDim.x + threadIdx.x; i < n; i += (size_t)gridDim.x * blockDim.x) out[i] = c;
}
#ifndef DBG_WHAT
#define DBG_WHAT 0
#endif
#endif


#if DBG_TIME
__global__ void time_encode(float* out, size_t n, const unsigned long long* ts) {
    auto ms = [&](int a, int b) { return (float)(ts[b] - ts[a]) * 1e-5f; };
    (void)ms; unsigned code = DBG_TIME_EXPR; if (code > 98) code = 98;
    const float c = sqrtf((float)code);
    for (size_t i = (size_t)blockIdx.x * blockDim.x + threadIdx.x; i < n; i += (size_t)gridDim.x * blockDim.x) out[i] = c;
}
#endif

extern "C" void kernel_launch(void* const* d_in, const int* in_sizes, int n_in, void* d_out, int out_size, void* d_ws, size_t ws_size, hipStream_t stream) {
    static int grid = 0;
    if (grid == 0) {
        if (n_in != 25 || out_size != T * D || ws_size < WS_END) { fprintf(stderr, "kernel_launch: unexpected problem (n_in %d out %d ws %zu)\n", n_in, out_size, ws_size); grid = -1; return; }
        if (hipFuncSetAttribute((const void*)fwd_kernel, hipFuncAttributeMaxDynamicSharedMemorySize, LDS_BYTES) != hipSuccess) { fprintf(stderr, "kernel_launch: hipFuncSetAttribute failed\n"); grid = -1; return; }
        int per_cu = 0; (void)hipOccupancyMaxActiveBlocksPerMultiprocessor(&per_cu, (const void*)fwd_kernel, NTHR, LDS_BYTES); (void)hipGetLastError();
        if (per_cu < 1) fprintf(stderr, "kernel_launch: occupancy query says %d\n", per_cu);
        grid = 256;
    }
    if (grid < 0) return;
    (void)hipMemsetAsync((char*)d_ws + WS_CTL, 0, CTL_ZERO_BYTES, stream);
    Args a{};
    for (int i = 0; i < 25; ++i) a.in[i] = (const float*)d_in[i];
    a.out = (float*)d_out; a.ws = (unsigned char*)d_ws;
#if DBG_CHECK
    ChkArgs ca{}; for (int i = 0; i < 25; ++i) ca.in[i] = (const float*)d_in[i]; ca.out = (float*)d_out; ca.ws = (unsigned char*)d_ws;
#define CHK(m, q) do { ca.mode = (m); ca.qd = (q); hipLaunchKernelGGL(chk_kernel, dim3(2048), dim3(256), 0, stream, ca); } while (0)
    for (int ph = 0; ph < NPHASE; ++ph) { a.lo = ph; a.hi = ph + 1;
        if (ph == 1) (void)hipMemsetAsync((char*)d_ws + Z_GTH, 0x3C, (size_t)256 * MiB, stream);
        hipLaunchKernelGGL(fwd_kernel, dim3(grid), dim3(NTHR), LDS_BYTES, stream, a);
        if (ph == 0) CHK(1, 0);
        if (ph == 1) for (int m = 2; m <= 12; ++m) CHK(m, 0);
        if (ph == 2) CHK(26, 0);
        if (ph == 3) CHK(25, 0);
        if (ph == 5) CHK(13, 0);
        if (ph == 6) CHK(14, 0);
        if (ph == 7) CHK(15, 0);
        if (ph == 8) CHK(16, 0);
        if (ph == 9) CHK(17, 0);
        if (ph >= PH_FIXED && ph < PH_TAIL0) { const int q = (ph - PH_FIXED) / PH_PER_Q, j = (ph - PH_FIXED) % PH_PER_Q;
            if (j == 0) { CHK(18, q); CHK(19, q); if (q > 0) CHK(22, q - 1); } if (j == 1) CHK(20, q); }
        if (ph == PH_TAIL0) CHK(22, NQ - 1);
        if (ph == PH_TAIL0 + 1) for (int q = 0; q < NQ; ++q) { CHK(21, q); CHK(24, q); } }
    hipLaunchKernelGGL(chk_encode, dim3(2048), dim3(256), 0, stream, (float*)d_out, (size_t)out_size, (const unsigned*)((unsigned char*)d_ws + WS_CTL) + CHK_WORD0, DBG_WHAT);
#elif MK_PER_PHASE
    for (int ph = 0; ph < NPHASE; ++ph) { a.lo = ph; a.hi = ph + 1; hipLaunchKernelGGL(fwd_kernel, dim3(grid), dim3(NTHR), LDS_BYTES, stream, a); }
#else
    a.lo = 0; a.hi = NPHASE;
    hipLaunchKernelGGL(fwd_kernel, dim3(grid), dim3(NTHR), LDS_BYTES, stream, a);
#if DBG_TIME
    hipLaunchKernelGGL(time_encode, dim3(2048), dim3(256), 0, stream, (float*)d_out, (size_t)out_size, (const unsigned long long*)((unsigned char*)d_ws + WS_CTL + 60 * 1024));
#endif
#endif
}
```

```cpp
#include <hip/hip_runtime.h>
#include <cstdio>
#include <cstdint>

#ifndef DBG_SLOT_LO
#define DBG_SLOT_LO 0
#define DBG_SLOT_HI 9
#endif
#ifndef DBG_SKIP_YA
#define DBG_SKIP_YA 0
#endif
#ifndef DBG_CHECK
#define DBG_CHECK 0
#endif
#ifndef DBG_PN_LO
#define DBG_PN_LO 0
#endif
#ifndef DBG_TIME
#define DBG_TIME 0
#endif
#ifndef USE_NAIVE_ATTN
#define USE_NAIVE_ATTN 0
#endif
#ifndef USE_NAIVE_HGRN
#define USE_NAIVE_HGRN 0
#endif
#ifndef DBG_DUP
#define DBG_DUP 0u
#endif
#define DUPN(bit) (((DBG_DUP) >> (bit)) & 1u ? 2 : 1)
#ifndef F8_SCALED
#define F8_SCALED 1
#endif
#ifndef MK_PER_PHASE
#define MK_PER_PHASE 0
#endif

#define LAS __attribute__((address_space(3)))
typedef unsigned short u16;
typedef short bf16x8 __attribute__((ext_vector_type(8)));
typedef float f32x4 __attribute__((ext_vector_type(4)));
typedef float f32x2 __attribute__((ext_vector_type(2)));
typedef unsigned u32x4 __attribute__((ext_vector_type(4)));
typedef unsigned u32x2 __attribute__((ext_vector_type(2)));
typedef int i32x16 __attribute__((ext_vector_type(16)));

constexpr int T = 65536, D = 1024, SEQ = 2048;
constexpr int NCOL = 6912;
constexpr int NQ = 2, TQ = T / NQ;
constexpr int NEXP = 256, NSLOT = 9;
constexpr int QTILES = (TQ * 8 + 256 * 255) / 256 + 1 + TQ / 256;
constexpr int WPC = 256 / NQ;
constexpr float ALPHA = 1.189207115002721f;
constexpr float LN_EPS = 1e-5f;
constexpr int NWAVES = 8, NTHR = 512;
constexpr float Y8_SCALE = 256.f;
constexpr float M8_SCALE = 16.f;
constexpr float H8_SCALE = 32.f;
constexpr float W8_SCALE = 64.f;

constexpr size_t MiB = (size_t)1 << 20;
constexpr size_t WS_CTL = 0, CTL_ZERO_BYTES = 64 * 1024;
constexpr size_t WS_WIN = 1 * MiB, WS_WBH = 15 * MiB, WS_WBA = 16 * MiB, WS_WO = 17 * MiB, WS_WR = 19 * MiB, WS_WPG = 20 * MiB, WS_WPP = 22 * MiB;
constexpr size_t WS_ROT = 22 * MiB + 512 * 1024, WS_LB = 22 * MiB + 768 * 1024;
constexpr size_t WS_HIST = 24 * MiB, WS_TOKE = 25 * MiB, WS_TOKR = 26 * MiB, WS_TOKG = 27 * MiB;
constexpr size_t WS_TOKD = 42 * MiB;
constexpr size_t WS_STOK = 29 * MiB, WS_SGATE = 33 * MiB, WS_SDST = 37 * MiB, WS_TILEE = 41 * MiB, WS_NTILES = 41 * MiB + 512 * 1024;
constexpr size_t WS_XB = 44 * MiB;
constexpr size_t WS_YH = WS_XB, WS_YA = WS_XB + 64 * MiB;
constexpr size_t WS_Z = 172 * MiB;
constexpr size_t Z_QH = WS_Z, Z_VH = WS_Z + 64 * MiB, Z_LFF = WS_Z + 128 * MiB, Z_LFB = WS_Z + 192 * MiB, Z_GS = WS_Z + 256 * MiB;
constexpr size_t Z_AQ = WS_Z + 320 * MiB, Z_AK = WS_Z + 416 * MiB, Z_AV = WS_Z + 512 * MiB, Z_GTH = WS_Z + 608 * MiB, Z_GTA = WS_Z + 736 * MiB;
constexpr size_t WS_X1PRE = WS_Z;
constexpr size_t WS_LOGITS = WS_Z;
constexpr size_t WS_H = WS_Z;
constexpr size_t WS_P2 = WS_Z + 296 * MiB;
constexpr size_t WS_X2B = WS_Z + 104 * MiB;
constexpr size_t WS_PB = WS_Z + 424 * MiB;
constexpr size_t WS_WGU = WS_Z + 296 * MiB;
constexpr size_t WS_WD = WS_Z + 425 * MiB;
constexpr size_t WS_X1F8 = WS_Z + 490 * MiB;
constexpr size_t WS_X3PRE = WS_Z + 802 * MiB;
constexpr size_t WS_X2F8 = WS_Z + 554 * MiB;
constexpr size_t WS_YS = WS_Z + 642 * MiB;
constexpr size_t WS_END = WS_Z + 931 * MiB;
constexpr size_t DO_OF = 0, DO_OB = 64 * MiB, DO_MERGED = 0, DO_MERGED8 = 128 * MiB;

constexpr int CW_BAR = 4096;

__device__ __forceinline__ unsigned cvt_pk_bf16(float lo, float hi) { unsigned r; asm volatile("v_cvt_pk_bf16_f32 %0, %1, %2" : "=v"(r) : "v"(lo), "v"(hi)); return r; }
typedef int i32x8 __attribute__((ext_vector_type(8)));
typedef int i32x4 __attribute__((ext_vector_type(4)));
__device__ __forceinline__ unsigned pk_fp8x4(float a, float b, float c, float d) { int w = 0; w = __builtin_amdgcn_cvt_pk_fp8_f32(a, b, w, false); w = __builtin_amdgcn_cvt_pk_fp8_f32(c, d, w, true); return (unsigned)w; }
typedef float f32x2_t __attribute__((ext_vector_type(2)));
__device__ __forceinline__ void fp8x4_to_f32(unsigned w, float (&o)[4]) { const f32x2_t lo = __builtin_amdgcn_cvt_pk_f32_fp8((int)w, false), hi = __builtin_amdgcn_cvt_pk_f32_fp8((int)w, true); o[0] = lo.x; o[1] = lo.y; o[2] = hi.x; o[3] = hi.y; }
__device__ __forceinline__ float bf_lo(unsigned w) { return __uint_as_float(w << 16); }
__device__ __forceinline__ float bf_hi(unsigned w) { return __uint_as_float(w & 0xffff0000u); }
__device__ __forceinline__ float bf1(u16 b) { return __uint_as_float(((unsigned)b) << 16); }
__device__ __forceinline__ float sigmoidf_(float z) { return __builtin_amdgcn_rcpf(1.0f + __expf(-z)); }
__device__ __forceinline__ unsigned pk_f16(float lo, float hi) { _Float16 a = (_Float16)lo, b = (_Float16)hi; unsigned short ua = __builtin_bit_cast(unsigned short, a), ub = __builtin_bit_cast(unsigned short, b); return (unsigned)ua | ((unsigned)ub << 16); }
__device__ __forceinline__ float f16_lo(unsigned w) { return (float)__builtin_bit_cast(_Float16, (unsigned short)(w & 0xffffu)); }
__device__ __forceinline__ float f16_hi(unsigned w) { return (float)__builtin_bit_cast(_Float16, (unsigned short)(w >> 16)); }
__device__ __forceinline__ float wave_sum(float v) {
    v += __int_as_float(__builtin_amdgcn_update_dpp(0, __float_as_int(v), 0xB1, 0xF, 0xF, true));
    v += __int_as_float(__builtin_amdgcn_update_dpp(0, __float_as_int(v), 0x4E, 0xF, 0xF, true));
    v += __int_as_float(__builtin_amdgcn_update_dpp(0, __float_as_int(v), 0x141, 0xF, 0xF, true));
    v += __int_as_float(__builtin_amdgcn_update_dpp(0, __float_as_int(v), 0x140, 0xF, 0xF, true));
    const int iv = __float_as_int(v);
    return (__int_as_float(__builtin_amdgcn_readlane(iv, 0)) + __int_as_float(__builtin_amdgcn_readlane(iv, 16))) + (__int_as_float(__builtin_amdgcn_readlane(iv, 32)) + __int_as_float(__builtin_amdgcn_readlane(iv, 48)));
}
__device__ __forceinline__ float wave_max(float v) {
#pragma unroll
    for (int o = 1; o < 64; o <<= 1) v = fmaxf(v, __shfl_xor(v, o));
    return v;
}
template <int CTRL> __device__ __forceinline__ float dpp_f(float x) { return __int_as_float(__builtin_amdgcn_update_dpp(0, __float_as_int(x), CTRL, 0xF, 0xF, true)); }
template <int CTRL> __device__ __forceinline__ int dpp_i(int x) { return __builtin_amdgcn_update_dpp(0, x, CTRL, 0xF, 0xF, true); }
__device__ __forceinline__ float rdlane_f(float x, int l) { return __int_as_float(__builtin_amdgcn_readlane(__float_as_int(x), l)); }
#define LDS_WAIT() asm volatile("s_waitcnt lgkmcnt(0)" ::: "memory")
#define VM_WAIT() asm volatile("s_waitcnt vmcnt(0)" ::: "memory")

#define XB_TMO      128
#define XB_XCNT(j)  (256  + 64 * (j))
#define XB_XSUB(j)  (1280 + 64 * (j))
#define XB_XGEN(j)  (2304 + 64 * (j))
#define XB_TOP      3328
#define XB_TOPGEN   3392
#define XCD_BAR_WORDS 3456
#define XB_SPIN_CAP (1u << 22)

__device__ __forceinline__ unsigned xb_ld(unsigned* p)              { return __hip_atomic_load(p, __ATOMIC_RELAXED, __HIP_MEMORY_SCOPE_AGENT); }
__device__ __forceinline__ unsigned xb_add(unsigned* p, unsigned v) { return __hip_atomic_fetch_add(p, v, __ATOMIC_RELAXED, __HIP_MEMORY_SCOPE_AGENT); }
__device__ __forceinline__ unsigned xb_xcc_id() { return (unsigned)__builtin_amdgcn_s_getreg((3 << 11) | 20) & 0xFu; }
#define XB_SPIN(cond, bar) do { unsigned _sp = 0; while (cond) { __builtin_amdgcn_s_sleep(1); \
    if ((++_sp & 255u) == 0u) { if (xb_ld(&(bar)[XB_TMO])) break; if (_sp > XB_SPIN_CAP) { atomicAdd(&(bar)[XB_TMO], 1u); break; } } } } while (0)

struct XcdBarrier { unsigned* bar; unsigned x; volatile LAS unsigned* st; };

__device__ __forceinline__ XcdBarrier xcd_barrier_post(unsigned* bar, volatile LAS unsigned* st) {
    XcdBarrier b; b.bar = bar; b.x = xb_xcc_id(); b.st = st;
    if (threadIdx.x == 0) (void)xb_add(&bar[XB_XCNT(b.x)], 1u);
    return b;
}
__device__ __forceinline__ void xcd_barrier_complete(unsigned* bar, unsigned x, unsigned& nloc, unsigned& nx) {
    const unsigned G = gridDim.x * gridDim.y * gridDim.z;
    unsigned sum, cnt, mine, sp = 0u;
    for (;;) {
        sum = 0u; cnt = 0u; mine = 0u;
#pragma unroll
        for (unsigned j = 0; j < 16; ++j) { const unsigned c = xb_ld(&bar[XB_XCNT(j)]); sum += c; cnt += (c > 0u) ? 1u : 0u; mine = (j == x) ? c : mine; }
        if (sum == G) break;
        __builtin_amdgcn_s_sleep(1);
        if ((++sp & 255u) == 0u) { if (xb_ld(&bar[XB_TMO])) break; if (sp > XB_SPIN_CAP) { atomicAdd(&bar[XB_TMO], 1u); break; } }
    }
    nloc = mine > 0u ? mine : 1u; nx = cnt > 0u ? cnt : 1u;
}
__device__ __forceinline__ void xcd_barrier(const XcdBarrier& b) {
    asm volatile("s_waitcnt vmcnt(0)" ::: "memory");
    __syncthreads();
    if (threadIdx.x == 0) {
        unsigned* bar = b.bar;
        __builtin_amdgcn_s_waitcnt(0);
        unsigned nloc = b.st[0], nx = b.st[1];
        if (nloc == 0u) { xcd_barrier_complete(bar, b.x, nloc, nx); b.st[0] = nloc; b.st[1] = nx; }
        const unsigned old = xb_add(&bar[XB_XSUB(b.x)], 1u);
        const unsigned gen = old / nloc;
        if (old + 1u == (gen + 1u) * nloc) {
            __builtin_amdgcn_fence(__ATOMIC_RELEASE, "agent");
            asm volatile("s_waitcnt vmcnt(0)" ::: "memory");
            const unsigned og = xb_add(&bar[XB_TOP], 1u);
            const unsigned tg = og / nx;
            if (og + 1u == (tg + 1u) * nx) xb_add(&bar[XB_TOPGEN], 1u);
            else XB_SPIN(xb_ld(&bar[XB_TOPGEN]) == tg, bar);
            __builtin_amdgcn_fence(__ATOMIC_ACQUIRE, "agent");
            xb_add(&bar[XB_XGEN(b.x)], 1u);
            asm volatile("s_waitcnt vmcnt(0)" ::: "memory");
        } else {
            XB_SPIN(xb_ld(&bar[XB_XGEN(b.x)]) == gen, bar);
            __builtin_amdgcn_fence(__ATOMIC_ACQUIRE, "agent");
            asm volatile("s_waitcnt vmcnt(0)" ::: "memory");
        }
    }
    __syncthreads();
}

namespace pg8 {
constexpr int BM = 256, BK = 64, HALF = 128, HTB = HALF * BK * 2, STAGE_BYTES = 8 * HTB;
__host__ __device__ __forceinline__ int lds_byte(int r, int c) { const int st = (r >> 4) * 2 + (c >> 5), rr = r & 15, cc = c & 31, ob = rr * 64 + cc * 2; return st * 1024 + (ob ^ (((ob >> 9) & 1) << 5)); }
__host__ __device__ __forceinline__ void stage_rc(int b, int& R, int& C) { const int st = b / 1024, sb = b % 1024, swz = sb ^ (((sb >> 9) & 1) << 5); R = (st >> 1) * 16 + swz / 64; C = (st & 1) * 32 + (swz % 64) / 2; }
__host__ __device__ __forceinline__ int perm32(int rho) { const int n = rho >> 4, i = rho & 15; return 8 * (i >> 2) + 4 * n + (i & 3); }

struct GUnit { const char* A; const char* B; int pm, pn, aux, par, li; };

struct DenseOrder {
    static constexpr bool GATHER_ROWS = false;
    const char* A; const char* Bt; int nM, nN, nwg, G, c, K, rev = 0;
    __device__ void init(const void* A_, const void* Bt_, int M, int N, int K_, int G_, int c_) { A = (const char*)A_; Bt = (const char*)Bt_; nM = M / BM; nN = N / BM; nwg = nM * nN; G = G_; c = c_; K = K_; }
    __device__ __forceinline__ bool next(int i, GUnit& u) const {
        if ((long)i * G + c >= nwg) return false; const int nr_ = (nwg + G - 1) / G; const long L = rev ? (long)(nr_ - 1 - i) * G + c : (long)i * G + c; if (L >= nwg) return false;
        int wgid = (int)L; { const int q = nwg / 8, r = nwg % 8, xcd = wgid % 8, off = wgid / 8; wgid = (xcd < r ? xcd * (q + 1) : r * (q + 1) + (xcd - r) * q) + off; }
        const int nig = 8 * nN, gid = wgid / nig, fm = gid * 8, gsz = (nM - fm) < 8 ? (nM - fm) : 8;
        u.pm = fm + ((wgid % nig) % gsz); u.pn = (wgid % nig) / gsz; u.aux = 0;
        u.A = A + (size_t)u.pm * BM * K * 2; u.B = Bt + (size_t)u.pn * BM * K * 2; return true;
    }
    __device__ __forceinline__ unsigned rowoff(const GUnit&, int r0, int sub) const { return (unsigned)(r0 + sub) * (unsigned)K * 2u; }
    __device__ __forceinline__ void unit_begin(const GUnit&, int, int) const {}
};
struct PanelOrder {
    static constexpr bool GATHER_ROWS = false;
    const char* A; const char* Bt; int pm, nN, K;
    __device__ __forceinline__ bool next(int i, GUnit& u) const { if (i >= nN) return false; u.pm = pm; u.pn = i; u.aux = 0; u.A = A + (size_t)pm * BM * K * 2; u.B = Bt + (size_t)i * BM * K * 2; return true; }
    __device__ __forceinline__ unsigned rowoff(const GUnit&, int r0, int sub) const { return (unsigned)(r0 + sub) * (unsigned)K * 2u; }
    __device__ __forceinline__ void unit_begin(const GUnit&, int, int) const {}
};
constexpr int LDS_SIDE = 131072, LDS_TILEE = 135680, LDS_ROWIDX = LDS_TILEE + ((QTILES * 4 + 255) & ~255), LDS_ROWSLOTS = 16;
template <int NT, bool GATHER> struct MoeOrder {
    static constexpr bool GATHER_ROWS = GATHER;
    const char* A; const char* W; LAS unsigned char* lds; const int* slot_tok; const int* sdst; const float* sgate; int ntiles, G, vc, K; size_t wstride_e, wstride_pn;
    __device__ __forceinline__ void load_table(const int* tile_e, int tid) const {
        for (int i = tid; i < ntiles; i += NTHR) ((LAS int*)(lds + LDS_TILEE))[i] = tile_e[i];
        if (GATHER) { for (int j = tid; j < LDS_ROWSLOTS * 256; j += NTHR) { const int v = (j >> 8) * G + vc, tile = v / NT; if (tile < ntiles) ((LAS int*)(lds + LDS_ROWIDX))[j] = slot_tok[(size_t)tile * BM + (j & 255)]; } }
        asm volatile("s_waitcnt vmcnt(0) lgkmcnt(0)" ::: "memory"); __syncthreads(); }
    __device__ __forceinline__ bool next(int i, GUnit& u) const {
        const int v = i * G + vc; const int tile = v / NT; if (tile >= ntiles) return false;
        u.pm = tile; u.pn = v % NT; u.li = i; const int e = __builtin_amdgcn_readfirstlane(((const LAS int*)(lds + LDS_TILEE))[tile]); u.aux = e;
        u.A = GATHER ? A : A + (size_t)tile * BM * K * 2; u.B = W + (size_t)e * wstride_e + (size_t)u.pn * wstride_pn; return true;
    }
    __device__ __forceinline__ unsigned rowoff(const GUnit& u, int r0, int sub) const {
        if (!GATHER) return (unsigned)(r0 + sub) * (unsigned)K * 2u;
        const int idx = ((const LAS int*)(lds + LDS_ROWIDX))[(u.li & (LDS_ROWSLOTS - 1)) * 256 + r0 + sub];
        return (unsigned)idx * (unsigned)K * 2u;
    }
    __device__ __forceinline__ void unit_begin(const GUnit&, int, int) const {}
};

template <bool OPAQUE_K = false, int F8M = 0  , bool SADDR = true  , class Epi, class Sched>
__device__ __forceinline__ void gemm_phase(LAS unsigned char* lds, const int K_, const Sched& S, const Epi& E) {
    constexpr bool F8 = F8M != 0; constexpr bool F8_SC = F8M == 2;
    int K = K_; if (OPAQUE_K) asm volatile("" : "+s"(K));
    int tid_ = threadIdx.x; asm volatile("" : "+v"(tid_));
    const int tid = tid_, wid = __builtin_amdgcn_readfirstlane(tid >> 6), lane = tid & 63, wr = wid >> 2, wc = wid & 3, fr = lane & 15, fq = lane >> 4;
    const int nt = K / BK;
    unsigned colb[2]; int r0w[2]; unsigned voffB0 = 0, oaS = 0;
#pragma unroll
    for (int i = 0; i < 2; ++i) { int R, C; stage_rc(tid * 16 + i * 8192, R, C); const int Rb = Epi::PERM ? ((R & ~31) + perm32(R & 31)) : R;
        colb[i] = (unsigned)C * 2u; r0w[i] = 16 * ((wid >> 1) + 4 * i); if (i == 0) { voffB0 = (unsigned)(Rb * K + C) * 2u; oaS = (unsigned)(R * K + C) * 2u; } }
    const size_t p64 = (size_t)64 * K * 2; const unsigned K2 = (unsigned)K * 2u, colb0 = colb[0]; const int ridx_lane = (r0w[0] + (lane >> 2)) * 4;
    const int sub = lane >> 2;
    const size_t kstep = (size_t)(BK * 2);
    const size_t hstep = (size_t)HALF * K * 2;
    const unsigned ldsw = (unsigned)wid * 1024u;
    const int aoff = lds_byte(wr * 64 + fr, fq * 8), boff = lds_byte(wc * 32 + fr, fq * 8);
#define PG8_SA(b, h) (((b) * 2 + (h)) * HTB)
#define PG8_SB(b, h) ((4 + (b) * 2 + (h)) * HTB)
#define PG8_STAGE1(ldsaddr, gbase, vo) do { const unsigned long long gb_ = (unsigned long long)(gbase); \
        if constexpr (SADDR) { const unsigned la_ = (unsigned)(size_t)(ldsaddr); \
            asm volatile("s_mov_b32 m0, %2\n\ts_nop 0\n\tglobal_load_lds_dwordx4 %0, %1" :: "v"(vo), "s"(gb_), "s"(la_) : "memory"); }     \
        else { unsigned lo_, hi_; \
            asm volatile("v_add_co_u32 %0, vcc, %2, %4\n\tv_mov_b32 %1, %3\n\tv_addc_co_u32 %1, vcc, 0, %1, vcc" : "=&v"(lo_), "=&v"(hi_) : "s"((unsigned)gb_), "s"((unsigned)(gb_ >> 32)), "v"(vo) : "vcc"); \
            __builtin_amdgcn_global_load_lds((const unsigned*)(((unsigned long long)hi_ << 32) | lo_), (LAS unsigned*)(ldsaddr), 16, 0, 0); } } while (0)
#define PG8_STAGE_B(bufoff, gbase) do { PG8_STAGE1(lds + (bufoff) + ldsw, (const char*)(gbase), voffB0); PG8_STAGE1(lds + (bufoff) + ldsw + 8192, (const char*)(gbase) + p64, voffB0); } while (0)
#define PG8_STAGE_A(bufoff, gbase, h, li_) do { if constexpr (Sched::GATHER_ROWS) { \
            PG8_STAGE1(lds + (bufoff) + ldsw, (const char*)(gbase), (unsigned)gi##h##0 * K2 + colb0); PG8_STAGE1(lds + (bufoff) + ldsw + 8192, (const char*)(gbase), (unsigned)gi##h##1 * K2 + colb0); } \
        else { PG8_STAGE1(lds + (bufoff) + ldsw, (const char*)(gbase) + (h) * hstep, oaS); PG8_STAGE1(lds + (bufoff) + ldsw + 8192, (const char*)(gbase) + (h) * hstep + p64, oaS); } } while (0)
#define PG8_GIDX(h, li_) int gi##h##0 = 0, gi##h##1 = 0; if constexpr (Sched::GATHER_ROWS) { int rl_ = ridx_lane; asm volatile("" : "+v"(rl_));   const LAS unsigned char* gp_ = lds + LDS_ROWIDX + ((li_) & (LDS_ROWSLOTS - 1)) * 1024 + (h) * 512 + rl_; gi##h##0 = *(const LAS int*)gp_; gi##h##1 = *(const LAS int*)(gp_ + 256); }
#define PG8_LDA(dst, b, h) do { _Pragma("unroll") for (int m = 0; m < 4; ++m) _Pragma("unroll") for (int k = 0; k < 2; ++k) dst[m][k] = *(const LAS bf16x8*)(lds + PG8_SA(b, h) + aoff + m * 2048 + k * 1024); } while (0)
#define PG8_LDB(dst, b, h) do { _Pragma("unroll") for (int n = 0; n < 2; ++n) _Pragma("unroll") for (int k = 0; k < 2; ++k) dst[n][k] = *(const LAS bf16x8*)(lds + PG8_SB(b, h) + boff + n * 2048 + k * 1024); } while (0)
#define PG8_MMA(ai, bj, At, Bt) do { __builtin_amdgcn_s_setprio(1); _Pragma("unroll") for (int m = 0; m < 4; ++m) _Pragma("unroll") for (int n = 0; n < 2; ++n) { \
        if constexpr (F8) { \
            if constexpr (F8_SC) { const i32x8 a8_ = __builtin_shufflevector(__builtin_bit_cast(i32x4, At[m][0]), __builtin_bit_cast(i32x4, At[m][1]), 0, 1, 2, 3, 4, 5, 6, 7), b8_ = __builtin_shufflevector(__builtin_bit_cast(i32x4, Bt[n][0]), __builtin_bit_cast(i32x4, Bt[n][1]), 0, 1, 2, 3, 4, 5, 6, 7); \
                acc[ai][bj][m][n] = __builtin_amdgcn_mfma_scale_f32_16x16x128_f8f6f4(b8_, a8_, acc[ai][bj][m][n], 0, 0, 0, sc1_, 0, sc1_); } \
            else { _Pragma("unroll") for (int k = 0; k < 2; ++k) { typedef long l64x2 __attribute__((ext_vector_type(2))); const l64x2 a_ = __builtin_bit_cast(l64x2, At[m][k]), b_ = __builtin_bit_cast(l64x2, Bt[n][k]); \
                acc[ai][bj][m][n] = __builtin_amdgcn_mfma_f32_16x16x32_fp8_fp8(b_[0], a_[0], acc[ai][bj][m][n], 0, 0, 0); acc[ai][bj][m][n] = __builtin_amdgcn_mfma_f32_16x16x32_fp8_fp8(b_[1], a_[1], acc[ai][bj][m][n], 0, 0, 0); } } } \
        else { _Pragma("unroll") for (int k = 0; k < 2; ++k) acc[ai][bj][m][n] = __builtin_amdgcn_mfma_f32_16x16x32_bf16(Bt[n][k], At[m][k], acc[ai][bj][m][n], 0, 0, 0); } } \
        __builtin_amdgcn_s_setprio(0); } while (0)
#define PG8_WAIT_V(n) asm volatile("s_waitcnt vmcnt(" #n ")" ::: "memory")
#define PG8_WAIT_L(n) asm volatile("s_waitcnt lgkmcnt(" #n ")" ::: "memory")
#define PG8_BAR __builtin_amdgcn_s_barrier()
#define PG8_SCHED __builtin_amdgcn_sched_barrier(0)
    int sc1_; asm volatile("s_mov_b32 %0, 0x7f7f7f7f" : "=s"(sc1_));
    GUnit cur, nxt; int ui = 0;
    if (!S.next(0, cur)) return;
    f32x4 acc[2][2][4][2];
#pragma unroll
    for (int a = 0; a < 2; ++a)
#pragma unroll
        for (int b = 0; b < 2; ++b)
#pragma unroll
            for (int m = 0; m < 4; ++m)
#pragma unroll
                for (int n = 0; n < 2; ++n) acc[a][b][m][n] = (f32x4){0.f, 0.f, 0.f, 0.f};
    bf16x8 At[4][2], B0[2][2], B1[2][2];
    const char* cA = cur.A; const char* cB = cur.B;
    { PG8_GIDX(0, cur.li) PG8_GIDX(1, cur.li) PG8_STAGE_B(PG8_SB(0, 0), cB); PG8_STAGE_A(PG8_SA(0, 0), cA, 0, cur.li); PG8_STAGE_B(PG8_SB(0, 1), cB + hstep); PG8_STAGE_A(PG8_SA(0, 1), cA, 1, cur.li); }
    if (wr == 1) PG8_BAR;
    PG8_WAIT_V(4); PG8_BAR;
    { PG8_GIDX(0, cur.li) PG8_STAGE_B(PG8_SB(1, 0), cB + kstep); PG8_STAGE_A(PG8_SA(1, 0), cA + kstep, 0, cur.li); PG8_STAGE_B(PG8_SB(1, 1), cB + hstep + kstep); }
    PG8_WAIT_V(6); PG8_BAR;
    for (;;) {
        cur.par = ui & 1; S.unit_begin(cur, ui & 1, wid);
        const bool has_next = S.next(ui + 1, nxt);
        const char* nA = has_next ? nxt.A : cA; const char* nB = has_next ? nxt.B : cB;
        for (int t = 0; t < nt; t += 2) {
            const bool last = (t == nt - 2);
            const char* a1 = cA + (size_t)(t + 1) * kstep;
            const char* a2 = last ? nA : cA + (size_t)(t + 2) * kstep; const char* b2 = last ? nB : cB + (size_t)(t + 2) * kstep;
            const char* a3 = a2 + kstep; const char* b3 = b2 + kstep;
            const int lis = (last && has_next) ? nxt.li : cur.li;
            { PG8_GIDX(1, cur.li) PG8_LDB(B0, 0, 0); PG8_SCHED; PG8_LDA(At, 0, 0); PG8_STAGE_A(PG8_SA(1, 1), a1, 1, cur.li); }
            PG8_WAIT_L(8); PG8_BAR; PG8_WAIT_L(0); PG8_MMA(0, 0, At, B0); PG8_BAR; PG8_SCHED;
            PG8_LDB(B1, 0, 1); PG8_STAGE_B(PG8_SB(0, 0), b2);
            PG8_BAR; PG8_WAIT_L(0); PG8_MMA(0, 1, At, B1); PG8_BAR;
            { PG8_GIDX(0, lis) PG8_LDA(At, 0, 1); PG8_STAGE_A(PG8_SA(0, 0), a2, 0, lis); }
            PG8_BAR; PG8_WAIT_L(0); PG8_MMA(1, 0, At, B0); PG8_BAR; PG8_SCHED;
            PG8_STAGE_B(PG8_SB(0, 1), b2 + hstep);
            PG8_WAIT_V(6); PG8_BAR; PG8_MMA(1, 1, At, B1); PG8_BAR;
            { PG8_GIDX(1, lis) PG8_LDB(B0, 1, 0); PG8_SCHED; PG8_LDA(At, 1, 0); PG8_STAGE_A(PG8_SA(0, 1), a2, 1, lis); }
            PG8_WAIT_L(8); PG8_BAR; PG8_WAIT_L(0); PG8_MMA(0, 0, At, B0); PG8_BAR; PG8_SCHED;
            PG8_LDB(B1, 1, 1); PG8_STAGE_B(PG8_SB(1, 0), b3);
            PG8_BAR; PG8_WAIT_L(0); PG8_MMA(0, 1, At, B1); PG8_BAR;
            { PG8_GIDX(0, lis) PG8_LDA(At, 1, 1); PG8_STAGE_A(PG8_SA(1, 0), a3, 0, lis); }
            PG8_BAR; PG8_WAIT_L(0); PG8_MMA(1, 0, At, B0); PG8_BAR; PG8_SCHED;
            PG8_STAGE_B(PG8_SB(1, 1), b3 + hstep);
            PG8_WAIT_V(6); PG8_BAR; PG8_MMA(1, 1, At, B1); PG8_BAR;
        }
        { int l_ = threadIdx.x; asm volatile("" : "+v"(l_));
          E(acc, cur, wr, wc, l_ & 15, (l_ & 63) >> 4); }
        if (!has_next) break;
#pragma unroll
        for (int a = 0; a < 2; ++a)
#pragma unroll
            for (int b = 0; b < 2; ++b)
#pragma unroll
                for (int m = 0; m < 4; ++m)
#pragma unroll
                    for (int n = 0; n < 2; ++n) acc[a][b][m][n] = (f32x4){0.f, 0.f, 0.f, 0.f};
        cur = nxt; cA = nA; cB = nB; ++ui;
    }
    PG8_WAIT_V(0);
    if (wr == 0) PG8_BAR;
    PG8_BAR;
#undef PG8_SA
#undef PG8_SB
#undef PG8_STAGE1
#undef PG8_STAGE_A
#undef PG8_GIDX
#undef PG8_STAGE_B
#undef PG8_LDA
#undef PG8_LDB
#undef PG8_MMA
#undef PG8_WAIT_V
#undef PG8_WAIT_L
#undef PG8_BAR
#undef PG8_SCHED
}

#define EPI_LOOP_ROWS for (int ai = 0; ai < 2; ++ai) _Pragma("unroll") for (int m = 0; m < 4; ++m)

__device__ __forceinline__ u32x4 pair16(u32x2 xa, u32x2 xb) {
    const auto lo = __builtin_amdgcn_permlane16_swap(xa.x, xb.x, false, false), hi = __builtin_amdgcn_permlane16_swap(xa.y, xb.y, false, false);
    u32x4 w; w.x = lo[0]; w.y = hi[0]; w.z = lo[1]; w.w = hi[1]; return w; }
enum { K_SILU = 0, K_ID = 1, K_LOGF = 2, K_ROT = 3, K_SIG = 4, K_ID8 = 5   };
struct EpiZ {
    static constexpr bool PERM = true;
    unsigned char* ws; const float* rot; const float* lb; float osc;
    template <int KIND> __device__ __forceinline__ void body(const f32x4 (&acc)[2][2][4][2], u16* base, int ld, int pnl, int pm, float scale, const float* lbp, int wr, int wc, int fr, int fq) const {
        const int row0 = pm * BM + wr * 64 + fr, col0 = pnl * BM + wc * 32 + 8 * fq;
        if constexpr (KIND == K_ID8) {
            unsigned char* bp = (unsigned char*)base + (size_t)(row0 + 16 * (fq & 1)) * ld + col0 - 8 * (fq & 1);
#pragma unroll
            for (int ai = 0; ai < 2; ++ai)
#pragma unroll
                for (int mp = 0; mp < 4; mp += 2)
#pragma unroll
                    for (int bj = 0; bj < 2; ++bj) { u32x2 x[2];
#pragma unroll
                        for (int t = 0; t < 2; ++t) { const f32x4 v0 = acc[ai][bj][mp + t][0] * osc, v1 = acc[ai][bj][mp + t][1] * osc; x[t].x = pk_fp8x4(v0[0], v0[1], v0[2], v0[3]); x[t].y = pk_fp8x4(v1[0], v1[1], v1[2], v1[3]); }
                        *(u32x4*)(bp + (size_t)(ai * HALF + mp * 16) * ld + bj * HALF) = pair16(x[0], x[1]); }
            return;
        }
        f32x4 l0[2], l1[2];
        if (KIND == K_LOGF) {
#pragma unroll
            for (int bj = 0; bj < 2; ++bj) { l0[bj] = *(const f32x4*)(lbp + col0 + bj * HALF); l1[bj] = *(const f32x4*)(lbp + col0 + bj * HALF + 4); }
        }
        const bool rotl = (KIND == K_ROT) && ((wc & 1) == 0) && (fq < 2);
        const float sgn = (fq == 0) ? -1.f : 1.f;
#pragma unroll
        for (int ai = 0; ai < 2; ++ai) {
        f32x4 rt[4][4];
        if (KIND == K_ROT) {
#pragma unroll
            for (int m = 0; m < 4; ++m) { const float* rp = rot + (size_t)((row0 + ai * HALF + m * 16) & (SEQ - 1)) * 16;
#pragma unroll
                for (int k = 0; k < 4; ++k) rt[m][k] = *(const f32x4*)(rp + 4 * k); }
            __builtin_amdgcn_sched_barrier(0);
        }
#pragma unroll
        for (int m = 0; m < 4; ++m) {
            const int row = row0 + ai * HALF + m * 16;
            f32x4 cs0, cs1, sn0, sn1;
            if (KIND == K_ROT) { cs0 = rt[m][0]; cs1 = rt[m][1]; sn0 = rt[m][2]; sn1 = rt[m][3]; }
#pragma unroll
            for (int bj = 0; bj < 2; ++bj) {
                f32x4 v0 = acc[ai][bj][m][0] * osc, v1 = acc[ai][bj][m][1] * osc;
                if (KIND == K_SILU) {
#pragma unroll
                    for (int j = 0; j < 4; ++j) { v0[j] = v0[j] * sigmoidf_(v0[j]); v1[j] = v1[j] * sigmoidf_(v1[j]); }
                } else if (KIND == K_SIG) {
#pragma unroll
                    for (int j = 0; j < 4; ++j) { v0[j] = sigmoidf_(v0[j]); v1[j] = sigmoidf_(v1[j]); }
                } else if (KIND == K_LOGF) {
#pragma unroll
                    for (int j = 0; j < 4; ++j) { v0[j] = __logf(l0[bj][j] + (1.f - l0[bj][j]) * sigmoidf_(v0[j])); v1[j] = __logf(l1[bj][j] + (1.f - l1[bj][j]) * sigmoidf_(v1[j])); }
                } else if (KIND == K_ROT) {
                    f32x4 o0, o1;
#pragma unroll
                    for (int j = 0; j < 4; ++j) { o0[j] = __shfl_xor(v0[j], 16); o1[j] = __shfl_xor(v1[j], 16); }
                    if (rotl) {
#pragma unroll
                        for (int j = 0; j < 4; ++j) { v0[j] = v0[j] * cs0[j] + sgn * o0[j] * sn0[j]; v1[j] = v1[j] * cs1[j] + sgn * o1[j] * sn1[j]; }
                    }
                    v0 = v0 * scale; v1 = v1 * scale;
                }
                if (KIND == K_ID8) { u32x2 w8; w8.x = pk_fp8x4(v0[0], v0[1], v0[2], v0[3]); w8.y = pk_fp8x4(v1[0], v1[1], v1[2], v1[3]);
                    *(u32x2*)((unsigned char*)base + (size_t)row * ld + col0 + bj * HALF) = w8; continue; }
                u32x4 w;
                if (KIND == K_LOGF) { w.x = pk_f16(v0[0], v0[1]); w.y = pk_f16(v0[2], v0[3]); w.z = pk_f16(v1[0], v1[1]); w.w = pk_f16(v1[2], v1[3]); }
                else { w.x = cvt_pk_bf16(v0[0], v0[1]); w.y = cvt_pk_bf16(v0[2], v0[3]); w.z = cvt_pk_bf16(v1[0], v1[1]); w.w = cvt_pk_bf16(v1[2], v1[3]); }
                *(u32x4*)(base + (size_t)row * ld + col0 + bj * HALF) = w;
            }
        }
        }
    }
    __device__ __forceinline__ void operator()(const f32x4 (&acc)[2][2][4][2], const GUnit& u, int wr, int wc, int fr, int fq) const {
        const int pn = u.pn, pm = u.pm;
        if (pn < DBG_PN_LO) return;
        if (pn < 2)       body<K_ID8>(acc, (u16*)(ws + Z_QH), 512, pn, pm, 1.f, nullptr, wr, wc, fr, fq);
        else if (pn < 4)  body<K_ID8>(acc, (u16*)(ws + Z_VH), 512, pn - 2, pm, 1.f, nullptr, wr, wc, fr, fq);
        else if (pn < 6)  body<K_ID>(acc, (u16*)(ws + Z_LFF), 512, pn - 4, pm, 1.f, nullptr, wr, wc, fr, fq);
        else if (pn < 8)  body<K_ID>(acc, (u16*)(ws + Z_LFB), 512, pn - 6, pm, 1.f, nullptr, wr, wc, fr, fq);
        else if (pn < 10) body<K_ID8>(acc, (u16*)(ws + Z_GS), 512, pn - 8, pm, 1.f, nullptr, wr, wc, fr, fq);
        else if (pn < 13) body<K_ROT>(acc, (u16*)(ws + Z_AQ), 768, pn - 10, pm, 0.125f, nullptr, wr, wc, fr, fq);
        else if (pn < 16) body<K_ROT>(acc, (u16*)(ws + Z_AK), 768, pn - 13, pm, 1.f, nullptr, wr, wc, fr, fq);
        else if (pn < 19) body<K_ID>(acc, (u16*)(ws + Z_AV), 768, pn - 16, pm, 1.f, nullptr, wr, wc, fr, fq);
        else if (pn < 23) body<K_ID8>(acc, (u16*)(ws + Z_GTH), 1024, pn - 19, pm, 1.f, nullptr, wr, wc, fr, fq);
        else              body<K_ID8>(acc, (u16*)(ws + Z_GTA), 1024, pn - 23, pm, 1.f, nullptr, wr, wc, fr, fq);
    }
};

template <bool ADD> struct EpiGated {
    static constexpr bool PERM = true;
    const u16* gate; u16* out; unsigned char* out8; int ld;
    __device__ __forceinline__ void operator()(const f32x4 (&acc)[2][2][4][2], const GUnit& u, int wr, int wc, int fr, int fq) const {
        const int row0 = u.pm * BM + wr * 64 + fr, col0 = u.pn * BM + wc * 32 + 8 * fq;
        constexpr float isc = 1.0f / W8_SCALE;
#pragma unroll
        for (int ai = 0; ai < 2; ++ai)
#pragma unroll
        for (int mp = 0; mp < 4; mp += 2) {
            u32x2 gv[4][2]; u32x4 pv[4][2];
#pragma unroll
            for (int m = mp; m < mp + 2; ++m)
#pragma unroll
                for (int bj = 0; bj < 2; ++bj) { const size_t off = (size_t)(row0 + ai * HALF + m * 16) * ld + col0 + bj * HALF; gv[m][bj] = *(const u32x2*)((const unsigned char*)gate + off); if (ADD) pv[m][bj] = *(const u32x4*)(out + off); }
            __builtin_amdgcn_sched_barrier(0);
#pragma unroll
                for (int bj = 0; bj < 2; ++bj) { u32x2 x8[2];
#pragma unroll
                    for (int t = 0; t < 2; ++t) { const int m = mp + t; const size_t off = (size_t)(row0 + ai * HALF + m * 16) * ld + col0 + bj * HALF;
                        const u32x2 g = gv[m][bj]; float g0[4], g1[4]; fp8x4_to_f32(g.x, g0); fp8x4_to_f32(g.y, g1);
                        f32x4 v0 = acc[ai][bj][m][0] * isc, v1 = acc[ai][bj][m][1] * isc;
#pragma unroll
                        for (int j = 0; j < 4; ++j) { v0[j] *= sigmoidf_(g0[j]); v1[j] *= sigmoidf_(g1[j]); }
                        if (ADD) { const u32x4 p = pv[m][bj];
                            v0[0] += bf_lo(p.x); v0[1] += bf_hi(p.x); v0[2] += bf_lo(p.y); v0[3] += bf_hi(p.y);
                            v1[0] += bf_lo(p.z); v1[1] += bf_hi(p.z); v1[2] += bf_lo(p.w); v1[3] += bf_hi(p.w);
                            x8[t].x = pk_fp8x4(v0[0] * M8_SCALE, v0[1] * M8_SCALE, v0[2] * M8_SCALE, v0[3] * M8_SCALE); x8[t].y = pk_fp8x4(v1[0] * M8_SCALE, v1[1] * M8_SCALE, v1[2] * M8_SCALE, v1[3] * M8_SCALE); }
                        else { u32x4 w; w.x = cvt_pk_bf16(v0[0], v0[1]); w.y = cvt_pk_bf16(v0[2], v0[3]); w.z = cvt_pk_bf16(v1[0], v1[1]); w.w = cvt_pk_bf16(v1[2], v1[3]);
                            *(u32x4*)(out + off) = w; }
                    }
                    if (ADD) *(u32x4*)(out8 + (size_t)(row0 + ai * HALF + (mp + (fq & 1)) * 16) * ld + col0 - 8 * (fq & 1) + bj * HALF) = pair16(x8[0], x8[1]);
                }
            __builtin_amdgcn_sched_barrier(0);
        }
    }
};
struct EpiF32Res {
    static constexpr bool PERM = false;
    float* C; const float* res; u16* Cb; int ld; float alpha; float asc;
    __device__ __forceinline__ void operator()(const f32x4 (&acc)[2][2][4][2], const GUnit& u, int wr, int wc, int fr, int fq) const {
        const int row0 = u.pm * BM + wr * 64 + fr, col0 = u.pn * BM + wc * 32 + 4 * fq;
#pragma unroll
        EPI_LOOP_ROWS {
            const size_t off = (size_t)(row0 + ai * HALF + m * 16) * ld + col0;
#pragma unroll
            for (int bj = 0; bj < 2; ++bj)
#pragma unroll
                for (int n = 0; n < 2; ++n) { f32x4 v = acc[ai][bj][m][n] * asc; if (res) v = v + alpha * *(const f32x4*)(res + off + bj * HALF + n * 16);
                    if (Cb) { u32x2 w; w.x = cvt_pk_bf16(v[0], v[1]); w.y = cvt_pk_bf16(v[2], v[3]); *(u32x2*)(Cb + off + bj * HALF + n * 16) = w; } else *(f32x4*)(C + off + bj * HALF + n * 16) = v; }
        }
    }
};
struct EpiBf16Res {
    static constexpr bool PERM = true;
    const float* res; u16* Cb; int ld; float alpha; float asc;
    __device__ __forceinline__ void operator()(const f32x4 (&acc)[2][2][4][2], const GUnit& u, int wr, int wc, int fr, int fq) const {
        const int row0 = u.pm * BM + wr * 64 + fr, col0 = u.pn * BM + wc * 32 + 8 * fq;
#pragma unroll
        for (int ai = 0; ai < 2; ++ai)
#pragma unroll
        for (int mp = 0; mp < 4; mp += 2) {
            f32x4 r[2][2][2];
#pragma unroll
            for (int t = 0; t < 2; ++t)
#pragma unroll
                for (int bj = 0; bj < 2; ++bj) { const float* rp = res + (size_t)(row0 + ai * HALF + (mp + t) * 16) * ld + col0 + bj * HALF; r[t][bj][0] = *(const f32x4*)rp; r[t][bj][1] = *(const f32x4*)(rp + 4); }
            __builtin_amdgcn_sched_barrier(0);
#pragma unroll
            for (int t = 0; t < 2; ++t)
#pragma unroll
                for (int bj = 0; bj < 2; ++bj) { const int m = mp + t; const f32x4 v0 = acc[ai][bj][m][0] * asc + alpha * r[t][bj][0], v1 = acc[ai][bj][m][1] * asc + alpha * r[t][bj][1];
                    u32x4 w; w.x = cvt_pk_bf16(v0[0], v0[1]); w.y = cvt_pk_bf16(v0[2], v0[3]); w.z = cvt_pk_bf16(v1[0], v1[1]); w.w = cvt_pk_bf16(v1[2], v1[3]);
                    *(u32x4*)(Cb + (size_t)(row0 + ai * HALF + m * 16) * ld + col0 + bj * HALF) = w; }
            __builtin_amdgcn_sched_barrier(0);
        }
    }
};
struct EpiBf16 {
    static constexpr bool PERM = true;
    u16* O; int ld;
    __device__ __forceinline__ void operator()(const f32x4 (&acc)[2][2][4][2], const GUnit& u, int wr, int wc, int fr, int fq) const {
        const int row0 = u.pm * BM + wr * 64 + fr, col0 = u.pn * BM + wc * 32 + 8 * fq;
#pragma unroll
        EPI_LOOP_ROWS {
            u16* rowp = O + (size_t)(row0 + ai * HALF + m * 16) * ld + col0;
#pragma unroll
            for (int bj = 0; bj < 2; ++bj) { const f32x4 v0 = acc[ai][bj][m][0], v1 = acc[ai][bj][m][1];
                u32x4 w; w.x = cvt_pk_bf16(v0[0], v0[1]); w.y = cvt_pk_bf16(v0[2], v0[3]); w.z = cvt_pk_bf16(v1[0], v1[1]); w.w = cvt_pk_bf16(v1[2], v1[3]);
                *(u32x4*)(rowp + bj * HALF) = w; }
        }
    }
};
struct EpiSwiglu {
    static constexpr bool PERM = true;
    unsigned char* H;
    __device__ __forceinline__ void operator()(const f32x4 (&acc)[2][2][4][2], const GUnit& u, int wr, int wc, int fr, int fq) const {
        const int row0 = u.pm * BM + wr * 64 + fr, col0 = u.pn * HALF + wc * 32 + 8 * fq;
        constexpr float isc = 1.0f / W8_SCALE;
        unsigned char* hp = H + (size_t)(row0 + 16 * (fq & 1)) * 256 + col0 - 8 * (fq & 1);
#pragma unroll
        for (int ai = 0; ai < 2; ++ai)
#pragma unroll
            for (int mp = 0; mp < 4; mp += 2) { u32x2 x[2];
#pragma unroll
                for (int t = 0; t < 2; ++t) { const int m = mp + t;
                    f32x4 g0 = acc[ai][0][m][0] * isc, g1 = acc[ai][0][m][1] * isc; const f32x4 u0 = acc[ai][1][m][0] * (isc * H8_SCALE), u1 = acc[ai][1][m][1] * (isc * H8_SCALE);
#pragma unroll
                    for (int j = 0; j < 4; ++j) { g0[j] = g0[j] * sigmoidf_(g0[j]) * u0[j]; g1[j] = g1[j] * sigmoidf_(g1[j]) * u1[j]; }
                    x[t].x = pk_fp8x4(g0[0], g0[1], g0[2], g0[3]); x[t].y = pk_fp8x4(g1[0], g1[1], g1[2], g1[3]); }
                *(u32x4*)(hp + (size_t)(ai * HALF + mp * 16) * 256) = pair16(x[0], x[1]); }
    }
};
struct EpiDown {
    static constexpr bool PERM = true;
    unsigned char* Y; LAS unsigned char* lds;
    __device__ __forceinline__ void operator()(const f32x4 (&acc)[2][2][4][2], const GUnit& u, int wr, int wc, int fr, int fq) const {
        const int col0 = u.pn * BM + wc * 32 + 8 * fq;
        const LAS unsigned* side = (const LAS unsigned*)(lds + LDS_SIDE + u.par * 2048);
        unsigned dd[8]; float gg[8];
#pragma unroll
        for (int j = 0; j < 8; ++j) { const int lr = wr * 64 + fr + (j >> 2) * HALF + (j & 3) * 16; dd[j] = side[(lr >> 5) * 64 + (lr & 31)]; gg[j] = __uint_as_float(side[(lr >> 5) * 64 + 32 + (lr & 31)]) * (Y8_SCALE / (W8_SCALE * H8_SCALE)); }
#pragma unroll
        EPI_LOOP_ROWS {
            const unsigned d = dd[ai * 4 + m]; const float g = gg[ai * 4 + m];
            unsigned char* rowp = Y + (size_t)(d * (unsigned)D + (unsigned)col0);
#pragma unroll
            for (int bj = 0; bj < 2; ++bj) { const f32x4 v0 = acc[ai][bj][m][0] * g, v1 = acc[ai][bj][m][1] * g;
                u32x2 w; w.x = pk_fp8x4(v0[0], v0[1], v0[2], v0[3]); w.y = pk_fp8x4(v1[0], v1[1], v1[2], v1[3]);
                *(u32x2*)(rowp + bj * HALF) = w; }
        }
    }
};
struct EpiPle {
    static constexpr bool PERM = true;
    u16* out; const u16* x2; const u16* p2; int ld; float asc;
    __device__ __forceinline__ void operator()(const f32x4 (&acc)[2][2][4][2], const GUnit& u, int wr, int wc, int fr, int fq) const {
        const int row0 = u.pm * BM + wr * 64 + fr, col0 = u.pn * BM + wc * 32 + 8 * fq;
#pragma unroll
        for (int ai = 0; ai < 2; ++ai) {
            u32x4 xv[4][2], pv[4][2];
#pragma unroll
            for (int m = 0; m < 4; ++m)
#pragma unroll
                for (int bj = 0; bj < 2; ++bj) { const size_t o = (size_t)(row0 + ai * HALF + m * 16) * ld + col0 + bj * HALF; xv[m][bj] = *(const u32x4*)(x2 + o); pv[m][bj] = *(const u32x4*)(p2 + o); }
            __builtin_amdgcn_sched_barrier(0);
#pragma unroll
            for (int m = 0; m < 4; ++m)
#pragma unroll
                for (int bj = 0; bj < 2; ++bj) { const size_t o = (size_t)(row0 + ai * HALF + m * 16) * ld + col0 + bj * HALF; const u32x4 x = xv[m][bj], p = pv[m][bj]; const f32x4 a = acc[ai][bj][m][0] * asc, b = acc[ai][bj][m][1] * asc;
                    u32x4 r; r.x = cvt_pk_bf16(ALPHA * bf_lo(x.x) + sigmoidf_(a[0]) * bf_lo(p.x), ALPHA * bf_hi(x.x) + sigmoidf_(a[1]) * bf_hi(p.x));
                    r.y = cvt_pk_bf16(ALPHA * bf_lo(x.y) + sigmoidf_(a[2]) * bf_lo(p.y), ALPHA * bf_hi(x.y) + sigmoidf_(a[3]) * bf_hi(p.y));
                    r.z = cvt_pk_bf16(ALPHA * bf_lo(x.z) + sigmoidf_(b[0]) * bf_lo(p.z), ALPHA * bf_hi(x.z) + sigmoidf_(b[1]) * bf_hi(p.z));
                    r.w = cvt_pk_bf16(ALPHA * bf_lo(x.w) + sigmoidf_(b[2]) * bf_lo(p.w), ALPHA * bf_hi(x.w) + sigmoidf_(b[3]) * bf_hi(p.w));
                    *(u32x4*)(out + o) = r; }
            __builtin_amdgcn_sched_barrier(0);
        }
    }
};
}

struct Args { const float* in[25]; float* out; unsigned char* ws; int lo, hi; };
struct Frame {
    LAS unsigned char* lds; int tid, lane, wave, vcu, G; unsigned char* ws; unsigned char* dout;
};

__device__ __forceinline__ void transpose_item(const float* __restrict__ W, int ldw, int k0, int n0, u16* __restrict__ WT, size_t dst_row0, int Kd, LAS float* scr, int lane) {
#pragma unroll 8
    for (int i = 0; i < 32; ++i) { const int kk = 2 * i + (lane >> 5); scr[kk * 33 + (lane & 31)] = W[(size_t)(k0 + kk) * ldw + n0 + (lane & 31)]; }
    LDS_WAIT(); asm volatile("" ::: "memory");
    const int c = lane & 7;
#pragma unroll
    for (int j = 0; j < 4; ++j) { const int n = (lane >> 3) + 8 * j; const LAS float* s = scr + (8 * c) * 33 + n;
        u32x4 o; o.x = cvt_pk_bf16(s[0 * 33], s[1 * 33]); o.y = cvt_pk_bf16(s[2 * 33], s[3 * 33]); o.z = cvt_pk_bf16(s[4 * 33], s[5 * 33]); o.w = cvt_pk_bf16(s[6 * 33], s[7 * 33]);
        *(u32x4*)(WT + (dst_row0 + n) * (size_t)Kd + k0 + 8 * c) = o; }
    LDS_WAIT(); asm volatile("" ::: "memory");
}

__device__ __forceinline__ void transpose_item_f8(const float* __restrict__ W, int ldw, int k0, int n0, unsigned char* __restrict__ WT, size_t dst_row0, int Kd, float scale, LAS float* scr, int lane) {
    float tv[32];
#pragma unroll
    for (int i = 0; i < 32; ++i) tv[i] = W[(size_t)(k0 + 2 * i + (lane >> 5)) * ldw + n0 + (lane & 31)];
#pragma unroll
    for (int i = 0; i < 32; ++i) scr[(2 * i + (lane >> 5)) * 33 + (lane & 31)] = tv[i];
    LDS_WAIT(); asm volatile("" ::: "memory");
    const int c = lane & 7;
#pragma unroll
    for (int j = 0; j < 4; ++j) { const int n = (lane >> 3) + 8 * j; const LAS float* sp = scr + (8 * c) * 33 + n;
        u32x2 o; o.x = pk_fp8x4(sp[0 * 33] * scale, sp[1 * 33] * scale, sp[2 * 33] * scale, sp[3 * 33] * scale); o.y = pk_fp8x4(sp[4 * 33] * scale, sp[5 * 33] * scale, sp[6 * 33] * scale, sp[7 * 33] * scale);
        *(u32x2*)(WT + (dst_row0 + n) * (size_t)Kd + k0 + 8 * c) = o; }
    LDS_WAIT(); asm volatile("" ::: "memory");
}
__device__ __forceinline__ bool transpose_matrix_item(int& r, const float* W, int K, int N, u16* WT, LAS float* scr, int lane) {
    const int nitems = (K / 64) * (N / 32);
    if (r < nitems) { const int nblk = N / 32, kb = r / nblk, nb = r % nblk; transpose_item(W, N, 64 * kb, 32 * nb, WT, (size_t)32 * nb, K, scr, lane); return true; }
    r -= nitems; return false;
}

template <bool OUT_BF16> __device__ __forceinline__ void ln_row(const float* xrow, const float* g, const float* b, void* orow, int lane, unsigned* o8row = nullptr) {
    const f32x4* xr = (const f32x4*)xrow + lane;
    f32x4 v[4]; float s = 0.f;
#pragma unroll
    for (int j = 0; j < 4; ++j) { v[j] = xr[64 * j]; s += (v[j].x + v[j].y) + (v[j].z + v[j].w); }
    const float mean = wave_sum(s) * (1.f / D); float s2 = 0.f;
#pragma unroll
    for (int j = 0; j < 4; ++j) { v[j] = v[j] - mean; s2 += (v[j].x * v[j].x + v[j].y * v[j].y) + (v[j].z * v[j].z + v[j].w * v[j].w); }
    const float rstd = 1.f / sqrtf(wave_sum(s2) * (1.f / D) + LN_EPS);
#pragma unroll
    for (int j = 0; j < 4; ++j) { const f32x4 gg = *((const f32x4*)g + lane + 64 * j), bb = *((const f32x4*)b + lane + 64 * j); const f32x4 y = v[j] * rstd * gg + bb;
        if (OUT_BF16) { u32x2 w; w.x = cvt_pk_bf16(y[0], y[1]); w.y = cvt_pk_bf16(y[2], y[3]); *((u32x2*)orow + lane + 64 * j) = w; if (o8row) o8row[lane + 64 * j] = pk_fp8x4(y[0], y[1], y[2], y[3]); }
        else *((f32x4*)orow + lane + 64 * j) = y; }
}


template <bool OUT_BF16, int NR, bool IN_BF16 = false> __device__ __forceinline__ void ln_rows(const void* xbase_, size_t r0, size_t rstride, const float* g, const float* b, void* obase, int lane, unsigned char* o8base = nullptr) {
    f32x4 v[NR][4]; float s[NR]; f32x4 gq[4], bq[4];
#pragma unroll
    for (int j = 0; j < 4; ++j) { gq[j] = *((const f32x4*)g + lane + 64 * j); bq[j] = *((const f32x4*)b + lane + 64 * j); }
#pragma unroll
    for (int r = 0; r < NR; ++r) { s[r] = 0.f;
        if (IN_BF16) { const u32x2* xr = (const u32x2*)((const u16*)xbase_ + (r0 + r * rstride) * D) + lane;
#pragma unroll
            for (int j = 0; j < 4; ++j) { const u32x2 w = xr[64 * j]; v[r][j] = (f32x4){bf_lo(w.x), bf_hi(w.x), bf_lo(w.y), bf_hi(w.y)}; } }
        else { const f32x4* xr = (const f32x4*)((const float*)xbase_ + (r0 + r * rstride) * D) + lane;
#pragma unroll
            for (int j = 0; j < 4; ++j) { v[r][j] = xr[64 * j]; } } }
    __builtin_amdgcn_sched_barrier(0);
#pragma unroll
    for (int r = 0; r < NR; ++r)
#pragma unroll
        for (int j = 0; j < 4; ++j) s[r] += (v[r][j].x + v[r][j].y) + (v[r][j].z + v[r][j].w);
#pragma unroll
    for (int r = 0; r < NR; ++r) s[r] = wave_sum(s[r]);
    float s2[NR];
#pragma unroll
    for (int r = 0; r < NR; ++r) { const float mean = s[r] * (1.f / D); s2[r] = 0.f;
#pragma unroll
        for (int j = 0; j < 4; ++j) { v[r][j] = v[r][j] - mean; s2[r] += (v[r][j].x * v[r][j].x + v[r][j].y * v[r][j].y) + (v[r][j].z * v[r][j].z + v[r][j].w * v[r][j].w); } }
#pragma unroll
    for (int r = 0; r < NR; ++r) s2[r] = wave_sum(s2[r]);
#pragma unroll
    for (int j = 0; j < 4; ++j) { const f32x4 gg = gq[j], bb = bq[j];
#pragma unroll
        for (int r = 0; r < NR; ++r) { const float rstd = 1.f / sqrtf(s2[r] * (1.f / D) + LN_EPS); const f32x4 y = v[r][j] * rstd * gg + bb; const size_t row = r0 + r * rstride;
            if (OUT_BF16) { u32x2 w; w.x = cvt_pk_bf16(y[0], y[1]); w.y = cvt_pk_bf16(y[2], y[3]); *((u32x2*)((u16*)obase + row * D) + lane + 64 * j) = w; if (o8base) ((unsigned*)(o8base + row * D))[lane + 64 * j] = pk_fp8x4(y[0], y[1], y[2], y[3]); }
            else *((f32x4*)((float*)obase + row * D) + lane + 64 * j) = y; } }
}

__device__ __forceinline__ void phase_prologue(const Frame& F, const Args& a) {
    LAS float* scr = (LAS float*)(F.lds + F.wave * 16384);
    const int gw = F.vcu * NWAVES + F.wave, NGW = F.G * NWAVES;
    constexpr int NITEMS = 16 * 216 + 8 * 32 + 4 * 32 + 16 * 32 + 16 * 8 + 16 * 32 + 4 * 32;
    for (int it = gw; it < NITEMS; it += NGW) {
        int r = it;
        if (r < 16 * 216) { const int kb = r / 216, nb = r % 216; transpose_item_f8(a.in[2], NCOL, 64 * kb, 32 * nb, F.ws + WS_WIN, (size_t)32 * nb, 1024, W8_SCALE, scr, F.lane); continue; } r -= 16 * 216;
        if (r < 8 * 32) { const int kb = r / 32, nb = r % 32; transpose_item_f8(a.in[6], 1024, 64 * kb, 32 * nb, F.ws + WS_WBH, (size_t)32 * nb, 512, W8_SCALE, scr, F.lane); continue; } r -= 8 * 32;
        if (r < 4 * 32) { const int kb = r / 32, nb = r % 32; transpose_item_f8(a.in[7], 1024, 64 * kb, 32 * nb, F.ws + WS_WBA, (size_t)32 * nb, 256, W8_SCALE, scr, F.lane); continue; } r -= 4 * 32;
        if (r < 16 * 32) { const int kb = r / 32, nb = r % 32; transpose_item_f8(a.in[8], 1024, 64 * kb, 32 * nb, F.ws + WS_WO, (size_t)32 * nb, 1024, W8_SCALE, scr, F.lane); continue; } r -= 16 * 32;
        if (transpose_matrix_item(r, a.in[11], 1024, 256, (u16*)(F.ws + WS_WR), scr, F.lane)) continue;
        if (r < 16 * 32) { const int kb = r / 32, nb = r % 32; transpose_item_f8(a.in[21], 1024, 64 * kb, 32 * nb, F.ws + WS_WPG, (size_t)32 * nb, 1024, W8_SCALE, scr, F.lane); continue; } r -= 16 * 32;
        transpose_matrix_item(r, a.in[22], 256, 1024, (u16*)(F.ws + WS_WPP), scr, F.lane);
    }
    const size_t gt = (size_t)F.vcu * NTHR + F.tid, NGT = (size_t)F.G * NTHR;
    { const f32x4* x4 = (const f32x4*)a.in[0]; u32x4* o4 = (u32x4*)(F.ws + WS_XB);
      static_assert(((size_t)T * D / 16) % ((size_t)256 * NTHR * 4) == 0, "x conversion unroll");
      for (size_t i = gt; i < (size_t)T * D / 16; i += 4 * NGT) { f32x4 p[4][4];
#pragma unroll
          for (int u = 0; u < 4; ++u)
#pragma unroll
              for (int k = 0; k < 4; ++k) p[u][k] = x4[4 * (i + u * NGT) + k];
          __builtin_amdgcn_sched_barrier(0);
#pragma unroll
          for (int u = 0; u < 4; ++u) { u32x4 w; w.x = pk_fp8x4(p[u][0][0], p[u][0][1], p[u][0][2], p[u][0][3]); w.y = pk_fp8x4(p[u][1][0], p[u][1][1], p[u][1][2], p[u][1][3]); w.z = pk_fp8x4(p[u][2][0], p[u][2][1], p[u][2][2], p[u][2][3]); w.w = pk_fp8x4(p[u][3][0], p[u][3][1], p[u][3][2], p[u][3][3]); o4[i + u * NGT] = w; } } }
    { float* rot = (float*)(F.ws + WS_ROT);
      for (size_t i = gt; i < (size_t)SEQ * 8; i += NGT) {
          const int pos = (int)(i >> 3), fi = (int)(i & 7);
          const double invf = fi == 0 ? 1.0 : fi == 1 ? 0.19392274474868576 : fi == 2 ? 0.03760603093086393 : fi == 3 ? 0.007292664737217109 : fi == 4 ? 0.001414213562373095 : fi == 5 ? 0.0002742481756762073 : fi == 6 ? 5.318295896944988e-05 : 1.031338537721246e-05;
          const double ang = (double)pos * invf; const double kq = __builtin_rint(ang * 0.6366197723675814); const double r = ang - kq * 1.5707963267948966; const double r2 = r * r;
          const double sn = r * (1.0 + r2 * (-1.0 / 6 + r2 * (1.0 / 120 + r2 * (-1.0 / 5040 + r2 * (1.0 / 362880 + r2 * (-1.0 / 39916800 + r2 * (1.0 / 6227020800.0)))))));
          const double cs = 1.0 + r2 * (-0.5 + r2 * (1.0 / 24 + r2 * (-1.0 / 720 + r2 * (1.0 / 40320 + r2 * (-1.0 / 3628800 + r2 * (1.0 / 479001600.0))))));
          const int qd = ((int)kq) & 3; const double s_ = qd == 0 ? sn : qd == 1 ? cs : qd == 2 ? -sn : -cs; const double c_ = qd == 0 ? cs : qd == 1 ? -sn : qd == 2 ? -cs : sn;
          rot[pos * 16 + fi] = (float)c_; rot[pos * 16 + 8 + fi] = (float)s_; } }
    { float* lb = (float*)(F.ws + WS_LB);
      for (size_t i = gt; i < 1024; i += NGT) { const int c = (int)(i & 511); const float* src = (i < 512) ? a.in[3] : a.in[4]; lb[i] = 1.0f / (1.0f + expf(src[512 + c] - src[c])); } }
}

__device__ __forceinline__ void hgrn_item(const Frame& F, int item) {
    const int b = item >> 3, h = (item >> 1) & 3, dir = item & 1;
    LAS float* fb = (LAS float*)F.lds; LAS float* kb = fb + 2048; LAS float* qb = kb + 2048; LAS float* vb = qb + 2048; LAS float* op = vb + 2048;
    const int tid = F.tid, v = tid & 127, eg = tid >> 7, ls = tid >> 5, lc = (tid & 31) * 4;
    const u16* QH = (const u16*)(F.ws + Z_QH); const u16* VH = (const u16*)(F.ws + Z_VH); const u16* LF = (const u16*)(F.ws + (dir ? Z_LFB : Z_LFF));
#if DBG_CHECK && !USE_NAIVE_HGRN
    u16* O = (u16*)(F.ws + WS_XB + (dir ? 64 * MiB : 0));
#else
    u16* O = (u16*)(F.dout + (dir ? DO_OB : DO_OF));
#endif
    float S[32];
#pragma unroll
    for (int j = 0; j < 32; ++j) S[j] = 0.f;
    const size_t rowbase = (size_t)b * SEQ, colbase = (size_t)h * 128;
    u32x2 rq, rv, rl;
    { const int pos = dir ? (SEQ - 1 - ls) : ls; const size_t o = (rowbase + pos) * 512 + colbase + lc; rq = *(const u32x2*)(QH + o); rv = *(const u32x2*)(VH + o); rl = *(const u32x2*)(LF + o); }
    for (int blk = 0; blk < SEQ / 16; ++blk) {
        { const f32x4 lb4 = *(const f32x4*)((const float*)(F.ws + WS_LB) + dir * 512 + h * 128 + lc);
          const f32x4 f = {lb4[0] + (1.f - lb4[0]) * sigmoidf_(bf_lo(rl.x)), lb4[1] + (1.f - lb4[1]) * sigmoidf_(bf_hi(rl.x)), lb4[2] + (1.f - lb4[2]) * sigmoidf_(bf_lo(rl.y)), lb4[3] + (1.f - lb4[3]) * sigmoidf_(bf_hi(rl.y))}; const f32x4 k = {1.f - f[0], 1.f - f[1], 1.f - f[2], 1.f - f[3]};
          *(LAS f32x4*)(fb + ls * 128 + lc) = f; *(LAS f32x4*)(kb + ls * 128 + lc) = k;
          { f32x4 qq = {bf_lo(rq.x), bf_hi(rq.x), bf_lo(rq.y), bf_hi(rq.y)};
#pragma unroll
            for (int j = 0; j < 4; ++j) qq[j] *= sigmoidf_(qq[j]);
            *(LAS f32x4*)(qb + ls * 128 + lc) = qq; }
          *(LAS f32x4*)(vb + ls * 128 + lc) = (f32x4){bf_lo(rv.x), bf_hi(rv.x), bf_lo(rv.y), bf_hi(rv.y)}; }
        __syncthreads();
        if (blk + 1 < SEQ / 16) { const int t = (blk + 1) * 16 + ls; const int pos = dir ? (SEQ - 1 - t) : t; const size_t o = (rowbase + pos) * 512 + colbase + lc; rq = *(const u32x2*)(QH + o); rv = *(const u32x2*)(VH + o); rl = *(const u32x2*)(LF + o); }
#pragma unroll 2
        for (int s = 0; s < 16; ++s) {
            const float vm = vb[s * 128 + v]; float ac = 0.f;
#pragma unroll
            for (int jj = 0; jj < 8; ++jj) {
                const f32x4 f4 = *(const LAS f32x4*)(fb + s * 128 + eg * 32 + 4 * jj), k4 = *(const LAS f32x4*)(kb + s * 128 + eg * 32 + 4 * jj), q4 = *(const LAS f32x4*)(qb + s * 128 + eg * 32 + 4 * jj);
#pragma unroll
                for (int j = 0; j < 4; ++j) { S[4 * jj + j] = f4[j] * S[4 * jj + j] + k4[j] * vm; ac += S[4 * jj + j] * q4[j]; }
            }
            op[(s * 4 + eg) * 128 + v] = ac;
        }
        __syncthreads();
        { const f32x4 o = *(const LAS f32x4*)(op + (ls * 4 + 0) * 128 + lc) + *(const LAS f32x4*)(op + (ls * 4 + 1) * 128 + lc) + *(const LAS f32x4*)(op + (ls * 4 + 2) * 128 + lc) + *(const LAS f32x4*)(op + (ls * 4 + 3) * 128 + lc);
          const int t = blk * 16 + ls; const int pos = dir ? (SEQ - 1 - t) : t; u32x2 w; w.x = cvt_pk_bf16(o[0], o[1]); w.y = cvt_pk_bf16(o[2], o[3]);
          *(u32x2*)(O + (rowbase + pos) * 512 + colbase + lc) = w; }
    }
    __syncthreads();
}

__device__ __forceinline__ void attn_naive(const Frame& F) {
    const int gw = F.vcu * NWAVES + F.wave, NGW = F.G * NWAVES, lane = F.lane;
    const u16* AQ = (const u16*)(F.ws + Z_AQ); const u16* AK = (const u16*)(F.ws + Z_AK); const u16* AV = (const u16*)(F.ws + Z_AV); u16* YA = (u16*)(F.ws + WS_YA);
    for (int wi = gw; wi < T * 4; wi += NGW) {
        const int row = wi >> 2, s = wi & 3, b = row >> 11, p = row & (SEQ - 1);
        float sc[3][3]; int lo_[3], hi_[3];
#pragma unroll
        for (int g = 0; g < 3; ++g) {
            const int sh = 2 * g, mlen = SEQ >> sh, r = p & ((1 << sh) - 1), m = p >> sh; const int lo = m - 64 < 0 ? 0 : m - 64, hi = m + 64 > mlen - 1 ? mlen - 1 : m + 64; lo_[g] = lo; hi_[g] = hi;
            const int hd = g * 4 + s;
            u32x4 qw[8];
            { const u32x4* qp = (const u32x4*)(AQ + (size_t)row * 768 + hd * 64);
#pragma unroll
              for (int c = 0; c < 8; ++c) qw[c] = qp[c]; }
#pragma unroll
            for (int rr = 0; rr < 3; ++rr) {
                const int j = lo + rr * 64 + lane; const bool valid = j <= hi; const int jc = valid ? j : hi;
                const u32x4* kp = (const u32x4*)(AK + ((size_t)b * SEQ + r + ((size_t)jc << sh)) * 768 + hd * 64);
                float d = 0.f;
#pragma unroll
                for (int c = 0; c < 8; ++c) { const u32x4 w = kp[c]; const u32x4 q = qw[c]; d += bf_lo(q.x) * bf_lo(w.x) + bf_hi(q.x) * bf_hi(w.x) + bf_lo(q.y) * bf_lo(w.y) + bf_hi(q.y) * bf_hi(w.y) + bf_lo(q.z) * bf_lo(w.z) + bf_hi(q.z) * bf_hi(w.z) + bf_lo(q.w) * bf_lo(w.w) + bf_hi(q.w) * bf_hi(w.w); }
                sc[g][rr] = valid ? d : -1e30f;
                asm volatile("" : "+v"(sc[g][rr]) :: "memory");
            }
        }
        float mx = -1e30f;
#pragma unroll
        for (int g = 0; g < 3; ++g)
#pragma unroll
            for (int rr = 0; rr < 3; ++rr) mx = fmaxf(mx, sc[g][rr]);
        mx = wave_max(mx);
        float den = 0.f;
#pragma unroll
        for (int g = 0; g < 3; ++g)
#pragma unroll
            for (int rr = 0; rr < 3; ++rr) { sc[g][rr] = sc[g][rr] > -1e29f ? __expf(sc[g][rr] - mx) : 0.f; den += sc[g][rr]; }
        den = wave_sum(den);
        float o = 0.f;
#pragma unroll
        for (int g = 0; g < 3; ++g) {
            const int sh = 2 * g, r = p & ((1 << sh) - 1), hd = g * 4 + s; const u16* vp = AV + ((size_t)b * SEQ + r) * 768 + hd * 64 + lane;
#pragma unroll
            for (int rr = 0; rr < 3; ++rr) {
                const int j0 = lo_[g] + rr * 64; int cnt = hi_[g] - j0 + 1; cnt = cnt > 64 ? 64 : cnt;
                const float e = sc[g][rr];
#pragma unroll 4
                for (int jj = 0; jj < cnt; ++jj) { const float pj = __uint_as_float(__builtin_amdgcn_readlane(__float_as_uint(e), jj)); o += pj * bf1(vp[((size_t)(j0 + jj) << sh) * 768]); }
            }
        }
        o = o / den;
        const float on = __shfl_down(o, 1);
        if ((lane & 1) == 0) *(unsigned*)(YA + (size_t)row * 256 + s * 64 + lane) = cvt_pk_bf16(o, on);
    }
}


typedef float f32x16 __attribute__((ext_vector_type(16)));
constexpr size_t DO_OP = 128 * MiB, DO_ML = 224 * MiB;
__device__ __forceinline__ bf16x8 pack_pt(const f32x16& x, const int s) {
    u32x4 p;
    asm volatile("v_cvt_pk_bf16_f32 %0, %4, %5\n\tv_cvt_pk_bf16_f32 %1, %6, %7\n\tv_cvt_pk_bf16_f32 %2, %8, %9\n\tv_cvt_pk_bf16_f32 %3, %10, %11\n\ts_nop 1"
                 : "=&v"(p[0]), "=&v"(p[1]), "=&v"(p[2]), "=&v"(p[3])
                 : "v"(x[8 * s]), "v"(x[8 * s + 1]), "v"(x[8 * s + 2]), "v"(x[8 * s + 3]), "v"(x[8 * s + 4]), "v"(x[8 * s + 5]), "v"(x[8 * s + 6]), "v"(x[8 * s + 7]));
    return __builtin_bit_cast(bf16x8, p);
}
__device__ __forceinline__ void attn_mfma(const Frame& F) {
    const int lane = F.lane, c = lane & 31, h = lane >> 5;
    LAS unsigned char* vbuf = F.lds + F.wave * 4608;
    const unsigned vb_addr = (unsigned)(size_t)vbuf;
    const u16* AQ = (const u16*)(F.ws + Z_AQ); const u16* AK = (const u16*)(F.ws + Z_AK); const u16* AV = (const u16*)(F.ws + Z_AV);
    u16* OP = (u16*)(F.dout + DO_OP); float* ML = (float*)(F.dout + DO_ML);
    const int gw = F.vcu * NWAVES + F.wave, NGW = F.G * NWAVES;
    const int blk = (lane >> 4) & 1, q4 = (lane & 15) >> 2, p4 = lane & 3;
    for (int it = gw; it < 32 * 12 * 64; it += NGW) {
        const int x = it & 63, bh = it >> 6, hd = bh % 12, b = bh / 12, g = hd >> 2, sh = 2 * g;
        const int nqb = 64 >> sh, r = x >> (6 - sh), qb = x & (nqb - 1), mlen = SEQ >> sh, m0 = qb * 32;
        const size_t rowb = (size_t)b * SEQ + r;
        const size_t qrow = rowb + ((size_t)(m0 + c) << sh);
        bf16x8 qf[4];
#pragma unroll
        for (int s = 0; s < 4; ++s) qf[s] = *(const bf16x8*)(AQ + qrow * 768 + hd * 64 + 16 * s + 8 * h);
        f32x16 st[5];
        bf16x8 kf[5][4];
#pragma unroll
        for (int kb = 0; kb < 5; ++kb) {
            int mk = m0 - 64 + 32 * kb + c; mk = mk < 0 ? 0 : (mk > mlen - 1 ? mlen - 1 : mk);
            const u16* kp = AK + (rowb + ((size_t)mk << sh)) * 768 + hd * 64 + 8 * h;
#pragma unroll
            for (int s = 0; s < 4; ++s) kf[kb][s] = *(const bf16x8*)(kp + 16 * s);
        }
        __builtin_amdgcn_sched_barrier(0);
#pragma unroll
        for (int kb = 0; kb < 5; ++kb) {
            f32x16 acc;
#pragma unroll
            for (int i = 0; i < 16; ++i) acc[i] = 0.f;
#pragma unroll
            for (int s = 0; s < 4; ++s) acc = __builtin_amdgcn_mfma_f32_32x32x16_bf16(kf[kb][s], qf[s], acc, 0, 0, 0);
            st[kb] = acc;
        }
        float mx = -1e30f;
#pragma unroll
        for (int kb = 0; kb < 5; ++kb)
#pragma unroll
            for (int i = 0; i < 16; ++i) { const int rel = 32 * kb - 64 + ((i & 3) + 8 * (i >> 2) + 4 * h) - c; const int key = m0 + c + rel; const bool valid = (key >= 0) && (key < mlen) && (rel >= -64) && (rel <= 64);
                const float v = valid ? st[kb][i] : -1e30f; st[kb][i] = v; mx = fmaxf(mx, v); }
        mx = fmaxf(mx, __shfl_xor(mx, 32));
        float l = 0.f;
#pragma unroll
        for (int kb = 0; kb < 5; ++kb)
#pragma unroll
            for (int i = 0; i < 16; ++i) { const float p = st[kb][i] > -1e29f ? __expf(st[kb][i] - mx) : 0.f; st[kb][i] = p; l += p; }
        l += __shfl_xor(l, 32);
        f32x16 y0, y1;
#pragma unroll
        for (int i = 0; i < 16; ++i) { y0[i] = 0.f; y1[i] = 0.f; }
        u32x4 vr[4];
#define LOADV(kb_) _Pragma("unroll") for (int i4 = 0; i4 < 4; ++i4) { const int row = (lane >> 3) + 8 * i4; int mk = m0 - 64 + 32 * (kb_) + row; mk = mk < 0 ? 0 : (mk > mlen - 1 ? mlen - 1 : mk); \
            vr[i4] = *(const u32x4*)(AV + (rowb + ((size_t)mk << sh)) * 768 + hd * 64 + (lane & 7) * 8); }
        LOADV(0)
#pragma unroll
        for (int kb = 0; kb < 5; ++kb) {
#pragma unroll
            for (int i4 = 0; i4 < 4; ++i4) { const int row = (lane >> 3) + 8 * i4; *(LAS u32x4*)(vbuf + row * 144 + (lane & 7) * 16) = vr[i4]; }
            if (kb < 4) { LOADV(kb + 1) }
            asm volatile("s_waitcnt lgkmcnt(0)" ::: "memory");
            u32x2 tq[2][4];
#pragma unroll
            for (int s = 0; s < 2; ++s) {
                const unsigned a0 = vb_addr + 144u * (unsigned)(16 * s + 4 * h + q4) + 2u * (unsigned)(16 * blk + 4 * p4);
                asm volatile("ds_read_b64_tr_b16 %0, %4\n\tds_read_b64_tr_b16 %1, %4 offset:1152\n\tds_read_b64_tr_b16 %2, %4 offset:64\n\tds_read_b64_tr_b16 %3, %4 offset:1216"
                             : "=&v"(tq[s][0]), "=&v"(tq[s][1]), "=&v"(tq[s][2]), "=&v"(tq[s][3]) : "v"(a0) : "memory");
            }
            asm volatile("s_waitcnt lgkmcnt(0)" : "+v"(tq[0][0]), "+v"(tq[0][1]), "+v"(tq[0][2]), "+v"(tq[0][3]), "+v"(tq[1][0]), "+v"(tq[1][1]), "+v"(tq[1][2]), "+v"(tq[1][3]) :: "memory");
#pragma unroll
            for (int s = 0; s < 2; ++s) {
                const bf16x8 xs = pack_pt(st[kb], s);
                u32x4 vv0, vv1; vv0.x = tq[s][0].x; vv0.y = tq[s][0].y; vv0.z = tq[s][1].x; vv0.w = tq[s][1].y; vv1.x = tq[s][2].x; vv1.y = tq[s][2].y; vv1.z = tq[s][3].x; vv1.w = tq[s][3].y;
                y0 = __builtin_amdgcn_mfma_f32_32x32x16_bf16(__builtin_bit_cast(bf16x8, vv0), xs, y0, 0, 0, 0);
                y1 = __builtin_amdgcn_mfma_f32_32x32x16_bf16(__builtin_bit_cast(bf16x8, vv1), xs, y1, 0, 0, 0);
            }
        }
#undef LOADV
        const float inv = 1.0f / l;
        u16* op = OP + qrow * 768 + hd * 64 + 4 * h;
#pragma unroll
        for (int gq = 0; gq < 4; ++gq) {
            u32x2 w0, w1; w0.x = cvt_pk_bf16(y0[4 * gq] * inv, y0[4 * gq + 1] * inv); w0.y = cvt_pk_bf16(y0[4 * gq + 2] * inv, y0[4 * gq + 3] * inv);
            w1.x = cvt_pk_bf16(y1[4 * gq] * inv, y1[4 * gq + 1] * inv); w1.y = cvt_pk_bf16(y1[4 * gq + 2] * inv, y1[4 * gq + 3] * inv);
            *(u32x2*)(op + 8 * gq) = w0; *(u32x2*)(op + 32 + 8 * gq) = w1; }
        if (h == 0) ML[qrow * 12 + hd] = mx + __logf(l);
    }
}


constexpr int HT_STRIDE = 272, HT_BYTES = 64 * HT_STRIDE;
constexpr int HL_QS = 0, HL_KS = HT_BYTES, HL_QIN = 2 * HT_BYTES, HL_KOUT = 3 * HT_BYTES, HL_V = 4 * HT_BYTES, HL_PSUM = 5 * HT_BYTES, HL_D = HL_PSUM + 4096;
#define TR2(dst0, dst1, addr, off1) asm volatile("ds_read_b64_tr_b16 %0, %2\n\tds_read_b64_tr_b16 %1, %2 offset:" #off1 "\n\ts_waitcnt lgkmcnt(0)" : "=&v"(dst0), "=&v"(dst1) : "v"(addr) : "memory")
__device__ __forceinline__ void hgrn_mfma_item(const Frame& F, int item, u16* OFp, u16* OBp) {
    const int b = item >> 3, hh = (item >> 1) & 3, dir = item & 1;
    const int tid = F.tid, lane = F.lane, wave = F.wave, vj = wave & 3, ci = wave >> 2, c = lane & 31, h = lane >> 5;
    const int blk = (lane >> 4) & 1, q4 = (lane & 15) >> 2, p4 = lane & 3;
    LAS unsigned char* L = F.lds; const unsigned Lb = (unsigned)(size_t)L;
    const int e2 = 2 * (tid & 63), part = tid >> 6;
    const u16* QH = (const u16*)(F.ws + Z_QH); const u16* VH = (const u16*)(F.ws + Z_VH); const u16* LF = (const u16*)(F.ws + (dir ? Z_LFB : Z_LFF));
    u16* O = dir ? OBp : OFp;
    const size_t rowbase = (size_t)b * SEQ, colbase = (size_t)hh * 128;
    f32x16 S[4];
#pragma unroll
    for (int et = 0; et < 4; ++et)
#pragma unroll
        for (int i = 0; i < 16; ++i) S[et][i] = 0.f;
    const f32x2 lbv = *(const f32x2*)((const float*)(F.ws + WS_LB) + dir * 512 + hh * 128 + e2);
    unsigned rq[8], rv[8], rl[8];
#pragma unroll
    for (int j = 0; j < 8; ++j) { const int tt = part * 8 + j; const int pos = dir ? (SEQ - 1 - tt) : tt; const size_t o = (rowbase + pos) * 512 + colbase + e2; rq[j] = *(const u16*)((const unsigned char*)QH + o); rv[j] = *(const u16*)((const unsigned char*)VH + o); rl[j] = *(const unsigned*)(LF + o); }
    for (int chunk = 0; chunk < SEQ / 64; ++chunk) {
        float bl0[8], bl1[8], fk0[8], fk1[8]; float r0 = 0.f, r1 = 0.f;
#pragma unroll
        for (int j = 0; j < 8; ++j) { const float f0 = lbv.x + (1.f - lbv.x) * sigmoidf_(bf_lo(rl[j])), f1 = lbv.y + (1.f - lbv.y) * sigmoidf_(bf_hi(rl[j])); fk0[j] = 1.f - f0; fk1[j] = 1.f - f1; r0 += __logf(f0); r1 += __logf(f1); bl0[j] = r0; bl1[j] = r1; }
        *(LAS f32x2*)(L + HL_PSUM + (part * 128 + e2) * 4) = (f32x2){r0, r1};
        __syncthreads();
        float offs0 = 0.f, offs1 = 0.f, bref0 = 0.f, bref1 = 0.f, blast0 = 0.f, blast1 = 0.f;
#pragma unroll
        for (int pp = 0; pp < 8; ++pp) { const f32x2 t = *(const LAS f32x2*)(L + HL_PSUM + (pp * 128 + e2) * 4); if (pp < part) { offs0 += t.x; offs1 += t.y; } if (pp < 4) { bref0 += t.x; bref1 += t.y; } blast0 += t.x; blast1 += t.y; }
        const float Cr0 = __expf(bref0), Cr1 = __expf(bref1), Cl0 = __expf(blast0 - bref0), Cl1 = __expf(blast1 - bref1);
        if (part == 0) *(LAS f32x2*)(L + HL_D + e2 * 4) = (f32x2){__expf(blast0), __expf(blast1)};
#pragma unroll
        for (int j = 0; j < 8; ++j) {
            const int t = part * 8 + j; const unsigned a = (unsigned)(t * HT_STRIDE + e2 * 2);
            const float E0 = __expf(offs0 + bl0[j] - bref0), E1 = __expf(offs1 + bl1[j] - bref1); const float R0 = __builtin_amdgcn_rcpf(E0), R1 = __builtin_amdgcn_rcpf(E1);
            const f32x2_t qq_ = __builtin_amdgcn_cvt_pk_f32_fp8((int)rq[j], false), vv_ = __builtin_amdgcn_cvt_pk_f32_fp8((int)rv[j], false);
            float q0 = qq_.x, q1 = qq_.y; q0 *= sigmoidf_(q0); q1 *= sigmoidf_(q1); const float k0 = fk0[j], k1 = fk1[j];
            *(LAS unsigned*)(L + HL_QS + a) = cvt_pk_bf16(q0 * E0, q1 * E1);
            *(LAS unsigned*)(L + HL_KS + a) = cvt_pk_bf16(k0 * R0, k1 * R1);
            *(LAS unsigned*)(L + HL_QIN + a) = cvt_pk_bf16(q0 * E0 * Cr0, q1 * E1 * Cr1);
            *(LAS unsigned*)(L + HL_KOUT + a) = cvt_pk_bf16(k0 * R0 * Cl0, k1 * R1 * Cl1);
            *(LAS unsigned*)(L + HL_V + a) = cvt_pk_bf16(vv_.x, vv_.y);
        }
        __syncthreads();
        if (chunk + 1 < SEQ / 64) {
#pragma unroll
            for (int j = 0; j < 8; ++j) { const int tt = (chunk + 1) * 64 + part * 8 + j; const int pos = dir ? (SEQ - 1 - tt) : tt; const size_t o = (rowbase + pos) * 512 + colbase + e2; rq[j] = *(const u16*)((const unsigned char*)QH + o); rv[j] = *(const u16*)((const unsigned char*)VH + o); rl[j] = *(const unsigned*)(LF + o); }
        }
        f32x16 z;
#pragma unroll
        for (int i = 0; i < 16; ++i) z[i] = 0.f;
#pragma unroll
        for (int et = 0; et < 4; ++et)
#pragma unroll
            for (int st = 0; st < 2; ++st) {
                const bf16x8 A = pack_pt(S[et], st);
                const LAS unsigned char* qp = L + HL_QIN + (32 * ci + c) * HT_STRIDE + (32 * et + 16 * st + 4 * h) * 2;
                const u32x2 lo = *(const LAS u32x2*)qp, hi = *(const LAS u32x2*)(qp + 16);
                u32x4 bb; bb.x = lo.x; bb.y = lo.y; bb.z = hi.x; bb.w = hi.y;
                z = __builtin_amdgcn_mfma_f32_32x32x16_bf16(A, __builtin_bit_cast(bf16x8, bb), z, 0, 0, 0);
            }
#pragma unroll
        for (int stile = 0; stile < 2; ++stile) {
            if (stile <= ci) {
                f32x16 pt;
#pragma unroll
                for (int i = 0; i < 16; ++i) pt[i] = 0.f;
#pragma unroll
                for (int ek = 0; ek < 8; ++ek) {
                    const bf16x8 A = *(const LAS bf16x8*)(L + HL_KS + (32 * stile + c) * HT_STRIDE + (16 * ek + 8 * h) * 2);
                    const bf16x8 B = *(const LAS bf16x8*)(L + HL_QS + (32 * ci + c) * HT_STRIDE + (16 * ek + 8 * h) * 2);
                    pt = __builtin_amdgcn_mfma_f32_32x32x16_bf16(A, B, pt, 0, 0, 0);
                }
#pragma unroll
                for (int i = 0; i < 16; ++i) { const int srow = 32 * stile + (i & 3) + 8 * (i >> 2) + 4 * h; pt[i] = (srow <= 32 * ci + c) ? pt[i] : 0.f; }
#pragma unroll
                for (int st = 0; st < 2; ++st) {
                    const bf16x8 Bp = pack_pt(pt, st);
                    u32x2 t0, t1; const unsigned a0 = Lb + HL_V + (unsigned)((32 * stile + 16 * st + 4 * h + q4) * HT_STRIDE + (32 * vj + 16 * blk + 4 * p4) * 2);
                    TR2(t0, t1, a0, 2176);
                    u32x4 av; av.x = t0.x; av.y = t0.y; av.z = t1.x; av.w = t1.y;
                    z = __builtin_amdgcn_mfma_f32_32x32x16_bf16(__builtin_bit_cast(bf16x8, av), Bp, z, 0, 0, 0);
                }
            }
        }
        { const int tt = chunk * 64 + 32 * ci + c; const int pos = dir ? (SEQ - 1 - tt) : tt; u16* op = O + (rowbase + pos) * 512 + colbase + 32 * vj + 4 * h;
#pragma unroll
          for (int gq = 0; gq < 4; ++gq) { u32x2 w; w.x = cvt_pk_bf16(z[4 * gq], z[4 * gq + 1]); w.y = cvt_pk_bf16(z[4 * gq + 2], z[4 * gq + 3]); *(u32x2*)(op + 8 * gq) = w; } }
        bf16x8 Vb[4];
#pragma unroll
        for (int tk = 0; tk < 4; ++tk) { u32x2 t0, t1; const unsigned a0 = Lb + HL_V + (unsigned)((16 * tk + 8 * h + q4) * HT_STRIDE + (32 * vj + 16 * blk + 4 * p4) * 2);
            TR2(t0, t1, a0, 1088);
            u32x4 bv; bv.x = t0.x; bv.y = t0.y; bv.z = t1.x; bv.w = t1.y; Vb[tk] = __builtin_bit_cast(bf16x8, bv); }
#pragma unroll
        for (int et = 0; et < 4; ++et) {
#pragma unroll
            for (int gq = 0; gq < 4; ++gq) { const f32x4 dv = *(const LAS f32x4*)(L + HL_D + (32 * et + 8 * gq + 4 * h) * 4);
#pragma unroll
                for (int e = 0; e < 4; ++e) S[et][4 * gq + e] *= dv[e]; }
#pragma unroll
            for (int tk = 0; tk < 4; ++tk) { u32x2 t0, t1; const unsigned a0 = Lb + HL_KOUT + (unsigned)((16 * tk + 8 * h + q4) * HT_STRIDE + (32 * et + 16 * blk + 4 * p4) * 2);
                TR2(t0, t1, a0, 1088);
                u32x4 ak; ak.x = t0.x; ak.y = t0.y; ak.z = t1.x; ak.w = t1.y;
                S[et] = __builtin_amdgcn_mfma_f32_32x32x16_bf16(__builtin_bit_cast(bf16x8, ak), Vb[tk], S[et], 0, 0, 0); }
        }
    }
    __syncthreads();
}

__device__ __forceinline__ void phase_hg_combine(const Frame& F, const Args& a) {
    const int gw = F.vcu * NWAVES + F.wave, NGW = F.G * NWAVES, lane = F.lane;
    const u16* OF = (const u16*)(F.dout + DO_OF); const u16* OB = (const u16*)(F.dout + DO_OB); const u16* GS = (const u16*)(F.ws + Z_GS); u16* YH = (u16*)(F.ws + WS_YH);
    const u16* OP = (const u16*)(F.dout + DO_OP); const float* ML = (const float*)(F.dout + DO_ML); u16* YA = (u16*)(F.ws + WS_YA);
    const f32x4 ng0 = *(const f32x4*)(a.in[5] + 8 * lane), ng1 = *(const f32x4*)(a.in[5] + 8 * lane + 4);
    const int sl = lane >> 4, dd = (4 * lane) & 63;
    constexpr int NR = 4;
    for (int row0 = gw; row0 < T; row0 += NR * NGW) {
        u32x4 fv[NR], bv[NR]; u32x2 gv[NR], av[NR][3]; float lv[NR][3];
#pragma unroll
        for (int r = 0; r < NR; ++r) { const int row = row0 + r * NGW; const size_t o = (size_t)row * 512 + 8 * lane;
            fv[r] = *(const u32x4*)(OF + o); bv[r] = *(const u32x4*)(OB + o); gv[r] = *(const u32x2*)((const unsigned char*)GS + o);
#pragma unroll
            for (int k = 0; k < 3; ++k) { lv[r][k] = ML[(size_t)row * 12 + 4 * k + sl]; av[r][k] = *(const u32x2*)(OP + (size_t)row * 768 + (4 * k + sl) * 64 + dd); } }
        __builtin_amdgcn_sched_barrier(0);
#pragma unroll
        for (int r = 0; r < NR; ++r) { const int row = row0 + r * NGW; const size_t o = (size_t)row * 512 + 8 * lane;
            const u32x4 f = fv[r], bq = bv[r]; const u32x2 g = gv[r];
            float v[8] = {bf_lo(f.x) + bf_lo(bq.x), bf_hi(f.x) + bf_hi(bq.x), bf_lo(f.y) + bf_lo(bq.y), bf_hi(f.y) + bf_hi(bq.y), bf_lo(f.z) + bf_lo(bq.z), bf_hi(f.z) + bf_hi(bq.z), bf_lo(f.w) + bf_lo(bq.w), bf_hi(f.w) + bf_hi(bq.w)};
            float ss = 0.f;
#pragma unroll
            for (int j = 0; j < 8; ++j) ss += v[j] * v[j];
            ss += __int_as_float(__builtin_amdgcn_update_dpp(0, __float_as_int(ss), 0xB1, 0xF, 0xF, true)); ss += __int_as_float(__builtin_amdgcn_update_dpp(0, __float_as_int(ss), 0x4E, 0xF, 0xF, true));
            ss += __int_as_float(__builtin_amdgcn_update_dpp(0, __float_as_int(ss), 0x141, 0xF, 0xF, true)); ss += __int_as_float(__builtin_amdgcn_update_dpp(0, __float_as_int(ss), 0x140, 0xF, 0xF, true));
            const float rs = 1.0f / sqrtf(ss * (1.f / 128.f) + LN_EPS);
            float gg[8]; { float t0[4], t1[4]; fp8x4_to_f32(g.x, t0); fp8x4_to_f32(g.y, t1);
#pragma unroll
              for (int j = 0; j < 4; ++j) { gg[j] = t0[j]; gg[4 + j] = t1[j]; } }
#pragma unroll
            for (int j = 0; j < 8; ++j) gg[j] *= sigmoidf_(gg[j]);
            u32x2 w; w.x = pk_fp8x4(v[0] * rs * ng0[0] * gg[0], v[1] * rs * ng0[1] * gg[1], v[2] * rs * ng0[2] * gg[2], v[3] * rs * ng0[3] * gg[3]);
            w.y = pk_fp8x4(v[4] * rs * ng1[0] * gg[4], v[5] * rs * ng1[1] * gg[5], v[6] * rs * ng1[2] * gg[6], v[7] * rs * ng1[3] * gg[7]);
            *(u32x2*)((unsigned char*)YH + o) = w;
            const float l0 = lv[r][0], l1 = lv[r][1], l2 = lv[r][2];
            const float lm = fmaxf(l0, fmaxf(l1, l2)); float w0 = __expf(l0 - lm), w1 = __expf(l1 - lm), w2 = __expf(l2 - lm); const float ws_ = 1.0f / (w0 + w1 + w2); w0 *= ws_; w1 *= ws_; w2 *= ws_;
            const u32x2 a0 = av[r][0], a1 = av[r][1], a2 = av[r][2];
            const unsigned wv = pk_fp8x4(w0 * bf_lo(a0.x) + w1 * bf_lo(a1.x) + w2 * bf_lo(a2.x), w0 * bf_hi(a0.x) + w1 * bf_hi(a1.x) + w2 * bf_hi(a2.x), w0 * bf_lo(a0.y) + w1 * bf_lo(a1.y) + w2 * bf_lo(a2.y), w0 * bf_hi(a0.y) + w1 * bf_hi(a1.y) + w2 * bf_hi(a2.y));
            *(unsigned*)((unsigned char*)YA + (size_t)row * 256 + 4 * lane) = wv;
        }
    }
}

template <bool DO_LN, bool DO_CONV> __device__ __forceinline__ void phase_ln1_convert(const Frame& F, const Args& a, int part = 0, int nparts = 1) {
    const int gw = F.vcu * NWAVES + F.wave, NGW = F.G * NWAVES;
    const float* X1 = (const float*)(F.ws + WS_X1PRE); u16* X1B = (u16*)(F.ws + WS_XB);
    if constexpr (DO_LN)
    for (int row = gw; row < T; row += 4 * NGW) ln_rows<true, 4, true>(X1, (size_t)row, (size_t)NGW, a.in[9], a.in[10], X1B, F.lane, F.ws + WS_X1F8);
    if constexpr (!DO_CONV) return;
    LAS float* scr = (LAS float*)(F.lds + F.wave * 16384);
    unsigned char* WGU = F.ws + WS_WGU; unsigned char* WD = F.ws + WS_WD;
    constexpr int PER_E = 384, NIT = 257 * PER_E;
    const int lane = F.lane;
#define CV_DECODE(it_, sp_, ldw_, dp_, kd_) { const int e = (it_) / PER_E, r = (it_) % PER_E; const int which = r >> 7, q = r & 127; \
        if (which < 2) { const float* src = (e < 256) ? a.in[13 + which] + (size_t)e * 1024 * 256 : a.in[16 + which]; const int kb = q >> 3, nb = q & 7; ldw_ = 256; kd_ = 1024; \
            sp_ = src + (size_t)(64 * kb + (lane >> 5)) * 256 + 32 * nb + (lane & 31); dp_ = WGU + ((size_t)e * 512 + (nb >> 2) * 256 + which * 128 + (nb & 3) * 32) * 1024 + 64 * kb; } \
        else { const float* src = (e < 256) ? a.in[15] + (size_t)e * 256 * 1024 : a.in[18]; const int kb = q >> 5, nb = q & 31; ldw_ = 1024; kd_ = 256; \
            sp_ = src + (size_t)(64 * kb + (lane >> 5)) * 1024 + 32 * nb + (lane & 31); dp_ = WD + ((size_t)e * 1024 + 32 * nb) * 256 + 64 * kb; } }
#define CV_LOAD(tv_, sp_, ldw_) { _Pragma("unroll") for (int i = 0; i < 32; ++i) tv_[i] = sp_[(size_t)(2 * i) * ldw_]; }
#define CV_FINISH(tv_, dp_, kd_) { _Pragma("unroll") for (int i = 0; i < 32; ++i) scr[(2 * i + (lane >> 5)) * 33 + (lane & 31)] = tv_[i]; \
        LDS_WAIT(); asm volatile("" ::: "memory"); const int c = lane & 7; \
        _Pragma("unroll") for (int j = 0; j < 4; ++j) { const int n = (lane >> 3) + 8 * j; const LAS float* sp = scr + (8 * c) * 33 + n; \
            u32x2 o; o.x = pk_fp8x4(sp[0 * 33] * W8_SCALE, sp[1 * 33] * W8_SCALE, sp[2 * 33] * W8_SCALE, sp[3 * 33] * W8_SCALE); o.y = pk_fp8x4(sp[4 * 33] * W8_SCALE, sp[5 * 33] * W8_SCALE, sp[6 * 33] * W8_SCALE, sp[7 * 33] * W8_SCALE); \
            *(u32x2*)(dp_ + (size_t)n * kd_ + 8 * c) = o; } \
        LDS_WAIT(); asm volatile("" ::: "memory"); }
    float tva[32], tvb[32]; const float* spa = nullptr; const float* spb = nullptr; unsigned char* dpa = nullptr; unsigned char* dpb = nullptr; int lda = 0, ldb = 0, kda = 0, kdb = 0;
    const int step = nparts * NGW; int it = gw + part * NGW;
    if (it < NIT) { CV_DECODE(it, spa, lda, dpa, kda) CV_LOAD(tva, spa, lda) }
    for (; it < NIT; it += 2 * step) {
        const bool hb = it + step < NIT, ha = it + 2 * step < NIT;
        if (hb) { CV_DECODE(it + step, spb, ldb, dpb, kdb) CV_LOAD(tvb, spb, ldb) }
        CV_FINISH(tva, dpa, kda)
        if (ha) { CV_DECODE(it + 2 * step, spa, lda, dpa, kda) CV_LOAD(tva, spa, lda) }
        if (hb) CV_FINISH(tvb, dpb, kdb)
    }
#undef CV_DECODE
#undef CV_LOAD
#undef CV_FINISH
}

__device__ __forceinline__ void phase_topk(const Frame& F, const Args& a) {
    LAS int* hist = (LAS int*)F.lds;
    for (int i = F.tid; i < 8 * 256; i += NTHR) hist[i] = 0;
    __syncthreads();
    const int w = F.vcu, lane = F.lane;
    const float* logits = (const float*)(F.ws + WS_LOGITS); u16* tok_e = (u16*)(F.ws + WS_TOKE); u16* tok_r = (u16*)(F.ws + WS_TOKR); float* tok_g = (float*)(F.ws + WS_TOKG);
    const f32x4 bs = *(const f32x4*)(a.in[12] + 4 * lane);
    constexpr int TB = 4;
    for (int i0 = 0; i0 < 32; i0 += TB) {
        float s0[TB], s1[TB], s2[TB], s3[TB], v0[TB], v1[TB], v2[TB], v3[TB], my_s[TB]; int my_e[TB];
        const float NINF = -__builtin_inff();
        { float b0[TB], b1[TB], b2[TB], b3[TB], m1[TB], m2[TB], gs[TB]; int rank[TB];
#pragma unroll
          for (int u = 0; u < TB; ++u) { const int t = w * 256 + F.wave * 32 + i0 + u; const f32x4 lg = *(const f32x4*)(logits + (size_t)t * 256 + 4 * lane);
              s0[u] = sigmoidf_(lg[0]); s1[u] = sigmoidf_(lg[1]); s2[u] = sigmoidf_(lg[2]); s3[u] = sigmoidf_(lg[3]);
              b0[u] = s0[u] + bs[0]; b1[u] = s1[u] + bs[1]; b2[u] = s2[u] + bs[2]; b3[u] = s3[u] + bs[3];
              const float h01 = fmaxf(b0[u], b1[u]), l01 = fminf(b0[u], b1[u]), h23 = fmaxf(b2[u], b3[u]), l23 = fminf(b2[u], b3[u]);
              m1[u] = fmaxf(h01, h23); m2[u] = fmaxf(fminf(h01, h23), fmaxf(l01, l23)); }
#define TOP2_STEP(CTRL) _Pragma("unroll") for (int u = 0; u < TB; ++u) { const float p1 = dpp_f<CTRL>(m1[u]), p2 = dpp_f<CTRL>(m2[u]); const float n1 = fmaxf(m1[u], p1), n2 = fmaxf(fminf(m1[u], p1), fmaxf(m2[u], p2)); m1[u] = n1; m2[u] = n2; }
          TOP2_STEP(0xB1) TOP2_STEP(0x4E) TOP2_STEP(0x141)
#undef TOP2_STEP
          const int mygroup = lane >> 3;
#pragma unroll
          for (int u = 0; u < TB; ++u) { gs[u] = m1[u] + m2[u]; rank[u] = 0; }
#pragma unroll
          for (int j = 0; j < 8; ++j)
#pragma unroll
              for (int u = 0; u < TB; ++u) { const float gj = rdlane_f(gs[u], 8 * j); rank[u] += (gj > gs[u] || (gj == gs[u] && j < mygroup)) ? 1 : 0; }
#pragma unroll
          for (int u = 0; u < TB; ++u) { const bool sel = rank[u] < 4; v0[u] = sel ? b0[u] : NINF; v1[u] = sel ? b1[u] : NINF; v2[u] = sel ? b2[u] : NINF; v3[u] = sel ? b3[u] : NINF; my_e[u] = 0; my_s[u] = 0.f; } }
#pragma unroll
        for (int k = 0; k < 8; ++k) {
            float bv[TB]; int bi[TB];
#pragma unroll
            for (int u = 0; u < TB; ++u) { bv[u] = v0[u]; bi[u] = 4 * lane;
                if (v1[u] > bv[u]) { bv[u] = v1[u]; bi[u] = 4 * lane + 1; }
                if (v2[u] > bv[u]) { bv[u] = v2[u]; bi[u] = 4 * lane + 2; }
                if (v3[u] > bv[u]) { bv[u] = v3[u]; bi[u] = 4 * lane + 3; } }
#define AMX_STEP(CTRL) _Pragma("unroll") for (int u = 0; u < TB; ++u) { const float ov = dpp_f<CTRL>(bv[u]); const int oi = dpp_i<CTRL>(bi[u]); if (ov > bv[u] || (ov == bv[u] && oi < bi[u])) { bv[u] = ov; bi[u] = oi; } }
            AMX_STEP(0xB1) AMX_STEP(0x4E) AMX_STEP(0x141) AMX_STEP(0x140)
#undef AMX_STEP
#pragma unroll
            for (int u = 0; u < TB; ++u) { float fv = rdlane_f(bv[u], 0); int fi = __builtin_amdgcn_readlane(bi[u], 0);
#pragma unroll
                for (int rw = 1; rw < 4; ++rw) { const float ov = rdlane_f(bv[u], 16 * rw); const int oi = __builtin_amdgcn_readlane(bi[u], 16 * rw); if (ov > fv || (ov == fv && oi < fi)) { fv = ov; fi = oi; } }
                bv[u] = fv; bi[u] = fi; }
#pragma unroll
            for (int u = 0; u < TB; ++u) { const int owner = bi[u] >> 2, wi = bi[u] & 3;
                const float cand = wi == 0 ? s0[u] : wi == 1 ? s1[u] : wi == 2 ? s2[u] : s3[u];
                const float sk = rdlane_f(cand, owner);
                if (lane == owner) { if (wi == 0) v0[u] = NINF; else if (wi == 1) v1[u] = NINF; else if (wi == 2) v2[u] = NINF; else v3[u] = NINF; }
                if (lane == k) { my_e[u] = bi[u]; my_s[u] = sk; } }
        }
#pragma unroll
        for (int u = 0; u < TB; ++u) { const int t = w * 256 + F.wave * 32 + i0 + u;
            float sum = (lane < 8) ? my_s[u] : 0.f; sum += dpp_f<0xB1>(sum); sum += dpp_f<0x4E>(sum); sum += dpp_f<0x141>(sum);
            if (lane < 8) { const int rk = hist[F.wave * 256 + my_e[u]]; hist[F.wave * 256 + my_e[u]] = rk + 1; tok_e[(size_t)t * 8 + lane] = (u16)my_e[u]; tok_r[(size_t)t * 8 + lane] = (u16)rk; tok_g[(size_t)t * 8 + lane] = my_s[u] / sum * 2.5f; } }
    }
    __syncthreads();
    if (F.tid < 256) { int run = 0;
#pragma unroll
        for (int wv = 0; wv < 8; ++wv) { const int h = hist[wv * 256 + F.tid]; hist[wv * 256 + F.tid] = run; run += h; }
        ((int*)(F.ws + WS_HIST))[w * 256 + F.tid] = run; }
    __syncthreads();
    for (int i = 0; i < 32; ++i) { const int t = w * 256 + F.wave * 32 + i; if (lane < 8) { const int e = tok_e[(size_t)t * 8 + lane]; tok_r[(size_t)t * 8 + lane] = (u16)(tok_r[(size_t)t * 8 + lane] + hist[F.wave * 256 + e]); } }
    __syncthreads();
}

__device__ __forceinline__ void phase_sort(const Frame& F) {
    LAS int* start = (LAS int*)F.lds; LAS int* base = start + 260; LAS int* tot = base + 260; LAS int* pad = tot + 260; LAS int* dbase = pad + 260;
    const int w = F.vcu, qd = w / WPC, wl = w % WPC, tid = F.tid;
    const int* hist = (const int*)(F.ws + WS_HIST);
    int mytot = 0, mypre = 0;
    if (tid < 256) {
        for (int w2 = qd * WPC; w2 < qd * WPC + WPC; ++w2) { const int h = hist[w2 * 256 + tid]; mytot += h; mypre += (w2 < w) ? h : 0; }
        tot[tid] = mytot; pad[tid] = (mytot + 255) & ~255;
    }
    __syncthreads();
    if (tid == 0) { int s = 0, d = 0; for (int e = 0; e < 256; ++e) { start[e] = s; s += pad[e]; dbase[e] = d; d += tot[e]; } start[256] = s; }
    __syncthreads();
    if (tid < 256) { base[tid] = start[tid] + mypre; dbase[tid] += mypre; }
    __syncthreads();
    int* stok = (int*)(F.ws + WS_STOK) + (size_t)qd * QTILES * 256; float* sgate = (float*)(F.ws + WS_SGATE) + (size_t)qd * QTILES * 256; int* sdst = (int*)(F.ws + WS_SDST) + (size_t)qd * QTILES * 256;
    int* tile_e = (int*)(F.ws + WS_TILEE) + qd * QTILES;
    const u16* tok_e = (const u16*)(F.ws + WS_TOKE); const u16* tok_r = (const u16*)(F.ws + WS_TOKR); const float* tok_g = (const float*)(F.ws + WS_TOKG);
    for (int aidx = tid; aidx < 2048; aidx += NTHR) {
        const int t = w * 256 + (aidx >> 3), k = aidx & 7; const int e = tok_e[(size_t)t * 8 + k], rk = tok_r[(size_t)t * 8 + k];
        const int slot = base[e] + rk, dn = dbase[e] + rk; stok[slot] = t; sgate[slot] = tok_g[(size_t)t * 8 + k]; sdst[slot] = dn; ((int*)(F.ws + WS_TOKD))[(size_t)t * 8 + k] = dn;
    }
    const int ssh = start[256];
    if (tid < 256) { const int t = w * 256 + tid; const int slot = ssh + (t - qd * TQ); stok[slot] = t; sgate[slot] = 1.0f; sdst[slot] = TQ * 8 + (t - qd * TQ); }
    if (tid < 256 && (tid % WPC) == wl) {
        const int e = tid; const int s0 = start[e], n = tot[e], np = pad[e];
        for (int j = n; j < np; ++j) { stok[s0 + j] = qd * TQ; sgate[s0 + j] = 0.f; sdst[s0 + j] = TQ * NSLOT; }
        for (int tl = s0 >> 8; tl < (s0 + np) >> 8; ++tl) tile_e[tl] = e;
    }
    if (wl == 0 && tid < TQ / 256) tile_e[(ssh >> 8) + tid] = 256;
    if (wl == 0 && tid == 0) ((int*)(F.ws + WS_NTILES))[qd] = (ssh >> 8) + TQ / 256;
    __syncthreads();
}


constexpr int DN_ROWP = 80, DN_PLANE = 256 * DN_ROWP;
__device__ __forceinline__ void moe_down_phase(const Frame& F, int qd) {
    unsigned char* ws = F.ws; LAS unsigned char* L = F.lds; const int tid = F.tid, lane = F.lane, wave = F.wave, i16 = lane & 15, q = lane >> 4;
    const int ntiles = __builtin_amdgcn_readfirstlane(((const int*)(ws + WS_NTILES))[qd]);
    const int* tile_e = (const int*)(ws + WS_TILEE) + qd * QTILES;
    LAS int* estart = (LAS int*)(L + 4 * DN_PLANE);
    LAS int* te = estart + 512;
    for (int i = tid; i < ntiles; i += NTHR) te[i] = tile_e[i];
    __syncthreads();
    if (tid < 258) { int lo = 0, hi = ntiles; while (lo < hi) { const int mid = (lo + hi) >> 1; if (te[mid] < tid) lo = mid + 1; else hi = mid; } estart[tid] = lo; }
    __syncthreads();
    const long U = (long)ntiles * 4; const int u0 = (int)((long)F.vcu * U / F.G), u1 = (int)((long)(F.vcu + 1) * U / F.G);
    const unsigned char* H8 = ws + WS_H; const unsigned char* WD8 = ws + WS_WD; unsigned char* YS = ws + WS_YS;
    const int* sdst = (const int*)(ws + WS_SDST) + (size_t)qd * QTILES * 256; const float* sgate = (const float*)(ws + WS_SGATE) + (size_t)qd * QTILES * 256;
    int sc1; asm volatile("v_mov_b32 %0, 0x7f7f7f7f" : "=v"(sc1));
    int cur_key = -1, e = 0;
#define DN_DECODE(u_, e_, pn_, tile_) { while (4 * estart[e_ + 1] <= (u_)) ++e_; const int ts_ = estart[e_], nte_ = estart[e_ + 1] - ts_, r_ = (u_) - 4 * ts_; pn_ = r_ / nte_; tile_ = ts_ + r_ % nte_; }
#define DN_LOADA(dst, tile_) { const size_t row0_ = (size_t)(tile_) * 256 + wave * 32; \
        _Pragma("unroll") for (int rg = 0; rg < 2; ++rg) { _Pragma("unroll") for (int ks = 0; ks < 2; ++ks) { const unsigned char* ap = H8 + (row0_ + 16 * rg + i16) * 256 + 128 * ks + 32 * q; const i32x4 lo = *(const i32x4*)ap, hi = *(const i32x4*)(ap + 16); dst[rg][ks] = __builtin_shufflevector(lo, hi, 0, 1, 2, 3, 4, 5, 6, 7); } \
            } }
#define DN_LOADN(tile_) { const size_t row0_ = (size_t)(tile_) * 256 + wave * 32; \
        _Pragma("unroll") for (int rg = 0; rg < 2; ++rg) { _Pragma("unroll") for (int ks = 0; ks < 2; ++ks) { const unsigned char* ap = H8 + (row0_ + 16 * rg + i16) * 256 + 128 * ks + 32 * q; \
            asm volatile("global_load_dwordx4 %0, %2, off\n\tglobal_load_dwordx4 %1, %2, off offset:16" : "=&v"(nl[rg][ks]), "=&v"(nh[rg][ks]) : "v"(ap) : "memory"); } \
            { const size_t rr_ = row0_ + 16 * rg + i16; const int* dp_ = sdst + rr_; const float* gp_ = sgate + rr_; \
              asm volatile("global_load_dword %0, %2, off\n\tglobal_load_dword %1, %3, off" : "=&v"(ndd[rg]), "=&v"(ngg[rg]) : "v"(dp_), "v"(gp_) : "memory"); } } }
    i32x8 af[2][2]; i32x4 nl[2][2] = {}, nh[2][2] = {}; unsigned ndd[2] = {0u, 0u}; float ngg[2] = {0.f, 0.f};
    unsigned dd[2] = {0u, 0u}; float gg[2] = {0.f, 0.f};
    int pn = 0, tile = 0, en = 0, pnn = 0, tilen = 0;
    if (u0 < u1) { DN_DECODE(u0, e, pn, tile) DN_LOADA(af, tile) en = e;
#pragma unroll
        for (int rg = 0; rg < 2; ++rg) { const size_t rr = (size_t)tile * 256 + wave * 32 + 16 * rg + i16; dd[rg] = (unsigned)sdst[rr]; gg[rg] = sgate[rr] * (Y8_SCALE / (W8_SCALE * H8_SCALE)); }
        asm volatile("" : "+v"(af[0][0]), "+v"(af[0][1]), "+v"(af[1][0]), "+v"(af[1][1]), "+v"(dd[0]), "+v"(dd[1]), "+v"(gg[0]), "+v"(gg[1]));
    }
    for (int u = u0; u < u1; ++u) {
        const int key = e * 4 + pn;
        if (key != cur_key) {
            __syncthreads();
            const unsigned char* src = WD8 + ((size_t)e * 1024 + (size_t)pn * 256) * 256;
#pragma unroll
            for (int j = 0; j < 8; ++j) { const int p = tid + NTHR * j, rho = p >> 4, c = p & 15; const int n = (rho & ~63) + 16 * ((rho & 15) >> 2) + 4 * ((rho >> 4) & 3) + (rho & 3);
                *(LAS u32x4*)(L + ((c >> 1) & 3) * DN_PLANE + rho * DN_ROWP + (c >> 3) * 32 + (c & 1) * 16) = *(const u32x4*)(src + (size_t)n * 256 + 16 * c); }
            __syncthreads();
            cur_key = key;
        }
        const bool more = u + 1 < u1;
        if (more) { DN_DECODE(u + 1, en, pnn, tilen) DN_LOADN(tilen) }
        int vb = q * DN_PLANE + i16 * DN_ROWP; asm volatile("" : "+v"(vb));
        unsigned char* yp0 = YS + (size_t)dd[0] * D + pn * 256 + 16 * q; unsigned char* yp1 = YS + (size_t)dd[1] * D + pn * 256 + 16 * q; const float g0 = gg[0], g1 = gg[1];
#define DN_LDB(s_) ({ const LAS unsigned char* bp_ = L + vb + ((s_) >> 1) * (16 * DN_ROWP) + ((s_) & 1) * 32; const i32x4 lo_ = *(const LAS i32x4*)bp_, hi_ = *(const LAS i32x4*)(bp_ + 16); __builtin_shufflevector(lo_, hi_, 0, 1, 2, 3, 4, 5, 6, 7); })
        i32x8 bq[3]; bq[0] = DN_LDB(0); bq[1] = DN_LDB(1);
#pragma unroll
        for (int hb = 0; hb < 2; ++hb) {
            f32x4 acc[2][8];
#pragma unroll
            for (int rg = 0; rg < 2; ++rg)
#pragma unroll
                for (int ng = 0; ng < 8; ++ng) acc[rg][ng] = (f32x4){0.f, 0.f, 0.f, 0.f};
#pragma unroll
            for (int s2 = 0; s2 < 16; ++s2) { const int st = 16 * hb + s2;
                if (st + 2 < 32) bq[(st + 2) % 3] = DN_LDB(st + 2);
#pragma unroll
                for (int rg = 0; rg < 2; ++rg) acc[rg][s2 >> 1] = __builtin_amdgcn_mfma_scale_f32_16x16x128_f8f6f4(bq[st % 3], af[rg][st & 1], acc[rg][s2 >> 1], 0, 0, 0, sc1, 0, sc1);
                __builtin_amdgcn_sched_barrier(0);
            }
            if (hb == 1) {
                asm volatile("s_waitcnt vmcnt(0)" : "+v"(nl[0][0]), "+v"(nl[0][1]), "+v"(nl[1][0]), "+v"(nl[1][1]), "+v"(nh[0][0]), "+v"(nh[0][1]), "+v"(nh[1][0]), "+v"(nh[1][1]), "+v"(ndd[0]), "+v"(ndd[1]), "+v"(ngg[0]), "+v"(ngg[1]) :: "memory");
                dd[0] = ndd[0]; dd[1] = ndd[1]; gg[0] = ngg[0] * (Y8_SCALE / (W8_SCALE * H8_SCALE)); gg[1] = ngg[1] * (Y8_SCALE / (W8_SCALE * H8_SCALE));
#pragma unroll
                for (int rg = 0; rg < 2; ++rg) { af[rg][0] = __builtin_shufflevector(nl[rg][0], nh[rg][0], 0, 1, 2, 3, 4, 5, 6, 7); af[rg][1] = __builtin_shufflevector(nl[rg][1], nh[rg][1], 0, 1, 2, 3, 4, 5, 6, 7); }
            }
#pragma unroll
            for (int rg = 0; rg < 2; ++rg) { unsigned char* yp = (rg ? yp1 : yp0) + 128 * hb; const float g = rg ? g1 : g0;
#pragma unroll
                for (int cb = 0; cb < 2; ++cb) { u32x4 w;
#pragma unroll
                    for (int k = 0; k < 4; ++k) { const f32x4 v = acc[rg][4 * cb + k] * g; w[k] = pk_fp8x4(v[0], v[1], v[2], v[3]); }
                    *(u32x4*)(yp + 64 * cb) = w; } }
        }
#undef DN_LDB
        e = en; pn = pnn; tile = tilen;
    }
#undef DN_DECODE
#undef DN_LOADA
#undef DN_LOADN
    __syncthreads();
}

__device__ __forceinline__ void phase_moe_combine(const Frame& F, const Args& a, int qd) {
    const int gw = F.vcu * NWAVES + F.wave, NGW = F.G * NWAVES, lane = F.lane;
    const u16* X1B = (const u16*)(F.ws + WS_XB) + (size_t)qd * TQ * D; const unsigned char* YS = F.ws + WS_YS; u16* X2B = (u16*)(F.ws + WS_X2B) + (size_t)qd * TQ * D;
    typedef float f32x2v __attribute__((ext_vector_type(2)));
    constexpr int NT = 2;
    f32x4 gq[4], bq[4];
#pragma unroll
    for (int k = 0; k < 4; ++k) { gq[k] = *(const f32x4*)(a.in[19] + 16 * lane + 4 * k); bq[k] = *(const f32x4*)(a.in[20] + 16 * lane + 4 * k); }
    for (int tl0 = gw; tl0 < TQ; tl0 += NT * NGW) {
        int mydn[NT]; u32x4 yy[NT][NSLOT], xx[NT][2];
#pragma unroll
        for (int t = 0; t < NT; ++t) { const int tl = tl0 + t * NGW; mydn[t] = (lane < 8) ? ((const int*)(F.ws + WS_TOKD))[((size_t)qd * TQ + tl) * 8 + lane] : 0; }
#pragma unroll
        for (int t = 0; t < NT; ++t) { const int tl = tl0 + t * NGW;
#pragma unroll
            for (int c = 0; c < 2; ++c) xx[t][c] = *(const u32x4*)(X1B + (size_t)tl * D + 16 * lane + 8 * c);
#pragma unroll
            for (int k = 0; k < NSLOT; ++k) { const int dn = (k < 8) ? __builtin_amdgcn_readlane(mydn[t], k) : TQ * 8 + tl; yy[t][k] = *(const u32x4*)(YS + (size_t)dn * D + 16 * lane); } }
        __builtin_amdgcn_sched_barrier(0);
#pragma unroll
        for (int t = 0; t < NT; ++t) { const int tl = tl0 + t * NGW;
            float v[16];
#pragma unroll
            for (int c = 0; c < 2; ++c) { const u32x4 x = xx[t][c];
                v[8 * c + 0] = ALPHA * bf_lo(x.x); v[8 * c + 1] = ALPHA * bf_hi(x.x); v[8 * c + 2] = ALPHA * bf_lo(x.y); v[8 * c + 3] = ALPHA * bf_hi(x.y); v[8 * c + 4] = ALPHA * bf_lo(x.z); v[8 * c + 5] = ALPHA * bf_hi(x.z); v[8 * c + 6] = ALPHA * bf_lo(x.w); v[8 * c + 7] = ALPHA * bf_hi(x.w); }
            float ys[16];
#pragma unroll
            for (int j = 0; j < 16; ++j) ys[j] = 0.f;
#pragma unroll
            for (int k = 0; k < NSLOT; ++k)
#pragma unroll
                for (int q = 0; q < 4; ++q) { const int wv = (int)yy[t][k][q]; const f32x2v lo = __builtin_amdgcn_cvt_pk_f32_fp8(wv, false), hi = __builtin_amdgcn_cvt_pk_f32_fp8(wv, true);
                    ys[4 * q + 0] += lo.x; ys[4 * q + 1] += lo.y; ys[4 * q + 2] += hi.x; ys[4 * q + 3] += hi.y; }
#pragma unroll
            for (int j = 0; j < 16; ++j) v[j] += ys[j] * (1.0f / Y8_SCALE);
            float s = 0.f;
#pragma unroll
            for (int j = 0; j < 16; ++j) s += v[j];
            const float mean = wave_sum(s) * (1.f / D); float s2 = 0.f;
#pragma unroll
            for (int j = 0; j < 16; ++j) { v[j] -= mean; s2 += v[j] * v[j]; }
            const float rstd = 1.f / sqrtf(wave_sum(s2) * (1.f / D) + LN_EPS);
            u32x4 w8;
#pragma unroll
            for (int c = 0; c < 2; ++c) { const int col = 16 * lane + 8 * c; const f32x4 g0 = gq[2 * c], g1 = gq[2 * c + 1], b0 = bq[2 * c], b1 = bq[2 * c + 1];
                u32x4 w; w.x = cvt_pk_bf16(v[8 * c + 0] * rstd * g0[0] + b0[0], v[8 * c + 1] * rstd * g0[1] + b0[1]); w.y = cvt_pk_bf16(v[8 * c + 2] * rstd * g0[2] + b0[2], v[8 * c + 3] * rstd * g0[3] + b0[3]);
                w.z = cvt_pk_bf16(v[8 * c + 4] * rstd * g1[0] + b1[0], v[8 * c + 5] * rstd * g1[1] + b1[1]); w.w = cvt_pk_bf16(v[8 * c + 6] * rstd * g1[2] + b1[2], v[8 * c + 7] * rstd * g1[3] + b1[3]);
                *(u32x4*)(X2B + (size_t)tl * D + col) = w;
                w8[2 * c] = pk_fp8x4(bf_lo(w.x), bf_hi(w.x), bf_lo(w.y), bf_hi(w.y)); w8[2 * c + 1] = pk_fp8x4(bf_lo(w.z), bf_hi(w.z), bf_lo(w.w), bf_hi(w.w)); }
            *(u32x4*)(F.ws + WS_X2F8 + ((size_t)qd * TQ + tl) * D + 16 * lane) = w8;
        }
    }
}

constexpr int LDS_BYTES = 163840;
static_assert(pg8::LDS_ROWIDX + pg8::LDS_ROWSLOTS * 1024 <= LDS_BYTES && (QTILES * 2 + 255) / 256 <= pg8::LDS_ROWSLOTS, "LDS side tables");
constexpr int MISC_OFF = 131072 + 4096;
constexpr int PH_FIXED = 11, PH_PER_Q = 2, PH_TAIL0 = PH_FIXED + NQ * PH_PER_Q, NPHASE = PH_TAIL0 + 2;

__global__ void __launch_bounds__(NTHR, 2) fwd_kernel(Args args) {
    extern __shared__ __attribute__((aligned(16))) unsigned char lds_raw[];
#define MKFRAME() Frame F; { int t_ = threadIdx.x; asm volatile("" : "+v"(t_)); F.lds = (LAS unsigned char*)lds_raw; F.tid = t_; F.lane = t_ & 63; F.wave = __builtin_amdgcn_readfirstlane(t_ >> 6); \
        F.G = gridDim.x; const int bx_ = blockIdx.x; F.vcu = (F.G % 8 == 0) ? (bx_ % 8) * (F.G / 8) + bx_ / 8 : bx_; size_t z_ = 0; asm volatile("" : "+s"(z_)); F.ws = args.ws + z_;     F.dout = (unsigned char*)args.out; }
    LAS unsigned char* const lds0 = (LAS unsigned char*)lds_raw;
    volatile LAS unsigned* MISC = (volatile LAS unsigned*)(lds0 + MISC_OFF);
    if (threadIdx.x < 64) MISC[threadIdx.x] = 0u;
    __syncthreads();
    unsigned* barw = (unsigned*)(args.ws + WS_CTL) + CW_BAR;
    const int lo = args.lo, hi = args.hi;
    XcdBarrier bar; bar.bar = barw; bar.x = 0; bar.st = nullptr;
    if (hi - lo > 1) bar = xcd_barrier_post(barw, MISC + 8);
#ifndef PHASE_MASK
#define PHASE_MASK 0xFFFFFFFFu
#endif
#define IN(k) (((PHASE_MASK >> (k)) & 1u) && lo <= (k) && (k) < hi)
#define INQ(j) (((PHASE_MASK >> (PH_FIXED + (j))) & 1u) && lo <= (pb + (j)) && (pb + (j)) < hi)
#define SEAMQ(j) do { if (lo <= (pb + (j)) && (pb + (j)) + 1 < hi) xcd_barrier(bar); STAMP(pb + (j) + 1); } while (0)
#if DBG_TIME
#define STAMP(i) do { if (blockIdx.x == 0 && threadIdx.x == 0) ((unsigned long long*)(args.ws + WS_CTL + 60 * 1024))[i] = __builtin_amdgcn_s_memrealtime(); } while (0)
#else
#define STAMP(i) do { } while (0)
#endif
    STAMP(0);
#define SEAM(k) do { if (lo <= (k) && (k) + 1 < hi) xcd_barrier(bar); STAMP((k) + 1); } while (0)
    const int G = gridDim.x, c = (int)blockIdx.x;
    const bool wg_odd_t = (blockIdx.x & 1) != 0  ;

    if (IN(0)) { MKFRAME(); phase_prologue(F, args); }
    SEAM(0);
    if (IN(1)) {
        MKFRAME(); unsigned char* ws = F.ws;
        pg8::DenseOrder S; S.init(ws + WS_XB, ws + WS_WIN, T, NCOL, 512, G, c);
        pg8::EpiZ E{ws, (const float*)(ws + WS_ROT), (const float*)(ws + WS_LB), 1.0f / W8_SCALE};
        for (int rep = 0; rep < DUPN(7); ++rep) pg8::gemm_phase<false, 2>(F.lds, 512, S, E);
    }
    SEAM(1);
    if (IN(2)) {
        MKFRAME();
#ifndef NO_HGRN
#if USE_NAIVE_HGRN
        for (int it = F.vcu; it < 256; it += G) hgrn_item(F, it);
#else
        for (int it = F.vcu; it < 256; it += G) hgrn_mfma_item(F, it, (u16*)(F.dout + DO_OF), (u16*)(F.dout + DO_OB));
#if DBG_CHECK
        for (int it = F.vcu; it < 256; it += G) hgrn_item(F, it);
#endif
#endif
#endif
        STAMP(40);
#if USE_NAIVE_ATTN
        attn_naive(F);
#else
        for (int rep2 = 0; rep2 < DUPN(15); ++rep2) attn_mfma(F);
#endif
    }
    SEAM(2);
    if (IN(3)) { MKFRAME(); for (int rep = 0; rep < DUPN(8); ++rep) phase_hg_combine(F, args); }
    SEAM(3);
    if (IN(4)) {
        MKFRAME(); unsigned char* ws = F.ws;
        pg8::DenseOrder S; S.init(ws + WS_YH, ws + WS_WBH, T, D, 256, G, c);
        pg8::EpiGated<false> E{(const u16*)(ws + Z_GTH), (u16*)(F.dout + DO_MERGED), nullptr, D};
        pg8::gemm_phase<false, 2, false>(F.lds, 256, S, E);
    }
    SEAM(4);
    if (IN(5) && !DBG_SKIP_YA) {
        MKFRAME(); unsigned char* ws = F.ws;
        pg8::DenseOrder S; S.init(ws + WS_YA, ws + WS_WBA, T, D, 128, G, c);
        pg8::EpiGated<true> E{(const u16*)(ws + Z_GTA), (u16*)(F.dout + DO_MERGED), F.dout + DO_MERGED8, D};
        pg8::gemm_phase<true, 2, false>(F.lds, 128, S, E);
    }
    SEAM(5);
    if (IN(6)) {
        MKFRAME(); unsigned char* ws = F.ws;
        pg8::DenseOrder S; S.init(F.dout + DO_MERGED8, ws + WS_WO, T, D, 512, G, c);
        pg8::EpiBf16Res E{args.in[0], (u16*)(ws + WS_X1PRE), D, ALPHA, 1.0f / (W8_SCALE * M8_SCALE)};
        pg8::gemm_phase<false, 2>(F.lds, 512, S, E);
    }
    SEAM(6);
    if (IN(7)) { MKFRAME(); phase_ln1_convert<true, false>(F, args); }
    SEAM(7);
    if (IN(8) && !wg_odd_t) { { MKFRAME(); phase_ln1_convert<false, true>(F, args, 0, 3); } VM_WAIT(); __syncthreads(); }
    if (IN(8)) {
        MKFRAME(); unsigned char* ws = F.ws;
        pg8::DenseOrder S; S.init(ws + WS_XB, ws + WS_WR, T, 256, 1024, G, c);
        pg8::EpiF32Res E{(float*)(ws + WS_LOGITS), nullptr, nullptr, 256, 0.f, 1.f};
        for (int rep = 0; rep < DUPN(11); ++rep) pg8::gemm_phase(F.lds, 1024, S, E);
    }
    if (IN(8) && wg_odd_t) { VM_WAIT(); __syncthreads(); MKFRAME(); phase_ln1_convert<false, true>(F, args, 0, 3); }
    SEAM(8);
    if (IN(9) && !wg_odd_t) { { MKFRAME(); phase_ln1_convert<false, true>(F, args, 1, 3); } VM_WAIT(); __syncthreads(); }
    if (IN(9)) { MKFRAME(); phase_topk(F, args); }
    if (IN(9) && wg_odd_t) { VM_WAIT(); __syncthreads(); MKFRAME(); phase_ln1_convert<false, true>(F, args, 1, 3); }
    SEAM(9);
    if (IN(10) && !wg_odd_t) { { MKFRAME(); phase_ln1_convert<false, true>(F, args, 2, 3); } VM_WAIT(); __syncthreads(); }
    if (IN(10)) { MKFRAME(); phase_sort(F); }
    if (IN(10) && wg_odd_t) { VM_WAIT(); __syncthreads(); MKFRAME(); phase_ln1_convert<false, true>(F, args, 2, 3); }
    SEAM(10);
    for (int qd = 0; qd < NQ; ++qd) {
        const int pb = PH_FIXED + qd * PH_PER_Q;
        const size_t lo_off = (size_t)qd * QTILES * 256;
        const bool wg_odd = (blockIdx.x & 1) != 0  ;
        if (INQ(0) && qd > 0 && !wg_odd) { MKFRAME(); phase_moe_combine(F, args, qd - 1); }
        if (INQ(0)) {
            MKFRAME(); unsigned char* ws = F.ws;
            const int ntiles = __builtin_amdgcn_readfirstlane(((const int*)(ws + WS_NTILES))[qd]);
            pg8::MoeOrder<2, true> S; S.A = (const char*)(ws + WS_X1F8); S.W = (const char*)(ws + WS_WGU); S.lds = F.lds; S.slot_tok = (const int*)(ws + WS_STOK) + lo_off; S.sdst = nullptr; S.sgate = nullptr;
            S.ntiles = ntiles; S.G = G; S.vc = F.vcu; S.K = 512; S.wstride_e = (size_t)512 * 1024; S.wstride_pn = (size_t)256 * 1024;
            S.load_table((const int*)(ws + WS_TILEE) + qd * QTILES, F.tid);
            pg8::EpiSwiglu E{ws + WS_H};
            for (int rep = 0; rep < DUPN(0); ++rep) pg8::gemm_phase<false, 2>(F.lds, 512, S, E);
        }
        if (INQ(0) && qd > 0 && wg_odd) { __syncthreads(); MKFRAME(); phase_moe_combine(F, args, qd - 1); }
        SEAMQ(0);
        if (INQ(1)) { MKFRAME(); moe_down_phase(F, qd); }
        SEAMQ(1);
    }
    if (IN(PH_TAIL0) && !wg_odd_t) { MKFRAME(); phase_moe_combine(F, args, NQ - 1); }
    if (IN(PH_TAIL0)) {
        { MKFRAME(); unsigned char* ws = F.ws; const int pm = F.vcu;
          const f32x4* p4 = (const f32x4*)(args.in[1] + (size_t)pm * 256 * 256); u32x4* o4 = (u32x4*)(ws + WS_PB + (size_t)pm * 256 * 256 * 2);
          for (int i = F.tid; i < 256 * 256 / 8; i += NTHR) { const f32x4 p = p4[2 * i], q = p4[2 * i + 1]; u32x4 w; w.x = cvt_pk_bf16(p[0], p[1]); w.y = cvt_pk_bf16(p[2], p[3]); w.z = cvt_pk_bf16(q[0], q[1]); w.w = cvt_pk_bf16(q[2], q[3]); o4[i] = w; } }
        VM_WAIT(); __syncthreads(); __builtin_amdgcn_fence(__ATOMIC_ACQUIRE, "agent"); VM_WAIT();
        { MKFRAME(); unsigned char* ws = F.ws; pg8::PanelOrder S; S.A = (const char*)(ws + WS_PB); S.Bt = (const char*)(ws + WS_WPP); S.pm = F.vcu; S.nN = 4; S.K = 256;
          pg8::EpiBf16 E{(u16*)(ws + WS_P2), D};
          pg8::gemm_phase<true>(F.lds, 256, S, E); }
        VM_WAIT(); __syncthreads();
    }
    if (IN(PH_TAIL0) && wg_odd_t) { MKFRAME(); phase_moe_combine(F, args, NQ - 1); }
    SEAM(PH_TAIL0);
    if (IN(PH_TAIL0 + 1)) {
        { MKFRAME(); unsigned char* ws = F.ws; pg8::PanelOrder S; S.A = (const char*)(ws + WS_X2F8); S.Bt = (const char*)(ws + WS_WPG); S.pm = F.vcu; S.nN = 4; S.K = 512;
          pg8::EpiPle E{(u16*)(ws + WS_X3PRE), (const u16*)(ws + WS_X2B), (const u16*)(ws + WS_P2), D, 1.0f / W8_SCALE};
          pg8::gemm_phase<false, 2>(F.lds, 512, S, E); }
        VM_WAIT(); __syncthreads(); __builtin_amdgcn_fence(__ATOMIC_ACQUIRE, "agent"); VM_WAIT();
        { MKFRAME(); unsigned char* ws = F.ws; const int pm = F.vcu;
          for (int r = F.wave; r < 256; r += 4 * NWAVES) ln_rows<false, 4, true>((const u16*)(ws + WS_X3PRE), (size_t)pm * 256 + r, (size_t)NWAVES, args.in[23], args.in[24], args.out, F.lane); }
    }
#undef IN
#undef SEAM
#undef INQ
#undef SEAMQ
}


#ifndef DBG_CHECK
#define DBG_CHECK 0
#endif
#if DBG_CHECK
constexpr int CHK_WORD0 = 12288;
struct ChkArgs { const float* in[25]; float* out; unsigned char* ws; int mode, qd; };
__device__ __forceinline__ float dotb(const u16* a, const u16* b, int K) { float s = 0.f; for (int k = 0; k < K; k += 8) { const u32x4 x = *(const u32x4*)(a + k), y = *(const u32x4*)(b + k);
    s += bf_lo(x.x) * bf_lo(y.x) + bf_hi(x.x) * bf_hi(y.x) + bf_lo(x.y) * bf_lo(y.y) + bf_hi(x.y) * bf_hi(y.y) + bf_lo(x.z) * bf_lo(y.z) + bf_hi(x.z) * bf_hi(y.z) + bf_lo(x.w) * bf_lo(y.w) + bf_hi(x.w) * bf_hi(y.w); } return s; }
__device__ __forceinline__ float sigm(float z) { return 1.f / (1.f + expf(-z)); }
__device__ __forceinline__ bool badv(float got, float ref, float rel, float ab) { return !(fabsf(got - ref) <= rel * fabsf(ref) + ab); }
__global__ void chk_kernel(ChkArgs a) {
    unsigned char* ws = a.ws; unsigned* res = (unsigned*)(ws + WS_CTL) + CHK_WORD0; const int mode = a.mode, qd = a.qd;
    const size_t gt = (size_t)blockIdx.x * blockDim.x + threadIdx.x, NGT = (size_t)gridDim.x * blockDim.x;
    const u16* XB = (const u16*)(ws + WS_XB); const u16* WIN = (const u16*)(ws + WS_WIN);
    unsigned bad = 0;
    if (mode == 1) { for (size_t i = gt; i < (size_t)T * D; i += NGT) { if (badv(bf1(XB[i]), a.in[0][i], 0.005f, 1e-6f)) ++bad; } }
    else if (mode >= 2 && mode <= 11) {
        const int ty = mode - 2; const int ncol = ty < 5 ? 512 : ty < 8 ? 768 : 1024; const int cbase = ty < 5 ? 512 * ty : ty < 8 ? 2560 + 768 * (ty - 5) : 4864 + 1024 * (ty - 8);
        const size_t zoff[10] = {Z_QH, Z_VH, Z_LFF, Z_LFB, Z_GS, Z_AQ, Z_AK, Z_AV, Z_GTH, Z_GTA}; const u16* Zt = (const u16*)(ws + zoff[ty]); const float* lb = (const float*)(ws + WS_LB); const float* rot = (const float*)(ws + WS_ROT);
        for (size_t i = gt; i < (size_t)(T / 8) * ncol; i += NGT) { const int row = (int)(i / ncol) * 8 + 3, c = (int)(i % ncol);
            float z = dotb(XB + (size_t)row * D, WIN + (size_t)(cbase + c) * D, D), ref, got = bf1(Zt[(size_t)row * ncol + c]);
            if (ty <= 4 || ty == 7 || ty == 8 || ty == 9) ref = z;
            else { const int d = c & 63; ref = z; if (d < 16) { const int cp = (d < 8) ? c + 8 : c - 8; const float zp = dotb(XB + (size_t)row * D, WIN + (size_t)(cbase + cp) * D, D); const int fi = d & 7, pos = row & (SEQ - 1); const float cs = rot[pos * 16 + fi], sn = rot[pos * 16 + 8 + fi]; ref = (d < 8) ? z * cs - zp * sn : z * cs + zp * sn; } if (ty == 5) ref *= 0.125f; }
            if (badv(got, ref, 0.02f, 0.02f)) { ++bad; if (mode == 10) { atomicAdd(res + 80 + ((c & 255) >> 2), 1u); atomicAdd(res + 160 + ((row & 255) >> 2), 1u); atomicAdd(res + 240 + ((row >> 8) & 255), 1u); if (got > 1.5f || got < -0.5f) atomicAdd(res + 500, 1u); atomicAdd(res + 600 + ((((row >> 8) & 31) >> 3) * 8 + ((row >> 6) & 1) * 4 + ((c >> 5) & 3)), 1u); } } } }
    else if (mode == 12) { const u16* Zt = (const u16*)(ws + Z_GTH); unsigned nm = 0, no = 0; for (size_t i = gt; i < (size_t)2 * T * D; i += NGT) { const u16 h = Zt[i]; if (h == 0x3C3C) ++nm; else { const float g = bf1(h); if (!(g >= 0.f && g <= 1.f)) ++no; } }
        for (int o = 32; o >= 1; o >>= 1) { nm += __shfl_xor(nm, o); no += __shfl_xor(no, o); } if ((threadIdx.x & 63) == 0) { if (nm) atomicAdd(res + 700, nm); if (no) atomicAdd(res + 701, no); } }
    else if (mode == 25) { const u16* AQ = (const u16*)(ws + Z_AQ); const u16* AK = (const u16*)(ws + Z_AK); const u16* AV = (const u16*)(ws + Z_AV); const u16* YA = (const u16*)(ws + WS_YA);
        for (size_t i = gt; i < (size_t)(T / 64) * 256; i += NGT) { const int row = (int)(i / 256) * 64 + 7, sl = (int)((i % 256) / 64), d = (int)(i % 64); const int b = row >> 11, p = row & (SEQ - 1);
            float mx = -1e30f; for (int pass = 0; pass < 2; ++pass) { float den = 0.f, o = 0.f; for (int g = 0; g < 3; ++g) { const int sh = 2 * g, mlen = SEQ >> sh, r = p & ((1 << sh) - 1), m = p >> sh, hd = g * 4 + sl; const int lo = m - 64 < 0 ? 0 : m - 64, hi = m + 64 > mlen - 1 ? mlen - 1 : m + 64;
                    for (int j = lo; j <= hi; ++j) { const size_t kr = (size_t)b * SEQ + r + ((size_t)j << sh); const float sc = dotb(AQ + (size_t)row * 768 + hd * 64, AK + kr * 768 + hd * 64, 64); if (pass == 0) mx = fmaxf(mx, sc); else { const float e = expf(sc - mx); den += e; o += e * bf1(AV[kr * 768 + hd * 64 + d]); } } }
                if (pass == 1) { if (badv(bf1(YA[(size_t)row * 256 + sl * 64 + d]), o / den, 0.03f, 0.004f)) ++bad; } } } }
    else if (mode == 26) { const u16* A0 = (const u16*)((unsigned char*)a.out + DO_OF); const u16* R0 = (const u16*)(ws + WS_XB);
        for (size_t i = gt; i < (size_t)2 * T * 512; i += NGT) { if (badv(bf1(A0[i]), bf1(R0[i]), 0.03f, 0.03f)) ++bad; } }
    else if (mode == 13) { const u16* YH = (const u16*)(ws + WS_YH); const u16* YA = (const u16*)(ws + WS_YA); const u16* GH = (const u16*)(ws + Z_GTH); const u16* GA = (const u16*)(ws + Z_GTA); const u16* M = (const u16*)((unsigned char*)a.out + DO_MERGED);
        for (size_t i = gt; i < (size_t)(T / 4) * D; i += NGT) { const int row = (int)(i / D) * 4 + 1, c = (int)(i % D);
            const float ref = sigm(bf1(GH[(size_t)row * D + c])) * dotb(YH + (size_t)row * 512, (const u16*)(ws + WS_WBH) + (size_t)c * 512, 512) + sigm(bf1(GA[(size_t)row * D + c])) * dotb(YA + (size_t)row * 256, (const u16*)(ws + WS_WBA) + (size_t)c * 256, 256);
            if (badv(bf1(M[(size_t)row * D + c]), ref, 0.02f, 0.01f)) ++bad; } }
    else if (mode == 14) { const u16* M = (const u16*)((unsigned char*)a.out + DO_MERGED); const float* X1 = (const float*)(ws + WS_X1PRE);
        for (size_t i = gt; i < (size_t)T * D; i += NGT) { const int row = (int)(i / D), c = (int)(i % D);
            const float ref = ALPHA * a.in[0][i] + dotb(M + (size_t)row * D, (const u16*)(ws + WS_WO) + (size_t)c * D, D); if (badv(X1[i], ref, 0.002f, 0.002f)) ++bad; } }
    else if (mode == 15) { const float* X1 = (const float*)(ws + WS_X1PRE);
        for (size_t row = gt; row < T; row += NGT) { float m = 0.f; for (int c = 0; c < D; ++c) m += X1[row * D + c]; m /= D; float v = 0.f; for (int c = 0; c < D; ++c) { const float d = X1[row * D + c] - m; v += d * d; } const float rs = 1.f / sqrtf(v / D + LN_EPS);
            for (int c = 0; c < D; ++c) { const float ref = (X1[row * D + c] - m) * rs * a.in[9][c] + a.in[10][c]; if (badv(bf1(XB[row * D + c]), ref, 0.01f, 0.01f)) ++bad; } } }
    else if (mode == 16) { const float* LG = (const float*)(ws + WS_LOGITS);
        for (size_t i = gt; i < (size_t)T * 256; i += NGT) { const int row = (int)(i / 256), c = (int)(i % 256); if (badv(LG[i], dotb(XB + (size_t)row * D, (const u16*)(ws + WS_WR) + (size_t)c * D, D), 0.002f, 0.002f)) ++bad; } }
    else if (mode == 17) { const float* LG = (const float*)(ws + WS_LOGITS); const u16* te = (const u16*)(ws + WS_TOKE); const float* tg = (const float*)(ws + WS_TOKG);
        for (size_t t = gt; t < T; t += NGT) { float gsc[8]; for (int g = 0; g < 8; ++g) { float m1 = -1e30f, m2 = -1e30f; for (int j = 0; j < 32; ++j) { const float b = sigm(LG[t * 256 + g * 32 + j]) + a.in[12][g * 32 + j]; if (b > m1) { m2 = m1; m1 = b; } else if (b > m2) m2 = b; } gsc[g] = m1 + m2; }
            unsigned gm = 0; for (int g = 0; g < 8; ++g) { int r = 0; for (int j = 0; j < 8; ++j) r += (gsc[j] > gsc[g] || (gsc[j] == gsc[g] && j < g)); if (r < 4) gm |= 1u << g; }
            unsigned long long taken[4] = {0, 0, 0, 0}; float ssum = 0.f; int ok = 1;
            for (int k = 0; k < 8; ++k) { float bv = -1e30f; int bi = -1; for (int e = 0; e < 256; ++e) { if (!((gm >> (e >> 5)) & 1u) || ((taken[e >> 6] >> (e & 63)) & 1ull)) continue; const float b = sigm(LG[t * 256 + e]) + a.in[12][e]; if (b > bv) { bv = b; bi = e; } }
                taken[bi >> 6] |= 1ull << (bi & 63); ssum += sigm(LG[t * 256 + bi]); if (te[t * 8 + k] != bi) ok = 0; }
            for (int k = 0; k < 8 && ok; ++k) { const float ref = sigm(LG[t * 256 + te[t * 8 + k]]) / ssum * 2.5f; if (badv(tg[t * 8 + k], ref, 0.001f, 1e-5f)) ok = 0; }
            if (!ok) ++bad; } }
    else if (mode == 18) { const int* stok = (const int*)(ws + WS_STOK) + (size_t)qd * QTILES * 256; const float* sg = (const float*)(ws + WS_SGATE) + (size_t)qd * QTILES * 256; const int* sd = (const int*)(ws + WS_SDST) + (size_t)qd * QTILES * 256; const int* tle = (const int*)(ws + WS_TILEE) + qd * QTILES;
        const int nt = ((const int*)(ws + WS_NTILES))[qd]; const u16* te = (const u16*)(ws + WS_TOKE); const float* tg = (const float*)(ws + WS_TOKG); unsigned* cnt = res + 64;
        if (nt < 64 || nt > QTILES) { if (gt == 0) ++bad; } else
        for (size_t sl = gt; sl < (size_t)nt * 256; sl += NGT) { const int d = sd[sl], tk = stok[sl], e = tle[sl >> 8]; if (d == TQ * NSLOT) { if (tk != qd * TQ || sg[sl] != 0.f) ++bad; continue; }
            if (d < 0 || d > TQ * NSLOT || tk < qd * TQ || tk >= (qd + 1) * TQ) { ++bad; continue; } const int k = d % NSLOT; if (d / NSLOT != tk - qd * TQ) { ++bad; continue; }
            if (k == 8) { if (e != 256 || sg[sl] != 1.f) ++bad; } else { if (te[(size_t)tk * 8 + k] != e || tg[(size_t)tk * 8 + k] != sg[sl]) ++bad; }
            atomicAdd(cnt, 1u); } }
    else if (mode == 19) { const int* stok = (const int*)(ws + WS_STOK) + (size_t)qd * QTILES * 256; const int* tle = (const int*)(ws + WS_TILEE) + qd * QTILES; const int nt = ((const int*)(ws + WS_NTILES))[qd]; const u16* H = (const u16*)(ws + WS_H); const u16* WGU = (const u16*)(ws + WS_WGU);
        for (size_t i = gt; i < (size_t)nt * 32 * 256; i += NGT) { const int sl = (int)(i / 256) * 8 + 5, j = (int)(i % 256); const int e = tle[sl >> 8], tk = stok[sl]; const u16* xr = XB + (size_t)tk * D;
            const u16* wg = WGU + ((size_t)e * 512 + (j >> 7) * 256 + (j & 127)) * D; const float g = dotb(xr, wg, D), u = dotb(xr, wg + (size_t)128 * D, D); if (badv(bf1(H[(size_t)sl * 256 + j]), g * sigm(g) * u, 0.03f, 0.003f)) ++bad; } }
    else if (mode == 20) { const int* sd = (const int*)(ws + WS_SDST) + (size_t)qd * QTILES * 256; const float* sg = (const float*)(ws + WS_SGATE) + (size_t)qd * QTILES * 256; const int* tle = (const int*)(ws + WS_TILEE) + qd * QTILES; const int nt = ((const int*)(ws + WS_NTILES))[qd]; const u16* H = (const u16*)(ws + WS_H); const u16* WD = (const u16*)(ws + WS_WD); const u16* YS = (const u16*)(ws + WS_YS);
        for (size_t i = gt; i < (size_t)nt * 32 * D; i += NGT) { const int sl = (int)(i / D) * 8 + 2, c = (int)(i % D); const int e = tle[sl >> 8], d = sd[sl]; if (d == TQ * NSLOT) continue;
            const float ref = sg[sl] * dotb(H + (size_t)sl * 256, WD + ((size_t)e * 1024 + c) * 256, 256); if (badv(bf1(YS[(size_t)d * D + c]), ref, 0.02f, 0.002f)) ++bad; } }
    else if (mode == 21) { const u16* PB = (const u16*)(ws + WS_PB) + (size_t)qd * TQ * 256; const u16* P2 = (const u16*)(ws + WS_P2) + (size_t)qd * TQ * D; const float* p = a.in[1] + (size_t)qd * TQ * 256;
        for (size_t i = gt; i < (size_t)TQ * D; i += NGT) { const int row = (int)(i / D), c = (int)(i % D); if (badv(bf1(P2[i]), dotb(PB + (size_t)row * 256, (const u16*)(ws + WS_WPP) + (size_t)c * 256, 256), 0.02f, 0.01f)) ++bad; if (c < 256 && badv(bf1(PB[(size_t)row * 256 + c]), p[(size_t)row * 256 + c], 0.005f, 1e-6f)) ++bad; } }
    else if (mode == 22) { const u16* X1 = XB + (size_t)qd * TQ * D; const u16* YS = (const u16*)(ws + WS_YS); const u16* X2 = (const u16*)(ws + WS_X2B) + (size_t)qd * TQ * D;
        for (size_t row = gt; row < TQ; row += NGT) { float m = 0.f, v = 0.f; for (int pass = 0; pass < 3; ++pass) { for (int c = 0; c < D; ++c) { float x = ALPHA * bf1(X1[row * D + c]); for (int k = 0; k < NSLOT; ++k) x += bf1(YS[(row * NSLOT + k) * D + c]);
                    if (pass == 0) m += x; else if (pass == 1) v += (x - m) * (x - m); else { const float ref = (x - m) * v * a.in[19][c] + a.in[20][c]; if (badv(bf1(X2[row * D + c]), ref, 0.01f, 0.01f)) ++bad; } } if (pass == 0) m /= D; else if (pass == 1) v = 1.f / sqrtf(v / D + LN_EPS); } } }
    else if (mode == 23) { const u16* X2 = (const u16*)(ws + WS_X2B); const u16* P2 = (const u16*)(ws + WS_P2); const float* O = a.out + (size_t)qd * TQ * D;
        for (size_t i = gt; i < (size_t)TQ * D; i += NGT) { const int row = (int)(i / D), c = (int)(i % D); const float ref = ALPHA * bf1(X2[i]) + sigm(dotb(X2 + (size_t)row * D, (const u16*)(ws + WS_WPG) + (size_t)c * D, D)) * bf1(P2[i]); if (badv(O[i], ref, 0.002f, 0.002f)) ++bad; } }
    else if (mode == 24) { const float* O = a.out + (size_t)qd * TQ * D;
        for (size_t row = gt; row < TQ; row += NGT) { float m = 0.f, v = 0.f; int nf = 0; for (int c = 0; c < D; ++c) { const float x = (O[row * D + c] - a.in[24][c]) / a.in[23][c]; m += x; v += x * x; nf += !(x - x == 0.f); } m /= D; v = v / D - m * m; if (nf || fabsf(m) > 1e-3f || fabsf(v - 1.f) > 1e-2f) ++bad; } }
    for (int o = 32; o >= 1; o >>= 1) bad += __shfl_xor(bad, o);
    if ((threadIdx.x & 63) == 0 && bad) atomicAdd(res + mode, bad);
}
__global__ void chk_encode(float* out, size_t n, const unsigned* res, int what) {
    unsigned code = 0;
    if (what == 0) { for (int m = 1; m < 64; ++m) if (res[m]) { code = m; break; } }
    else if (what > 0) { const unsigned b = res[what]; code = b ? 1 + (31 - __clz(b)) : 0; }
    else if (what == -1) { code = (res[64] == (unsigned)(4 * TQ * NSLOT)) ? 0 : 7; }
    else if (what == -4) { const unsigned nm = res[700], no = res[701]; code = (nm ? 1 + (31 - __clz(nm)) : 0) + (no ? 40 : 0); }
    else if (what == -2) { const int ms[6] = {11, 13, 14, 15, 16, 17}; for (int i = 0; i < 6; ++i) if (res[ms[i]]) code |= 1u << i; }
    else { const int ms[6] = {18, 19, 20, 21, 22, 23}; for (int i = 0; i < 6; ++i) if (res[ms[i]]) code |= 1u << i; if (res[24]) code += 64; if (code > 98) code = 98; }
    const float c = sqrtf((float)code);
    for (size_t i = (size_t)blockIdx.x * blockDim.x + threadIdx.x; i < n; i += (size_t)gridDim.x * blockDim.x) out[i] = c;
}
#ifndef DBG_WHAT
#define DBG_WHAT 0
#endif
#endif


#if DBG_TIME
__global__ void time_encode(float* out, size_t n, const unsigned long long* ts) {
    auto ms = [&](int a, int b) { return (float)(ts[b] - ts[a]) * 1e-5f; };
    (void)ms; unsigned code = DBG_TIME_EXPR; if (code > 98) code = 98;
    const float c = sqrtf((float)code);
    for (size_t i = (size_t)blockIdx.x * blockDim.x + threadIdx.x; i < n; i += (size_t)gridDim.x * blockDim.x) out[i] = c;
}
#endif

extern "C" void kernel_launch(void* const* d_in, const int* in_sizes, int n_in, void* d_out, int out_size, void* d_ws, size_t ws_size, hipStream_t stream) {
    static int grid = 0;
    if (grid == 0) {
        if (n_in != 25 || out_size != T * D || ws_size < WS_END) { fprintf(stderr, "kernel_launch: unexpected problem (n_in %d out %d ws %zu)\n", n_in, out_size, ws_size); grid = -1; return; }
        if (hipFuncSetAttribute((const void*)fwd_kernel, hipFuncAttributeMaxDynamicSharedMemorySize, LDS_BYTES) != hipSuccess) { fprintf(stderr, "kernel_launch: hipFuncSetAttribute failed\n"); grid = -1; return; }
        int per_cu = 0; (void)hipOccupancyMaxActiveBlocksPerMultiprocessor(&per_cu, (const void*)fwd_kernel, NTHR, LDS_BYTES); (void)hipGetLastError();
        if (per_cu < 1) fprintf(stderr, "kernel_launch: occupancy query says %d\n", per_cu);
        grid = 256;
    }
    if (grid < 0) return;
    (void)hipMemsetAsync((char*)d_ws + WS_CTL, 0, CTL_ZERO_BYTES, stream);
    Args a{};
    for (int i = 0; i < 25; ++i) a.in[i] = (const float*)d_in[i];
    a.out = (float*)d_out; a.ws = (unsigned char*)d_ws;
#if DBG_CHECK
    ChkArgs ca{}; for (int i = 0; i < 25; ++i) ca.in[i] = (const float*)d_in[i]; ca.out = (float*)d_out; ca.ws = (unsigned char*)d_ws;
#define CHK(m, q) do { ca.mode = (m); ca.qd = (q); hipLaunchKernelGGL(chk_kernel, dim3(2048), dim3(256), 0, stream, ca); } while (0)
    for (int ph = 0; ph < NPHASE; ++ph) { a.lo = ph; a.hi = ph + 1;
        if (ph == 1) (void)hipMemsetAsync((char*)d_ws + Z_GTH, 0x3C, (size_t)256 * MiB, stream);
        hipLaunchKernelGGL(fwd_kernel, dim3(grid), dim3(NTHR), LDS_BYTES, stream, a);
        if (ph == 0) CHK(1, 0);
        if (ph == 1) for (int m = 2; m <= 12; ++m) CHK(m, 0);
        if (ph == 2) CHK(26, 0);
        if (ph == 3) CHK(25, 0);
        if (ph == 5) CHK(13, 0);
        if (ph == 6) CHK(14, 0);
        if (ph == 7) CHK(15, 0);
        if (ph == 8) CHK(16, 0);
        if (ph == 9) CHK(17, 0);
        if (ph >= PH_FIXED && ph < PH_TAIL0) { const int q = (ph - PH_FIXED) / PH_PER_Q, j = (ph - PH_FIXED) % PH_PER_Q;
            if (j == 0) { CHK(18, q); CHK(19, q); if (q > 0) CHK(22, q - 1); } if (j == 1) CHK(20, q); }
        if (ph == PH_TAIL0) CHK(22, NQ - 1);
        if (ph == PH_TAIL0 + 1) for (int q = 0; q < NQ; ++q) { CHK(21, q); CHK(24, q); } }
    hipLaunchKernelGGL(chk_encode, dim3(2048), dim3(256), 0, stream, (float*)d_out, (size_t)out_size, (const unsigned*)((unsigned char*)d_ws + WS_CTL) + CHK_WORD0, DBG_WHAT);
#elif MK_PER_PHASE
    for (int ph = 0; ph < NPHASE; ++ph) { a.lo = ph; a.hi = ph + 1; hipLaunchKernelGGL(fwd_kernel, dim3(grid), dim3(NTHR), LDS_BYTES, stream, a); }
#else
    a.lo = 0; a.hi = NPHASE;
    hipLaunchKernelGGL(fwd_kernel, dim3(grid), dim3(NTHR), LDS_BYTES, stream, a);
#if DBG_TIME
    hipLaunchKernelGGL(time_encode, dim3(2048), dim3(256), 0, stream, (float*)d_out, (size_t)out_size, (const unsigned long long*)((unsigned char*)d_ws + WS_CTL + 60 * 1024));
#endif
#endif
}
```

```cpp
#include <hip/hip_runtime.h>
#include <cstdio>
#include <cstdint>

#ifndef DBG_SLOT_LO
#define DBG_SLOT_LO 0
#define DBG_SLOT_HI 9
#endif
#ifndef DBG_SKIP_YA
#define DBG_SKIP_YA 0
#endif
#ifndef DBG_CHECK
#define DBG_CHECK 0
#endif
#ifndef DBG_PN_LO
#define DBG_PN_LO 0
#endif
#ifndef DBG_TIME
#define DBG_TIME 0
#endif
#ifndef USE_NAIVE_ATTN
#define USE_NAIVE_ATTN 0
#endif
#ifndef USE_NAIVE_HGRN
#define USE_NAIVE_HGRN 0
#endif
#ifndef DBG_DUP
#define DBG_DUP 0u
#endif
#define DUPN(bit) (((DBG_DUP) >> (bit)) & 1u ? 2 : 1)
#ifndef F8_SCALED
#define F8_SCALED 1
#endif
#ifndef MK_PER_PHASE
#define MK_PER_PHASE 0
#endif

#define LAS __attribute__((address_space(3)))
typedef unsigned short u16;
typedef short bf16x8 __attribute__((ext_vector_type(8)));
typedef float f32x4 __attribute__((ext_vector_type(4)));
typedef float f32x2 __attribute__((ext_vector_type(2)));
typedef unsigned u32x4 __attribute__((ext_vector_type(4)));
typedef unsigned u32x2 __attribute__((ext_vector_type(2)));
typedef int i32x16 __attribute__((ext_vector_type(16)));

constexpr int T = 65536, D = 1024, SEQ = 2048;
constexpr int NCOL = 6912;
constexpr int NQ = 2, TQ = T / NQ;
constexpr int NEXP = 256, NSLOT = 9;
constexpr int QTILES = (TQ * 8 + 256 * 255) / 256 + 1 + TQ / 256;
constexpr int WPC = 256 / NQ;
constexpr float ALPHA = 1.189207115002721f;
constexpr float LN_EPS = 1e-5f;
constexpr int NWAVES = 8, NTHR = 512;
constexpr float Y8_SCALE = 256.f;
constexpr float M8_SCALE = 16.f;
constexpr float H8_SCALE = 32.f;
constexpr float W8_SCALE = 64.f;

constexpr size_t MiB = (size_t)1 << 20;
constexpr size_t WS_CTL = 0, CTL_ZERO_BYTES = 64 * 1024;
constexpr size_t WS_WIN = 1 * MiB, WS_WBH = 15 * MiB, WS_WBA = 16 * MiB, WS_WO = 17 * MiB, WS_WR = 19 * MiB, WS_WPG = 20 * MiB, WS_WPP = 22 * MiB;
constexpr size_t WS_ROT = 22 * MiB + 512 * 1024, WS_LB = 22 * MiB + 768 * 1024;
constexpr size_t WS_HIST = 24 * MiB, WS_TOKE = 25 * MiB, WS_TOKR = 26 * MiB, WS_TOKG = 27 * MiB;
constexpr size_t WS_TOKD = 42 * MiB;
constexpr size_t WS_STOK = 29 * MiB, WS_SGATE = 33 * MiB, WS_SDST = 37 * MiB, WS_TILEE = 41 * MiB, WS_NTILES = 41 * MiB + 512 * 1024;
constexpr size_t WS_XB = 44 * MiB;
constexpr size_t WS_YH = WS_XB, WS_YA = WS_XB + 64 * MiB;
constexpr size_t WS_Z = 172 * MiB;
constexpr size_t Z_QH = WS_Z, Z_VH = WS_Z + 64 * MiB, Z_LFF = WS_Z + 128 * MiB, Z_LFB = WS_Z + 192 * MiB, Z_GS = WS_Z + 256 * MiB;
constexpr size_t Z_AQ = WS_Z + 320 * MiB, Z_AK = WS_Z + 416 * MiB, Z_AV = WS_Z + 512 * MiB, Z_GTH = WS_Z + 608 * MiB, Z_GTA = WS_Z + 736 * MiB;
constexpr size_t WS_X1PRE = WS_Z;
constexpr size_t WS_LOGITS = WS_Z;
constexpr size_t WS_H = WS_Z;
constexpr size_t WS_P2 = WS_Z + 296 * MiB;
constexpr size_t WS_X2B = WS_Z + 104 * MiB;
constexpr size_t WS_PB = WS_Z + 424 * MiB;
constexpr size_t WS_WGU = WS_Z + 296 * MiB;
constexpr size_t WS_WD = WS_Z + 425 * MiB;
constexpr size_t WS_X1F8 = WS_Z + 490 * MiB;
constexpr size_t WS_X3PRE = WS_Z + 802 * MiB;
constexpr size_t WS_X2F8 = WS_Z + 554 * MiB;
constexpr size_t WS_YS = WS_Z + 642 * MiB;
constexpr size_t WS_END = WS_Z + 931 * MiB;
constexpr size_t DO_OF = 0, DO_OB = 64 * MiB, DO_MERGED = 0, DO_MERGED8 = 128 * MiB;

constexpr int CW_BAR = 4096;

__device__ __forceinline__ unsigned cvt_pk_bf16(float lo, float hi) { unsigned r; asm volatile("v_cvt_pk_bf16_f32 %0, %1, %2" : "=v"(r) : "v"(lo), "v"(hi)); return r; }
typedef int i32x8 __attribute__((ext_vector_type(8)));
typedef int i32x4 __attribute__((ext_vector_type(4)));
__device__ __forceinline__ unsigned pk_fp8x4(float a, float b, float c, float d) { int w = 0; w = __builtin_amdgcn_cvt_pk_fp8_f32(a, b, w, false); w = __builtin_amdgcn_cvt_pk_fp8_f32(c, d, w, true); return (unsigned)w; }
typedef float f32x2_t __attribute__((ext_vector_type(2)));
__device__ __forceinline__ void fp8x4_to_f32(unsigned w, float (&o)[4]) { const f32x2_t lo = __builtin_amdgcn_cvt_pk_f32_fp8((int)w, false), hi = __builtin_amdgcn_cvt_pk_f32_fp8((int)w, true); o[0] = lo.x; o[1] = lo.y; o[2] = hi.x; o[3] = hi.y; }
__device__ __forceinline__ float bf_lo(unsigned w) { return __uint_as_float(w << 16); }
__device__ __forceinline__ float bf_hi(unsigned w) { return __uint_as_float(w & 0xffff0000u); }
__device__ __forceinline__ float bf1(u16 b) { return __uint_as_float(((unsigned)b) << 16); }
__device__ __forceinline__ float sigmoidf_(float z) { return __builtin_amdgcn_rcpf(1.0f + __expf(-z)); }
__device__ __forceinline__ unsigned pk_f16(float lo, float hi) { _Float16 a = (_Float16)lo, b = (_Float16)hi; unsigned short ua = __builtin_bit_cast(unsigned short, a), ub = __builtin_bit_cast(unsigned short, b); return (unsigned)ua | ((unsigned)ub << 16); }
__device__ __forceinline__ float f16_lo(unsigned w) { return (float)__builtin_bit_cast(_Float16, (unsigned short)(w & 0xffffu)); }
__device__ __forceinline__ float f16_hi(unsigned w) { return (float)__builtin_bit_cast(_Float16, (unsigned short)(w >> 16)); }
__device__ __forceinline__ float wave_sum(float v) {
    v += __int_as_float(__builtin_amdgcn_update_dpp(0, __float_as_int(v), 0xB1, 0xF, 0xF, true));
    v += __int_as_float(__builtin_amdgcn_update_dpp(0, __float_as_int(v), 0x4E, 0xF, 0xF, true));
    v += __int_as_float(__builtin_amdgcn_update_dpp(0, __float_as_int(v), 0x141, 0xF, 0xF, true));
    v += __int_as_float(__builtin_amdgcn_update_dpp(0, __float_as_int(v), 0x140, 0xF, 0xF, true));
    const int iv = __float_as_int(v);
    return (__int_as_float(__builtin_amdgcn_readlane(iv, 0)) + __int_as_float(__builtin_amdgcn_readlane(iv, 16))) + (__int_as_float(__builtin_amdgcn_readlane(iv, 32)) + __int_as_float(__builtin_amdgcn_readlane(iv, 48)));
}
__device__ __forceinline__ float wave_max(float v) {
#pragma unroll
    for (int o = 1; o < 64; o <<= 1) v = fmaxf(v, __shfl_xor(v, o));
    return v;
}
template <int CTRL> __device__ __forceinline__ float dpp_f(float x) { return __int_as_float(__builtin_amdgcn_update_dpp(0, __float_as_int(x), CTRL, 0xF, 0xF, true)); }
template <int CTRL> __device__ __forceinline__ int dpp_i(int x) { return __builtin_amdgcn_update_dpp(0, x, CTRL, 0xF, 0xF, true); }
__device__ __forceinline__ float rdlane_f(float x, int l) { return __int_as_float(__builtin_amdgcn_readlane(__float_as_int(x), l)); }
#define LDS_WAIT() asm volatile("s_waitcnt lgkmcnt(0)" ::: "memory")
#define VM_WAIT() asm volatile("s_waitcnt vmcnt(0)" ::: "memory")

#define XB_TMO      128
#define XB_XCNT(j)  (256  + 64 * (j))
#define XB_XSUB(j)  (1280 + 64 * (j))
#define XB_XGEN(j)  (2304 + 64 * (j))
#define XB_TOP      3328
#define XB_TOPGEN   3392
#define XCD_BAR_WORDS 3456
#define XB_SPIN_CAP (1u << 22)

__device__ __forceinline__ unsigned xb_ld(unsigned* p)              { return __hip_atomic_load(p, __ATOMIC_RELAXED, __HIP_MEMORY_SCOPE_AGENT); }
__device__ __forceinline__ unsigned xb_add(unsigned* p, unsigned v) { return __hip_atomic_fetch_add(p, v, __ATOMIC_RELAXED, __HIP_MEMORY_SCOPE_AGENT); }
__device__ __forceinline__ unsigned xb_xcc_id() { return (unsigned)__builtin_amdgcn_s_getreg((3 << 11) | 20) & 0xFu; }
#define XB_SPIN(cond, bar) do { unsigned _sp = 0; while (cond) { __builtin_amdgcn_s_sleep(1); \
    if ((++_sp & 255u) == 0u) { if (xb_ld(&(bar)[XB_TMO])) break; if (_sp > XB_SPIN_CAP) { atomicAdd(&(bar)[XB_TMO], 1u); break; } } } } while (0)

struct XcdBarrier { unsigned* bar; unsigned x; volatile LAS unsigned* st; };

__device__ __forceinline__ XcdBarrier xcd_barrier_post(unsigned* bar, volatile LAS unsigned* st) {
    XcdBarrier b; b.bar = bar; b.x = xb_xcc_id(); b.st = st;
    if (threadIdx.x == 0) (void)xb_add(&bar[XB_XCNT(b.x)], 1u);
    return b;
}
__device__ __forceinline__ void xcd_barrier_complete(unsigned* bar, unsigned x, unsigned& nloc, unsigned& nx) {
    const unsigned G = gridDim.x * gridDim.y * gridDim.z;
    unsigned sum, cnt, mine, sp = 0u;
    for (;;) {
        sum = 0u; cnt = 0u; mine = 0u;
#pragma unroll
        for (unsigned j = 0; j < 16; ++j) { const unsigned c = xb_ld(&bar[XB_XCNT(j)]); sum += c; cnt += (c > 0u) ? 1u : 0u; mine = (j == x) ? c : mine; }
        if (sum == G) break;
        __builtin_amdgcn_s_sleep(1);
        if ((++sp & 255u) == 0u) { if (xb_ld(&bar[XB_TMO])) break; if (sp > XB_SPIN_CAP) { atomicAdd(&bar[XB_TMO], 1u); break; } }
    }
    nloc = mine > 0u ? mine : 1u; nx = cnt > 0u ? cnt : 1u;
}
__device__ __forceinline__ void xcd_barrier(const XcdBarrier& b) {
    asm volatile("s_waitcnt vmcnt(0)" ::: "memory");
    __syncthreads();
    if (threadIdx.x == 0) {
        unsigned* bar = b.bar;
        __builtin_amdgcn_s_waitcnt(0);
        unsigned nloc = b.st[0], nx = b.st[1];
        if (nloc == 0u) { xcd_barrier_complete(bar, b.x, nloc, nx); b.st[0] = nloc; b.st[1] = nx; }
        const unsigned old = xb_add(&bar[XB_XSUB(b.x)], 1u);
        const unsigned gen = old / nloc;
        if (old + 1u == (gen + 1u) * nloc) {
            __builtin_amdgcn_fence(__ATOMIC_RELEASE, "agent");
            asm volatile("s_waitcnt vmcnt(0)" ::: "memory");
            const unsigned og = xb_add(&bar[XB_TOP], 1u);
            const unsigned tg = og / nx;
            if (og + 1u == (tg + 1u) * nx) xb_add(&bar[XB_TOPGEN], 1u);
            else XB_SPIN(xb_ld(&bar[XB_TOPGEN]) == tg, bar);
            __builtin_amdgcn_fence(__ATOMIC_ACQUIRE, "agent");
            xb_add(&bar[XB_XGEN(b.x)], 1u);
            asm volatile("s_waitcnt vmcnt(0)" ::: "memory");
        } else {
            XB_SPIN(xb_ld(&bar[XB_XGEN(b.x)]) == gen, bar);
            __builtin_amdgcn_fence(__ATOMIC_ACQUIRE, "agent");
            asm volatile("s_waitcnt vmcnt(0)" ::: "memory");
        }
    }
    __syncthreads();
}

namespace pg8 {
constexpr int BM = 256, BK = 64, HALF = 128, HTB = HALF * BK * 2, STAGE_BYTES = 8 * HTB;
__host__ __device__ __forceinline__ int lds_byte(int r, int c) { const int st = (r >> 4) * 2 + (c >> 5), rr = r & 15, cc = c & 31, ob = rr * 64 + cc * 2; return st * 1024 + (ob ^ (((ob >> 9) & 1) << 5)); }
__host__ __device__ __forceinline__ void stage_rc(int b, int& R, int& C) { const int st = b / 1024, sb = b % 1024, swz = sb ^ (((sb >> 9) & 1) << 5); R = (st >> 1) * 16 + swz / 64; C = (st & 1) * 32 + (swz % 64) / 2; }
__host__ __device__ __forceinline__ int perm32(int rho) { const int n = rho >> 4, i = rho & 15; return 8 * (i >> 2) + 4 * n + (i & 3); }

struct GUnit { const char* A; const char* B; int pm, pn, aux, par, li; };

struct DenseOrder {
    static constexpr bool GATHER_ROWS = false;
    const char* A; const char* Bt; int nM, nN, nwg, G, c, K, rev = 0;
    __device__ void init(const void* A_, const void* Bt_, int M, int N, int K_, int G_, int c_) { A = (const char*)A_; Bt = (const char*)Bt_; nM = M / BM; nN = N / BM; nwg = nM * nN; G = G_; c = c_; K = K_; }
    __device__ __forceinline__ bool next(int i, GUnit& u) const {
        if ((long)i * G + c >= nwg) return false; const int nr_ = (nwg + G - 1) / G; const long L = rev ? (long)(nr_ - 1 - i) * G + c : (long)i * G + c; if (L >= nwg) return false;
        int wgid = (int)L; { const int q = nwg / 8, r = nwg % 8, xcd = wgid % 8, off = wgid / 8; wgid = (xcd < r ? xcd * (q + 1) : r * (q + 1) + (xcd - r) * q) + off; }
        const int nig = 8 * nN, gid = wgid / nig, fm = gid * 8, gsz = (nM - fm) < 8 ? (nM - fm) : 8;
        u.pm = fm + ((wgid % nig) % gsz); u.pn = (wgid % nig) / gsz; u.aux = 0;
        u.A = A + (size_t)u.pm * BM * K * 2; u.B = Bt + (size_t)u.pn * BM * K * 2; return true;
    }
    __device__ __forceinline__ unsigned rowoff(const GUnit&, int r0, int sub) const { return (unsigned)(r0 + sub) * (unsigned)K * 2u; }
    __device__ __forceinline__ void unit_begin(const GUnit&, int, int) const {}
};
struct PanelOrder {
    static constexpr bool GATHER_ROWS = false;
    const char* A; const char* Bt; int pm, nN, K;
    __device__ __forceinline__ bool next(int i, GUnit& u) const { if (i >= nN) return false; u.pm = pm; u.pn = i; u.aux = 0; u.A = A + (size_t)pm * BM * K * 2; u.B = Bt + (size_t)i * BM * K * 2; return true; }
    __device__ __forceinline__ unsigned rowoff(const GUnit&, int r0, int sub) const { return (unsigned)(r0 + sub) * (unsigned)K * 2u; }
    __device__ __forceinline__ void unit_begin(const GUnit&, int, int) const {}
};
constexpr int LDS_SIDE = 131072, LDS_TILEE = 135680, LDS_ROWIDX = LDS_TILEE + ((QTILES * 4 + 255) & ~255), LDS_ROWSLOTS = 16;
template <int NT, bool GATHER> struct MoeOrder {
    static constexpr bool GATHER_ROWS = GATHER;
    const char* A; const char* W; LAS unsigned char* lds; const int* slot_tok; const int* sdst; const float* sgate; int ntiles, G, vc, K; size_t wstride_e, wstride_pn; int i0 = 0, di = 1;
    __device__ __forceinline__ void load_table(const int* tile_e, int tid) const {
        for (int i = tid; i < ntiles; i += NTHR) ((LAS int*)(lds + LDS_TILEE))[i] = tile_e[i];
        if (GATHER) { for (int j = tid; j < LDS_ROWSLOTS * 256; j += NTHR) { const int v = (j >> 8) * G + vc, tile = v / NT; if (tile < ntiles) ((LAS int*)(lds + LDS_ROWIDX))[j] = slot_tok[(size_t)tile * BM + (j & 255)]; } }
        asm volatile("s_waitcnt vmcnt(0) lgkmcnt(0)" ::: "memory"); __syncthreads(); }
    __device__ __forceinline__ bool next(int i, GUnit& u) const {
        const int li_ = i0 + i * di; const int v = li_ * G + vc; const int tile = v / NT; if (tile >= ntiles) return false;
        u.pm = tile; u.pn = v % NT; u.li = li_; const int e = __builtin_amdgcn_readfirstlane(((const LAS int*)(lds + LDS_TILEE))[tile]); u.aux = e;
        u.A = GATHER ? A : A + (size_t)tile * BM * K * 2; u.B = W + (size_t)e * wstride_e + (size_t)u.pn * wstride_pn; return true;
    }
    __device__ __forceinline__ unsigned rowoff(const GUnit& u, int r0, int sub) const {
        if (!GATHER) return (unsigned)(r0 + sub) * (unsigned)K * 2u;
        const int idx = ((const LAS int*)(lds + LDS_ROWIDX))[(u.li & (LDS_ROWSLOTS - 1)) * 256 + r0 + sub];
        return (unsigned)idx * (unsigned)K * 2u;
    }
    __device__ __forceinline__ void unit_begin(const GUnit&, int, int) const {}
};

template <bool OPAQUE_K = false, int F8M = 0  , bool SADDR = true  , class Epi, class Sched>
__device__ __forceinline__ void gemm_phase(LAS unsigned char* lds, const int K_, const Sched& S, const Epi& E) {
    constexpr bool F8 = F8M != 0; constexpr bool F8_SC = F8M == 2;
    int K = K_; if (OPAQUE_K) asm volatile("" : "+s"(K));
    int tid_ = threadIdx.x; asm volatile("" : "+v"(tid_));
    const int tid = tid_, wid = __builtin_amdgcn_readfirstlane(tid >> 6), lane = tid & 63, wr = wid >> 2, wc = wid & 3, fr = lane & 15, fq = lane >> 4;
    const int nt = K / BK;
    unsigned colb[2]; int r0w[2]; unsigned voffB0 = 0, oaS = 0;
#pragma unroll
    for (int i = 0; i < 2; ++i) { int R, C; stage_rc(tid * 16 + i * 8192, R, C); const int Rb = Epi::PERM ? ((R & ~31) + perm32(R & 31)) : R;
        colb[i] = (unsigned)C * 2u; r0w[i] = 16 * ((wid >> 1) + 4 * i); if (i == 0) { voffB0 = (unsigned)(Rb * K + C) * 2u; oaS = (unsigned)(R * K + C) * 2u; } }
    const size_t p64 = (size_t)64 * K * 2; const unsigned K2 = (unsigned)K * 2u, colb0 = colb[0]; const int ridx_lane = (r0w[0] + (lane >> 2)) * 4;
    const int sub = lane >> 2;
    const size_t kstep = (size_t)(BK * 2);
    const size_t hstep = (size_t)HALF * K * 2;
    const unsigned ldsw = (unsigned)wid * 1024u;
    const int aoff = lds_byte(wr * 64 + fr, fq * 8), boff = lds_byte(wc * 32 + fr, fq * 8);
#define PG8_SA(b, h) (((b) * 2 + (h)) * HTB)
#define PG8_SB(b, h) ((4 + (b) * 2 + (h)) * HTB)
#define PG8_STAGE1(ldsaddr, gbase, vo) do { const unsigned long long gb_ = (unsigned long long)(gbase); \
        if constexpr (SADDR) { const unsigned la_ = (unsigned)(size_t)(ldsaddr); \
            asm volatile("s_mov_b32 m0, %2\n\ts_nop 0\n\tglobal_load_lds_dwordx4 %0, %1" :: "v"(vo), "s"(gb_), "s"(la_) : "memory"); }     \
        else { unsigned lo_, hi_; \
            asm volatile("v_add_co_u32 %0, vcc, %2, %4\n\tv_mov_b32 %1, %3\n\tv_addc_co_u32 %1, vcc, 0, %1, vcc" : "=&v"(lo_), "=&v"(hi_) : "s"((unsigned)gb_), "s"((unsigned)(gb_ >> 32)), "v"(vo) : "vcc"); \
            __builtin_amdgcn_global_load_lds((const unsigned*)(((unsigned long long)hi_ << 32) | lo_), (LAS unsigned*)(ldsaddr), 16, 0, 0); } } while (0)
#define PG8_STAGE_B(bufoff, gbase) do { PG8_STAGE1(lds + (bufoff) + ldsw, (const char*)(gbase), voffB0); PG8_STAGE1(lds + (bufoff) + ldsw + 8192, (const char*)(gbase) + p64, voffB0); } while (0)
#define PG8_STAGE_A(bufoff, gbase, h, li_) do { if constexpr (Sched::GATHER_ROWS) { \
            PG8_STAGE1(lds + (bufoff) + ldsw, (const char*)(gbase), (unsigned)gi##h##0 * K2 + colb0); PG8_STAGE1(lds + (bufoff) + ldsw + 8192, (const char*)(gbase), (unsigned)gi##h##1 * K2 + colb0); } \
        else { PG8_STAGE1(lds + (bufoff) + ldsw, (const char*)(gbase) + (h) * hstep, oaS); PG8_STAGE1(lds + (bufoff) + ldsw + 8192, (const char*)(gbase) + (h) * hstep + p64, oaS); } } while (0)
#define PG8_GIDX(h, li_) int gi##h##0 = 0, gi##h##1 = 0; if constexpr (Sched::GATHER_ROWS) { int rl_ = ridx_lane; asm volatile("" : "+v"(rl_));   const LAS unsigned char* gp_ = lds + LDS_ROWIDX + ((li_) & (LDS_ROWSLOTS - 1)) * 1024 + (h) * 512 + rl_; gi##h##0 = *(const LAS int*)gp_; gi##h##1 = *(const LAS int*)(gp_ + 256); }
#define PG8_LDA(dst, b, h) do { _Pragma("unroll") for (int m = 0; m < 4; ++m) _Pragma("unroll") for (int k = 0; k < 2; ++k) dst[m][k] = *(const LAS bf16x8*)(lds + PG8_SA(b, h) + aoff + m * 2048 + k * 1024); } while (0)
#define PG8_LDB(dst, b, h) do { _Pragma("unroll") for (int n = 0; n < 2; ++n) _Pragma("unroll") for (int k = 0; k < 2; ++k) dst[n][k] = *(const LAS bf16x8*)(lds + PG8_SB(b, h) + boff + n * 2048 + k * 1024); } while (0)
#define PG8_MMA(ai, bj, At, Bt) do { __builtin_amdgcn_s_setprio(1); _Pragma("unroll") for (int m = 0; m < 4; ++m) _Pragma("unroll") for (int n = 0; n < 2; ++n) { \
        if constexpr (F8) { \
            if constexpr (F8_SC) { const i32x8 a8_ = __builtin_shufflevector(__builtin_bit_cast(i32x4, At[m][0]), __builtin_bit_cast(i32x4, At[m][1]), 0, 1, 2, 3, 4, 5, 6, 7), b8_ = __builtin_shufflevector(__builtin_bit_cast(i32x4, Bt[n][0]), __builtin_bit_cast(i32x4, Bt[n][1]), 0, 1, 2, 3, 4, 5, 6, 7); \
                acc[ai][bj][m][n] = __builtin_amdgcn_mfma_scale_f32_16x16x128_f8f6f4(b8_, a8_, acc[ai][bj][m][n], 0, 0, 0, sc1_, 0, sc1_); } \
            else { _Pragma("unroll") for (int k = 0; k < 2; ++k) { typedef long l64x2 __attribute__((ext_vector_type(2))); const l64x2 a_ = __builtin_bit_cast(l64x2, At[m][k]), b_ = __builtin_bit_cast(l64x2, Bt[n][k]); \
                acc[ai][bj][m][n] = __builtin_amdgcn_mfma_f32_16x16x32_fp8_fp8(b_[0], a_[0], acc[ai][bj][m][n], 0, 0, 0); acc[ai][bj][m][n] = __builtin_amdgcn_mfma_f32_16x16x32_fp8_fp8(b_[1], a_[1], acc[ai][bj][m][n], 0, 0, 0); } } } \
        else { _Pragma("unroll") for (int k = 0; k < 2; ++k) acc[ai][bj][m][n] = __builtin_amdgcn_mfma_f32_16x16x32_bf16(Bt[n][k], At[m][k], acc[ai][bj][m][n], 0, 0, 0); } } \
        __builtin_amdgcn_s_setprio(0); } while (0)
#define PG8_WAIT_V(n) asm volatile("s_waitcnt vmcnt(" #n ")" ::: "memory")
#define PG8_WAIT_L(n) asm volatile("s_waitcnt lgkmcnt(" #n ")" ::: "memory")
#define PG8_BAR __builtin_amdgcn_s_barrier()
#define PG8_SCHED __builtin_amdgcn_sched_barrier(0)
    int sc1_; asm volatile("s_mov_b32 %0, 0x7f7f7f7f" : "=s"(sc1_));
    GUnit cur, nxt; int ui = 0;
    if (!S.next(0, cur)) return;
    f32x4 acc[2][2][4][2];
#pragma unroll
    for (int a = 0; a < 2; ++a)
#pragma unroll
        for (int b = 0; b < 2; ++b)
#pragma unroll
            for (int m = 0; m < 4; ++m)
#pragma unroll
                for (int n = 0; n < 2; ++n) acc[a][b][m][n] = (f32x4){0.f, 0.f, 0.f, 0.f};
    bf16x8 At[4][2], B0[2][2], B1[2][2];
    const char* cA = cur.A; const char* cB = cur.B;
    { PG8_GIDX(0, cur.li) PG8_GIDX(1, cur.li) PG8_STAGE_B(PG8_SB(0, 0), cB); PG8_STAGE_A(PG8_SA(0, 0), cA, 0, cur.li); PG8_STAGE_B(PG8_SB(0, 1), cB + hstep); PG8_STAGE_A(PG8_SA(0, 1), cA, 1, cur.li); }
    if (wr == 1) PG8_BAR;
    PG8_WAIT_V(4); PG8_BAR;
    { PG8_GIDX(0, cur.li) PG8_STAGE_B(PG8_SB(1, 0), cB + kstep); PG8_STAGE_A(PG8_SA(1, 0), cA + kstep, 0, cur.li); PG8_STAGE_B(PG8_SB(1, 1), cB + hstep + kstep); }
    PG8_WAIT_V(6); PG8_BAR;
    for (;;) {
        cur.par = ui & 1; S.unit_begin(cur, ui & 1, wid);
        const bool has_next = S.next(ui + 1, nxt);
        const char* nA = has_next ? nxt.A : cA; const char* nB = has_next ? nxt.B : cB;
        for (int t = 0; t < nt; t += 2) {
            const bool last = (t == nt - 2);
            const char* a1 = cA + (size_t)(t + 1) * kstep;
            const char* a2 = last ? nA : cA + (size_t)(t + 2) * kstep; const char* b2 = last ? nB : cB + (size_t)(t + 2) * kstep;
            const char* a3 = a2 + kstep; const char* b3 = b2 + kstep;
            const int lis = (last && has_next) ? nxt.li : cur.li;
            { PG8_GIDX(1, cur.li) PG8_LDB(B0, 0, 0); PG8_SCHED; PG8_LDA(At, 0, 0); PG8_STAGE_A(PG8_SA(1, 1), a1, 1, cur.li); }
            PG8_WAIT_L(8); PG8_BAR; PG8_WAIT_L(0); PG8_MMA(0, 0, At, B0); PG8_BAR; PG8_SCHED;
            PG8_LDB(B1, 0, 1); PG8_STAGE_B(PG8_SB(0, 0), b2);
            PG8_BAR; PG8_WAIT_L(0); PG8_MMA(0, 1, At, B1); PG8_BAR;
            { PG8_GIDX(0, lis) PG8_LDA(At, 0, 1); PG8_STAGE_A(PG8_SA(0, 0), a2, 0, lis); }
            PG8_BAR; PG8_WAIT_L(0); PG8_MMA(1, 0, At, B0); PG8_BAR; PG8_SCHED;
            PG8_STAGE_B(PG8_SB(0, 1), b2 + hstep);
            PG8_WAIT_V(6); PG8_BAR; PG8_MMA(1, 1, At, B1); PG8_BAR;
            { PG8_GIDX(1, lis) PG8_LDB(B0, 1, 0); PG8_SCHED; PG8_LDA(At, 1, 0); PG8_STAGE_A(PG8_SA(0, 1), a2, 1, lis); }
            PG8_WAIT_L(8); PG8_BAR; PG8_WAIT_L(0); PG8_MMA(0, 0, At, B0); PG8_BAR; PG8_SCHED;
            PG8_LDB(B1, 1, 1); PG8_STAGE_B(PG8_SB(1, 0), b3);
            PG8_BAR; PG8_WAIT_L(0); PG8_MMA(0, 1, At, B1); PG8_BAR;
            { PG8_GIDX(0, lis) PG8_LDA(At, 1, 1); PG8_STAGE_A(PG8_SA(1, 0), a3, 0, lis); }
            PG8_BAR; PG8_WAIT_L(0); PG8_MMA(1, 0, At, B0); PG8_BAR; PG8_SCHED;
            PG8_STAGE_B(PG8_SB(1, 1), b3 + hstep);
            PG8_WAIT_V(6); PG8_BAR; PG8_MMA(1, 1, At, B1); PG8_BAR;
        }
        { int l_ = threadIdx.x; asm volatile("" : "+v"(l_));
          E(acc, cur, wr, wc, l_ & 15, (l_ & 63) >> 4); }
        if (!has_next) break;
#pragma unroll
        for (int a = 0; a < 2; ++a)
#pragma unroll
            for (int b = 0; b < 2; ++b)
#pragma unroll
                for (int m = 0; m < 4; ++m)
#pragma unroll
                    for (int n = 0; n < 2; ++n) acc[a][b][m][n] = (f32x4){0.f, 0.f, 0.f, 0.f};
        cur = nxt; cA = nA; cB = nB; ++ui;
    }
    PG8_WAIT_V(0);
    if (wr == 0) PG8_BAR;
    PG8_BAR;
#undef PG8_SA
#undef PG8_SB
#undef PG8_STAGE1
#undef PG8_STAGE_A
#undef PG8_GIDX
#undef PG8_STAGE_B
#undef PG8_LDA
#undef PG8_LDB
#undef PG8_MMA
#undef PG8_WAIT_V
#undef PG8_WAIT_L
#undef PG8_BAR
#undef PG8_SCHED
}

#define EPI_LOOP_ROWS for (int ai = 0; ai < 2; ++ai) _Pragma("unroll") for (int m = 0; m < 4; ++m)

__device__ __forceinline__ u32x4 pair16(u32x2 xa, u32x2 xb) {
    const auto lo = __builtin_amdgcn_permlane16_swap(xa.x, xb.x, false, false), hi = __builtin_amdgcn_permlane16_swap(xa.y, xb.y, false, false);
    u32x4 w; w.x = lo[0]; w.y = hi[0]; w.z = lo[1]; w.w = hi[1]; return w; }
enum { K_SILU = 0, K_ID = 1, K_LOGF = 2, K_ROT = 3, K_SIG = 4, K_ID8 = 5   };
struct EpiZ {
    static constexpr bool PERM = true;
    unsigned char* ws; const float* rot; const float* lb; float osc;
    template <int KIND> __device__ __forceinline__ void body(const f32x4 (&acc)[2][2][4][2], u16* base, int ld, int pnl, int pm, float scale, const float* lbp, int wr, int wc, int fr, int fq) const {
        const int row0 = pm * BM + wr * 64 + fr, col0 = pnl * BM + wc * 32 + 8 * fq;
        if constexpr (KIND == K_ID8) {
            unsigned char* bp = (unsigned char*)base + (size_t)(row0 + 16 * (fq & 1)) * ld + col0 - 8 * (fq & 1);
#pragma unroll
            for (int ai = 0; ai < 2; ++ai)
#pragma unroll
                for (int mp = 0; mp < 4; mp += 2)
#pragma unroll
                    for (int bj = 0; bj < 2; ++bj) { u32x2 x[2];
#pragma unroll
                        for (int t = 0; t < 2; ++t) { const f32x4 v0 = acc[ai][bj][mp + t][0] * osc, v1 = acc[ai][bj][mp + t][1] * osc; x[t].x = pk_fp8x4(v0[0], v0[1], v0[2], v0[3]); x[t].y = pk_fp8x4(v1[0], v1[1], v1[2], v1[3]); }
                        *(u32x4*)(bp + (size_t)(ai * HALF + mp * 16) * ld + bj * HALF) = pair16(x[0], x[1]); }
            return;
        }
        f32x4 l0[2], l1[2];
        if (KIND == K_LOGF) {
#pragma unroll
            for (int bj = 0; bj < 2; ++bj) { l0[bj] = *(const f32x4*)(lbp + col0 + bj * HALF); l1[bj] = *(const f32x4*)(lbp + col0 + bj * HALF + 4); }
        }
        const bool rotl = (KIND == K_ROT) && ((wc & 1) == 0) && (fq < 2);
        const float sgn = (fq == 0) ? -1.f : 1.f;
#pragma unroll
        for (int ai = 0; ai < 2; ++ai) {
        f32x4 rt[4][4];
        if (KIND == K_ROT) {
#pragma unroll
            for (int m = 0; m < 4; ++m) { const float* rp = rot + (size_t)((row0 + ai * HALF + m * 16) & (SEQ - 1)) * 16;
#pragma unroll
                for (int k = 0; k < 4; ++k) rt[m][k] = *(const f32x4*)(rp + 4 * k); }
            __builtin_amdgcn_sched_barrier(0);
        }
#pragma unroll
        for (int m = 0; m < 4; ++m) {
            const int row = row0 + ai * HALF + m * 16;
            f32x4 cs0, cs1, sn0, sn1;
            if (KIND == K_ROT) { cs0 = rt[m][0]; cs1 = rt[m][1]; sn0 = rt[m][2]; sn1 = rt[m][3]; }
#pragma unroll
            for (int bj = 0; bj < 2; ++bj) {
                f32x4 v0 = acc[ai][bj][m][0] * osc, v1 = acc[ai][bj][m][1] * osc;
                if (KIND == K_SILU) {
#pragma unroll
                    for (int j = 0; j < 4; ++j) { v0[j] = v0[j] * sigmoidf_(v0[j]); v1[j] = v1[j] * sigmoidf_(v1[j]); }
                } else if (KIND == K_SIG) {
#pragma unroll
                    for (int j = 0; j < 4; ++j) { v0[j] = sigmoidf_(v0[j]); v1[j] = sigmoidf_(v1[j]); }
                } else if (KIND == K_LOGF) {
#pragma unroll
                    for (int j = 0; j < 4; ++j) { v0[j] = __logf(l0[bj][j] + (1.f - l0[bj][j]) * sigmoidf_(v0[j])); v1[j] = __logf(l1[bj][j] + (1.f - l1[bj][j]) * sigmoidf_(v1[j])); }
                } else if (KIND == K_ROT) {
                    f32x4 o0, o1;
#pragma unroll
                    for (int j = 0; j < 4; ++j) { o0[j] = __shfl_xor(v0[j], 16); o1[j] = __shfl_xor(v1[j], 16); }
                    if (rotl) {
#pragma unroll
                        for (int j = 0; j < 4; ++j) { v0[j] = v0[j] * cs0[j] + sgn * o0[j] * sn0[j]; v1[j] = v1[j] * cs1[j] + sgn * o1[j] * sn1[j]; }
                    }
                    v0 = v0 * scale; v1 = v1 * scale;
                }
                if (KIND == K_ID8) { u32x2 w8; w8.x = pk_fp8x4(v0[0], v0[1], v0[2], v0[3]); w8.y = pk_fp8x4(v1[0], v1[1], v1[2], v1[3]);
                    *(u32x2*)((unsigned char*)base + (size_t)row * ld + col0 + bj * HALF) = w8; continue; }
                u32x4 w;
                if (KIND == K_LOGF) { w.x = pk_f16(v0[0], v0[1]); w.y = pk_f16(v0[2], v0[3]); w.z = pk_f16(v1[0], v1[1]); w.w = pk_f16(v1[2], v1[3]); }
                else { w.x = cvt_pk_bf16(v0[0], v0[1]); w.y = cvt_pk_bf16(v0[2], v0[3]); w.z = cvt_pk_bf16(v1[0], v1[1]); w.w = cvt_pk_bf16(v1[2], v1[3]); }
                *(u32x4*)(base + (size_t)row * ld + col0 + bj * HALF) = w;
            }
        }
        }
    }
    __device__ __forceinline__ void operator()(const f32x4 (&acc)[2][2][4][2], const GUnit& u, int wr, int wc, int fr, int fq) const {
        const int pn = u.pn, pm = u.pm;
        if (pn < DBG_PN_LO) return;
        if (pn < 2)       body<K_ID8>(acc, (u16*)(ws + Z_QH), 512, pn, pm, 1.f, nullptr, wr, wc, fr, fq);
        else if (pn < 4)  body<K_ID8>(acc, (u16*)(ws + Z_VH), 512, pn - 2, pm, 1.f, nullptr, wr, wc, fr, fq);
        else if (pn < 6)  body<K_ID>(acc, (u16*)(ws + Z_LFF), 512, pn - 4, pm, 1.f, nullptr, wr, wc, fr, fq);
        else if (pn < 8)  body<K_ID>(acc, (u16*)(ws + Z_LFB), 512, pn - 6, pm, 1.f, nullptr, wr, wc, fr, fq);
        else if (pn < 10) body<K_ID8>(acc, (u16*)(ws + Z_GS), 512, pn - 8, pm, 1.f, nullptr, wr, wc, fr, fq);
        else if (pn < 13) body<K_ROT>(acc, (u16*)(ws + Z_AQ), 768, pn - 10, pm, 0.125f, nullptr, wr, wc, fr, fq);
        else if (pn < 16) body<K_ROT>(acc, (u16*)(ws + Z_AK), 768, pn - 13, pm, 1.f, nullptr, wr, wc, fr, fq);
        else if (pn < 19) body<K_ID>(acc, (u16*)(ws + Z_AV), 768, pn - 16, pm, 1.f, nullptr, wr, wc, fr, fq);
        else if (pn < 23) body<K_ID8>(acc, (u16*)(ws + Z_GTH), 1024, pn - 19, pm, 1.f, nullptr, wr, wc, fr, fq);
        else              body<K_ID8>(acc, (u16*)(ws + Z_GTA), 1024, pn - 23, pm, 1.f, nullptr, wr, wc, fr, fq);
    }
};

template <bool ADD> struct EpiGated {
    static constexpr bool PERM = true;
    const u16* gate; u16* out; unsigned char* out8; int ld;
    __device__ __forceinline__ void operator()(const f32x4 (&acc)[2][2][4][2], const GUnit& u, int wr, int wc, int fr, int fq) const {
        const int row0 = u.pm * BM + wr * 64 + fr, col0 = u.pn * BM + wc * 32 + 8 * fq;
        constexpr float isc = 1.0f / W8_SCALE;
#pragma unroll
        for (int ai = 0; ai < 2; ++ai)
#pragma unroll
        for (int mp = 0; mp < 4; mp += 2) {
            u32x2 gv[4][2]; u32x4 pv[4][2];
#pragma unroll
            for (int m = mp; m < mp + 2; ++m)
#pragma unroll
                for (int bj = 0; bj < 2; ++bj) { const size_t off = (size_t)(row0 + ai * HALF + m * 16) * ld + col0 + bj * HALF; gv[m][bj] = *(const u32x2*)((const unsigned char*)gate + off); if (ADD) pv[m][bj] = *(const u32x4*)(out + off); }
            __builtin_amdgcn_sched_barrier(0);
#pragma unroll
                for (int bj = 0; bj < 2; ++bj) { u32x2 x8[2];
#pragma unroll
                    for (int t = 0; t < 2; ++t) { const int m = mp + t; const size_t off = (size_t)(row0 + ai * HALF + m * 16) * ld + col0 + bj * HALF;
                        const u32x2 g = gv[m][bj]; float g0[4], g1[4]; fp8x4_to_f32(g.x, g0); fp8x4_to_f32(g.y, g1);
                        f32x4 v0 = acc[ai][bj][m][0] * isc, v1 = acc[ai][bj][m][1] * isc;
#pragma unroll
                        for (int j = 0; j < 4; ++j) { v0[j] *= sigmoidf_(g0[j]); v1[j] *= sigmoidf_(g1[j]); }
                        if (ADD) { const u32x4 p = pv[m][bj];
                            v0[0] += bf_lo(p.x); v0[1] += bf_hi(p.x); v0[2] += bf_lo(p.y); v0[3] += bf_hi(p.y);
                            v1[0] += bf_lo(p.z); v1[1] += bf_hi(p.z); v1[2] += bf_lo(p.w); v1[3] += bf_hi(p.w);
                            x8[t].x = pk_fp8x4(v0[0] * M8_SCALE, v0[1] * M8_SCALE, v0[2] * M8_SCALE, v0[3] * M8_SCALE); x8[t].y = pk_fp8x4(v1[0] * M8_SCALE, v1[1] * M8_SCALE, v1[2] * M8_SCALE, v1[3] * M8_SCALE); }
                        else { u32x4 w; w.x = cvt_pk_bf16(v0[0], v0[1]); w.y = cvt_pk_bf16(v0[2], v0[3]); w.z = cvt_pk_bf16(v1[0], v1[1]); w.w = cvt_pk_bf16(v1[2], v1[3]);
                            *(u32x4*)(out + off) = w; }
                    }
                    if (ADD) *(u32x4*)(out8 + (size_t)(row0 + ai * HALF + (mp + (fq & 1)) * 16) * ld + col0 - 8 * (fq & 1) + bj * HALF) = pair16(x8[0], x8[1]);
                }
            __builtin_amdgcn_sched_barrier(0);
        }
    }
};
struct EpiF32Res {
    static constexpr bool PERM = false;
    float* C; const float* res; u16* Cb; int ld; float alpha; float asc;
    __device__ __forceinline__ void operator()(const f32x4 (&acc)[2][2][4][2], const GUnit& u, int wr, int wc, int fr, int fq) const {
        const int row0 = u.pm * BM + wr * 64 + fr, col0 = u.pn * BM + wc * 32 + 4 * fq;
#pragma unroll
        EPI_LOOP_ROWS {
            const size_t off = (size_t)(row0 + ai * HALF + m * 16) * ld + col0;
#pragma unroll
            for (int bj = 0; bj < 2; ++bj)
#pragma unroll
                for (int n = 0; n < 2; ++n) { f32x4 v = acc[ai][bj][m][n] * asc; if (res) v = v + alpha * *(const f32x4*)(res + off + bj * HALF + n * 16);
                    if (Cb) { u32x2 w; w.x = cvt_pk_bf16(v[0], v[1]); w.y = cvt_pk_bf16(v[2], v[3]); *(u32x2*)(Cb + off + bj * HALF + n * 16) = w; } else *(f32x4*)(C + off + bj * HALF + n * 16) = v; }
        }
    }
};
struct EpiBf16Res {
    static constexpr bool PERM = true;
    const float* res; u16* Cb; int ld; float alpha; float asc;
    __device__ __forceinline__ void operator()(const f32x4 (&acc)[2][2][4][2], const GUnit& u, int wr, int wc, int fr, int fq) const {
        const int row0 = u.pm * BM + wr * 64 + fr, col0 = u.pn * BM + wc * 32 + 8 * fq;
#pragma unroll
        for (int ai = 0; ai < 2; ++ai)
#pragma unroll
        for (int mp = 0; mp < 4; mp += 2) {
            f32x4 r[2][2][2];
#pragma unroll
            for (int t = 0; t < 2; ++t)
#pragma unroll
                for (int bj = 0; bj < 2; ++bj) { const float* rp = res + (size_t)(row0 + ai * HALF + (mp + t) * 16) * ld + col0 + bj * HALF; r[t][bj][0] = *(const f32x4*)rp; r[t][bj][1] = *(const f32x4*)(rp + 4); }
            __builtin_amdgcn_sched_barrier(0);
#pragma unroll
            for (int t = 0; t < 2; ++t)
#pragma unroll
                for (int bj = 0; bj < 2; ++bj) { const int m = mp + t; const f32x4 v0 = acc[ai][bj][m][0] * asc + alpha * r[t][bj][0], v1 = acc[ai][bj][m][1] * asc + alpha * r[t][bj][1];
                    u32x4 w; w.x = cvt_pk_bf16(v0[0], v0[1]); w.y = cvt_pk_bf16(v0[2], v0[3]); w.z = cvt_pk_bf16(v1[0], v1[1]); w.w = cvt_pk_bf16(v1[2], v1[3]);
                    *(u32x4*)(Cb + (size_t)(row0 + ai * HALF + m * 16) * ld + col0 + bj * HALF) = w; }
            __builtin_amdgcn_sched_barrier(0);
        }
    }
};
struct EpiBf16 {
    static constexpr bool PERM = true;
    u16* O; int ld;
    __device__ __forceinline__ void operator()(const f32x4 (&acc)[2][2][4][2], const GUnit& u, int wr, int wc, int fr, int fq) const {
        const int row0 = u.pm * BM + wr * 64 + fr, col0 = u.pn * BM + wc * 32 + 8 * fq;
#pragma unroll
        EPI_LOOP_ROWS {
            u16* rowp = O + (size_t)(row0 + ai * HALF + m * 16) * ld + col0;
#pragma unroll
            for (int bj = 0; bj < 2; ++bj) { const f32x4 v0 = acc[ai][bj][m][0], v1 = acc[ai][bj][m][1];
                u32x4 w; w.x = cvt_pk_bf16(v0[0], v0[1]); w.y = cvt_pk_bf16(v0[2], v0[3]); w.z = cvt_pk_bf16(v1[0], v1[1]); w.w = cvt_pk_bf16(v1[2], v1[3]);
                *(u32x4*)(rowp + bj * HALF) = w; }
        }
    }
};
struct EpiSwiglu {
    static constexpr bool PERM = true;
    unsigned char* H;
    __device__ __forceinline__ void operator()(const f32x4 (&acc)[2][2][4][2], const GUnit& u, int wr, int wc, int fr, int fq) const {
        const int row0 = u.pm * BM + wr * 64 + fr, col0 = u.pn * HALF + wc * 32 + 8 * fq;
        constexpr float isc = 1.0f / W8_SCALE;
        unsigned char* hp = H + (size_t)(row0 + 16 * (fq & 1)) * 256 + col0 - 8 * (fq & 1);
#pragma unroll
        for (int ai = 0; ai < 2; ++ai)
#pragma unroll
            for (int mp = 0; mp < 4; mp += 2) { u32x2 x[2];
#pragma unroll
                for (int t = 0; t < 2; ++t) { const int m = mp + t;
                    f32x4 g0 = acc[ai][0][m][0] * isc, g1 = acc[ai][0][m][1] * isc; const f32x4 u0 = acc[ai][1][m][0] * (isc * H8_SCALE), u1 = acc[ai][1][m][1] * (isc * H8_SCALE);
#pragma unroll
                    for (int j = 0; j < 4; ++j) { g0[j] = g0[j] * sigmoidf_(g0[j]) * u0[j]; g1[j] = g1[j] * sigmoidf_(g1[j]) * u1[j]; }
                    x[t].x = pk_fp8x4(g0[0], g0[1], g0[2], g0[3]); x[t].y = pk_fp8x4(g1[0], g1[1], g1[2], g1[3]); }
                *(u32x4*)(hp + (size_t)(ai * HALF + mp * 16) * 256) = pair16(x[0], x[1]); }
    }
};
struct EpiDown {
    static constexpr bool PERM = true;
    unsigned char* Y; LAS unsigned char* lds;
    __device__ __forceinline__ void operator()(const f32x4 (&acc)[2][2][4][2], const GUnit& u, int wr, int wc, int fr, int fq) const {
        const int col0 = u.pn * BM + wc * 32 + 8 * fq;
        const LAS unsigned* side = (const LAS unsigned*)(lds + LDS_SIDE + u.par * 2048);
        unsigned dd[8]; float gg[8];
#pragma unroll
        for (int j = 0; j < 8; ++j) { const int lr = wr * 64 + fr + (j >> 2) * HALF + (j & 3) * 16; dd[j] = side[(lr >> 5) * 64 + (lr & 31)]; gg[j] = __uint_as_float(side[(lr >> 5) * 64 + 32 + (lr & 31)]) * (Y8_SCALE / (W8_SCALE * H8_SCALE)); }
#pragma unroll
        EPI_LOOP_ROWS {
            const unsigned d = dd[ai * 4 + m]; const float g = gg[ai * 4 + m];
            unsigned char* rowp = Y + (size_t)(d * (unsigned)D + (unsigned)col0);
#pragma unroll
            for (int bj = 0; bj < 2; ++bj) { const f32x4 v0 = acc[ai][bj][m][0] * g, v1 = acc[ai][bj][m][1] * g;
                u32x2 w; w.x = pk_fp8x4(v0[0], v0[1], v0[2], v0[3]); w.y = pk_fp8x4(v1[0], v1[1], v1[2], v1[3]);
                *(u32x2*)(rowp + bj * HALF) = w; }
        }
    }
};
struct EpiPle {
    static constexpr bool PERM = true;
    u16* out; const u16* x2; const u16* p2; int ld; float asc;
    __device__ __forceinline__ void operator()(const f32x4 (&acc)[2][2][4][2], const GUnit& u, int wr, int wc, int fr, int fq) const {
        const int row0 = u.pm * BM + wr * 64 + fr, col0 = u.pn * BM + wc * 32 + 8 * fq;
#pragma unroll
        for (int ai = 0; ai < 2; ++ai) {
            u32x4 xv[4][2], pv[4][2];
#pragma unroll
            for (int m = 0; m < 4; ++m)
#pragma unroll
                for (int bj = 0; bj < 2; ++bj) { const size_t o = (size_t)(row0 + ai * HALF + m * 16) * ld + col0 + bj * HALF; xv[m][bj] = *(const u32x4*)(x2 + o); pv[m][bj] = *(const u32x4*)(p2 + o); }
            __builtin_amdgcn_sched_barrier(0);
#pragma unroll
            for (int m = 0; m < 4; ++m)
#pragma unroll
                for (int bj = 0; bj < 2; ++bj) { const size_t o = (size_t)(row0 + ai * HALF + m * 16) * ld + col0 + bj * HALF; const u32x4 x = xv[m][bj], p = pv[m][bj]; const f32x4 a = acc[ai][bj][m][0] * asc, b = acc[ai][bj][m][1] * asc;
                    u32x4 r; r.x = cvt_pk_bf16(ALPHA * bf_lo(x.x) + sigmoidf_(a[0]) * bf_lo(p.x), ALPHA * bf_hi(x.x) + sigmoidf_(a[1]) * bf_hi(p.x));
                    r.y = cvt_pk_bf16(ALPHA * bf_lo(x.y) + sigmoidf_(a[2]) * bf_lo(p.y), ALPHA * bf_hi(x.y) + sigmoidf_(a[3]) * bf_hi(p.y));
                    r.z = cvt_pk_bf16(ALPHA * bf_lo(x.z) + sigmoidf_(b[0]) * bf_lo(p.z), ALPHA * bf_hi(x.z) + sigmoidf_(b[1]) * bf_hi(p.z));
                    r.w = cvt_pk_bf16(ALPHA * bf_lo(x.w) + sigmoidf_(b[2]) * bf_lo(p.w), ALPHA * bf_hi(x.w) + sigmoidf_(b[3]) * bf_hi(p.w));
                    *(u32x4*)(out + o) = r; }
            __builtin_amdgcn_sched_barrier(0);
        }
    }
};
}

struct Args { const float* in[25]; float* out; unsigned char* ws; int lo, hi; };
struct Frame {
    LAS unsigned char* lds; int tid, lane, wave, vcu, G; unsigned char* ws; unsigned char* dout;
};

__device__ __forceinline__ void transpose_item(const float* __restrict__ W, int ldw, int k0, int n0, u16* __restrict__ WT, size_t dst_row0, int Kd, LAS float* scr, int lane) {
#pragma unroll 8
    for (int i = 0; i < 32; ++i) { const int kk = 2 * i + (lane >> 5); scr[kk * 33 + (lane & 31)] = W[(size_t)(k0 + kk) * ldw + n0 + (lane & 31)]; }
    LDS_WAIT(); asm volatile("" ::: "memory");
    const int c = lane & 7;
#pragma unroll
    for (int j = 0; j < 4; ++j) { const int n = (lane >> 3) + 8 * j; const LAS float* s = scr + (8 * c) * 33 + n;
        u32x4 o; o.x = cvt_pk_bf16(s[0 * 33], s[1 * 33]); o.y = cvt_pk_bf16(s[2 * 33], s[3 * 33]); o.z = cvt_pk_bf16(s[4 * 33], s[5 * 33]); o.w = cvt_pk_bf16(s[6 * 33], s[7 * 33]);
        *(u32x4*)(WT + (dst_row0 + n) * (size_t)Kd + k0 + 8 * c) = o; }
    LDS_WAIT(); asm volatile("" ::: "memory");
}

__device__ __forceinline__ void transpose_item_f8(const float* __restrict__ W, int ldw, int k0, int n0, unsigned char* __restrict__ WT, size_t dst_row0, int Kd, float scale, LAS float* scr, int lane) {
    float tv[32];
#pragma unroll
    for (int i = 0; i < 32; ++i) tv[i] = W[(size_t)(k0 + 2 * i + (lane >> 5)) * ldw + n0 + (lane & 31)];
#pragma unroll
    for (int i = 0; i < 32; ++i) scr[(2 * i + (lane >> 5)) * 33 + (lane & 31)] = tv[i];
    LDS_WAIT(); asm volatile("" ::: "memory");
    const int c = lane & 7;
#pragma unroll
    for (int j = 0; j < 4; ++j) { const int n = (lane >> 3) + 8 * j; const LAS float* sp = scr + (8 * c) * 33 + n;
        u32x2 o; o.x = pk_fp8x4(sp[0 * 33] * scale, sp[1 * 33] * scale, sp[2 * 33] * scale, sp[3 * 33] * scale); o.y = pk_fp8x4(sp[4 * 33] * scale, sp[5 * 33] * scale, sp[6 * 33] * scale, sp[7 * 33] * scale);
        *(u32x2*)(WT + (dst_row0 + n) * (size_t)Kd + k0 + 8 * c) = o; }
    LDS_WAIT(); asm volatile("" ::: "memory");
}
__device__ __forceinline__ bool transpose_matrix_item(int& r, const float* W, int K, int N, u16* WT, LAS float* scr, int lane) {
    const int nitems = (K / 64) * (N / 32);
    if (r < nitems) { const int nblk = N / 32, kb = r / nblk, nb = r % nblk; transpose_item(W, N, 64 * kb, 32 * nb, WT, (size_t)32 * nb, K, scr, lane); return true; }
    r -= nitems; return false;
}

template <bool OUT_BF16> __device__ __forceinline__ void ln_row(const float* xrow, const float* g, const float* b, void* orow, int lane, unsigned* o8row = nullptr) {
    const f32x4* xr = (const f32x4*)xrow + lane;
    f32x4 v[4]; float s = 0.f;
#pragma unroll
    for (int j = 0; j < 4; ++j) { v[j] = xr[64 * j]; s += (v[j].x + v[j].y) + (v[j].z + v[j].w); }
    const float mean = wave_sum(s) * (1.f / D); float s2 = 0.f;
#pragma unroll
    for (int j = 0; j < 4; ++j) { v[j] = v[j] - mean; s2 += (v[j].x * v[j].x + v[j].y * v[j].y) + (v[j].z * v[j].z + v[j].w * v[j].w); }
    const float rstd = 1.f / sqrtf(wave_sum(s2) * (1.f / D) + LN_EPS);
#pragma unroll
    for (int j = 0; j < 4; ++j) { const f32x4 gg = *((const f32x4*)g + lane + 64 * j), bb = *((const f32x4*)b + lane + 64 * j); const f32x4 y = v[j] * rstd * gg + bb;
        if (OUT_BF16) { u32x2 w; w.x = cvt_pk_bf16(y[0], y[1]); w.y = cvt_pk_bf16(y[2], y[3]); *((u32x2*)orow + lane + 64 * j) = w; if (o8row) o8row[lane + 64 * j] = pk_fp8x4(y[0], y[1], y[2], y[3]); }
        else *((f32x4*)orow + lane + 64 * j) = y; }
}


template <bool OUT_BF16, int NR, bool IN_BF16 = false> __device__ __forceinline__ void ln_rows(const void* xbase_, size_t r0, size_t rstride, const float* g, const float* b, void* obase, int lane, unsigned char* o8base = nullptr) {
    f32x4 v[NR][4]; float s[NR]; f32x4 gq[4], bq[4];
#pragma unroll
    for (int j = 0; j < 4; ++j) { gq[j] = *((const f32x4*)g + lane + 64 * j); bq[j] = *((const f32x4*)b + lane + 64 * j); }
#pragma unroll
    for (int r = 0; r < NR; ++r) { s[r] = 0.f;
        if (IN_BF16) { const u32x2* xr = (const u32x2*)((const u16*)xbase_ + (r0 + r * rstride) * D) + lane;
#pragma unroll
            for (int j = 0; j < 4; ++j) { const u32x2 w = xr[64 * j]; v[r][j] = (f32x4){bf_lo(w.x), bf_hi(w.x), bf_lo(w.y), bf_hi(w.y)}; } }
        else { const f32x4* xr = (const f32x4*)((const float*)xbase_ + (r0 + r * rstride) * D) + lane;
#pragma unroll
            for (int j = 0; j < 4; ++j) { v[r][j] = xr[64 * j]; } } }
    __builtin_amdgcn_sched_barrier(0);
#pragma unroll
    for (int r = 0; r < NR; ++r)
#pragma unroll
        for (int j = 0; j < 4; ++j) s[r] += (v[r][j].x + v[r][j].y) + (v[r][j].z + v[r][j].w);
#pragma unroll
    for (int r = 0; r < NR; ++r) s[r] = wave_sum(s[r]);
    float s2[NR];
#pragma unroll
    for (int r = 0; r < NR; ++r) { const float mean = s[r] * (1.f / D); s2[r] = 0.f;
#pragma unroll
        for (int j = 0; j < 4; ++j) { v[r][j] = v[r][j] - mean; s2[r] += (v[r][j].x * v[r][j].x + v[r][j].y * v[r][j].y) + (v[r][j].z * v[r][j].z + v[r][j].w * v[r][j].w); } }
#pragma unroll
    for (int r = 0; r < NR; ++r) s2[r] = wave_sum(s2[r]);
#pragma unroll
    for (int j = 0; j < 4; ++j) { const f32x4 gg = gq[j], bb = bq[j];
#pragma unroll
        for (int r = 0; r < NR; ++r) { const float rstd = 1.f / sqrtf(s2[r] * (1.f / D) + LN_EPS); const f32x4 y = v[r][j] * rstd * gg + bb; const size_t row = r0 + r * rstride;
            if (OUT_BF16) { u32x2 w; w.x = cvt_pk_bf16(y[0], y[1]); w.y = cvt_pk_bf16(y[2], y[3]); *((u32x2*)((u16*)obase + row * D) + lane + 64 * j) = w; if (o8base) ((unsigned*)(o8base + row * D))[lane + 64 * j] = pk_fp8x4(y[0], y[1], y[2], y[3]); }
            else *((f32x4*)((float*)obase + row * D) + lane + 64 * j) = y; } }
}

__device__ __forceinline__ void phase_prologue(const Frame& F, const Args& a) {
    LAS float* scr = (LAS float*)(F.lds + F.wave * 16384);
    const int gw = F.vcu * NWAVES + F.wave, NGW = F.G * NWAVES;
    constexpr int NITEMS = 16 * 216 + 8 * 32 + 4 * 32 + 16 * 32 + 16 * 8 + 16 * 32 + 4 * 32;
    for (int it = gw; it < NITEMS; it += NGW) {
        int r = it;
        if (r < 16 * 216) { const int kb = r / 216, nb = r % 216; transpose_item_f8(a.in[2], NCOL, 64 * kb, 32 * nb, F.ws + WS_WIN, (size_t)32 * nb, 1024, W8_SCALE, scr, F.lane); continue; } r -= 16 * 216;
        if (r < 8 * 32) { const int kb = r / 32, nb = r % 32; transpose_item_f8(a.in[6], 1024, 64 * kb, 32 * nb, F.ws + WS_WBH, (size_t)32 * nb, 512, W8_SCALE, scr, F.lane); continue; } r -= 8 * 32;
        if (r < 4 * 32) { const int kb = r / 32, nb = r % 32; transpose_item_f8(a.in[7], 1024, 64 * kb, 32 * nb, F.ws + WS_WBA, (size_t)32 * nb, 256, W8_SCALE, scr, F.lane); continue; } r -= 4 * 32;
        if (r < 16 * 32) { const int kb = r / 32, nb = r % 32; transpose_item_f8(a.in[8], 1024, 64 * kb, 32 * nb, F.ws + WS_WO, (size_t)32 * nb, 1024, W8_SCALE, scr, F.lane); continue; } r -= 16 * 32;
        if (transpose_matrix_item(r, a.in[11], 1024, 256, (u16*)(F.ws + WS_WR), scr, F.lane)) continue;
        if (r < 16 * 32) { const int kb = r / 32, nb = r % 32; transpose_item_f8(a.in[21], 1024, 64 * kb, 32 * nb, F.ws + WS_WPG, (size_t)32 * nb, 1024, W8_SCALE, scr, F.lane); continue; } r -= 16 * 32;
        transpose_matrix_item(r, a.in[22], 256, 1024, (u16*)(F.ws + WS_WPP), scr, F.lane);
    }
    const size_t gt = (size_t)F.vcu * NTHR + F.tid, NGT = (size_t)F.G * NTHR;
    { const f32x4* x4 = (const f32x4*)a.in[0]; u32x4* o4 = (u32x4*)(F.ws + WS_XB);
      static_assert(((size_t)T * D / 16) % ((size_t)256 * NTHR * 4) == 0, "x conversion unroll");
      for (size_t i = gt; i < (size_t)T * D / 16; i += 4 * NGT) { f32x4 p[4][4];
#pragma unroll
          for (int u = 0; u < 4; ++u)
#pragma unroll
              for (int k = 0; k < 4; ++k) p[u][k] = x4[4 * (i + u * NGT) + k];
          __builtin_amdgcn_sched_barrier(0);
#pragma unroll
          for (int u = 0; u < 4; ++u) { u32x4 w; w.x = pk_fp8x4(p[u][0][0], p[u][0][1], p[u][0][2], p[u][0][3]); w.y = pk_fp8x4(p[u][1][0], p[u][1][1], p[u][1][2], p[u][1][3]); w.z = pk_fp8x4(p[u][2][0], p[u][2][1], p[u][2][2], p[u][2][3]); w.w = pk_fp8x4(p[u][3][0], p[u][3][1], p[u][3][2], p[u][3][3]); o4[i + u * NGT] = w; } } }
    { float* rot = (float*)(F.ws + WS_ROT);
      for (size_t i = gt; i < (size_t)SEQ * 8; i += NGT) {
          const int pos = (int)(i >> 3), fi = (int)(i & 7);
          const double invf = fi == 0 ? 1.0 : fi == 1 ? 0.19392274474868576 : fi == 2 ? 0.03760603093086393 : fi == 3 ? 0.007292664737217109 : fi == 4 ? 0.001414213562373095 : fi == 5 ? 0.0002742481756762073 : fi == 6 ? 5.318295896944988e-05 : 1.031338537721246e-05;
          const double ang = (double)pos * invf; const double kq = __builtin_rint(ang * 0.6366197723675814); const double r = ang - kq * 1.5707963267948966; const double r2 = r * r;
          const double sn = r * (1.0 + r2 * (-1.0 / 6 + r2 * (1.0 / 120 + r2 * (-1.0 / 5040 + r2 * (1.0 / 362880 + r2 * (-1.0 / 39916800 + r2 * (1.0 / 6227020800.0)))))));
          const double cs = 1.0 + r2 * (-0.5 + r2 * (1.0 / 24 + r2 * (-1.0 / 720 + r2 * (1.0 / 40320 + r2 * (-1.0 / 3628800 + r2 * (1.0 / 479001600.0))))));
          const int qd = ((int)kq) & 3; const double s_ = qd == 0 ? sn : qd == 1 ? cs : qd == 2 ? -sn : -cs; const double c_ = qd == 0 ? cs : qd == 1 ? -sn : qd == 2 ? -cs : sn;
          rot[pos * 16 + fi] = (float)c_; rot[pos * 16 + 8 + fi] = (float)s_; } }
    { float* lb = (float*)(F.ws + WS_LB);
      for (size_t i = gt; i < 1024; i += NGT) { const int c = (int)(i & 511); const float* src = (i < 512) ? a.in[3] : a.in[4]; lb[i] = 1.0f / (1.0f + expf(src[512 + c] - src[c])); } }
}

__device__ __forceinline__ void hgrn_item(const Frame& F, int item) {
    const int b = item >> 3, h = (item >> 1) & 3, dir = item & 1;
    LAS float* fb = (LAS float*)F.lds; LAS float* kb = fb + 2048; LAS float* qb = kb + 2048; LAS float* vb = qb + 2048; LAS float* op = vb + 2048;
    const int tid = F.tid, v = tid & 127, eg = tid >> 7, ls = tid >> 5, lc = (tid & 31) * 4;
    const u16* QH = (const u16*)(F.ws + Z_QH); const u16* VH = (const u16*)(F.ws + Z_VH); const u16* LF = (const u16*)(F.ws + (dir ? Z_LFB : Z_LFF));
#if DBG_CHECK && !USE_NAIVE_HGRN
    u16* O = (u16*)(F.ws + WS_XB + (dir ? 64 * MiB : 0));
#else
    u16* O = (u16*)(F.dout + (dir ? DO_OB : DO_OF));
#endif
    float S[32];
#pragma unroll
    for (int j = 0; j < 32; ++j) S[j] = 0.f;
    const size_t rowbase = (size_t)b * SEQ, colbase = (size_t)h * 128;
    u32x2 rq, rv, rl;
    { const int pos = dir ? (SEQ - 1 - ls) : ls; const size_t o = (rowbase + pos) * 512 + colbase + lc; rq = *(const u32x2*)(QH + o); rv = *(const u32x2*)(VH + o); rl = *(const u32x2*)(LF + o); }
    for (int blk = 0; blk < SEQ / 16; ++blk) {
        { const f32x4 lb4 = *(const f32x4*)((const float*)(F.ws + WS_LB) + dir * 512 + h * 128 + lc);
          const f32x4 f = {lb4[0] + (1.f - lb4[0]) * sigmoidf_(bf_lo(rl.x)), lb4[1] + (1.f - lb4[1]) * sigmoidf_(bf_hi(rl.x)), lb4[2] + (1.f - lb4[2]) * sigmoidf_(bf_lo(rl.y)), lb4[3] + (1.f - lb4[3]) * sigmoidf_(bf_hi(rl.y))}; const f32x4 k = {1.f - f[0], 1.f - f[1], 1.f - f[2], 1.f - f[3]};
          *(LAS f32x4*)(fb + ls * 128 + lc) = f; *(LAS f32x4*)(kb + ls * 128 + lc) = k;
          { f32x4 qq = {bf_lo(rq.x), bf_hi(rq.x), bf_lo(rq.y), bf_hi(rq.y)};
#pragma unroll
            for (int j = 0; j < 4; ++j) qq[j] *= sigmoidf_(qq[j]);
            *(LAS f32x4*)(qb + ls * 128 + lc) = qq; }
          *(LAS f32x4*)(vb + ls * 128 + lc) = (f32x4){bf_lo(rv.x), bf_hi(rv.x), bf_lo(rv.y), bf_hi(rv.y)}; }
        __syncthreads();
        if (blk + 1 < SEQ / 16) { const int t = (blk + 1) * 16 + ls; const int pos = dir ? (SEQ - 1 - t) : t; const size_t o = (rowbase + pos) * 512 + colbase + lc; rq = *(const u32x2*)(QH + o); rv = *(const u32x2*)(VH + o); rl = *(const u32x2*)(LF + o); }
#pragma unroll 2
        for (int s = 0; s < 16; ++s) {
            const float vm = vb[s * 128 + v]; float ac = 0.f;
#pragma unroll
            for (int jj = 0; jj < 8; ++jj) {
                const f32x4 f4 = *(const LAS f32x4*)(fb + s * 128 + eg * 32 + 4 * jj), k4 = *(const LAS f32x4*)(kb + s * 128 + eg * 32 + 4 * jj), q4 = *(const LAS f32x4*)(qb + s * 128 + eg * 32 + 4 * jj);
#pragma unroll
                for (int j = 0; j < 4; ++j) { S[4 * jj + j] = f4[j] * S[4 * jj + j] + k4[j] * vm; ac += S[4 * jj + j] * q4[j]; }
            }
            op[(s * 4 + eg) * 128 + v] = ac;
        }
        __syncthreads();
        { const f32x4 o = *(const LAS f32x4*)(op + (ls * 4 + 0) * 128 + lc) + *(const LAS f32x4*)(op + (ls * 4 + 1) * 128 + lc) + *(const LAS f32x4*)(op + (ls * 4 + 2) * 128 + lc) + *(const LAS f32x4*)(op + (ls * 4 + 3) * 128 + lc);
          const int t = blk * 16 + ls; const int pos = dir ? (SEQ - 1 - t) : t; u32x2 w; w.x = cvt_pk_bf16(o[0], o[1]); w.y = cvt_pk_bf16(o[2], o[3]);
          *(u32x2*)(O + (rowbase + pos) * 512 + colbase + lc) = w; }
    }
    __syncthreads();
}

__device__ __forceinline__ void attn_naive(const Frame& F) {
    const int gw = F.vcu * NWAVES + F.wave, NGW = F.G * NWAVES, lane = F.lane;
    const u16* AQ = (const u16*)(F.ws + Z_AQ); const u16* AK = (const u16*)(F.ws + Z_AK); const u16* AV = (const u16*)(F.ws + Z_AV); u16* YA = (u16*)(F.ws + WS_YA);
    for (int wi = gw; wi < T * 4; wi += NGW) {
        const int row = wi >> 2, s = wi & 3, b = row >> 11, p = row & (SEQ - 1);
        float sc[3][3]; int lo_[3], hi_[3];
#pragma unroll
        for (int g = 0; g < 3; ++g) {
            const int sh = 2 * g, mlen = SEQ >> sh, r = p & ((1 << sh) - 1), m = p >> sh; const int lo = m - 64 < 0 ? 0 : m - 64, hi = m + 64 > mlen - 1 ? mlen - 1 : m + 64; lo_[g] = lo; hi_[g] = hi;
            const int hd = g * 4 + s;
            u32x4 qw[8];
            { const u32x4* qp = (const u32x4*)(AQ + (size_t)row * 768 + hd * 64);
#pragma unroll
              for (int c = 0; c < 8; ++c) qw[c] = qp[c]; }
#pragma unroll
            for (int rr = 0; rr < 3; ++rr) {
                const int j = lo + rr * 64 + lane; const bool valid = j <= hi; const int jc = valid ? j : hi;
                const u32x4* kp = (const u32x4*)(AK + ((size_t)b * SEQ + r + ((size_t)jc << sh)) * 768 + hd * 64);
                float d = 0.f;
#pragma unroll
                for (int c = 0; c < 8; ++c) { const u32x4 w = kp[c]; const u32x4 q = qw[c]; d += bf_lo(q.x) * bf_lo(w.x) + bf_hi(q.x) * bf_hi(w.x) + bf_lo(q.y) * bf_lo(w.y) + bf_hi(q.y) * bf_hi(w.y) + bf_lo(q.z) * bf_lo(w.z) + bf_hi(q.z) * bf_hi(w.z) + bf_lo(q.w) * bf_lo(w.w) + bf_hi(q.w) * bf_hi(w.w); }
                sc[g][rr] = valid ? d : -1e30f;
                asm volatile("" : "+v"(sc[g][rr]) :: "memory");
            }
        }
        float mx = -1e30f;
#pragma unroll
        for (int g = 0; g < 3; ++g)
#pragma unroll
            for (int rr = 0; rr < 3; ++rr) mx = fmaxf(mx, sc[g][rr]);
        mx = wave_max(mx);
        float den = 0.f;
#pragma unroll
        for (int g = 0; g < 3; ++g)
#pragma unroll
            for (int rr = 0; rr < 3; ++rr) { sc[g][rr] = sc[g][rr] > -1e29f ? __expf(sc[g][rr] - mx) : 0.f; den += sc[g][rr]; }
        den = wave_sum(den);
        float o = 0.f;
#pragma unroll
        for (int g = 0; g < 3; ++g) {
            const int sh = 2 * g, r = p & ((1 << sh) - 1), hd = g * 4 + s; const u16* vp = AV + ((size_t)b * SEQ + r) * 768 + hd * 64 + lane;
#pragma unroll
            for (int rr = 0; rr < 3; ++rr) {
                const int j0 = lo_[g] + rr * 64; int cnt = hi_[g] - j0 + 1; cnt = cnt > 64 ? 64 : cnt;
                const float e = sc[g][rr];
#pragma unroll 4
                for (int jj = 0; jj < cnt; ++jj) { const float pj = __uint_as_float(__builtin_amdgcn_readlane(__float_as_uint(e), jj)); o += pj * bf1(vp[((size_t)(j0 + jj) << sh) * 768]); }
            }
        }
        o = o / den;
        const float on = __shfl_down(o, 1);
        if ((lane & 1) == 0) *(unsigned*)(YA + (size_t)row * 256 + s * 64 + lane) = cvt_pk_bf16(o, on);
    }
}


typedef float f32x16 __attribute__((ext_vector_type(16)));
constexpr size_t DO_OP = 128 * MiB, DO_ML = 224 * MiB;
__device__ __forceinline__ bf16x8 pack_pt(const f32x16& x, const int s) {
    u32x4 p;
    asm volatile("v_cvt_pk_bf16_f32 %0, %4, %5\n\tv_cvt_pk_bf16_f32 %1, %6, %7\n\tv_cvt_pk_bf16_f32 %2, %8, %9\n\tv_cvt_pk_bf16_f32 %3, %10, %11\n\ts_nop 1"
                 : "=&v"(p[0]), "=&v"(p[1]), "=&v"(p[2]), "=&v"(p[3])
                 : "v"(x[8 * s]), "v"(x[8 * s + 1]), "v"(x[8 * s + 2]), "v"(x[8 * s + 3]), "v"(x[8 * s + 4]), "v"(x[8 * s + 5]), "v"(x[8 * s + 6]), "v"(x[8 * s + 7]));
    return __builtin_bit_cast(bf16x8, p);
}
__device__ __forceinline__ void attn_mfma(const Frame& F) {
    const int lane = F.lane, c = lane & 31, h = lane >> 5;
    LAS unsigned char* vbuf = F.lds + F.wave * 4608;
    const unsigned vb_addr = (unsigned)(size_t)vbuf;
    const u16* AQ = (const u16*)(F.ws + Z_AQ); const u16* AK = (const u16*)(F.ws + Z_AK); const u16* AV = (const u16*)(F.ws + Z_AV);
    u16* OP = (u16*)(F.dout + DO_OP); float* ML = (float*)(F.dout + DO_ML);
    const int gw = F.vcu * NWAVES + F.wave, NGW = F.G * NWAVES;
    const int blk = (lane >> 4) & 1, q4 = (lane & 15) >> 2, p4 = lane & 3;
    for (int it = gw; it < 32 * 12 * 64; it += NGW) {
        const int x = it & 63, bh = it >> 6, hd = bh % 12, b = bh / 12, g = hd >> 2, sh = 2 * g;
        const int nqb = 64 >> sh, r = x >> (6 - sh), qb = x & (nqb - 1), mlen = SEQ >> sh, m0 = qb * 32;
        const size_t rowb = (size_t)b * SEQ + r;
        const size_t qrow = rowb + ((size_t)(m0 + c) << sh);
        bf16x8 qf[4];
#pragma unroll
        for (int s = 0; s < 4; ++s) qf[s] = *(const bf16x8*)(AQ + qrow * 768 + hd * 64 + 16 * s + 8 * h);
        f32x16 st[5];
        bf16x8 kf[5][4];
#pragma unroll
        for (int kb = 0; kb < 5; ++kb) {
            int mk = m0 - 64 + 32 * kb + c; mk = mk < 0 ? 0 : (mk > mlen - 1 ? mlen - 1 : mk);
            const u16* kp = AK + (rowb + ((size_t)mk << sh)) * 768 + hd * 64 + 8 * h;
#pragma unroll
            for (int s = 0; s < 4; ++s) kf[kb][s] = *(const bf16x8*)(kp + 16 * s);
        }
        __builtin_amdgcn_sched_barrier(0);
#pragma unroll
        for (int kb = 0; kb < 5; ++kb) {
            f32x16 acc;
#pragma unroll
            for (int i = 0; i < 16; ++i) acc[i] = 0.f;
#pragma unroll
            for (int s = 0; s < 4; ++s) acc = __builtin_amdgcn_mfma_f32_32x32x16_bf16(kf[kb][s], qf[s], acc, 0, 0, 0);
            st[kb] = acc;
        }
        float mx = -1e30f;
#pragma unroll
        for (int kb = 0; kb < 5; ++kb)
#pragma unroll
            for (int i = 0; i < 16; ++i) { const int rel = 32 * kb - 64 + ((i & 3) + 8 * (i >> 2) + 4 * h) - c; const int key = m0 + c + rel; const bool valid = (key >= 0) && (key < mlen) && (rel >= -64) && (rel <= 64);
                const float v = valid ? st[kb][i] : -1e30f; st[kb][i] = v; mx = fmaxf(mx, v); }
        mx = fmaxf(mx, __shfl_xor(mx, 32));
        float l = 0.f;
#pragma unroll
        for (int kb = 0; kb < 5; ++kb)
#pragma unroll
            for (int i = 0; i < 16; ++i) { const float p = st[kb][i] > -1e29f ? __expf(st[kb][i] - mx) : 0.f; st[kb][i] = p; l += p; }
        l += __shfl_xor(l, 32);
        f32x16 y0, y1;
#pragma unroll
        for (int i = 0; i < 16; ++i) { y0[i] = 0.f; y1[i] = 0.f; }
        u32x4 vr[4];
#define LOADV(kb_) _Pragma("unroll") for (int i4 = 0; i4 < 4; ++i4) { const int row = (lane >> 3) + 8 * i4; int mk = m0 - 64 + 32 * (kb_) + row; mk = mk < 0 ? 0 : (mk > mlen - 1 ? mlen - 1 : mk); \
            vr[i4] = *(const u32x4*)(AV + (rowb + ((size_t)mk << sh)) * 768 + hd * 64 + (lane & 7) * 8); }
        LOADV(0)
#pragma unroll
        for (int kb = 0; kb < 5; ++kb) {
#pragma unroll
            for (int i4 = 0; i4 < 4; ++i4) { const int row = (lane >> 3) + 8 * i4; *(LAS u32x4*)(vbuf + row * 144 + (lane & 7) * 16) = vr[i4]; }
            if (kb < 4) { LOADV(kb + 1) }
            asm volatile("s_waitcnt lgkmcnt(0)" ::: "memory");
            u32x2 tq[2][4];
#pragma unroll
            for (int s = 0; s < 2; ++s) {
                const unsigned a0 = vb_addr + 144u * (unsigned)(16 * s + 4 * h + q4) + 2u * (unsigned)(16 * blk + 4 * p4);
                asm volatile("ds_read_b64_tr_b16 %0, %4\n\tds_read_b64_tr_b16 %1, %4 offset:1152\n\tds_read_b64_tr_b16 %2, %4 offset:64\n\tds_read_b64_tr_b16 %3, %4 offset:1216"
                             : "=&v"(tq[s][0]), "=&v"(tq[s][1]), "=&v"(tq[s][2]), "=&v"(tq[s][3]) : "v"(a0) : "memory");
            }
            asm volatile("s_waitcnt lgkmcnt(0)" : "+v"(tq[0][0]), "+v"(tq[0][1]), "+v"(tq[0][2]), "+v"(tq[0][3]), "+v"(tq[1][0]), "+v"(tq[1][1]), "+v"(tq[1][2]), "+v"(tq[1][3]) :: "memory");
#pragma unroll
            for (int s = 0; s < 2; ++s) {
                const bf16x8 xs = pack_pt(st[kb], s);
                u32x4 vv0, vv1; vv0.x = tq[s][0].x; vv0.y = tq[s][0].y; vv0.z = tq[s][1].x; vv0.w = tq[s][1].y; vv1.x = tq[s][2].x; vv1.y = tq[s][2].y; vv1.z = tq[s][3].x; vv1.w = tq[s][3].y;
                y0 = __builtin_amdgcn_mfma_f32_32x32x16_bf16(__builtin_bit_cast(bf16x8, vv0), xs, y0, 0, 0, 0);
                y1 = __builtin_amdgcn_mfma_f32_32x32x16_bf16(__builtin_bit_cast(bf16x8, vv1), xs, y1, 0, 0, 0);
            }
        }
#undef LOADV
        const float inv = 1.0f / l;
        u16* op = OP + qrow * 768 + hd * 64 + 4 * h;
#pragma unroll
        for (int gq = 0; gq < 4; ++gq) {
            u32x2 w0, w1; w0.x = cvt_pk_bf16(y0[4 * gq] * inv, y0[4 * gq + 1] * inv); w0.y = cvt_pk_bf16(y0[4 * gq + 2] * inv, y0[4 * gq + 3] * inv);
            w1.x = cvt_pk_bf16(y1[4 * gq] * inv, y1[4 * gq + 1] * inv); w1.y = cvt_pk_bf16(y1[4 * gq + 2] * inv, y1[4 * gq + 3] * inv);
            *(u32x2*)(op + 8 * gq) = w0; *(u32x2*)(op + 32 + 8 * gq) = w1; }
        if (h == 0) ML[qrow * 12 + hd] = mx + __logf(l);
    }
}


constexpr int HT_STRIDE = 272, HT_BYTES = 64 * HT_STRIDE;
constexpr int HL_QS = 0, HL_KS = HT_BYTES, HL_QIN = 2 * HT_BYTES, HL_KOUT = 3 * HT_BYTES, HL_V = 4 * HT_BYTES, HL_PSUM = 5 * HT_BYTES, HL_D = HL_PSUM + 4096;
#define TR2(dst0, dst1, addr, off1) asm volatile("ds_read_b64_tr_b16 %0, %2\n\tds_read_b64_tr_b16 %1, %2 offset:" #off1 "\n\ts_waitcnt lgkmcnt(0)" : "=&v"(dst0), "=&v"(dst1) : "v"(addr) : "memory")
__device__ __forceinline__ void hgrn_mfma_item(const Frame& F, int item, u16* OFp, u16* OBp) {
    const int b = item >> 3, hh = (item >> 1) & 3, dir = item & 1;
    const int tid = F.tid, lane = F.lane, wave = F.wave, vj = wave & 3, ci = wave >> 2, c = lane & 31, h = lane >> 5;
    const int blk = (lane >> 4) & 1, q4 = (lane & 15) >> 2, p4 = lane & 3;
    LAS unsigned char* L = F.lds; const unsigned Lb = (unsigned)(size_t)L;
    const int e2 = 2 * (tid & 63), part = tid >> 6;
    const u16* QH = (const u16*)(F.ws + Z_QH); const u16* VH = (const u16*)(F.ws + Z_VH); const u16* LF = (const u16*)(F.ws + (dir ? Z_LFB : Z_LFF));
    u16* O = dir ? OBp : OFp;
    const size_t rowbase = (size_t)b * SEQ, colbase = (size_t)hh * 128;
    f32x16 S[4];
#pragma unroll
    for (int et = 0; et < 4; ++et)
#pragma unroll
        for (int i = 0; i < 16; ++i) S[et][i] = 0.f;
    const f32x2 lbv = *(const f32x2*)((const float*)(F.ws + WS_LB) + dir * 512 + hh * 128 + e2);
    unsigned rq[8], rv[8], rl[8];
#pragma unroll
    for (int j = 0; j < 8; ++j) { const int tt = part * 8 + j; const int pos = dir ? (SEQ - 1 - tt) : tt; const size_t o = (rowbase + pos) * 512 + colbase + e2; rq[j] = *(const u16*)((const unsigned char*)QH + o); rv[j] = *(const u16*)((const unsigned char*)VH + o); rl[j] = *(const unsigned*)(LF + o); }
    for (int chunk = 0; chunk < SEQ / 64; ++chunk) {
        float bl0[8], bl1[8], fk0[8], fk1[8]; float r0 = 0.f, r1 = 0.f;
#pragma unroll
        for (int j = 0; j < 8; ++j) { const float f0 = lbv.x + (1.f - lbv.x) * sigmoidf_(bf_lo(rl[j])), f1 = lbv.y + (1.f - lbv.y) * sigmoidf_(bf_hi(rl[j])); fk0[j] = 1.f - f0; fk1[j] = 1.f - f1; r0 += __logf(f0); r1 += __logf(f1); bl0[j] = r0; bl1[j] = r1; }
        *(LAS f32x2*)(L + HL_PSUM + (part * 128 + e2) * 4) = (f32x2){r0, r1};
        __syncthreads();
        float offs0 = 0.f, offs1 = 0.f, bref0 = 0.f, bref1 = 0.f, blast0 = 0.f, blast1 = 0.f;
#pragma unroll
        for (int pp = 0; pp < 8; ++pp) { const f32x2 t = *(const LAS f32x2*)(L + HL_PSUM + (pp * 128 + e2) * 4); if (pp < part) { offs0 += t.x; offs1 += t.y; } if (pp < 4) { bref0 += t.x; bref1 += t.y; } blast0 += t.x; blast1 += t.y; }
        const float Cr0 = __expf(bref0), Cr1 = __expf(bref1), Cl0 = __expf(blast0 - bref0), Cl1 = __expf(blast1 - bref1);
        if (part == 0) *(LAS f32x2*)(L + HL_D + e2 * 4) = (f32x2){__expf(blast0), __expf(blast1)};
#pragma unroll
        for (int j = 0; j < 8; ++j) {
            const int t = part * 8 + j; const unsigned a = (unsigned)(t * HT_STRIDE + e2 * 2);
            const float E0 = __expf(offs0 + bl0[j] - bref0), E1 = __expf(offs1 + bl1[j] - bref1); const float R0 = __builtin_amdgcn_rcpf(E0), R1 = __builtin_amdgcn_rcpf(E1);
            const f32x2_t qq_ = __builtin_amdgcn_cvt_pk_f32_fp8((int)rq[j], false), vv_ = __builtin_amdgcn_cvt_pk_f32_fp8((int)rv[j], false);
            float q0 = qq_.x, q1 = qq_.y; q0 *= sigmoidf_(q0); q1 *= sigmoidf_(q1); const float k0 = fk0[j], k1 = fk1[j];
            *(LAS unsigned*)(L + HL_QS + a) = cvt_pk_bf16(q0 * E0, q1 * E1);
            *(LAS unsigned*)(L + HL_KS + a) = cvt_pk_bf16(k0 * R0, k1 * R1);
            *(LAS unsigned*)(L + HL_QIN + a) = cvt_pk_bf16(q0 * E0 * Cr0, q1 * E1 * Cr1);
            *(LAS unsigned*)(L + HL_KOUT + a) = cvt_pk_bf16(k0 * R0 * Cl0, k1 * R1 * Cl1);
            *(LAS unsigned*)(L + HL_V + a) = cvt_pk_bf16(vv_.x, vv_.y);
        }
        __syncthreads();
        if (chunk + 1 < SEQ / 64) {
#pragma unroll
            for (int j = 0; j < 8; ++j) { const int tt = (chunk + 1) * 64 + part * 8 + j; const int pos = dir ? (SEQ - 1 - tt) : tt; const size_t o = (rowbase + pos) * 512 + colbase + e2; rq[j] = *(const u16*)((const unsigned char*)QH + o); rv[j] = *(const u16*)((const unsigned char*)VH + o); rl[j] = *(const unsigned*)(LF + o); }
        }
        f32x16 z;
#pragma unroll
        for (int i = 0; i < 16; ++i) z[i] = 0.f;
#pragma unroll
        for (int et = 0; et < 4; ++et)
#pragma unroll
            for (int st = 0; st < 2; ++st) {
                const bf16x8 A = pack_pt(S[et], st);
                const LAS unsigned char* qp = L + HL_QIN + (32 * ci + c) * HT_STRIDE + (32 * et + 16 * st + 4 * h) * 2;
                const u32x2 lo = *(const LAS u32x2*)qp, hi = *(const LAS u32x2*)(qp + 16);
                u32x4 bb; bb.x = lo.x; bb.y = lo.y; bb.z = hi.x; bb.w = hi.y;
                z = __builtin_amdgcn_mfma_f32_32x32x16_bf16(A, __builtin_bit_cast(bf16x8, bb), z, 0, 0, 0);
            }
#pragma unroll
        for (int stile = 0; stile < 2; ++stile) {
            if (stile <= ci) {
                f32x16 pt;
#pragma unroll
                for (int i = 0; i < 16; ++i) pt[i] = 0.f;
#pragma unroll
                for (int ek = 0; ek < 8; ++ek) {
                    const bf16x8 A = *(const LAS bf16x8*)(L + HL_KS + (32 * stile + c) * HT_STRIDE + (16 * ek + 8 * h) * 2);
                    const bf16x8 B = *(const LAS bf16x8*)(L + HL_QS + (32 * ci + c) * HT_STRIDE + (16 * ek + 8 * h) * 2);
                    pt = __builtin_amdgcn_mfma_f32_32x32x16_bf16(A, B, pt, 0, 0, 0);
                }
#pragma unroll
                for (int i = 0; i < 16; ++i) { const int srow = 32 * stile + (i & 3) + 8 * (i >> 2) + 4 * h; pt[i] = (srow <= 32 * ci + c) ? pt[i] : 0.f; }
#pragma unroll
                for (int st = 0; st < 2; ++st) {
                    const bf16x8 Bp = pack_pt(pt, st);
                    u32x2 t0, t1; const unsigned a0 = Lb + HL_V + (unsigned)((32 * stile + 16 * st + 4 * h + q4) * HT_STRIDE + (32 * vj + 16 * blk + 4 * p4) * 2);
                    TR2(t0, t1, a0, 2176);
                    u32x4 av; av.x = t0.x; av.y = t0.y; av.z = t1.x; av.w = t1.y;
                    z = __builtin_amdgcn_mfma_f32_32x32x16_bf16(__builtin_bit_cast(bf16x8, av), Bp, z, 0, 0, 0);
                }
            }
        }
        { const int tt = chunk * 64 + 32 * ci + c; const int pos = dir ? (SEQ - 1 - tt) : tt; u16* op = O + (rowbase + pos) * 512 + colbase + 32 * vj + 4 * h;
#pragma unroll
          for (int gq = 0; gq < 4; ++gq) { u32x2 w; w.x = cvt_pk_bf16(z[4 * gq], z[4 * gq + 1]); w.y = cvt_pk_bf16(z[4 * gq + 2], z[4 * gq + 3]); *(u32x2*)(op + 8 * gq) = w; } }
        bf16x8 Vb[4];
#pragma unroll
        for (int tk = 0; tk < 4; ++tk) { u32x2 t0, t1; const unsigned a0 = Lb + HL_V + (unsigned)((16 * tk + 8 * h + q4) * HT_STRIDE + (32 * vj + 16 * blk + 4 * p4) * 2);
            TR2(t0, t1, a0, 1088);
            u32x4 bv; bv.x = t0.x; bv.y = t0.y; bv.z = t1.x; bv.w = t1.y; Vb[tk] = __builtin_bit_cast(bf16x8, bv); }
#pragma unroll
        for (int et = 0; et < 4; ++et) {
#pragma unroll
            for (int gq = 0; gq < 4; ++gq) { const f32x4 dv = *(const LAS f32x4*)(L + HL_D + (32 * et + 8 * gq + 4 * h) * 4);
#pragma unroll
                for (int e = 0; e < 4; ++e) S[et][4 * gq + e] *= dv[e]; }
#pragma unroll
            for (int tk = 0; tk < 4; ++tk) { u32x2 t0, t1; const unsigned a0 = Lb + HL_KOUT + (unsigned)((16 * tk + 8 * h + q4) * HT_STRIDE + (32 * et + 16 * blk + 4 * p4) * 2);
                TR2(t0, t1, a0, 1088);
                u32x4 ak; ak.x = t0.x; ak.y = t0.y; ak.z = t1.x; ak.w = t1.y;
                S[et] = __builtin_amdgcn_mfma_f32_32x32x16_bf16(__builtin_bit_cast(bf16x8, ak), Vb[tk], S[et], 0, 0, 0); }
        }
    }
    __syncthreads();
}

__device__ __forceinline__ void phase_hg_combine(const Frame& F, const Args& a) {
    const int gw = F.vcu * NWAVES + F.wave, NGW = F.G * NWAVES, lane = F.lane;
    const u16* OF = (const u16*)(F.dout + DO_OF); const u16* OB = (const u16*)(F.dout + DO_OB); const u16* GS = (const u16*)(F.ws + Z_GS); u16* YH = (u16*)(F.ws + WS_YH);
    const u16* OP = (const u16*)(F.dout + DO_OP); const float* ML = (const float*)(F.dout + DO_ML); u16* YA = (u16*)(F.ws + WS_YA);
    const f32x4 ng0 = *(const f32x4*)(a.in[5] + 8 * lane), ng1 = *(const f32x4*)(a.in[5] + 8 * lane + 4);
    const int sl = lane >> 4, dd = (4 * lane) & 63;
    constexpr int NR = 4;
    for (int row0 = gw; row0 < T; row0 += NR * NGW) {
        u32x4 fv[NR], bv[NR]; u32x2 gv[NR], av[NR][3]; float lv[NR][3];
#pragma unroll
        for (int r = 0; r < NR; ++r) { const int row = row0 + r * NGW; const size_t o = (size_t)row * 512 + 8 * lane;
            fv[r] = *(const u32x4*)(OF + o); bv[r] = *(const u32x4*)(OB + o); gv[r] = *(const u32x2*)((const unsigned char*)GS + o);
#pragma unroll
            for (int k = 0; k < 3; ++k) { lv[r][k] = ML[(size_t)row * 12 + 4 * k + sl]; av[r][k] = *(const u32x2*)(OP + (size_t)row * 768 + (4 * k + sl) * 64 + dd); } }
        __builtin_amdgcn_sched_barrier(0);
#pragma unroll
        for (int r = 0; r < NR; ++r) { const int row = row0 + r * NGW; const size_t o = (size_t)row * 512 + 8 * lane;
            const u32x4 f = fv[r], bq = bv[r]; const u32x2 g = gv[r];
            float v[8] = {bf_lo(f.x) + bf_lo(bq.x), bf_hi(f.x) + bf_hi(bq.x), bf_lo(f.y) + bf_lo(bq.y), bf_hi(f.y) + bf_hi(bq.y), bf_lo(f.z) + bf_lo(bq.z), bf_hi(f.z) + bf_hi(bq.z), bf_lo(f.w) + bf_lo(bq.w), bf_hi(f.w) + bf_hi(bq.w)};
            float ss = 0.f;
#pragma unroll
            for (int j = 0; j < 8; ++j) ss += v[j] * v[j];
            ss += __int_as_float(__builtin_amdgcn_update_dpp(0, __float_as_int(ss), 0xB1, 0xF, 0xF, true)); ss += __int_as_float(__builtin_amdgcn_update_dpp(0, __float_as_int(ss), 0x4E, 0xF, 0xF, true));
            ss += __int_as_float(__builtin_amdgcn_update_dpp(0, __float_as_int(ss), 0x141, 0xF, 0xF, true)); ss += __int_as_float(__builtin_amdgcn_update_dpp(0, __float_as_int(ss), 0x140, 0xF, 0xF, true));
            const float rs = 1.0f / sqrtf(ss * (1.f / 128.f) + LN_EPS);
            float gg[8]; { float t0[4], t1[4]; fp8x4_to_f32(g.x, t0); fp8x4_to_f32(g.y, t1);
#pragma unroll
              for (int j = 0; j < 4; ++j) { gg[j] = t0[j]; gg[4 + j] = t1[j]; } }
#pragma unroll
            for (int j = 0; j < 8; ++j) gg[j] *= sigmoidf_(gg[j]);
            u32x2 w; w.x = pk_fp8x4(v[0] * rs * ng0[0] * gg[0], v[1] * rs * ng0[1] * gg[1], v[2] * rs * ng0[2] * gg[2], v[3] * rs * ng0[3] * gg[3]);
            w.y = pk_fp8x4(v[4] * rs * ng1[0] * gg[4], v[5] * rs * ng1[1] * gg[5], v[6] * rs * ng1[2] * gg[6], v[7] * rs * ng1[3] * gg[7]);
            *(u32x2*)((unsigned char*)YH + o) = w;
            const float l0 = lv[r][0], l1 = lv[r][1], l2 = lv[r][2];
            const float lm = fmaxf(l0, fmaxf(l1, l2)); float w0 = __expf(l0 - lm), w1 = __expf(l1 - lm), w2 = __expf(l2 - lm); const float ws_ = 1.0f / (w0 + w1 + w2); w0 *= ws_; w1 *= ws_; w2 *= ws_;
            const u32x2 a0 = av[r][0], a1 = av[r][1], a2 = av[r][2];
            const unsigned wv = pk_fp8x4(w0 * bf_lo(a0.x) + w1 * bf_lo(a1.x) + w2 * bf_lo(a2.x), w0 * bf_hi(a0.x) + w1 * bf_hi(a1.x) + w2 * bf_hi(a2.x), w0 * bf_lo(a0.y) + w1 * bf_lo(a1.y) + w2 * bf_lo(a2.y), w0 * bf_hi(a0.y) + w1 * bf_hi(a1.y) + w2 * bf_hi(a2.y));
            *(unsigned*)((unsigned char*)YA + (size_t)row * 256 + 4 * lane) = wv;
        }
    }
}

template <bool DO_LN, bool DO_CONV> __device__ __forceinline__ void phase_ln1_convert(const Frame& F, const Args& a, int part = 0, int nparts = 1) {
    const int gw = F.vcu * NWAVES + F.wave, NGW = F.G * NWAVES;
    const float* X1 = (const float*)(F.ws + WS_X1PRE); u16* X1B = (u16*)(F.ws + WS_XB);
    if constexpr (DO_LN)
    for (int row = gw; row < T; row += 4 * NGW) ln_rows<true, 4, true>(X1, (size_t)row, (size_t)NGW, a.in[9], a.in[10], X1B, F.lane, F.ws + WS_X1F8);
    if constexpr (!DO_CONV) return;
    LAS float* scr = (LAS float*)(F.lds + F.wave * 16384);
    unsigned char* WGU = F.ws + WS_WGU; unsigned char* WD = F.ws + WS_WD;
    constexpr int PER_E = 384, NIT = 257 * PER_E;
    const int lane = F.lane;
#define CV_DECODE(it_, sp_, ldw_, dp_, kd_) { const int e = (it_) / PER_E, r = (it_) % PER_E; const int which = r >> 7, q = r & 127; \
        if (which < 2) { const float* src = (e < 256) ? a.in[13 + which] + (size_t)e * 1024 * 256 : a.in[16 + which]; const int kb = q >> 3, nb = q & 7; ldw_ = 256; kd_ = 1024; \
            sp_ = src + (size_t)(64 * kb + (lane >> 5)) * 256 + 32 * nb + (lane & 31); dp_ = WGU + ((size_t)e * 512 + (nb >> 2) * 256 + which * 128 + (nb & 3) * 32) * 1024 + 64 * kb; } \
        else { const float* src = (e < 256) ? a.in[15] + (size_t)e * 256 * 1024 : a.in[18]; const int kb = q >> 5, nb = q & 31; ldw_ = 1024; kd_ = 256; \
            sp_ = src + (size_t)(64 * kb + (lane >> 5)) * 1024 + 32 * nb + (lane & 31); dp_ = WD + ((size_t)e * 1024 + 32 * nb) * 256 + 64 * kb; } }
#define CV_LOAD(tv_, sp_, ldw_) { _Pragma("unroll") for (int i = 0; i < 32; ++i) tv_[i] = sp_[(size_t)(2 * i) * ldw_]; }
#define CV_FINISH(tv_, dp_, kd_) { _Pragma("unroll") for (int i = 0; i < 32; ++i) scr[(2 * i + (lane >> 5)) * 33 + (lane & 31)] = tv_[i]; \
        LDS_WAIT(); asm volatile("" ::: "memory"); const int c = lane & 7; \
        _Pragma("unroll") for (int j = 0; j < 4; ++j) { const int n = (lane >> 3) + 8 * j; const LAS float* sp = scr + (8 * c) * 33 + n; \
            u32x2 o; o.x = pk_fp8x4(sp[0 * 33] * W8_SCALE, sp[1 * 33] * W8_SCALE, sp[2 * 33] * W8_SCALE, sp[3 * 33] * W8_SCALE); o.y = pk_fp8x4(sp[4 * 33] * W8_SCALE, sp[5 * 33] * W8_SCALE, sp[6 * 33] * W8_SCALE, sp[7 * 33] * W8_SCALE); \
            *(u32x2*)(dp_ + (size_t)n * kd_ + 8 * c) = o; } \
        LDS_WAIT(); asm volatile("" ::: "memory"); }
    float tva[32], tvb[32]; const float* spa = nullptr; const float* spb = nullptr; unsigned char* dpa = nullptr; unsigned char* dpb = nullptr; int lda = 0, ldb = 0, kda = 0, kdb = 0;
    const int step = nparts * NGW; int it = gw + part * NGW;
    if (it < NIT) { CV_DECODE(it, spa, lda, dpa, kda) CV_LOAD(tva, spa, lda) }
    for (; it < NIT; it += 2 * step) {
        const bool hb = it + step < NIT, ha = it + 2 * step < NIT;
        if (hb) { CV_DECODE(it + step, spb, ldb, dpb, kdb) CV_LOAD(tvb, spb, ldb) }
        CV_FINISH(tva, dpa, kda)
        if (ha) { CV_DECODE(it + 2 * step, spa, lda, dpa, kda) CV_LOAD(tva, spa, lda) }
        if (hb) CV_FINISH(tvb, dpb, kdb)
    }
#undef CV_DECODE
#undef CV_LOAD
#undef CV_FINISH
}

__device__ __forceinline__ void phase_topk(const Frame& F, const Args& a) {
    LAS int* hist = (LAS int*)F.lds;
    for (int i = F.tid; i < 8 * 256; i += NTHR) hist[i] = 0;
    __syncthreads();
    const int w = F.vcu, lane = F.lane;
    const float* logits = (const float*)(F.ws + WS_LOGITS); u16* tok_e = (u16*)(F.ws + WS_TOKE); u16* tok_r = (u16*)(F.ws + WS_TOKR); float* tok_g = (float*)(F.ws + WS_TOKG);
    const f32x4 bs = *(const f32x4*)(a.in[12] + 4 * lane);
    constexpr int TB = 4;
    for (int i0 = 0; i0 < 32; i0 += TB) {
        float s0[TB], s1[TB], s2[TB], s3[TB], v0[TB], v1[TB], v2[TB], v3[TB], my_s[TB]; int my_e[TB];
        const float NINF = -__builtin_inff();
        { float b0[TB], b1[TB], b2[TB], b3[TB], m1[TB], m2[TB], gs[TB]; int rank[TB];
#pragma unroll
          for (int u = 0; u < TB; ++u) { const int t = w * 256 + F.wave * 32 + i0 + u; const f32x4 lg = *(const f32x4*)(logits + (size_t)t * 256 + 4 * lane);
              s0[u] = sigmoidf_(lg[0]); s1[u] = sigmoidf_(lg[1]); s2[u] = sigmoidf_(lg[2]); s3[u] = sigmoidf_(lg[3]);
              b0[u] = s0[u] + bs[0]; b1[u] = s1[u] + bs[1]; b2[u] = s2[u] + bs[2]; b3[u] = s3[u] + bs[3];
              const float h01 = fmaxf(b0[u], b1[u]), l01 = fminf(b0[u], b1[u]), h23 = fmaxf(b2[u], b3[u]), l23 = fminf(b2[u], b3[u]);
              m1[u] = fmaxf(h01, h23); m2[u] = fmaxf(fminf(h01, h23), fmaxf(l01, l23)); }
#define TOP2_STEP(CTRL) _Pragma("unroll") for (int u = 0; u < TB; ++u) { const float p1 = dpp_f<CTRL>(m1[u]), p2 = dpp_f<CTRL>(m2[u]); const float n1 = fmaxf(m1[u], p1), n2 = fmaxf(fminf(m1[u], p1), fmaxf(m2[u], p2)); m1[u] = n1; m2[u] = n2; }
          TOP2_STEP(0xB1) TOP2_STEP(0x4E) TOP2_STEP(0x141)
#undef TOP2_STEP
          const int mygroup = lane >> 3;
#pragma unroll
          for (int u = 0; u < TB; ++u) { gs[u] = m1[u] + m2[u]; rank[u] = 0; }
#pragma unroll
          for (int j = 0; j < 8; ++j)
#pragma unroll
              for (int u = 0; u < TB; ++u) { const float gj = rdlane_f(gs[u], 8 * j); rank[u] += (gj > gs[u] || (gj == gs[u] && j < mygroup)) ? 1 : 0; }
#pragma unroll
          for (int u = 0; u < TB; ++u) { const bool sel = rank[u] < 4; v0[u] = sel ? b0[u] : NINF; v1[u] = sel ? b1[u] : NINF; v2[u] = sel ? b2[u] : NINF; v3[u] = sel ? b3[u] : NINF; my_e[u] = 0; my_s[u] = 0.f; } }
#pragma unroll
        for (int k = 0; k < 8; ++k) {
            float bv[TB]; int bi[TB];
#pragma unroll
            for (int u = 0; u < TB; ++u) { bv[u] = v0[u]; bi[u] = 4 * lane;
                if (v1[u] > bv[u]) { bv[u] = v1[u]; bi[u] = 4 * lane + 1; }
                if (v2[u] > bv[u]) { bv[u] = v2[u]; bi[u] = 4 * lane + 2; }
                if (v3[u] > bv[u]) { bv[u] = v3[u]; bi[u] = 4 * lane + 3; } }
#define AMX_STEP(CTRL) _Pragma("unroll") for (int u = 0; u < TB; ++u) { const float ov = dpp_f<CTRL>(bv[u]); const int oi = dpp_i<CTRL>(bi[u]); if (ov > bv[u] || (ov == bv[u] && oi < bi[u])) { bv[u] = ov; bi[u] = oi; } }
            AMX_STEP(0xB1) AMX_STEP(0x4E) AMX_STEP(0x141) AMX_STEP(0x140)
#undef AMX_STEP
#pragma unroll
            for (int u = 0; u < TB; ++u) { float fv = rdlane_f(bv[u], 0); int fi = __builtin_amdgcn_readlane(bi[u], 0);
#pragma unroll
                for (int rw = 1; rw < 4; ++rw) { const float ov = rdlane_f(bv[u], 16 * rw); const int oi = __builtin_amdgcn_readlane(bi[u], 16 * rw); if (ov > fv || (ov == fv && oi < fi)) { fv = ov; fi = oi; } }
                bv[u] = fv; bi[u] = fi; }
#pragma unroll
            for (int u = 0; u < TB; ++u) { const int owner = bi[u] >> 2, wi = bi[u] & 3;
                const float cand = wi == 0 ? s0[u] : wi == 1 ? s1[u] : wi == 2 ? s2[u] : s3[u];
                const float sk = rdlane_f(cand, owner);
                if (lane == owner) { if (wi == 0) v0[u] = NINF; else if (wi == 1) v1[u] = NINF; else if (wi == 2) v2[u] = NINF; else v3[u] = NINF; }
                if (lane == k) { my_e[u] = bi[u]; my_s[u] = sk; } }
        }
#pragma unroll
        for (int u = 0; u < TB; ++u) { const int t = w * 256 + F.wave * 32 + i0 + u;
            float sum = (lane < 8) ? my_s[u] : 0.f; sum += dpp_f<0xB1>(sum); sum += dpp_f<0x4E>(sum); sum += dpp_f<0x141>(sum);
            if (lane < 8) { const int rk = hist[F.wave * 256 + my_e[u]]; hist[F.wave * 256 + my_e[u]] = rk + 1; tok_e[(size_t)t * 8 + lane] = (u16)my_e[u]; tok_r[(size_t)t * 8 + lane] = (u16)rk; tok_g[(size_t)t * 8 + lane] = my_s[u] / sum * 2.5f; } }
    }
    __syncthreads();
    if (F.tid < 256) { int run = 0;
#pragma unroll
        for (int wv = 0; wv < 8; ++wv) { const int h = hist[wv * 256 + F.tid]; hist[wv * 256 + F.tid] = run; run += h; }
        ((int*)(F.ws + WS_HIST))[w * 256 + F.tid] = run; }
    __syncthreads();
    for (int i = 0; i < 32; ++i) { const int t = w * 256 + F.wave * 32 + i; if (lane < 8) { const int e = tok_e[(size_t)t * 8 + lane]; tok_r[(size_t)t * 8 + lane] = (u16)(tok_r[(size_t)t * 8 + lane] + hist[F.wave * 256 + e]); } }
    __syncthreads();
}

__device__ __forceinline__ void phase_sort(const Frame& F) {
    LAS int* start = (LAS int*)F.lds; LAS int* base = start + 260; LAS int* tot = base + 260; LAS int* pad = tot + 260; LAS int* dbase = pad + 260;
    const int w = F.vcu, qd = w / WPC, wl = w % WPC, tid = F.tid;
    const int* hist = (const int*)(F.ws + WS_HIST);
    int mytot = 0, mypre = 0;
    if (tid < 256) {
        for (int w2 = qd * WPC; w2 < qd * WPC + WPC; ++w2) { const int h = hist[w2 * 256 + tid]; mytot += h; mypre += (w2 < w) ? h : 0; }
        tot[tid] = mytot; pad[tid] = (mytot + 255) & ~255;
    }
    __syncthreads();
    if (tid == 0) { int s = 0, d = 0; for (int e = 0; e < 256; ++e) { start[e] = s; s += pad[e]; dbase[e] = d; d += tot[e]; } start[256] = s; }
    __syncthreads();
    if (tid < 256) { base[tid] = start[tid] + mypre; dbase[tid] += mypre; }
    __syncthreads();
    int* stok = (int*)(F.ws + WS_STOK) + (size_t)qd * QTILES * 256; float* sgate = (float*)(F.ws + WS_SGATE) + (size_t)qd * QTILES * 256; int* sdst = (int*)(F.ws + WS_SDST) + (size_t)qd * QTILES * 256;
    int* tile_e = (int*)(F.ws + WS_TILEE) + qd * QTILES;
    const u16* tok_e = (const u16*)(F.ws + WS_TOKE); const u16* tok_r = (const u16*)(F.ws + WS_TOKR); const float* tok_g = (const float*)(F.ws + WS_TOKG);
    for (int aidx = tid; aidx < 2048; aidx += NTHR) {
        const int t = w * 256 + (aidx >> 3), k = aidx & 7; const int e = tok_e[(size_t)t * 8 + k], rk = tok_r[(size_t)t * 8 + k];
        const int slot = base[e] + rk, dn = dbase[e] + rk; stok[slot] = t; sgate[slot] = tok_g[(size_t)t * 8 + k]; sdst[slot] = dn; ((int*)(F.ws + WS_TOKD))[(size_t)t * 8 + k] = dn;
    }
    const int ssh = start[256];
    if (tid < 256) { const int t = w * 256 + tid; const int slot = ssh + (t - qd * TQ); stok[slot] = t; sgate[slot] = 1.0f; sdst[slot] = TQ * 8 + (t - qd * TQ); }
    if (tid < 256 && (tid % WPC) == wl) {
        const int e = tid; const int s0 = start[e], n = tot[e], np = pad[e];
        for (int j = n; j < np; ++j) { stok[s0 + j] = qd * TQ; sgate[s0 + j] = 0.f; sdst[s0 + j] = TQ * NSLOT; }
        for (int tl = s0 >> 8; tl < (s0 + np) >> 8; ++tl) tile_e[tl] = e;
    }
    if (wl == 0 && tid < TQ / 256) tile_e[(ssh >> 8) + tid] = 256;
    if (wl == 0 && tid == 0) ((int*)(F.ws + WS_NTILES))[qd] = (ssh >> 8) + TQ / 256;
    __syncthreads();
}


constexpr int DN_ROWP = 80, DN_PLANE = 256 * DN_ROWP;
__device__ __forceinline__ void moe_down_phase(const Frame& F, int qd, const unsigned char* H8) {
    unsigned char* ws = F.ws; LAS unsigned char* L = F.lds; const int tid = F.tid, lane = F.lane, wave = F.wave, i16 = lane & 15, q = lane >> 4;
    const int ntiles = __builtin_amdgcn_readfirstlane(((const int*)(ws + WS_NTILES))[qd]);
    const int* tile_e = (const int*)(ws + WS_TILEE) + qd * QTILES;
    LAS int* estart = (LAS int*)(L + 4 * DN_PLANE);
    LAS int* te = estart + 512;
    for (int i = tid; i < ntiles; i += NTHR) te[i] = tile_e[i];
    __syncthreads();
    if (tid < 258) { int lo = 0, hi = ntiles; while (lo < hi) { const int mid = (lo + hi) >> 1; if (te[mid] < tid) lo = mid + 1; else hi = mid; } estart[tid] = lo; }
    __syncthreads();
    const long U = (long)ntiles * 4; const int u0 = (int)((long)F.vcu * U / F.G), u1 = (int)((long)(F.vcu + 1) * U / F.G);
    const unsigned char* WD8 = ws + WS_WD; unsigned char* YS = ws + WS_YS;
    const int* sdst = (const int*)(ws + WS_SDST) + (size_t)qd * QTILES * 256; const float* sgate = (const float*)(ws + WS_SGATE) + (size_t)qd * QTILES * 256;
    int sc1; asm volatile("v_mov_b32 %0, 0x7f7f7f7f" : "=v"(sc1));
    int cur_key = -1, e = 0;
#define DN_DECODE(u_, e_, pn_, tile_) { while (4 * estart[e_ + 1] <= (u_)) ++e_; const int ts_ = estart[e_], nte_ = estart[e_ + 1] - ts_, r_ = (u_) - 4 * ts_; pn_ = r_ / nte_; tile_ = ts_ + r_ % nte_; }
#define DN_LOADA(dst, tile_) { const size_t row0_ = (size_t)(tile_) * 256 + wave * 32; \
        _Pragma("unroll") for (int rg = 0; rg < 2; ++rg) { _Pragma("unroll") for (int ks = 0; ks < 2; ++ks) { const unsigned char* ap = H8 + (row0_ + 16 * rg + i16) * 256 + 128 * ks + 32 * q; const i32x4 lo = *(const i32x4*)ap, hi = *(const i32x4*)(ap + 16); dst[rg][ks] = __builtin_shufflevector(lo, hi, 0, 1, 2, 3, 4, 5, 6, 7); } \
            } }
#define DN_LOADN(tile_) { const size_t row0_ = (size_t)(tile_) * 256 + wave * 32; \
        _Pragma("unroll") for (int rg = 0; rg < 2; ++rg) { _Pragma("unroll") for (int ks = 0; ks < 2; ++ks) { const unsigned char* ap = H8 + (row0_ + 16 * rg + i16) * 256 + 128 * ks + 32 * q; \
            asm volatile("global_load_dwordx4 %0, %2, off\n\tglobal_load_dwordx4 %1, %2, off offset:16" : "=&v"(nl[rg][ks]), "=&v"(nh[rg][ks]) : "v"(ap) : "memory"); } \
            { const size_t rr_ = row0_ + 16 * rg + i16; const int* dp_ = sdst + rr_; const float* gp_ = sgate + rr_; \
              asm volatile("global_load_dword %0, %2, off\n\tglobal_load_dword %1, %3, off" : "=&v"(ndd[rg]), "=&v"(ngg[rg]) : "v"(dp_), "v"(gp_) : "memory"); } } }
    i32x8 af[2][2]; i32x4 nl[2][2] = {}, nh[2][2] = {}; unsigned ndd[2] = {0u, 0u}; float ngg[2] = {0.f, 0.f};
    unsigned dd[2] = {0u, 0u}; float gg[2] = {0.f, 0.f};
    int pn = 0, tile = 0, en = 0, pnn = 0, tilen = 0;
    if (u0 < u1) { DN_DECODE(u0, e, pn, tile) DN_LOADA(af, tile) en = e;
#pragma unroll
        for (int rg = 0; rg < 2; ++rg) { const size_t rr = (size_t)tile * 256 + wave * 32 + 16 * rg + i16; dd[rg] = (unsigned)sdst[rr]; gg[rg] = sgate[rr] * (Y8_SCALE / (W8_SCALE * H8_SCALE)); }
        asm volatile("" : "+v"(af[0][0]), "+v"(af[0][1]), "+v"(af[1][0]), "+v"(af[1][1]), "+v"(dd[0]), "+v"(dd[1]), "+v"(gg[0]), "+v"(gg[1]));
    }
    for (int u = u0; u < u1; ++u) {
        const int key = e * 4 + pn;
        if (key != cur_key) {
            __syncthreads();
            const unsigned char* src = WD8 + ((size_t)e * 1024 + (size_t)pn * 256) * 256;
#pragma unroll
            for (int j = 0; j < 8; ++j) { const int p = tid + NTHR * j, rho = p >> 4, c = p & 15; const int n = (rho & ~63) + 16 * ((rho & 15) >> 2) + 4 * ((rho >> 4) & 3) + (rho & 3);
                *(LAS u32x4*)(L + ((c >> 1) & 3) * DN_PLANE + rho * DN_ROWP + (c >> 3) * 32 + (c & 1) * 16) = *(const u32x4*)(src + (size_t)n * 256 + 16 * c); }
            __syncthreads();
            cur_key = key;
        }
        const bool more = u + 1 < u1;
        if (more) { DN_DECODE(u + 1, en, pnn, tilen) DN_LOADN(tilen) }
        int vb = q * DN_PLANE + i16 * DN_ROWP; asm volatile("" : "+v"(vb));
        unsigned char* yp0 = YS + (size_t)dd[0] * D + pn * 256 + 16 * q; unsigned char* yp1 = YS + (size_t)dd[1] * D + pn * 256 + 16 * q; const float g0 = gg[0], g1 = gg[1];
#define DN_LDB(s_) ({ const LAS unsigned char* bp_ = L + vb + ((s_) >> 1) * (16 * DN_ROWP) + ((s_) & 1) * 32; const i32x4 lo_ = *(const LAS i32x4*)bp_, hi_ = *(const LAS i32x4*)(bp_ + 16); __builtin_shufflevector(lo_, hi_, 0, 1, 2, 3, 4, 5, 6, 7); })
        i32x8 bq[3]; bq[0] = DN_LDB(0); bq[1] = DN_LDB(1);
#pragma unroll
        for (int hb = 0; hb < 2; ++hb) {
            f32x4 acc[2][8];
#pragma unroll
            for (int rg = 0; rg < 2; ++rg)
#pragma unroll
                for (int ng = 0; ng < 8; ++ng) acc[rg][ng] = (f32x4){0.f, 0.f, 0.f, 0.f};
#pragma unroll
            for (int s2 = 0; s2 < 16; ++s2) { const int st = 16 * hb + s2;
                if (st + 2 < 32) bq[(st + 2) % 3] = DN_LDB(st + 2);
#pragma unroll
                for (int rg = 0; rg < 2; ++rg) acc[rg][s2 >> 1] = __builtin_amdgcn_mfma_scale_f32_16x16x128_f8f6f4(bq[st % 3], af[rg][st & 1], acc[rg][s2 >> 1], 0, 0, 0, sc1, 0, sc1);
                __builtin_amdgcn_sched_barrier(0);
            }
            if (hb == 1) {
                asm volatile("s_waitcnt vmcnt(0)" : "+v"(nl[0][0]), "+v"(nl[0][1]), "+v"(nl[1][0]), "+v"(nl[1][1]), "+v"(nh[0][0]), "+v"(nh[0][1]), "+v"(nh[1][0]), "+v"(nh[1][1]), "+v"(ndd[0]), "+v"(ndd[1]), "+v"(ngg[0]), "+v"(ngg[1]) :: "memory");
                dd[0] = ndd[0]; dd[1] = ndd[1]; gg[0] = ngg[0] * (Y8_SCALE / (W8_SCALE * H8_SCALE)); gg[1] = ngg[1] * (Y8_SCALE / (W8_SCALE * H8_SCALE));
#pragma unroll
                for (int rg = 0; rg < 2; ++rg) { af[rg][0] = __builtin_shufflevector(nl[rg][0], nh[rg][0], 0, 1, 2, 3, 4, 5, 6, 7); af[rg][1] = __builtin_shufflevector(nl[rg][1], nh[rg][1], 0, 1, 2, 3, 4, 5, 6, 7); }
            }
#pragma unroll
            for (int rg = 0; rg < 2; ++rg) { unsigned char* yp = (rg ? yp1 : yp0) + 128 * hb; const float g = rg ? g1 : g0;
#pragma unroll
                for (int cb = 0; cb < 2; ++cb) { u32x4 w;
#pragma unroll
                    for (int k = 0; k < 4; ++k) { const f32x4 v = acc[rg][4 * cb + k] * g; w[k] = pk_fp8x4(v[0], v[1], v[2], v[3]); }
                    *(u32x4*)(yp + 64 * cb) = w; } }
        }
#undef DN_LDB
        e = en; pn = pnn; tile = tilen;
    }
#undef DN_DECODE
#undef DN_LOADA
#undef DN_LOADN
    __syncthreads();
}

__device__ __forceinline__ void phase_moe_combine(const Frame& F, const Args& a, int qd) {
    const int gw = F.vcu * NWAVES + F.wave, NGW = F.G * NWAVES, lane = F.lane;
    const u16* X1B = (const u16*)(F.ws + WS_XB) + (size_t)qd * TQ * D; const unsigned char* YS = F.ws + WS_YS; u16* X2B = (u16*)(F.ws + WS_X2B) + (size_t)qd * TQ * D;
    typedef float f32x2v __attribute__((ext_vector_type(2)));
    constexpr int NT = 2;
    f32x4 gq[4], bq[4];
#pragma unroll
    for (int k = 0; k < 4; ++k) { gq[k] = *(const f32x4*)(a.in[19] + 16 * lane + 4 * k); bq[k] = *(const f32x4*)(a.in[20] + 16 * lane + 4 * k); }
    for (int tl0 = gw; tl0 < TQ; tl0 += NT * NGW) {
        int mydn[NT]; u32x4 yy[NT][NSLOT], xx[NT][2];
#pragma unroll
        for (int t = 0; t < NT; ++t) { const int tl = tl0 + t * NGW; mydn[t] = (lane < 8) ? ((const int*)(F.ws + WS_TOKD))[((size_t)qd * TQ + tl) * 8 + lane] : 0; }
#pragma unroll
        for (int t = 0; t < NT; ++t) { const int tl = tl0 + t * NGW;
#pragma unroll
            for (int c = 0; c < 2; ++c) xx[t][c] = *(const u32x4*)(X1B + (size_t)tl * D + 16 * lane + 8 * c);
#pragma unroll
            for (int k = 0; k < NSLOT; ++k) { const int dn = (k < 8) ? __builtin_amdgcn_readlane(mydn[t], k) : TQ * 8 + tl; yy[t][k] = *(const u32x4*)(YS + (size_t)dn * D + 16 * lane); } }
        __builtin_amdgcn_sched_barrier(0);
#pragma unroll
        for (int t = 0; t < NT; ++t) { const int tl = tl0 + t * NGW;
            float v[16];
#pragma unroll
            for (int c = 0; c < 2; ++c) { const u32x4 x = xx[t][c];
                v[8 * c + 0] = ALPHA * bf_lo(x.x); v[8 * c + 1] = ALPHA * bf_hi(x.x); v[8 * c + 2] = ALPHA * bf_lo(x.y); v[8 * c + 3] = ALPHA * bf_hi(x.y); v[8 * c + 4] = ALPHA * bf_lo(x.z); v[8 * c + 5] = ALPHA * bf_hi(x.z); v[8 * c + 6] = ALPHA * bf_lo(x.w); v[8 * c + 7] = ALPHA * bf_hi(x.w); }
            float ys[16];
#pragma unroll
            for (int j = 0; j < 16; ++j) ys[j] = 0.f;
#pragma unroll
            for (int k = 0; k < NSLOT; ++k)
#pragma unroll
                for (int q = 0; q < 4; ++q) { const int wv = (int)yy[t][k][q]; const f32x2v lo = __builtin_amdgcn_cvt_pk_f32_fp8(wv, false), hi = __builtin_amdgcn_cvt_pk_f32_fp8(wv, true);
                    ys[4 * q + 0] += lo.x; ys[4 * q + 1] += lo.y; ys[4 * q + 2] += hi.x; ys[4 * q + 3] += hi.y; }
#pragma unroll
            for (int j = 0; j < 16; ++j) v[j] += ys[j] * (1.0f / Y8_SCALE);
            float s = 0.f;
#pragma unroll
            for (int j = 0; j < 16; ++j) s += v[j];
            const float mean = wave_sum(s) * (1.f / D); float s2 = 0.f;
#pragma unroll
            for (int j = 0; j < 16; ++j) { v[j] -= mean; s2 += v[j] * v[j]; }
            const float rstd = 1.f / sqrtf(wave_sum(s2) * (1.f / D) + LN_EPS);
            u32x4 w8;
#pragma unroll
            for (int c = 0; c < 2; ++c) { const int col = 16 * lane + 8 * c; const f32x4 g0 = gq[2 * c], g1 = gq[2 * c + 1], b0 = bq[2 * c], b1 = bq[2 * c + 1];
                u32x4 w; w.x = cvt_pk_bf16(v[8 * c + 0] * rstd * g0[0] + b0[0], v[8 * c + 1] * rstd * g0[1] + b0[1]); w.y = cvt_pk_bf16(v[8 * c + 2] * rstd * g0[2] + b0[2], v[8 * c + 3] * rstd * g0[3] + b0[3]);
                w.z = cvt_pk_bf16(v[8 * c + 4] * rstd * g1[0] + b1[0], v[8 * c + 5] * rstd * g1[1] + b1[1]); w.w = cvt_pk_bf16(v[8 * c + 6] * rstd * g1[2] + b1[2], v[8 * c + 7] * rstd * g1[3] + b1[3]);
                *(u32x4*)(X2B + (size_t)tl * D + col) = w;
                w8[2 * c] = pk_fp8x4(bf_lo(w.x), bf_hi(w.x), bf_lo(w.y), bf_hi(w.y)); w8[2 * c + 1] = pk_fp8x4(bf_lo(w.z), bf_hi(w.z), bf_lo(w.w), bf_hi(w.w)); }
            *(u32x4*)(F.ws + WS_X2F8 + ((size_t)qd * TQ + tl) * D + 16 * lane) = w8;
        }
    }
}

constexpr int LDS_BYTES = 163840;
static_assert(pg8::LDS_ROWIDX + pg8::LDS_ROWSLOTS * 1024 <= LDS_BYTES && (QTILES * 2 + 255) / 256 <= pg8::LDS_ROWSLOTS, "LDS side tables");
constexpr int MISC_OFF = 131072 + 4096;
constexpr int PH_FIXED = 11, PH_PER_Q = 2, PH_TAIL0 = PH_FIXED + NQ * PH_PER_Q, NPHASE = PH_TAIL0 + 2;

__global__ void __launch_bounds__(NTHR, 2) fwd_kernel(Args args) {
    extern __shared__ __attribute__((aligned(16))) unsigned char lds_raw[];
#define MKFRAME() Frame F; { int t_ = threadIdx.x; asm volatile("" : "+v"(t_)); F.lds = (LAS unsigned char*)lds_raw; F.tid = t_; F.lane = t_ & 63; F.wave = __builtin_amdgcn_readfirstlane(t_ >> 6); \
        F.G = gridDim.x; const int bx_ = blockIdx.x; F.vcu = (F.G % 8 == 0) ? (bx_ % 8) * (F.G / 8) + bx_ / 8 : bx_; size_t z_ = 0; asm volatile("" : "+s"(z_)); F.ws = args.ws + z_;     F.dout = (unsigned char*)args.out; }
    LAS unsigned char* const lds0 = (LAS unsigned char*)lds_raw;
    volatile LAS unsigned* MISC = (volatile LAS unsigned*)(lds0 + MISC_OFF);
    if (threadIdx.x < 64) MISC[threadIdx.x] = 0u;
    __syncthreads();
    unsigned* barw = (unsigned*)(args.ws + WS_CTL) + CW_BAR;
    const int lo = args.lo, hi = args.hi;
    XcdBarrier bar; bar.bar = barw; bar.x = 0; bar.st = nullptr;
    if (hi - lo > 1) bar = xcd_barrier_post(barw, MISC + 8);
#ifndef PHASE_MASK
#define PHASE_MASK 0xFFFFFFFFu
#endif
#define IN(k) (((PHASE_MASK >> (k)) & 1u) && lo <= (k) && (k) < hi)
#define INQ(j) (((PHASE_MASK >> (PH_FIXED + (j))) & 1u) && lo <= (pb + (j)) && (pb + (j)) < hi)
#define SEAMQ(j) do { if (lo <= (pb + (j)) && (pb + (j)) + 1 < hi) xcd_barrier(bar); STAMP(pb + (j) + 1); } while (0)
#if DBG_TIME
#define STAMP(i) do { if (blockIdx.x == 0 && threadIdx.x == 0) ((unsigned long long*)(args.ws + WS_CTL + 60 * 1024))[i] = __builtin_amdgcn_s_memrealtime(); } while (0)
#else
#define STAMP(i) do { } while (0)
#endif
    STAMP(0);
#define SEAM(k) do { if (lo <= (k) && (k) + 1 < hi) xcd_barrier(bar); STAMP((k) + 1); } while (0)
    const int G = gridDim.x, c = (int)blockIdx.x;
    const bool wg_odd_t = (blockIdx.x & 1) != 0  ;

    if (IN(0)) { MKFRAME(); phase_prologue(F, args); }
    SEAM(0);
    if (IN(1)) {
        MKFRAME(); unsigned char* ws = F.ws;
        pg8::DenseOrder S; S.init(ws + WS_XB, ws + WS_WIN, T, NCOL, 512, G, c);
        pg8::EpiZ E{ws, (const float*)(ws + WS_ROT), (const float*)(ws + WS_LB), 1.0f / W8_SCALE};
        for (int rep = 0; rep < DUPN(7); ++rep) pg8::gemm_phase<false, 2>(F.lds, 512, S, E);
    }
    SEAM(1);
    if (IN(2)) {
        MKFRAME();
#ifndef NO_HGRN
#if USE_NAIVE_HGRN
        for (int it = F.vcu; it < 256; it += G) hgrn_item(F, it);
#else
        for (int it = F.vcu; it < 256; it += G) hgrn_mfma_item(F, it, (u16*)(F.dout + DO_OF), (u16*)(F.dout + DO_OB));
#if DBG_CHECK
        for (int it = F.vcu; it < 256; it += G) hgrn_item(F, it);
#endif
#endif
#endif
        STAMP(40);
#if USE_NAIVE_ATTN
        attn_naive(F);
#else
        for (int rep2 = 0; rep2 < DUPN(15); ++rep2) attn_mfma(F);
#endif
    }
    SEAM(2);
    if (IN(3)) { MKFRAME(); for (int rep = 0; rep < DUPN(8); ++rep) phase_hg_combine(F, args); }
    SEAM(3);
    if (IN(4)) {
        MKFRAME(); unsigned char* ws = F.ws;
        pg8::DenseOrder S; S.init(ws + WS_YH, ws + WS_WBH, T, D, 256, G, c);
        pg8::EpiGated<false> E{(const u16*)(ws + Z_GTH), (u16*)(F.dout + DO_MERGED), nullptr, D};
        pg8::gemm_phase<false, 2, false>(F.lds, 256, S, E);
    }
    SEAM(4);
    if (IN(5) && !DBG_SKIP_YA) {
        MKFRAME(); unsigned char* ws = F.ws;
        pg8::DenseOrder S; S.init(ws + WS_YA, ws + WS_WBA, T, D, 128, G, c);
        pg8::EpiGated<true> E{(const u16*)(ws + Z_GTA), (u16*)(F.dout + DO_MERGED), F.dout + DO_MERGED8, D};
        pg8::gemm_phase<true, 2, false>(F.lds, 128, S, E);
    }
    SEAM(5);
    if (IN(6)) {
        MKFRAME(); unsigned char* ws = F.ws;
        pg8::DenseOrder S; S.init(F.dout + DO_MERGED8, ws + WS_WO, T, D, 512, G, c);
        pg8::EpiBf16Res E{args.in[0], (u16*)(ws + WS_X1PRE), D, ALPHA, 1.0f / (W8_SCALE * M8_SCALE)};
        pg8::gemm_phase<false, 2>(F.lds, 512, S, E);
    }
    SEAM(6);
    if (IN(7)) { MKFRAME(); phase_ln1_convert<true, false>(F, args); }
    SEAM(7);
    if (IN(8) && !wg_odd_t) { { MKFRAME(); phase_ln1_convert<false, true>(F, args, 0, 3); } VM_WAIT(); __syncthreads(); }
    if (IN(8)) {
        MKFRAME(); unsigned char* ws = F.ws;
        pg8::DenseOrder S; S.init(ws + WS_XB, ws + WS_WR, T, 256, 1024, G, c);
        pg8::EpiF32Res E{(float*)(ws + WS_LOGITS), nullptr, nullptr, 256, 0.f, 1.f};
        for (int rep = 0; rep < DUPN(11); ++rep) pg8::gemm_phase(F.lds, 1024, S, E);
    }
    if (IN(8) && wg_odd_t) { VM_WAIT(); __syncthreads(); MKFRAME(); phase_ln1_convert<false, true>(F, args, 0, 3); }
    SEAM(8);
    if (IN(9) && !wg_odd_t) { { MKFRAME(); phase_ln1_convert<false, true>(F, args, 1, 3); } VM_WAIT(); __syncthreads(); }
    if (IN(9)) { MKFRAME(); phase_topk(F, args); }
    if (IN(9) && wg_odd_t) { VM_WAIT(); __syncthreads(); MKFRAME(); phase_ln1_convert<false, true>(F, args, 1, 3); }
    SEAM(9);
    if (IN(10) && !wg_odd_t) { { MKFRAME(); phase_ln1_convert<false, true>(F, args, 2, 3); } VM_WAIT(); __syncthreads(); }
    if (IN(10)) { MKFRAME(); phase_sort(F); }
    if (IN(10) && wg_odd_t) { VM_WAIT(); __syncthreads(); MKFRAME(); phase_ln1_convert<false, true>(F, args, 2, 3); }
    SEAM(10);
    for (int qd = 0; qd < NQ; ++qd) {
        const int pb = PH_FIXED + qd * PH_PER_Q;
        const size_t lo_off = (size_t)qd * QTILES * 256;
        const bool wg_odd = (blockIdx.x & 1) != 0  ;
#define GU_BLOCK(q_, i0_, di_) { MKFRAME(); unsigned char* ws = F.ws; \
            const int ntiles = __builtin_amdgcn_readfirstlane(((const int*)(ws + WS_NTILES))[q_]); \
            pg8::MoeOrder<2, true> S; S.A = (const char*)(ws + WS_X1F8); S.W = (const char*)(ws + WS_WGU); S.lds = F.lds; S.slot_tok = (const int*)(ws + WS_STOK) + (size_t)(q_) * QTILES * 256; S.sdst = nullptr; S.sgate = nullptr; \
            S.ntiles = ntiles; S.G = G; S.vc = F.vcu; S.K = 512; S.wstride_e = (size_t)512 * 1024; S.wstride_pn = (size_t)256 * 1024; S.i0 = (i0_); S.di = (di_); \
            S.load_table((const int*)(ws + WS_TILEE) + (q_) * QTILES, F.tid); \
            pg8::EpiSwiglu E{(q_) ? F.dout : ws + WS_H}; \
            pg8::gemm_phase<false, 2>(F.lds, 512, S, E); }
        if (INQ(0) && qd > 0 && !wg_odd) { MKFRAME(); phase_moe_combine(F, args, qd - 1); }
        if (INQ(0)) { if (qd == 0) GU_BLOCK(0, 0, 1) else GU_BLOCK(1, 1, 2) }
        if (INQ(0) && qd > 0 && wg_odd) { __syncthreads(); MKFRAME(); phase_moe_combine(F, args, qd - 1); }
        SEAMQ(0);
        if (INQ(1) && (wg_odd || qd + 1 == NQ)) { MKFRAME(); moe_down_phase(F, qd, qd ? F.dout : F.ws + WS_H); }
        if (INQ(1) && qd + 1 < NQ) { __syncthreads(); GU_BLOCK(1, 0, 2) __syncthreads(); }
        if (INQ(1) && !wg_odd && qd + 1 < NQ) { MKFRAME(); moe_down_phase(F, qd, qd ? F.dout : F.ws + WS_H); }
        SEAMQ(1);
#undef GU_BLOCK
    }
    if (IN(PH_TAIL0) && !wg_odd_t) { MKFRAME(); phase_moe_combine(F, args, NQ - 1); }
    if (IN(PH_TAIL0)) {
        { MKFRAME(); unsigned char* ws = F.ws; const int pm = F.vcu;
          const f32x4* p4 = (const f32x4*)(args.in[1] + (size_t)pm * 256 * 256); u32x4* o4 = (u32x4*)(ws + WS_PB + (size_t)pm * 256 * 256 * 2);
          for (int i = F.tid; i < 256 * 256 / 8; i += NTHR) { const f32x4 p = p4[2 * i], q = p4[2 * i + 1]; u32x4 w; w.x = cvt_pk_bf16(p[0], p[1]); w.y = cvt_pk_bf16(p[2], p[3]); w.z = cvt_pk_bf16(q[0], q[1]); w.w = cvt_pk_bf16(q[2], q[3]); o4[i] = w; } }
        VM_WAIT(); __syncthreads(); __builtin_amdgcn_fence(__ATOMIC_ACQUIRE, "agent"); VM_WAIT();
        { MKFRAME(); unsigned char* ws = F.ws; pg8::PanelOrder S; S.A = (const char*)(ws + WS_PB); S.Bt = (const char*)(ws + WS_WPP); S.pm = F.vcu; S.nN = 4; S.K = 256;
          pg8::EpiBf16 E{(u16*)(ws + WS_P2), D};
          pg8::gemm_phase<true>(F.lds, 256, S, E); }
        VM_WAIT(); __syncthreads();
    }
    if (IN(PH_TAIL0) && wg_odd_t) { MKFRAME(); phase_moe_combine(F, args, NQ - 1); }
    SEAM(PH_TAIL0);
    if (IN(PH_TAIL0 + 1)) {
        { MKFRAME(); unsigned char* ws = F.ws; pg8::PanelOrder S; S.A = (const char*)(ws + WS_X2F8); S.Bt = (const char*)(ws + WS_WPG); S.pm = F.vcu; S.nN = 4; S.K = 512;
          pg8::EpiPle E{(u16*)(ws + WS_X3PRE), (const u16*)(ws + WS_X2B), (const u16*)(ws + WS_P2), D, 1.0f / W8_SCALE};
          pg8::gemm_phase<false, 2>(F.lds, 512, S, E); }
        VM_WAIT(); __syncthreads(); __builtin_amdgcn_fence(__ATOMIC_ACQUIRE, "agent"); VM_WAIT();
        { MKFRAME(); unsigned char* ws = F.ws; const int pm = F.vcu;
          for (int r = F.wave; r < 256; r += 4 * NWAVES) ln_rows<false, 4, true>((const u16*)(ws + WS_X3PRE), (size_t)pm * 256 + r, (size_t)NWAVES, args.in[23], args.in[24], args.out, F.lane); }
    }
#undef IN
#undef SEAM
#undef INQ
#undef SEAMQ
}


#ifndef DBG_CHECK
#define DBG_CHECK 0
#endif
#if DBG_CHECK
constexpr int CHK_WORD0 = 12288;
struct ChkArgs { const float* in[25]; float* out; unsigned char* ws; int mode, qd; };
__device__ __forceinline__ float dotb(const u16* a, const u16* b, int K) { float s = 0.f; for (int k = 0; k < K; k += 8) { const u32x4 x = *(const u32x4*)(a + k), y = *(const u32x4*)(b + k);
    s += bf_lo(x.x) * bf_lo(y.x) + bf_hi(x.x) * bf_hi(y.x) + bf_lo(x.y) * bf_lo(y.y) + bf_hi(x.y) * bf_hi(y.y) + bf_lo(x.z) * bf_lo(y.z) + bf_hi(x.z) * bf_hi(y.z) + bf_lo(x.w) * bf_lo(y.w) + bf_hi(x.w) * bf_hi(y.w); } return s; }
__device__ __forceinline__ float sigm(float z) { return 1.f / (1.f + expf(-z)); }
__device__ __forceinline__ bool badv(float got, float ref, float rel, float ab) { return !(fabsf(got - ref) <= rel * fabsf(ref) + ab); }
__global__ void chk_kernel(ChkArgs a) {
    unsigned char* ws = a.ws; unsigned* res = (unsigned*)(ws + WS_CTL) + CHK_WORD0; const int mode = a.mode, qd = a.qd;
    const size_t gt = (size_t)blockIdx.x * blockDim.x + threadIdx.x, NGT = (size_t)gridDim.x * blockDim.x;
    const u16* XB = (const u16*)(ws + WS_XB); const u16* WIN = (const u16*)(ws + WS_WIN);
    unsigned bad = 0;
    if (mode == 1) { for (size_t i = gt; i < (size_t)T * D; i += NGT) { if (badv(bf1(XB[i]), a.in[0][i], 0.005f, 1e-6f)) ++bad; } }
    else if (mode >= 2 && mode <= 11) {
        const int ty = mode - 2; const int ncol = ty < 5 ? 512 : ty < 8 ? 768 : 1024; const int cbase = ty < 5 ? 512 * ty : ty < 8 ? 2560 + 768 * (ty - 5) : 4864 + 1024 * (ty - 8);
        const size_t zoff[10] = {Z_QH, Z_VH, Z_LFF, Z_LFB, Z_GS, Z_AQ, Z_AK, Z_AV, Z_GTH, Z_GTA}; const u16* Zt = (const u16*)(ws + zoff[ty]); const float* lb = (const float*)(ws + WS_LB); const float* rot = (const float*)(ws + WS_ROT);
        for (size_t i = gt; i < (size_t)(T / 8) * ncol; i += NGT) { const int row = (int)(i / ncol) * 8 + 3, c = (int)(i % ncol);
            float z = dotb(XB + (size_t)row * D, WIN + (size_t)(cbase + c) * D, D), ref, got = bf1(Zt[(size_t)row * ncol + c]);
            if (ty <= 4 || ty == 7 || ty == 8 || ty == 9) ref = z;
            else { const int d = c & 63; ref = z; if (d < 16) { const int cp = (d < 8) ? c + 8 : c - 8; const float zp = dotb(XB + (size_t)row * D, WIN + (size_t)(cbase + cp) * D, D); const int fi = d & 7, pos = row & (SEQ - 1); const float cs = rot[pos * 16 + fi], sn = rot[pos * 16 + 8 + fi]; ref = (d < 8) ? z * cs - zp * sn : z * cs + zp * sn; } if (ty == 5) ref *= 0.125f; }
            if (badv(got, ref, 0.02f, 0.02f)) { ++bad; if (mode == 10) { atomicAdd(res + 80 + ((c & 255) >> 2), 1u); atomicAdd(res + 160 + ((row & 255) >> 2), 1u); atomicAdd(res + 240 + ((row >> 8) & 255), 1u); if (got > 1.5f || got < -0.5f) atomicAdd(res + 500, 1u); atomicAdd(res + 600 + ((((row >> 8) & 31) >> 3) * 8 + ((row >> 6) & 1) * 4 + ((c >> 5) & 3)), 1u); } } } }
    else if (mode == 12) { const u16* Zt = (const u16*)(ws + Z_GTH); unsigned nm = 0, no = 0; for (size_t i = gt; i < (size_t)2 * T * D; i += NGT) { const u16 h = Zt[i]; if (h == 0x3C3C) ++nm; else { const float g = bf1(h); if (!(g >= 0.f && g <= 1.f)) ++no; } }
        for (int o = 32; o >= 1; o >>= 1) { nm += __shfl_xor(nm, o); no += __shfl_xor(no, o); } if ((threadIdx.x & 63) == 0) { if (nm) atomicAdd(res + 700, nm); if (no) atomicAdd(res + 701, no); } }
    else if (mode == 25) { const u16* AQ = (const u16*)(ws + Z_AQ); const u16* AK = (const u16*)(ws + Z_AK); const u16* AV = (const u16*)(ws + Z_AV); const u16* YA = (const u16*)(ws + WS_YA);
        for (size_t i = gt; i < (size_t)(T / 64) * 256; i += NGT) { const int row = (int)(i / 256) * 64 + 7, sl = (int)((i % 256) / 64), d = (int)(i % 64); const int b = row >> 11, p = row & (SEQ - 1);
            float mx = -1e30f; for (int pass = 0; pass < 2; ++pass) { float den = 0.f, o = 0.f; for (int g = 0; g < 3; ++g) { const int sh = 2 * g, mlen = SEQ >> sh, r = p & ((1 << sh) - 1), m = p >> sh, hd = g * 4 + sl; const int lo = m - 64 < 0 ? 0 : m - 64, hi = m + 64 > mlen - 1 ? mlen - 1 : m + 64;
                    for (int j = lo; j <= hi; ++j) { const size_t kr = (size_t)b * SEQ + r + ((size_t)j << sh); const float sc = dotb(AQ + (size_t)row * 768 + hd * 64, AK + kr * 768 + hd * 64, 64); if (pass == 0) mx = fmaxf(mx, sc); else { const float e = expf(sc - mx); den += e; o += e * bf1(AV[kr * 768 + hd * 64 + d]); } } }
                if (pass == 1) { if (badv(bf1(YA[(size_t)row * 256 + sl * 64 + d]), o / den, 0.03f, 0.004f)) ++bad; } } } }
    else if (mode == 26) { const u16* A0 = (const u16*)((unsigned char*)a.out + DO_OF); const u16* R0 = (const u16*)(ws + WS_XB);
        for (size_t i = gt; i < (size_t)2 * T * 512; i += NGT) { if (badv(bf1(A0[i]), bf1(R0[i]), 0.03f, 0.03f)) ++bad; } }
    else if (mode == 13) { const u16* YH = (const u16*)(ws + WS_YH); const u16* YA = (const u16*)(ws + WS_YA); const u16* GH = (const u16*)(ws + Z_GTH); const u16* GA = (const u16*)(ws + Z_GTA); const u16* M = (const u16*)((unsigned char*)a.out + DO_MERGED);
        for (size_t i = gt; i < (size_t)(T / 4) * D; i += NGT) { const int row = (int)(i / D) * 4 + 1, c = (int)(i % D);
            const float ref = sigm(bf1(GH[(size_t)row * D + c])) * dotb(YH + (size_t)row * 512, (const u16*)(ws + WS_WBH) + (size_t)c * 512, 512) + sigm(bf1(GA[(size_t)row * D + c])) * dotb(YA + (size_t)row * 256, (const u16*)(ws + WS_WBA) + (size_t)c * 256, 256);
            if (badv(bf1(M[(size_t)row * D + c]), ref, 0.02f, 0.01f)) ++bad; } }
    else if (mode == 14) { const u16* M = (const u16*)((unsigned char*)a.out + DO_MERGED); const float* X1 = (const float*)(ws + WS_X1PRE);
        for (size_t i = gt; i < (size_t)T * D; i += NGT) { const int row = (int)(i / D), c = (int)(i % D);
            const float ref = ALPHA * a.in[0][i] + dotb(M + (size_t)row * D, (const u16*)(ws + WS_WO) + (size_t)c * D, D); if (badv(X1[i], ref, 0.002f, 0.002f)) ++bad; } }
    else if (mode == 15) { const float* X1 = (const float*)(ws + WS_X1PRE);
        for (size_t row = gt; row < T; row += NGT) { float m = 0.f; for (int c = 0; c < D; ++c) m += X1[row * D + c]; m /= D; float v = 0.f; for (int c = 0; c < D; ++c) { const float d = X1[row * D + c] - m; v += d * d; } const float rs = 1.f / sqrtf(v / D + LN_EPS);
            for (int c = 0; c < D; ++c) { const float ref = (X1[row * D + c] - m) * rs * a.in[9][c] + a.in[10][c]; if (badv(bf1(XB[row * D + c]), ref, 0.01f, 0.01f)) ++bad; } } }
    else if (mode == 16) { const float* LG = (const float*)(ws + WS_LOGITS);
        for (size_t i = gt; i < (size_t)T * 256; i += NGT) { const int row = (int)(i / 256), c = (int)(i % 256); if (badv(LG[i], dotb(XB + (size_t)row * D, (const u16*)(ws + WS_WR) + (size_t)c * D, D), 0.002f, 0.002f)) ++bad; } }
    else if (mode == 17) { const float* LG = (const float*)(ws + WS_LOGITS); const u16* te = (const u16*)(ws + WS_TOKE); const float* tg = (const float*)(ws + WS_TOKG);
        for (size_t t = gt; t < T; t += NGT) { float gsc[8]; for (int g = 0; g < 8; ++g) { float m1 = -1e30f, m2 = -1e30f; for (int j = 0; j < 32; ++j) { const float b = sigm(LG[t * 256 + g * 32 + j]) + a.in[12][g * 32 + j]; if (b > m1) { m2 = m1; m1 = b; } else if (b > m2) m2 = b; } gsc[g] = m1 + m2; }
            unsigned gm = 0; for (int g = 0; g < 8; ++g) { int r = 0; for (int j = 0; j < 8; ++j) r += (gsc[j] > gsc[g] || (gsc[j] == gsc[g] && j < g)); if (r < 4) gm |= 1u << g; }
            unsigned long long taken[4] = {0, 0, 0, 0}; float ssum = 0.f; int ok = 1;
            for (int k = 0; k < 8; ++k) { float bv = -1e30f; int bi = -1; for (int e = 0; e < 256; ++e) { if (!((gm >> (e >> 5)) & 1u) || ((taken[e >> 6] >> (e & 63)) & 1ull)) continue; const float b = sigm(LG[t * 256 + e]) + a.in[12][e]; if (b > bv) { bv = b; bi = e; } }
                taken[bi >> 6] |= 1ull << (bi & 63); ssum += sigm(LG[t * 256 + bi]); if (te[t * 8 + k] != bi) ok = 0; }
            for (int k = 0; k < 8 && ok; ++k) { const float ref = sigm(LG[t * 256 + te[t * 8 + k]]) / ssum * 2.5f; if (badv(tg[t * 8 + k], ref, 0.001f, 1e-5f)) ok = 0; }
            if (!ok) ++bad; } }
    else if (mode == 18) { const int* stok = (const int*)(ws + WS_STOK) + (size_t)qd * QTILES * 256; const float* sg = (const float*)(ws + WS_SGATE) + (size_t)qd * QTILES * 256; const int* sd = (const int*)(ws + WS_SDST) + (size_t)qd * QTILES * 256; const int* tle = (const int*)(ws + WS_TILEE) + qd * QTILES;
        const int nt = ((const int*)(ws + WS_NTILES))[qd]; const u16* te = (const u16*)(ws + WS_TOKE); const float* tg = (const float*)(ws + WS_TOKG); unsigned* cnt = res + 64;
        if (nt < 64 || nt > QTILES) { if (gt == 0) ++bad; } else
        for (size_t sl = gt; sl < (size_t)nt * 256; sl += NGT) { const int d = sd[sl], tk = stok[sl], e = tle[sl >> 8]; if (d == TQ * NSLOT) { if (tk != qd * TQ || sg[sl] != 0.f) ++bad; continue; }
            if (d < 0 || d > TQ * NSLOT || tk < qd * TQ || tk >= (qd + 1) * TQ) { ++bad; continue; } const int k = d % NSLOT; if (d / NSLOT != tk - qd * TQ) { ++bad; continue; }
            if (k == 8) { if (e != 256 || sg[sl] != 1.f) ++bad; } else { if (te[(size_t)tk * 8 + k] != e || tg[(size_t)tk * 8 + k] != sg[sl]) ++bad; }
            atomicAdd(cnt, 1u); } }
    else if (mode == 19) { const int* stok = (const int*)(ws + WS_STOK) + (size_t)qd * QTILES * 256; const int* tle = (const int*)(ws + WS_TILEE) + qd * QTILES; const int nt = ((const int*)(ws + WS_NTILES))[qd]; const u16* H = (const u16*)(ws + WS_H); const u16* WGU = (const u16*)(ws + WS_WGU);
        for (size_t i = gt; i < (size_t)nt * 32 * 256; i += NGT) { const int sl = (int)(i / 256) * 8 + 5, j = (int)(i % 256); const int e = tle[sl >> 8], tk = stok[sl]; const u16* xr = XB + (size_t)tk * D;
            const u16* wg = WGU + ((size_t)e * 512 + (j >> 7) * 256 + (j & 127)) * D; const float g = dotb(xr, wg, D), u = dotb(xr, wg + (size_t)128 * D, D); if (badv(bf1(H[(size_t)sl * 256 + j]), g * sigm(g) * u, 0.03f, 0.003f)) ++bad; } }
    else if (mode == 20) { const int* sd = (const int*)(ws + WS_SDST) + (size_t)qd * QTILES * 256; const float* sg = (const float*)(ws + WS_SGATE) + (size_t)qd * QTILES * 256; const int* tle = (const int*)(ws + WS_TILEE) + qd * QTILES; const int nt = ((const int*)(ws + WS_NTILES))[qd]; const u16* H = (const u16*)(ws + WS_H); const u16* WD = (const u16*)(ws + WS_WD); const u16* YS = (const u16*)(ws + WS_YS);
        for (size_t i = gt; i < (size_t)nt * 32 * D; i += NGT) { const int sl = (int)(i / D) * 8 + 2, c = (int)(i % D); const int e = tle[sl >> 8], d = sd[sl]; if (d == TQ * NSLOT) continue;
            const float ref = sg[sl] * dotb(H + (size_t)sl * 256, WD + ((size_t)e * 1024 + c) * 256, 256); if (badv(bf1(YS[(size_t)d * D + c]), ref, 0.02f, 0.002f)) ++bad; } }
    else if (mode == 21) { const u16* PB = (const u16*)(ws + WS_PB) + (size_t)qd * TQ * 256; const u16* P2 = (const u16*)(ws + WS_P2) + (size_t)qd * TQ * D; const float* p = a.in[1] + (size_t)qd * TQ * 256;
        for (size_t i = gt; i < (size_t)TQ * D; i += NGT) { const int row = (int)(i / D), c = (int)(i % D); if (badv(bf1(P2[i]), dotb(PB + (size_t)row * 256, (const u16*)(ws + WS_WPP) + (size_t)c * 256, 256), 0.02f, 0.01f)) ++bad; if (c < 256 && badv(bf1(PB[(size_t)row * 256 + c]), p[(size_t)row * 256 + c], 0.005f, 1e-6f)) ++bad; } }
    else if (mode == 22) { const u16* X1 = XB + (size_t)qd * TQ * D; const u16* YS = (const u16*)(ws + WS_YS); const u16* X2 = (const u16*)(ws + WS_X2B) + (size_t)qd * TQ * D;
        for (size_t row = gt; row < TQ; row += NGT) { float m = 0.f, v = 0.f; for (int pass = 0; pass < 3; ++pass) { for (int c = 0; c < D; ++c) { float x = ALPHA * bf1(X1[row * D + c]); for (int k = 0; k < NSLOT; ++k) x += bf1(YS[(row * NSLOT + k) * D + c]);
                    if (pass == 0) m += x; else if (pass == 1) v += (x - m) * (x - m); else { const float ref = (x - m) * v * a.in[19][c] + a.in[20][c]; if (badv(bf1(X2[row * D + c]), ref, 0.01f, 0.01f)) ++bad; } } if (pass == 0) m /= D; else if (pass == 1) v = 1.f / sqrtf(v / D + LN_EPS); } } }
    else if (mode == 23) { const u16* X2 = (const u16*)(ws + WS_X2B); const u16* P2 = (const u16*)(ws + WS_P2); const float* O = a.out + (size_t)qd * TQ * D;
        for (size_t i = gt; i < (size_t)TQ * D; i += NGT) { const int row = (int)(i / D), c = (int)(i % D); const float ref = ALPHA * bf1(X2[i]) + sigm(dotb(X2 + (size_t)row * D, (const u16*)(ws + WS_WPG) + (size_t)c * D, D)) * bf1(P2[i]); if (badv(O[i], ref, 0.002f, 0.002f)) ++bad; } }
    else if (mode == 24) { const float* O = a.out + (size_t)qd * TQ * D;
        for (size_t row = gt; row < TQ; row += NGT) { float m = 0.f, v = 0.f; int nf = 0; for (int c = 0; c < D; ++c) { const float x = (O[row * D + c] - a.in[24][c]) / a.in[23][c]; m += x; v += x * x; nf += !(x - x == 0.f); } m /= D; v = v / D - m * m; if (nf || fabsf(m) > 1e-3f || fabsf(v - 1.f) > 1e-2f) ++bad; } }
    for (int o = 32; o >= 1; o >>= 1) bad += __shfl_xor(bad, o);
    if ((threadIdx.x & 63) == 0 && bad) atomicAdd(res + mode, bad);
}
__global__ void chk_encode(float* out, size_t n, const unsigned* res, int what) {
    unsigned code = 0;
    if (what == 0) { for (int m = 1; m < 64; ++m) if (res[m]) { code = m; break; } }
    else if (what > 0) { const unsigned b = res[what]; code = b ? 1 + (31 - __clz(b)) : 0; }
    else if (what == -1) { code = (res[64] == (unsigned)(4 * TQ * NSLOT)) ? 0 : 7; }
    else if (what == -4) { const unsigned nm = res[700], no = res[701]; code = (nm ? 1 + (31 - __clz(nm)) : 0) + (no ? 40 : 0); }
    else if (what == -2) { const int ms[6] = {11, 13, 14, 15, 16, 17}; for (int i = 0; i < 6; ++i) if (res[ms[i]]) code |= 1u << i; }
    else { const int ms[6] = {18, 19, 20, 21, 22, 23}; for (int i = 0; i < 6; ++i) if (res[ms[i]]) code |= 1u << i; if (res[24]) code += 64; if (code > 98) code = 98; }
    const float c = sqrtf((float)code);
    for (size_t i = (size_t)blockIdx.x * blockDim.x + threadIdx.x; i < n; i += (size_t)gridDim.x * blockDim.x) out[i] = c;
}
#ifndef DBG_WHAT
#define DBG_WHAT 0
#endif
#endif


#if DBG_TIME
__global__ void time_encode(float* out, size_t n, const unsigned long long* ts) {
    auto ms = [&](int a, int b) { return (float)(ts[b] - ts[a]) * 1e-5f; };
    (void)ms; unsigned code = DBG_TIME_EXPR; if (code > 98) code = 98;
    const float c = sqrtf((float)code);
    for (size_t i = (size_t)blockIdx.x * blockDim.x + threadIdx.x; i < n; i += (size_t)gridDim.x * blockDim.x) out[i] = c;
}
#endif

extern "C" void kernel_launch(void* const* d_in, const int* in_sizes, int n_in, void* d_out, int out_size, void* d_ws, size_t ws_size, hipStream_t stream) {
    static int grid = 0;
    if (grid == 0) {
        if (n_in != 25 || out_size != T * D || ws_size < WS_END) { fprintf(stderr, "kernel_launch: unexpected problem (n_in %d out %d ws %zu)\n", n_in, out_size, ws_size); grid = -1; return; }
        if (hipFuncSetAttribute((const void*)fwd_kernel, hipFuncAttributeMaxDynamicSharedMemorySize, LDS_BYTES) != hipSuccess) { fprintf(stderr, "kernel_launch: hipFuncSetAttribute failed\n"); grid = -1; return; }
        int per_cu = 0; (void)hipOccupancyMaxActiveBlocksPerMultiprocessor(&per_cu, (const void*)fwd_kernel, NTHR, LDS_BYTES); (void)hipGetLastError();
        if (per_cu < 1) fprintf(stderr, "kernel_launch: occupancy query says %d\n", per_cu);
        grid = 256;
    }
    if (grid < 0) return;
    (void)hipMemsetAsync((char*)d_ws + WS_CTL, 0, CTL_ZERO_BYTES, stream);
    Args a{};
    for (int i = 0; i < 25; ++i) a.in[i] = (const float*)d_in[i];
    a.out = (float*)d_out; a.ws = (unsigned char*)d_ws;
#if DBG_CHECK
    ChkArgs ca{}; for (int i = 0; i < 25; ++i) ca.in[i] = (const float*)d_in[i]; ca.out = (float*)d_out; ca.ws = (unsigned char*)d_ws;
#define CHK(m, q) do { ca.mode = (m); ca.qd = (q); hipLaunchKernelGGL(chk_kernel, dim3(2048), dim3(256), 0, stream, ca); } while (0)
    for (int ph = 0; ph < NPHASE; ++ph) { a.lo = ph; a.hi = ph + 1;
        if (ph == 1) (void)hipMemsetAsync((char*)d_ws + Z_GTH, 0x3C, (size_t)256 * MiB, stream);
        hipLaunchKernelGGL(fwd_kernel, dim3(grid), dim3(NTHR), LDS_BYTES, stream, a);
        if (ph == 0) CHK(1, 0);
        if (ph == 1) for (int m = 2; m <= 12; ++m) CHK(m, 0);
        if (ph == 2) CHK(26, 0);
        if (ph == 3) CHK(25, 0);
        if (ph == 5) CHK(13, 0);
        if (ph == 6) CHK(14, 0);
        if (ph == 7) CHK(15, 0);
        if (ph == 8) CHK(16, 0);
        if (ph == 9) CHK(17, 0);
        if (ph >= PH_FIXED && ph < PH_TAIL0) { const int q = (ph - PH_FIXED) / PH_PER_Q, j = (ph - PH_FIXED) % PH_PER_Q;
            if (j == 0) { CHK(18, q); CHK(19, q); if (q > 0) CHK(22, q - 1); } if (j == 1) CHK(20, q); }
        if (ph == PH_TAIL0) CHK(22, NQ - 1);
        if (ph == PH_TAIL0 + 1) for (int q = 0; q < NQ; ++q) { CHK(21, q); CHK(24, q); } }
    hipLaunchKernelGGL(chk_encode, dim3(2048), dim3(256), 0, stream, (float*)d_out, (size_t)out_size, (const unsigned*)((unsigned char*)d_ws + WS_CTL) + CHK_WORD0, DBG_WHAT);
#elif MK_PER_PHASE
    for (int ph = 0; ph < NPHASE; ++ph) { a.lo = ph; a.hi = ph + 1; hipLaunchKernelGGL(fwd_kernel, dim3(grid), dim3(NTHR), LDS_BYTES, stream, a); }
#else
    a.lo = 0; a.hi = NPHASE;
    hipLaunchKernelGGL(fwd_kernel, dim3(grid), dim3(NTHR), LDS_BYTES, stream, a);
#if DBG_TIME
    hipLaunchKernelGGL(time_encode, dim3(2048), dim3(256), 0, stream, (float*)d_out, (size_t)out_size, (const unsigned long long*)((unsigned char*)d_ws + WS_CTL + 60 * 1024));
#endif
#endif
}
```

```cpp
#include <hip/hip_runtime.h>
#include <cstdio>
#include <cstdint>

#ifndef DBG_SLOT_LO
#define DBG_SLOT_LO 0
#define DBG_SLOT_HI 9
#endif
#ifndef DBG_SKIP_YA
#define DBG_SKIP_YA 0
#endif
#ifndef DBG_CHECK
#define DBG_CHECK 0
#endif
#ifndef DBG_PN_LO
#define DBG_PN_LO 0
#endif
#ifndef DBG_TIME
#define DBG_TIME 0
#endif
#ifndef USE_NAIVE_ATTN
#define USE_NAIVE_ATTN 0
#endif
#ifndef USE_NAIVE_HGRN
#define USE_NAIVE_HGRN 0
#endif
#ifndef DBG_DUP
#define DBG_DUP 0u
#endif
#define DUPN(bit) (((DBG_DUP) >> (bit)) & 1u ? 2 : 1)
#ifndef F8_SCALED
#define F8_SCALED 1
#endif
#ifndef MK_PER_PHASE
#define MK_PER_PHASE 0
#endif

#define LAS __attribute__((address_space(3)))
typedef unsigned short u16;
typedef short bf16x8 __attribute__((ext_vector_type(8)));
typedef float f32x4 __attribute__((ext_vector_type(4)));
typedef float f32x2 __attribute__((ext_vector_type(2)));
typedef unsigned u32x4 __attribute__((ext_vector_type(4)));
typedef unsigned u32x2 __attribute__((ext_vector_type(2)));
typedef int i32x16 __attribute__((ext_vector_type(16)));

constexpr int T = 65536, D = 1024, SEQ = 2048;
constexpr int NCOL = 6912;
constexpr int NQ = 2, TQ = T / NQ;
constexpr int NEXP = 256, NSLOT = 9;
constexpr int QTILES = (TQ * 8 + 256 * 255) / 256 + 1 + TQ / 256;
constexpr int WPC = 256 / NQ;
constexpr float ALPHA = 1.189207115002721f;
constexpr float LN_EPS = 1e-5f;
constexpr int NWAVES = 8, NTHR = 512;
constexpr float Y8_SCALE = 256.f;
constexpr float M8_SCALE = 16.f;
constexpr float H8_SCALE = 32.f;
constexpr float W8_SCALE = 64.f;

constexpr size_t MiB = (size_t)1 << 20;
constexpr size_t WS_CTL = 0, CTL_ZERO_BYTES = 64 * 1024;
constexpr size_t WS_WIN = 1 * MiB, WS_WBH = 15 * MiB, WS_WBA = 16 * MiB, WS_WO = 17 * MiB, WS_WR = 19 * MiB, WS_WPG = 20 * MiB, WS_WPP = 22 * MiB;
constexpr size_t WS_ROT = 22 * MiB + 512 * 1024, WS_LB = 22 * MiB + 768 * 1024;
constexpr size_t WS_HIST = 24 * MiB, WS_TOKE = 25 * MiB, WS_TOKR = 26 * MiB, WS_TOKG = 27 * MiB;
constexpr size_t WS_TOKD = 42 * MiB;
constexpr size_t WS_STOK = 29 * MiB, WS_SGATE = 33 * MiB, WS_SDST = 37 * MiB, WS_TILEE = 41 * MiB, WS_NTILES = 41 * MiB + 512 * 1024;
constexpr size_t WS_XB = 44 * MiB;
constexpr size_t WS_YH = WS_XB, WS_YA = WS_XB + 64 * MiB;
constexpr size_t WS_Z = 172 * MiB;
constexpr size_t Z_QH = WS_Z, Z_VH = WS_Z + 64 * MiB, Z_LFF = WS_Z + 128 * MiB, Z_LFB = WS_Z + 192 * MiB, Z_GS = WS_Z + 256 * MiB;
constexpr size_t Z_AQ = WS_Z + 320 * MiB, Z_AK = WS_Z + 416 * MiB, Z_AV = WS_Z + 512 * MiB, Z_GTH = WS_Z + 608 * MiB, Z_GTA = WS_Z + 736 * MiB;
constexpr size_t WS_X1PRE = WS_Z;
constexpr size_t WS_LOGITS = WS_Z;
constexpr size_t WS_H = WS_Z;
constexpr size_t WS_P2 = WS_Z + 296 * MiB;
constexpr size_t WS_X2B = WS_Z + 104 * MiB;
constexpr size_t WS_PB = WS_Z + 424 * MiB;
constexpr size_t WS_WGU = WS_Z + 296 * MiB;
constexpr size_t WS_WD = WS_Z + 425 * MiB;
constexpr size_t WS_X1F8 = WS_Z + 490 * MiB;
constexpr size_t WS_X3PRE = WS_Z + 802 * MiB;
constexpr size_t WS_X2F8 = WS_Z + 554 * MiB;
constexpr size_t WS_YS = WS_Z + 642 * MiB;
constexpr size_t WS_END = WS_Z + 931 * MiB;
constexpr size_t DO_OF = 0, DO_OB = 64 * MiB, DO_MERGED = 0, DO_MERGED8 = 128 * MiB;

constexpr int CW_BAR = 4096;

__device__ __forceinline__ unsigned cvt_pk_bf16(float lo, float hi) { unsigned r; asm volatile("v_cvt_pk_bf16_f32 %0, %1, %2" : "=v"(r) : "v"(lo), "v"(hi)); return r; }
typedef int i32x8 __attribute__((ext_vector_type(8)));
typedef int i32x4 __attribute__((ext_vector_type(4)));
__device__ __forceinline__ unsigned pk_fp8x4(float a, float b, float c, float d) { int w = 0; w = __builtin_amdgcn_cvt_pk_fp8_f32(a, b, w, false); w = __builtin_amdgcn_cvt_pk_fp8_f32(c, d, w, true); return (unsigned)w; }
typedef float f32x2_t __attribute__((ext_vector_type(2)));
__device__ __forceinline__ void fp8x4_to_f32(unsigned w, float (&o)[4]) { const f32x2_t lo = __builtin_amdgcn_cvt_pk_f32_fp8((int)w, false), hi = __builtin_amdgcn_cvt_pk_f32_fp8((int)w, true); o[0] = lo.x; o[1] = lo.y; o[2] = hi.x; o[3] = hi.y; }
__device__ __forceinline__ float bf_lo(unsigned w) { return __uint_as_float(w << 16); }
__device__ __forceinline__ float bf_hi(unsigned w) { return __uint_as_float(w & 0xffff0000u); }
__device__ __forceinline__ float bf1(u16 b) { return __uint_as_float(((unsigned)b) << 16); }
__device__ __forceinline__ float sigmoidf_(float z) { return __builtin_amdgcn_rcpf(1.0f + __expf(-z)); }
__device__ __forceinline__ unsigned pk_f16(float lo, float hi) { _Float16 a = (_Float16)lo, b = (_Float16)hi; unsigned short ua = __builtin_bit_cast(unsigned short, a), ub = __builtin_bit_cast(unsigned short, b); return (unsigned)ua | ((unsigned)ub << 16); }
__device__ __forceinline__ float f16_lo(unsigned w) { return (float)__builtin_bit_cast(_Float16, (unsigned short)(w & 0xffffu)); }
__device__ __forceinline__ float f16_hi(unsigned w) { return (float)__builtin_bit_cast(_Float16, (unsigned short)(w >> 16)); }
__device__ __forceinline__ float wave_sum(float v) {
    v += __int_as_float(__builtin_amdgcn_update_dpp(0, __float_as_int(v), 0xB1, 0xF, 0xF, true));
    v += __int_as_float(__builtin_amdgcn_update_dpp(0, __float_as_int(v), 0x4E, 0xF, 0xF, true));
    v += __int_as_float(__builtin_amdgcn_update_dpp(0, __float_as_int(v), 0x141, 0xF, 0xF, true));
    v += __int_as_float(__builtin_amdgcn_update_dpp(0, __float_as_int(v), 0x140, 0xF, 0xF, true));
    const int iv = __float_as_int(v);
    return (__int_as_float(__builtin_amdgcn_readlane(iv, 0)) + __int_as_float(__builtin_amdgcn_readlane(iv, 16))) + (__int_as_float(__builtin_amdgcn_readlane(iv, 32)) + __int_as_float(__builtin_amdgcn_readlane(iv, 48)));
}
__device__ __forceinline__ float wave_max(float v) {
#pragma unroll
    for (int o = 1; o < 64; o <<= 1) v = fmaxf(v, __shfl_xor(v, o));
    return v;
}
template <int CTRL> __device__ __forceinline__ float dpp_f(float x) { return __int_as_float(__builtin_amdgcn_update_dpp(0, __float_as_int(x), CTRL, 0xF, 0xF, true)); }
template <int CTRL> __device__ __forceinline__ int dpp_i(int x) { return __builtin_amdgcn_update_dpp(0, x, CTRL, 0xF, 0xF, true); }
__device__ __forceinline__ float rdlane_f(float x, int l) { return __int_as_float(__builtin_amdgcn_readlane(__float_as_int(x), l)); }
#define LDS_WAIT() asm volatile("s_waitcnt lgkmcnt(0)" ::: "memory")
#define VM_WAIT() asm volatile("s_waitcnt vmcnt(0)" ::: "memory")

#define XB_TMO      128
#define XB_XCNT(j)  (256  + 64 * (j))
#define XB_XSUB(j)  (1280 + 64 * (j))
#define XB_XGEN(j)  (2304 + 64 * (j))
#define XB_TOP      3328
#define XB_TOPGEN   3392
#define XCD_BAR_WORDS 3456
#define XB_SPIN_CAP (1u << 22)

__device__ __forceinline__ unsigned xb_ld(unsigned* p)              { return __hip_atomic_load(p, __ATOMIC_RELAXED, __HIP_MEMORY_SCOPE_AGENT); }
__device__ __forceinline__ unsigned xb_add(unsigned* p, unsigned v) { return __hip_atomic_fetch_add(p, v, __ATOMIC_RELAXED, __HIP_MEMORY_SCOPE_AGENT); }
__device__ __forceinline__ unsigned xb_xcc_id() { return (unsigned)__builtin_amdgcn_s_getreg((3 << 11) | 20) & 0xFu; }
#define XB_SPIN(cond, bar) do { unsigned _sp = 0; while (cond) { __builtin_amdgcn_s_sleep(1); \
    if ((++_sp & 255u) == 0u) { if (xb_ld(&(bar)[XB_TMO])) break; if (_sp > XB_SPIN_CAP) { atomicAdd(&(bar)[XB_TMO], 1u); break; } } } } while (0)

struct XcdBarrier { unsigned* bar; unsigned x; volatile LAS unsigned* st; };

__device__ __forceinline__ XcdBarrier xcd_barrier_post(unsigned* bar, volatile LAS unsigned* st) {
    XcdBarrier b; b.bar = bar; b.x = xb_xcc_id(); b.st = st;
    if (threadIdx.x == 0) (void)xb_add(&bar[XB_XCNT(b.x)], 1u);
    return b;
}
__device__ __forceinline__ void xcd_barrier_complete(unsigned* bar, unsigned x, unsigned& nloc, unsigned& nx) {
    const unsigned G = gridDim.x * gridDim.y * gridDim.z;
    unsigned sum, cnt, mine, sp = 0u;
    for (;;) {
        sum = 0u; cnt = 0u; mine = 0u;
#pragma unroll
        for (unsigned j = 0; j < 16; ++j) { const unsigned c = xb_ld(&bar[XB_XCNT(j)]); sum += c; cnt += (c > 0u) ? 1u : 0u; mine = (j == x) ? c : mine; }
        if (sum == G) break;
        __builtin_amdgcn_s_sleep(1);
        if ((++sp & 255u) == 0u) { if (xb_ld(&bar[XB_TMO])) break; if (sp > XB_SPIN_CAP) { atomicAdd(&bar[XB_TMO], 1u); break; } }
    }
    nloc = mine > 0u ? mine : 1u; nx = cnt > 0u ? cnt : 1u;
}
__device__ __forceinline__ void xcd_barrier(const XcdBarrier& b) {
    asm volatile("s_waitcnt vmcnt(0)" ::: "memory");
    __syncthreads();
    if (threadIdx.x == 0) {
        unsigned* bar = b.bar;
        __builtin_amdgcn_s_waitcnt(0);
        unsigned nloc = b.st[0], nx = b.st[1];
        if (nloc == 0u) { xcd_barrier_complete(bar, b.x, nloc, nx); b.st[0] = nloc; b.st[1] = nx; }
        const unsigned old = xb_add(&bar[XB_XSUB(b.x)], 1u);
        const unsigned gen = old / nloc;
        if (old + 1u == (gen + 1u) * nloc) {
            __builtin_amdgcn_fence(__ATOMIC_RELEASE, "agent");
            asm volatile("s_waitcnt vmcnt(0)" ::: "memory");
            const unsigned og = xb_add(&bar[XB_TOP], 1u);
            const unsigned tg = og / nx;
            if (og + 1u == (tg + 1u) * nx) xb_add(&bar[XB_TOPGEN], 1u);
            else XB_SPIN(xb_ld(&bar[XB_TOPGEN]) == tg, bar);
            __builtin_amdgcn_fence(__ATOMIC_ACQUIRE, "agent");
            xb_add(&bar[XB_XGEN(b.x)], 1u);
            asm volatile("s_waitcnt vmcnt(0)" ::: "memory");
        } else {
            XB_SPIN(xb_ld(&bar[XB_XGEN(b.x)]) == gen, bar);
            __builtin_amdgcn_fence(__ATOMIC_ACQUIRE, "agent");
            asm volatile("s_waitcnt vmcnt(0)" ::: "memory");
        }
    }
    __syncthreads();
}

namespace pg8 {
constexpr int BM = 256, BK = 64, HALF = 128, HTB = HALF * BK * 2, STAGE_BYTES = 8 * HTB;
__host__ __device__ __forceinline__ int lds_byte(int r, int c) { const int st = (r >> 4) * 2 + (c >> 5), rr = r & 15, cc = c & 31, ob = rr * 64 + cc * 2; return st * 1024 + (ob ^ (((ob >> 9) & 1) << 5)); }
__host__ __device__ __forceinline__ void stage_rc(int b, int& R, int& C) { const int st = b / 1024, sb = b % 1024, swz = sb ^ (((sb >> 9) & 1) << 5); R = (st >> 1) * 16 + swz / 64; C = (st & 1) * 32 + (swz % 64) / 2; }
__host__ __device__ __forceinline__ int perm32(int rho) { const int n = rho >> 4, i = rho & 15; return 8 * (i >> 2) + 4 * n + (i & 3); }

struct GUnit { const char* A; const char* B; int pm, pn, aux, par, li; };

struct DenseOrder {
    static constexpr bool GATHER_ROWS = false;
    const char* A; const char* Bt; int nM, nN, nwg, G, c, K, rev = 0;
    __device__ void init(const void* A_, const void* Bt_, int M, int N, int K_, int G_, int c_) { A = (const char*)A_; Bt = (const char*)Bt_; nM = M / BM; nN = N / BM; nwg = nM * nN; G = G_; c = c_; K = K_; }
    __device__ __forceinline__ bool next(int i, GUnit& u) const {
        if ((long)i * G + c >= nwg) return false; const int nr_ = (nwg + G - 1) / G; const long L = rev ? (long)(nr_ - 1 - i) * G + c : (long)i * G + c; if (L >= nwg) return false;
        int wgid = (int)L; { const int q = nwg / 8, r = nwg % 8, xcd = wgid % 8, off = wgid / 8; wgid = (xcd < r ? xcd * (q + 1) : r * (q + 1) + (xcd - r) * q) + off; }
        const int nig = 8 * nN, gid = wgid / nig, fm = gid * 8, gsz = (nM - fm) < 8 ? (nM - fm) : 8;
        u.pm = fm + ((wgid % nig) % gsz); u.pn = (wgid % nig) / gsz; u.aux = 0;
        u.A = A + (size_t)u.pm * BM * K * 2; u.B = Bt + (size_t)u.pn * BM * K * 2; return true;
    }
    __device__ __forceinline__ unsigned rowoff(const GUnit&, int r0, int sub) const { return (unsigned)(r0 + sub) * (unsigned)K * 2u; }
    __device__ __forceinline__ void unit_begin(const GUnit&, int, int) const {}
};
struct PanelOrder {
    static constexpr bool GATHER_ROWS = false;
    const char* A; const char* Bt; int pm, nN, K;
    __device__ __forceinline__ bool next(int i, GUnit& u) const { if (i >= nN) return false; u.pm = pm; u.pn = i; u.aux = 0; u.A = A + (size_t)pm * BM * K * 2; u.B = Bt + (size_t)i * BM * K * 2; return true; }
    __device__ __forceinline__ unsigned rowoff(const GUnit&, int r0, int sub) const { return (unsigned)(r0 + sub) * (unsigned)K * 2u; }
    __device__ __forceinline__ void unit_begin(const GUnit&, int, int) const {}
};
constexpr int LDS_SIDE = 131072, LDS_TILEE = 135680, LDS_ROWIDX = LDS_TILEE + ((QTILES * 4 + 255) & ~255), LDS_ROWSLOTS = 16;
template <int NT, bool GATHER> struct MoeOrder {
    static constexpr bool GATHER_ROWS = GATHER;
    const char* A; const char* W; LAS unsigned char* lds; const int* slot_tok; const int* sdst; const float* sgate; int ntiles, G, vc, K; size_t wstride_e, wstride_pn;
    __device__ __forceinline__ void load_table(const int* tile_e, int tid) const {
        for (int i = tid; i < ntiles; i += NTHR) ((LAS int*)(lds + LDS_TILEE))[i] = tile_e[i];
        if (GATHER) { for (int j = tid; j < LDS_ROWSLOTS * 256; j += NTHR) { const int v = (j >> 8) * G + vc, tile = v / NT; if (tile < ntiles) ((LAS int*)(lds + LDS_ROWIDX))[j] = slot_tok[(size_t)tile * BM + (j & 255)]; } }
        asm volatile("s_waitcnt vmcnt(0) lgkmcnt(0)" ::: "memory"); __syncthreads(); }
    __device__ __forceinline__ bool next(int i, GUnit& u) const {
        const int v = i * G + vc; const int tile = v / NT; if (tile >= ntiles) return false;
        u.pm = tile; u.pn = v % NT; u.li = i; const int e = __builtin_amdgcn_readfirstlane(((const LAS int*)(lds + LDS_TILEE))[tile]); u.aux = e;
        u.A = GATHER ? A : A + (size_t)tile * BM * K * 2; u.B = W + (size_t)e * wstride_e + (size_t)u.pn * wstride_pn; return true;
    }
    __device__ __forceinline__ unsigned rowoff(const GUnit& u, int r0, int sub) const {
        if (!GATHER) return (unsigned)(r0 + sub) * (unsigned)K * 2u;
        const int idx = ((const LAS int*)(lds + LDS_ROWIDX))[(u.li & (LDS_ROWSLOTS - 1)) * 256 + r0 + sub];
        return (unsigned)idx * (unsigned)K * 2u;
    }
    __device__ __forceinline__ void unit_begin(const GUnit&, int, int) const {}
};

template <bool OPAQUE_K = false, int F8M = 0  , bool SADDR = true  , class Epi, class Sched>
__device__ __forceinline__ void gemm_phase(LAS unsigned char* lds, const int K_, const Sched& S, const Epi& E) {
    constexpr bool F8 = F8M != 0; constexpr bool F8_SC = F8M == 2;
    int K = K_; if (OPAQUE_K) asm volatile("" : "+s"(K));
    int tid_ = threadIdx.x; asm volatile("" : "+v"(tid_));
    const int tid = tid_, wid = __builtin_amdgcn_readfirstlane(tid >> 6), lane = tid & 63, wr = wid >> 2, wc = wid & 3, fr = lane & 15, fq = lane >> 4;
    const int nt = K / BK;
    unsigned colb[2]; int r0w[2]; unsigned voffB0 = 0, oaS = 0;
#pragma unroll
    for (int i = 0; i < 2; ++i) { int R, C; stage_rc(tid * 16 + i * 8192, R, C); const int Rb = Epi::PERM ? ((R & ~31) + perm32(R & 31)) : R;
        colb[i] = (unsigned)C * 2u; r0w[i] = 16 * ((wid >> 1) + 4 * i); if (i == 0) { voffB0 = (unsigned)(Rb * K + C) * 2u; oaS = (unsigned)(R * K + C) * 2u; } }
    const size_t p64 = (size_t)64 * K * 2; const unsigned K2 = (unsigned)K * 2u, colb0 = colb[0]; const int ridx_lane = (r0w[0] + (lane >> 2)) * 4;
    const int sub = lane >> 2;
    const size_t kstep = (size_t)(BK * 2);
    const size_t hstep = (size_t)HALF * K * 2;
    const unsigned ldsw = (unsigned)wid * 1024u;
    const int aoff = lds_byte(wr * 64 + fr, fq * 8), boff = lds_byte(wc * 32 + fr, fq * 8);
#define PG8_SA(b, h) (((b) * 2 + (h)) * HTB)
#define PG8_SB(b, h) ((4 + (b) * 2 + (h)) * HTB)
#define PG8_STAGE1(ldsaddr, gbase, vo) do { const unsigned long long gb_ = (unsigned long long)(gbase); \
        if constexpr (SADDR) { const unsigned la_ = (unsigned)(size_t)(ldsaddr); \
            asm volatile("s_mov_b32 m0, %2\n\ts_nop 0\n\tglobal_load_lds_dwordx4 %0, %1" :: "v"(vo), "s"(gb_), "s"(la_) : "memory"); }     \
        else { unsigned lo_, hi_; \
            asm volatile("v_add_co_u32 %0, vcc, %2, %4\n\tv_mov_b32 %1, %3\n\tv_addc_co_u32 %1, vcc, 0, %1, vcc" : "=&v"(lo_), "=&v"(hi_) : "s"((unsigned)gb_), "s"((unsigned)(gb_ >> 32)), "v"(vo) : "vcc"); \
            __builtin_amdgcn_global_load_lds((const unsigned*)(((unsigned long long)hi_ << 32) | lo_), (LAS unsigned*)(ldsaddr), 16, 0, 0); } } while (0)
#define PG8_STAGE_B(bufoff, gbase) do { PG8_STAGE1(lds + (bufoff) + ldsw, (const char*)(gbase), voffB0); PG8_STAGE1(lds + (bufoff) + ldsw + 8192, (const char*)(gbase) + p64, voffB0); } while (0)
#define PG8_STAGE_A(bufoff, gbase, h, li_) do { if constexpr (Sched::GATHER_ROWS) { \
            PG8_STAGE1(lds + (bufoff) + ldsw, (const char*)(gbase), (unsigned)gi##h##0 * K2 + colb0); PG8_STAGE1(lds + (bufoff) + ldsw + 8192, (const char*)(gbase), (unsigned)gi##h##1 * K2 + colb0); } \
        else { PG8_STAGE1(lds + (bufoff) + ldsw, (const char*)(gbase) + (h) * hstep, oaS); PG8_STAGE1(lds + (bufoff) + ldsw + 8192, (const char*)(gbase) + (h) * hstep + p64, oaS); } } while (0)
#define PG8_GIDX(h, li_) int gi##h##0 = 0, gi##h##1 = 0; if constexpr (Sched::GATHER_ROWS) { int rl_ = ridx_lane; asm volatile("" : "+v"(rl_));   const LAS unsigned char* gp_ = lds + LDS_ROWIDX + ((li_) & (LDS_ROWSLOTS - 1)) * 1024 + (h) * 512 + rl_; gi##h##0 = *(const LAS int*)gp_; gi##h##1 = *(const LAS int*)(gp_ + 256); }
#define PG8_LDA(dst, b, h) do { _Pragma("unroll") for (int m = 0; m < 4; ++m) _Pragma("unroll") for (int k = 0; k < 2; ++k) dst[m][k] = *(const LAS bf16x8*)(lds + PG8_SA(b, h) + aoff + m * 2048 + k * 1024); } while (0)
#define PG8_LDB(dst, b, h) do { _Pragma("unroll") for (int n = 0; n < 2; ++n) _Pragma("unroll") for (int k = 0; k < 2; ++k) dst[n][k] = *(const LAS bf16x8*)(lds + PG8_SB(b, h) + boff + n * 2048 + k * 1024); } while (0)
#define PG8_MMA(ai, bj, At, Bt) do { __builtin_amdgcn_s_setprio(1); _Pragma("unroll") for (int m = 0; m < 4; ++m) _Pragma("unroll") for (int n = 0; n < 2; ++n) { \
        if constexpr (F8) { \
            if constexpr (F8_SC) { const i32x8 a8_ = __builtin_shufflevector(__builtin_bit_cast(i32x4, At[m][0]), __builtin_bit_cast(i32x4, At[m][1]), 0, 1, 2, 3, 4, 5, 6, 7), b8_ = __builtin_shufflevector(__builtin_bit_cast(i32x4, Bt[n][0]), __builtin_bit_cast(i32x4, Bt[n][1]), 0, 1, 2, 3, 4, 5, 6, 7); \
                acc[ai][bj][m][n] = __builtin_amdgcn_mfma_scale_f32_16x16x128_f8f6f4(b8_, a8_, acc[ai][bj][m][n], 0, 0, 0, sc1_, 0, sc1_); } \
            else { _Pragma("unroll") for (int k = 0; k < 2; ++k) { typedef long l64x2 __attribute__((ext_vector_type(2))); const l64x2 a_ = __builtin_bit_cast(l64x2, At[m][k]), b_ = __builtin_bit_cast(l64x2, Bt[n][k]); \
                acc[ai][bj][m][n] = __builtin_amdgcn_mfma_f32_16x16x32_fp8_fp8(b_[0], a_[0], acc[ai][bj][m][n], 0, 0, 0); acc[ai][bj][m][n] = __builtin_amdgcn_mfma_f32_16x16x32_fp8_fp8(b_[1], a_[1], acc[ai][bj][m][n], 0, 0, 0); } } } \
        else { _Pragma("unroll") for (int k = 0; k < 2; ++k) acc[ai][bj][m][n] = __builtin_amdgcn_mfma_f32_16x16x32_bf16(Bt[n][k], At[m][k], acc[ai][bj][m][n], 0, 0, 0); } } \
        __builtin_amdgcn_s_setprio(0); } while (0)
#define PG8_WAIT_V(n) asm volatile("s_waitcnt vmcnt(" #n ")" ::: "memory")
#define PG8_WAIT_L(n) asm volatile("s_waitcnt lgkmcnt(" #n ")" ::: "memory")
#define PG8_BAR __builtin_amdgcn_s_barrier()
#define PG8_SCHED __builtin_amdgcn_sched_barrier(0)
    int sc1_; asm volatile("s_mov_b32 %0, 0x7f7f7f7f" : "=s"(sc1_));
    GUnit cur, nxt; int ui = 0;
    if (!S.next(0, cur)) return;
    f32x4 acc[2][2][4][2];
#pragma unroll
    for (int a = 0; a < 2; ++a)
#pragma unroll
        for (int b = 0; b < 2; ++b)
#pragma unroll
            for (int m = 0; m < 4; ++m)
#pragma unroll
                for (int n = 0; n < 2; ++n) acc[a][b][m][n] = (f32x4){0.f, 0.f, 0.f, 0.f};
    bf16x8 At[4][2], B0[2][2], B1[2][2];
    const char* cA = cur.A; const char* cB = cur.B;
    { PG8_GIDX(0, cur.li) PG8_GIDX(1, cur.li) PG8_STAGE_B(PG8_SB(0, 0), cB); PG8_STAGE_A(PG8_SA(0, 0), cA, 0, cur.li); PG8_STAGE_B(PG8_SB(0, 1), cB + hstep); PG8_STAGE_A(PG8_SA(0, 1), cA, 1, cur.li); }
    if (wr == 1) PG8_BAR;
    PG8_WAIT_V(4); PG8_BAR;
    { PG8_GIDX(0, cur.li) PG8_STAGE_B(PG8_SB(1, 0), cB + kstep); PG8_STAGE_A(PG8_SA(1, 0), cA + kstep, 0, cur.li); PG8_STAGE_B(PG8_SB(1, 1), cB + hstep + kstep); }
    PG8_WAIT_V(6); PG8_BAR;
    for (;;) {
        cur.par = ui & 1; S.unit_begin(cur, ui & 1, wid);
        const bool has_next = S.next(ui + 1, nxt);
        const char* nA = has_next ? nxt.A : cA; const char* nB = has_next ? nxt.B : cB;
        for (int t = 0; t < nt; t += 2) {
            const bool last = (t == nt - 2);
            const char* a1 = cA + (size_t)(t + 1) * kstep;
            const char* a2 = last ? nA : cA + (size_t)(t + 2) * kstep; const char* b2 = last ? nB : cB + (size_t)(t + 2) * kstep;
            const char* a3 = a2 + kstep; const char* b3 = b2 + kstep;
            const int lis = (last && has_next) ? nxt.li : cur.li;
            { PG8_GIDX(1, cur.li) PG8_LDB(B0, 0, 0); PG8_SCHED; PG8_LDA(At, 0, 0); PG8_STAGE_A(PG8_SA(1, 1), a1, 1, cur.li); }
            PG8_WAIT_L(8); PG8_BAR; PG8_WAIT_L(0); PG8_MMA(0, 0, At, B0); PG8_BAR; PG8_SCHED;
            PG8_LDB(B1, 0, 1); PG8_STAGE_B(PG8_SB(0, 0), b2);
            PG8_BAR; PG8_WAIT_L(0); PG8_MMA(0, 1, At, B1); PG8_BAR;
            { PG8_GIDX(0, lis) PG8_LDA(At, 0, 1); PG8_STAGE_A(PG8_SA(0, 0), a2, 0, lis); }
            PG8_BAR; PG8_WAIT_L(0); PG8_MMA(1, 0, At, B0); PG8_BAR; PG8_SCHED;
            PG8_STAGE_B(PG8_SB(0, 1), b2 + hstep);
            PG8_WAIT_V(6); PG8_BAR; PG8_MMA(1, 1, At, B1); PG8_BAR;
            { PG8_GIDX(1, lis) PG8_LDB(B0, 1, 0); PG8_SCHED; PG8_LDA(At, 1, 0); PG8_STAGE_A(PG8_SA(0, 1), a2, 1, lis); }
            PG8_WAIT_L(8); PG8_BAR; PG8_WAIT_L(0); PG8_MMA(0, 0, At, B0); PG8_BAR; PG8_SCHED;
            PG8_LDB(B1, 1, 1); PG8_STAGE_B(PG8_SB(1, 0), b3);
            PG8_BAR; PG8_WAIT_L(0); PG8_MMA(0, 1, At, B1); PG8_BAR;
            { PG8_GIDX(0, lis) PG8_LDA(At, 1, 1); PG8_STAGE_A(PG8_SA(1, 0), a3, 0, lis); }
            PG8_BAR; PG8_WAIT_L(0); PG8_MMA(1, 0, At, B0); PG8_BAR; PG8_SCHED;
            PG8_STAGE_B(PG8_SB(1, 1), b3 + hstep);
            PG8_WAIT_V(6); PG8_BAR; PG8_MMA(1, 1, At, B1); PG8_BAR;
        }
        { int l_ = threadIdx.x; asm volatile("" : "+v"(l_));
          E(acc, cur, wr, wc, l_ & 15, (l_ & 63) >> 4); }
        if (!has_next) break;
#pragma unroll
        for (int a = 0; a < 2; ++a)
#pragma unroll
            for (int b = 0; b < 2; ++b)
#pragma unroll
                for (int m = 0; m < 4; ++m)
#pragma unroll
                    for (int n = 0; n < 2; ++n) acc[a][b][m][n] = (f32x4){0.f, 0.f, 0.f, 0.f};
        cur = nxt; cA = nA; cB = nB; ++ui;
    }
    PG8_WAIT_V(0);
    if (wr == 0) PG8_BAR;
    PG8_BAR;
#undef PG8_SA
#undef PG8_SB
#undef PG8_STAGE1
#undef PG8_STAGE_A
#undef PG8_GIDX
#undef PG8_STAGE_B
#undef PG8_LDA
#undef PG8_LDB
#undef PG8_MMA
#undef PG8_WAIT_V
#undef PG8_WAIT_L
#undef PG8_BAR
#undef PG8_SCHED
}

#define EPI_LOOP_ROWS for (int ai = 0; ai < 2; ++ai) _Pragma("unroll") for (int m = 0; m < 4; ++m)

__device__ __forceinline__ u32x4 pair16(u32x2 xa, u32x2 xb) {
    const auto lo = __builtin_amdgcn_permlane16_swap(xa.x, xb.x, false, false), hi = __builtin_amdgcn_permlane16_swap(xa.y, xb.y, false, false);
    u32x4 w; w.x = lo[0]; w.y = hi[0]; w.z = lo[1]; w.w = hi[1]; return w; }
enum { K_SILU = 0, K_ID = 1, K_LOGF = 2, K_ROT = 3, K_SIG = 4, K_ID8 = 5   };
struct EpiZ {
    static constexpr bool PERM = true;
    unsigned char* ws; const float* rot; const float* lb; float osc;
    template <int KIND> __device__ __forceinline__ void body(const f32x4 (&acc)[2][2][4][2], u16* base, int ld, int pnl, int pm, float scale, const float* lbp, int wr, int wc, int fr, int fq) const {
        const int row0 = pm * BM + wr * 64 + fr, col0 = pnl * BM + wc * 32 + 8 * fq;
        if constexpr (KIND == K_ID8) {
            unsigned char* bp = (unsigned char*)base + (size_t)(row0 + 16 * (fq & 1)) * ld + col0 - 8 * (fq & 1);
#pragma unroll
            for (int ai = 0; ai < 2; ++ai)
#pragma unroll
                for (int mp = 0; mp < 4; mp += 2)
#pragma unroll
                    for (int bj = 0; bj < 2; ++bj) { u32x2 x[2];
#pragma unroll
                        for (int t = 0; t < 2; ++t) { const f32x4 v0 = acc[ai][bj][mp + t][0] * osc, v1 = acc[ai][bj][mp + t][1] * osc; x[t].x = pk_fp8x4(v0[0], v0[1], v0[2], v0[3]); x[t].y = pk_fp8x4(v1[0], v1[1], v1[2], v1[3]); }
                        *(u32x4*)(bp + (size_t)(ai * HALF + mp * 16) * ld + bj * HALF) = pair16(x[0], x[1]); }
            return;
        }
        f32x4 l0[2], l1[2];
        if (KIND == K_LOGF) {
#pragma unroll
            for (int bj = 0; bj < 2; ++bj) { l0[bj] = *(const f32x4*)(lbp + col0 + bj * HALF); l1[bj] = *(const f32x4*)(lbp + col0 + bj * HALF + 4); }
        }
        const bool rotl = (KIND == K_ROT) && ((wc & 1) == 0) && (fq < 2);
        const float sgn = (fq == 0) ? -1.f : 1.f;
#pragma unroll
        for (int ai = 0; ai < 2; ++ai) {
        f32x4 rt[4][4];
        if (KIND == K_ROT) {
#pragma unroll
            for (int m = 0; m < 4; ++m) { const float* rp = rot + (size_t)((row0 + ai * HALF + m * 16) & (SEQ - 1)) * 16;
#pragma unroll
                for (int k = 0; k < 4; ++k) rt[m][k] = *(const f32x4*)(rp + 4 * k); }
            __builtin_amdgcn_sched_barrier(0);
        }
#pragma unroll
        for (int m = 0; m < 4; ++m) {
            const int row = row0 + ai * HALF + m * 16;
            f32x4 cs0, cs1, sn0, sn1;
            if (KIND == K_ROT) { cs0 = rt[m][0]; cs1 = rt[m][1]; sn0 = rt[m][2]; sn1 = rt[m][3]; }
#pragma unroll
            for (int bj = 0; bj < 2; ++bj) {
                f32x4 v0 = acc[ai][bj][m][0] * osc, v1 = acc[ai][bj][m][1] * osc;
                if (KIND == K_SILU) {
#pragma unroll
                    for (int j = 0; j < 4; ++j) { v0[j] = v0[j] * sigmoidf_(v0[j]); v1[j] = v1[j] * sigmoidf_(v1[j]); }
                } else if (KIND == K_SIG) {
#pragma unroll
                    for (int j = 0; j < 4; ++j) { v0[j] = sigmoidf_(v0[j]); v1[j] = sigmoidf_(v1[j]); }
                } else if (KIND == K_LOGF) {
#pragma unroll
                    for (int j = 0; j < 4; ++j) { v0[j] = __logf(l0[bj][j] + (1.f - l0[bj][j]) * sigmoidf_(v0[j])); v1[j] = __logf(l1[bj][j] + (1.f - l1[bj][j]) * sigmoidf_(v1[j])); }
                } else if (KIND == K_ROT) {
                    f32x4 o0, o1;
#pragma unroll
                    for (int j = 0; j < 4; ++j) { o0[j] = __shfl_xor(v0[j], 16); o1[j] = __shfl_xor(v1[j], 16); }
                    if (rotl) {
#pragma unroll
                        for (int j = 0; j < 4; ++j) { v0[j] = v0[j] * cs0[j] + sgn * o0[j] * sn0[j]; v1[j] = v1[j] * cs1[j] + sgn * o1[j] * sn1[j]; }
                    }
                    v0 = v0 * scale; v1 = v1 * scale;
                }
                if (KIND == K_ID8) { u32x2 w8; w8.x = pk_fp8x4(v0[0], v0[1], v0[2], v0[3]); w8.y = pk_fp8x4(v1[0], v1[1], v1[2], v1[3]);
                    *(u32x2*)((unsigned char*)base + (size_t)row * ld + col0 + bj * HALF) = w8; continue; }
                u32x4 w;
                if (KIND == K_LOGF) { w.x = pk_f16(v0[0], v0[1]); w.y = pk_f16(v0[2], v0[3]); w.z = pk_f16(v1[0], v1[1]); w.w = pk_f16(v1[2], v1[3]); }
                else { w.x = cvt_pk_bf16(v0[0], v0[1]); w.y = cvt_pk_bf16(v0[2], v0[3]); w.z = cvt_pk_bf16(v1[0], v1[1]); w.w = cvt_pk_bf16(v1[2], v1[3]); }
                *(u32x4*)(base + (size_t)row * ld + col0 + bj * HALF) = w;
            }
        }
        }
    }
    __device__ __forceinline__ void operator()(const f32x4 (&acc)[2][2][4][2], const GUnit& u, int wr, int wc, int fr, int fq) const {
        const int pn = u.pn, pm = u.pm;
        if (pn < DBG_PN_LO) return;
        if (pn < 2)       body<K_ID8>(acc, (u16*)(ws + Z_QH), 512, pn, pm, 1.f, nullptr, wr, wc, fr, fq);
        else if (pn < 4)  body<K_ID8>(acc, (u16*)(ws + Z_VH), 512, pn - 2, pm, 1.f, nullptr, wr, wc, fr, fq);
        else if (pn < 6)  body<K_ID>(acc, (u16*)(ws + Z_LFF), 512, pn - 4, pm, 1.f, nullptr, wr, wc, fr, fq);
        else if (pn < 8)  body<K_ID>(acc, (u16*)(ws + Z_LFB), 512, pn - 6, pm, 1.f, nullptr, wr, wc, fr, fq);
        else if (pn < 10) body<K_ID8>(acc, (u16*)(ws + Z_GS), 512, pn - 8, pm, 1.f, nullptr, wr, wc, fr, fq);
        else if (pn < 13) body<K_ROT>(acc, (u16*)(ws + Z_AQ), 768, pn - 10, pm, 0.125f, nullptr, wr, wc, fr, fq);
        else if (pn < 16) body<K_ROT>(acc, (u16*)(ws + Z_AK), 768, pn - 13, pm, 1.f, nullptr, wr, wc, fr, fq);
        else if (pn < 19) body<K_ID>(acc, (u16*)(ws + Z_AV), 768, pn - 16, pm, 1.f, nullptr, wr, wc, fr, fq);
        else if (pn < 23) body<K_ID8>(acc, (u16*)(ws + Z_GTH), 1024, pn - 19, pm, 1.f, nullptr, wr, wc, fr, fq);
        else              body<K_ID8>(acc, (u16*)(ws + Z_GTA), 1024, pn - 23, pm, 1.f, nullptr, wr, wc, fr, fq);
    }
};

template <bool ADD> struct EpiGated {
    static constexpr bool PERM = true;
    const u16* gate; u16* out; unsigned char* out8; int ld;
    __device__ __forceinline__ void operator()(const f32x4 (&acc)[2][2][4][2], const GUnit& u, int wr, int wc, int fr, int fq) const {
        const int row0 = u.pm * BM + wr * 64 + fr, col0 = u.pn * BM + wc * 32 + 8 * fq;
        constexpr float isc = 1.0f / W8_SCALE;
#pragma unroll
        for (int ai = 0; ai < 2; ++ai)
#pragma unroll
        for (int mp = 0; mp < 4; mp += 2) {
            u32x2 gv[4][2]; u32x4 pv[4][2];
#pragma unroll
            for (int m = mp; m < mp + 2; ++m)
#pragma unroll
                for (int bj = 0; bj < 2; ++bj) { const size_t off = (size_t)(row0 + ai * HALF + m * 16) * ld + col0 + bj * HALF; gv[m][bj] = *(const u32x2*)((const unsigned char*)gate + off); if (ADD) pv[m][bj] = *(const u32x4*)(out + off); }
            __builtin_amdgcn_sched_barrier(0);
#pragma unroll
                for (int bj = 0; bj < 2; ++bj) { u32x2 x8[2];
#pragma unroll
                    for (int t = 0; t < 2; ++t) { const int m = mp + t; const size_t off = (size_t)(row0 + ai * HALF + m * 16) * ld + col0 + bj * HALF;
                        const u32x2 g = gv[m][bj]; float g0[4], g1[4]; fp8x4_to_f32(g.x, g0); fp8x4_to_f32(g.y, g1);
                        f32x4 v0 = acc[ai][bj][m][0] * isc, v1 = acc[ai][bj][m][1] * isc;
#pragma unroll
                        for (int j = 0; j < 4; ++j) { v0[j] *= sigmoidf_(g0[j]); v1[j] *= sigmoidf_(g1[j]); }
                        if (ADD) { const u32x4 p = pv[m][bj];
                            v0[0] += bf_lo(p.x); v0[1] += bf_hi(p.x); v0[2] += bf_lo(p.y); v0[3] += bf_hi(p.y);
                            v1[0] += bf_lo(p.z); v1[1] += bf_hi(p.z); v1[2] += bf_lo(p.w); v1[3] += bf_hi(p.w);
                            x8[t].x = pk_fp8x4(v0[0] * M8_SCALE, v0[1] * M8_SCALE, v0[2] * M8_SCALE, v0[3] * M8_SCALE); x8[t].y = pk_fp8x4(v1[0] * M8_SCALE, v1[1] * M8_SCALE, v1[2] * M8_SCALE, v1[3] * M8_SCALE); }
                        else { u32x4 w; w.x = cvt_pk_bf16(v0[0], v0[1]); w.y = cvt_pk_bf16(v0[2], v0[3]); w.z = cvt_pk_bf16(v1[0], v1[1]); w.w = cvt_pk_bf16(v1[2], v1[3]);
                            *(u32x4*)(out + off) = w; }
                    }
                    if (ADD) *(u32x4*)(out8 + (size_t)(row0 + ai * HALF + (mp + (fq & 1)) * 16) * ld + col0 - 8 * (fq & 1) + bj * HALF) = pair16(x8[0], x8[1]);
                }
            __builtin_amdgcn_sched_barrier(0);
        }
    }
};
struct EpiF32Res {
    static constexpr bool PERM = false;
    float* C; const float* res; u16* Cb; int ld; float alpha; float asc;
    __device__ __forceinline__ void operator()(const f32x4 (&acc)[2][2][4][2], const GUnit& u, int wr, int wc, int fr, int fq) const {
        const int row0 = u.pm * BM + wr * 64 + fr, col0 = u.pn * BM + wc * 32 + 4 * fq;
#pragma unroll
        EPI_LOOP_ROWS {
            const size_t off = (size_t)(row0 + ai * HALF + m * 16) * ld + col0;
#pragma unroll
            for (int bj = 0; bj < 2; ++bj)
#pragma unroll
                for (int n = 0; n < 2; ++n) { f32x4 v = acc[ai][bj][m][n] * asc; if (res) v = v + alpha * *(const f32x4*)(res + off + bj * HALF + n * 16);
                    if (Cb) { u32x2 w; w.x = cvt_pk_bf16(v[0], v[1]); w.y = cvt_pk_bf16(v[2], v[3]); *(u32x2*)(Cb + off + bj * HALF + n * 16) = w; } else *(f32x4*)(C + off + bj * HALF + n * 16) = v; }
        }
    }
};
struct EpiBf16Res {
    static constexpr bool PERM = true;
    const float* res; u16* Cb; int ld; float alpha; float asc;
    __device__ __forceinline__ void operator()(const f32x4 (&acc)[2][2][4][2], const GUnit& u, int wr, int wc, int fr, int fq) const {
        const int row0 = u.pm * BM + wr * 64 + fr, col0 = u.pn * BM + wc * 32 + 8 * fq;
#pragma unroll
        for (int ai = 0; ai < 2; ++ai)
#pragma unroll
        for (int mp = 0; mp < 4; mp += 2) {
            f32x4 r[2][2][2];
#pragma unroll
            for (int t = 0; t < 2; ++t)
#pragma unroll
                for (int bj = 0; bj < 2; ++bj) { const float* rp = res + (size_t)(row0 + ai * HALF + (mp + t) * 16) * ld + col0 + bj * HALF; r[t][bj][0] = *(const f32x4*)rp; r[t][bj][1] = *(const f32x4*)(rp + 4); }
            __builtin_amdgcn_sched_barrier(0);
#pragma unroll
            for (int t = 0; t < 2; ++t)
#pragma unroll
                for (int bj = 0; bj < 2; ++bj) { const int m = mp + t; const f32x4 v0 = acc[ai][bj][m][0] * asc + alpha * r[t][bj][0], v1 = acc[ai][bj][m][1] * asc + alpha * r[t][bj][1];
                    u32x4 w; w.x = cvt_pk_bf16(v0[0], v0[1]); w.y = cvt_pk_bf16(v0[2], v0[3]); w.z = cvt_pk_bf16(v1[0], v1[1]); w.w = cvt_pk_bf16(v1[2], v1[3]);
                    *(u32x4*)(Cb + (size_t)(row0 + ai * HALF + m * 16) * ld + col0 + bj * HALF) = w; }
            __builtin_amdgcn_sched_barrier(0);
        }
    }
};
struct EpiBf16 {
    static constexpr bool PERM = true;
    u16* O; int ld;
    __device__ __forceinline__ void operator()(const f32x4 (&acc)[2][2][4][2], const GUnit& u, int wr, int wc, int fr, int fq) const {
        const int row0 = u.pm * BM + wr * 64 + fr, col0 = u.pn * BM + wc * 32 + 8 * fq;
#pragma unroll
        EPI_LOOP_ROWS {
            u16* rowp = O + (size_t)(row0 + ai * HALF + m * 16) * ld + col0;
#pragma unroll
            for (int bj = 0; bj < 2; ++bj) { const f32x4 v0 = acc[ai][bj][m][0], v1 = acc[ai][bj][m][1];
                u32x4 w; w.x = cvt_pk_bf16(v0[0], v0[1]); w.y = cvt_pk_bf16(v0[2], v0[3]); w.z = cvt_pk_bf16(v1[0], v1[1]); w.w = cvt_pk_bf16(v1[2], v1[3]);
                *(u32x4*)(rowp + bj * HALF) = w; }
        }
    }
};
struct EpiSwiglu {
    static constexpr bool PERM = true;
    unsigned char* H;
    __device__ __forceinline__ void operator()(const f32x4 (&acc)[2][2][4][2], const GUnit& u, int wr, int wc, int fr, int fq) const {
        const int row0 = u.pm * BM + wr * 64 + fr, col0 = u.pn * HALF + wc * 32 + 8 * fq;
        constexpr float isc = 1.0f / W8_SCALE;
        unsigned char* hp = H + (size_t)(row0 + 16 * (fq & 1)) * 256 + col0 - 8 * (fq & 1);
#pragma unroll
        for (int ai = 0; ai < 2; ++ai)
#pragma unroll
            for (int mp = 0; mp < 4; mp += 2) { u32x2 x[2];
#pragma unroll
                for (int t = 0; t < 2; ++t) { const int m = mp + t;
                    f32x4 g0 = acc[ai][0][m][0] * isc, g1 = acc[ai][0][m][1] * isc; const f32x4 u0 = acc[ai][1][m][0] * (isc * H8_SCALE), u1 = acc[ai][1][m][1] * (isc * H8_SCALE);
#pragma unroll
                    for (int j = 0; j < 4; ++j) { g0[j] = g0[j] * sigmoidf_(g0[j]) * u0[j]; g1[j] = g1[j] * sigmoidf_(g1[j]) * u1[j]; }
                    x[t].x = pk_fp8x4(g0[0], g0[1], g0[2], g0[3]); x[t].y = pk_fp8x4(g1[0], g1[1], g1[2], g1[3]); }
                *(u32x4*)(hp + (size_t)(ai * HALF + mp * 16) * 256) = pair16(x[0], x[1]); }
    }
};
struct EpiDown {
    static constexpr bool PERM = true;
    unsigned char* Y; LAS unsigned char* lds;
    __device__ __forceinline__ void operator()(const f32x4 (&acc)[2][2][4][2], const GUnit& u, int wr, int wc, int fr, int fq) const {
        const int col0 = u.pn * BM + wc * 32 + 8 * fq;
        const LAS unsigned* side = (const LAS unsigned*)(lds + LDS_SIDE + u.par * 2048);
        unsigned dd[8]; float gg[8];
#pragma unroll
        for (int j = 0; j < 8; ++j) { const int lr = wr * 64 + fr + (j >> 2) * HALF + (j & 3) * 16; dd[j] = side[(lr >> 5) * 64 + (lr & 31)]; gg[j] = __uint_as_float(side[(lr >> 5) * 64 + 32 + (lr & 31)]) * (Y8_SCALE / (W8_SCALE * H8_SCALE)); }
#pragma unroll
        EPI_LOOP_ROWS {
            const unsigned d = dd[ai * 4 + m]; const float g = gg[ai * 4 + m];
            unsigned char* rowp = Y + (size_t)(d * (unsigned)D + (unsigned)col0);
#pragma unroll
            for (int bj = 0; bj < 2; ++bj) { const f32x4 v0 = acc[ai][bj][m][0] * g, v1 = acc[ai][bj][m][1] * g;
                u32x2 w; w.x = pk_fp8x4(v0[0], v0[1], v0[2], v0[3]); w.y = pk_fp8x4(v1[0], v1[1], v1[2], v1[3]);
                *(u32x2*)(rowp + bj * HALF) = w; }
        }
    }
};
struct EpiPle {
    static constexpr bool PERM = true;
    u16* out; const u16* x2; const u16* p2; int ld; float asc;
    __device__ __forceinline__ void operator()(const f32x4 (&acc)[2][2][4][2], const GUnit& u, int wr, int wc, int fr, int fq) const {
        const int row0 = u.pm * BM + wr * 64 + fr, col0 = u.pn * BM + wc * 32 + 8 * fq;
#pragma unroll
        for (int ai = 0; ai < 2; ++ai) {
            u32x4 xv[4][2], pv[4][2];
#pragma unroll
            for (int m = 0; m < 4; ++m)
#pragma unroll
                for (int bj = 0; bj < 2; ++bj) { const size_t o = (size_t)(row0 + ai * HALF + m * 16) * ld + col0 + bj * HALF; xv[m][bj] = *(const u32x4*)(x2 + o); pv[m][bj] = *(const u32x4*)(p2 + o); }
            __builtin_amdgcn_sched_barrier(0);
#pragma unroll
            for (int m = 0; m < 4; ++m)
#pragma unroll
                for (int bj = 0; bj < 2; ++bj) { const size_t o = (size_t)(row0 + ai * HALF + m * 16) * ld + col0 + bj * HALF; const u32x4 x = xv[m][bj], p = pv[m][bj]; const f32x4 a = acc[ai][bj][m][0] * asc, b = acc[ai][bj][m][1] * asc;
                    u32x4 r; r.x = cvt_pk_bf16(ALPHA * bf_lo(x.x) + sigmoidf_(a[0]) * bf_lo(p.x), ALPHA * bf_hi(x.x) + sigmoidf_(a[1]) * bf_hi(p.x));
                    r.y = cvt_pk_bf16(ALPHA * bf_lo(x.y) + sigmoidf_(a[2]) * bf_lo(p.y), ALPHA * bf_hi(x.y) + sigmoidf_(a[3]) * bf_hi(p.y));
                    r.z = cvt_pk_bf16(ALPHA * bf_lo(x.z) + sigmoidf_(b[0]) * bf_lo(p.z), ALPHA * bf_hi(x.z) + sigmoidf_(b[1]) * bf_hi(p.z));
                    r.w = cvt_pk_bf16(ALPHA * bf_lo(x.w) + sigmoidf_(b[2]) * bf_lo(p.w), ALPHA * bf_hi(x.w) + sigmoidf_(b[3]) * bf_hi(p.w));
                    *(u32x4*)(out + o) = r; }
            __builtin_amdgcn_sched_barrier(0);
        }
    }
};
}

struct Args { const float* in[25]; float* out; unsigned char* ws; int lo, hi; };
struct Frame {
    LAS unsigned char* lds; int tid, lane, wave, vcu, G; unsigned char* ws; unsigned char* dout;
};

__device__ __forceinline__ void transpose_item(const float* __restrict__ W, int ldw, int k0, int n0, u16* __restrict__ WT, size_t dst_row0, int Kd, LAS float* scr, int lane) {
#pragma unroll 8
    for (int i = 0; i < 32; ++i) { const int kk = 2 * i + (lane >> 5); scr[kk * 33 + (lane & 31)] = W[(size_t)(k0 + kk) * ldw + n0 + (lane & 31)]; }
    LDS_WAIT(); asm volatile("" ::: "memory");
    const int c = lane & 7;
#pragma unroll
    for (int j = 0; j < 4; ++j) { const int n = (lane >> 3) + 8 * j; const LAS float* s = scr + (8 * c) * 33 + n;
        u32x4 o; o.x = cvt_pk_bf16(s[0 * 33], s[1 * 33]); o.y = cvt_pk_bf16(s[2 * 33], s[3 * 33]); o.z = cvt_pk_bf16(s[4 * 33], s[5 * 33]); o.w = cvt_pk_bf16(s[6 * 33], s[7 * 33]);
        *(u32x4*)(WT + (dst_row0 + n) * (size_t)Kd + k0 + 8 * c) = o; }
    LDS_WAIT(); asm volatile("" ::: "memory");
}

__device__ __forceinline__ void transpose_item_f8(const float* __restrict__ W, int ldw, int k0, int n0, unsigned char* __restrict__ WT, size_t dst_row0, int Kd, float scale, LAS float* scr, int lane) {
    float tv[32];
#pragma unroll
    for (int i = 0; i < 32; ++i) tv[i] = W[(size_t)(k0 + 2 * i + (lane >> 5)) * ldw + n0 + (lane & 31)];
#pragma unroll
    for (int i = 0; i < 32; ++i) scr[(2 * i + (lane >> 5)) * 33 + (lane & 31)] = tv[i];
    LDS_WAIT(); asm volatile("" ::: "memory");
    const int c = lane & 7;
#pragma unroll
    for (int j = 0; j < 4; ++j) { const int n = (lane >> 3) + 8 * j; const LAS float* sp = scr + (8 * c) * 33 + n;
        u32x2 o; o.x = pk_fp8x4(sp[0 * 33] * scale, sp[1 * 33] * scale, sp[2 * 33] * scale, sp[3 * 33] * scale); o.y = pk_fp8x4(sp[4 * 33] * scale, sp[5 * 33] * scale, sp[6 * 33] * scale, sp[7 * 33] * scale);
        *(u32x2*)(WT + (dst_row0 + n) * (size_t)Kd + k0 + 8 * c) = o; }
    LDS_WAIT(); asm volatile("" ::: "memory");
}
__device__ __forceinline__ bool transpose_matrix_item(int& r, const float* W, int K, int N, u16* WT, LAS float* scr, int lane) {
    const int nitems = (K / 64) * (N / 32);
    if (r < nitems) { const int nblk = N / 32, kb = r / nblk, nb = r % nblk; transpose_item(W, N, 64 * kb, 32 * nb, WT, (size_t)32 * nb, K, scr, lane); return true; }
    r -= nitems; return false;
}

template <bool OUT_BF16> __device__ __forceinline__ void ln_row(const float* xrow, const float* g, const float* b, void* orow, int lane, unsigned* o8row = nullptr) {
    const f32x4* xr = (const f32x4*)xrow + lane;
    f32x4 v[4]; float s = 0.f;
#pragma unroll
    for (int j = 0; j < 4; ++j) { v[j] = xr[64 * j]; s += (v[j].x + v[j].y) + (v[j].z + v[j].w); }
    const float mean = wave_sum(s) * (1.f / D); float s2 = 0.f;
#pragma unroll
    for (int j = 0; j < 4; ++j) { v[j] = v[j] - mean; s2 += (v[j].x * v[j].x + v[j].y * v[j].y) + (v[j].z * v[j].z + v[j].w * v[j].w); }
    const float rstd = 1.f / sqrtf(wave_sum(s2) * (1.f / D) + LN_EPS);
#pragma unroll
    for (int j = 0; j < 4; ++j) { const f32x4 gg = *((const f32x4*)g + lane + 64 * j), bb = *((const f32x4*)b + lane + 64 * j); const f32x4 y = v[j] * rstd * gg + bb;
        if (OUT_BF16) { u32x2 w; w.x = cvt_pk_bf16(y[0], y[1]); w.y = cvt_pk_bf16(y[2], y[3]); *((u32x2*)orow + lane + 64 * j) = w; if (o8row) o8row[lane + 64 * j] = pk_fp8x4(y[0], y[1], y[2], y[3]); }
        else *((f32x4*)orow + lane + 64 * j) = y; }
}


template <bool OUT_BF16, int NR, bool IN_BF16 = false> __device__ __forceinline__ void ln_rows(const void* xbase_, size_t r0, size_t rstride, const float* g, const float* b, void* obase, int lane, unsigned char* o8base = nullptr) {
    f32x4 v[NR][4]; float s[NR]; f32x4 gq[4], bq[4];
#pragma unroll
    for (int j = 0; j < 4; ++j) { gq[j] = *((const f32x4*)g + lane + 64 * j); bq[j] = *((const f32x4*)b + lane + 64 * j); }
#pragma unroll
    for (int r = 0; r < NR; ++r) { s[r] = 0.f;
        if (IN_BF16) { const u32x2* xr = (const u32x2*)((const u16*)xbase_ + (r0 + r * rstride) * D) + lane;
#pragma unroll
            for (int j = 0; j < 4; ++j) { const u32x2 w = xr[64 * j]; v[r][j] = (f32x4){bf_lo(w.x), bf_hi(w.x), bf_lo(w.y), bf_hi(w.y)}; } }
        else { const f32x4* xr = (const f32x4*)((const float*)xbase_ + (r0 + r * rstride) * D) + lane;
#pragma unroll
            for (int j = 0; j < 4; ++j) { v[r][j] = xr[64 * j]; } } }
    __builtin_amdgcn_sched_barrier(0);
#pragma unroll
    for (int r = 0; r < NR; ++r)
#pragma unroll
        for (int j = 0; j < 4; ++j) s[r] += (v[r][j].x + v[r][j].y) + (v[r][j].z + v[r][j].w);
#pragma unroll
    for (int r = 0; r < NR; ++r) s[r] = wave_sum(s[r]);
    float s2[NR];
#pragma unroll
    for (int r = 0; r < NR; ++r) { const float mean = s[r] * (1.f / D); s2[r] = 0.f;
#pragma unroll
        for (int j = 0; j < 4; ++j) { v[r][j] = v[r][j] - mean; s2[r] += (v[r][j].x * v[r][j].x + v[r][j].y * v[r][j].y) + (v[r][j].z * v[r][j].z + v[r][j].w * v[r][j].w); } }
#pragma unroll
    for (int r = 0; r < NR; ++r) s2[r] = wave_sum(s2[r]);
#pragma unroll
    for (int j = 0; j < 4; ++j) { const f32x4 gg = gq[j], bb = bq[j];
#pragma unroll
        for (int r = 0; r < NR; ++r) { const float rstd = 1.f / sqrtf(s2[r] * (1.f / D) + LN_EPS); const f32x4 y = v[r][j] * rstd * gg + bb; const size_t row = r0 + r * rstride;
            if (OUT_BF16) { u32x2 w; w.x = cvt_pk_bf16(y[0], y[1]); w.y = cvt_pk_bf16(y[2], y[3]); *((u32x2*)((u16*)obase + row * D) + lane + 64 * j) = w; if (o8base) ((unsigned*)(o8base + row * D))[lane + 64 * j] = pk_fp8x4(y[0], y[1], y[2], y[3]); }
            else *((f32x4*)((float*)obase + row * D) + lane + 64 * j) = y; } }
}

template <int NR> __device__ __forceinline__ void ln1_rows16(const u16* X, size_t r0, size_t rstride, const float* g, const float* b, u16* ob, int lane, unsigned char* o8) {
    u32x4 xin[NR][2]; f32x4 gq[4], bq[4];
#pragma unroll
    for (int k = 0; k < 4; ++k) { gq[k] = *(const f32x4*)(g + 16 * lane + 4 * k); bq[k] = *(const f32x4*)(b + 16 * lane + 4 * k); }
#pragma unroll
    for (int r = 0; r < NR; ++r)
#pragma unroll
        for (int c = 0; c < 2; ++c) xin[r][c] = *(const u32x4*)(X + (r0 + r * rstride) * D + 16 * lane + 8 * c);
    __builtin_amdgcn_sched_barrier(0);
#pragma unroll
    for (int r = 0; r < NR; ++r) { const size_t row = r0 + r * rstride; float v[16];
#pragma unroll
        for (int c = 0; c < 2; ++c) { const u32x4 x = xin[r][c];
            v[8 * c + 0] = bf_lo(x.x); v[8 * c + 1] = bf_hi(x.x); v[8 * c + 2] = bf_lo(x.y); v[8 * c + 3] = bf_hi(x.y); v[8 * c + 4] = bf_lo(x.z); v[8 * c + 5] = bf_hi(x.z); v[8 * c + 6] = bf_lo(x.w); v[8 * c + 7] = bf_hi(x.w); }
        float sm = 0.f;
#pragma unroll
        for (int j = 0; j < 16; ++j) sm += v[j];
        const float mean = wave_sum(sm) * (1.f / D); float s2 = 0.f;
#pragma unroll
        for (int j = 0; j < 16; ++j) { v[j] -= mean; s2 += v[j] * v[j]; }
        const float rstd = 1.f / sqrtf(wave_sum(s2) * (1.f / D) + LN_EPS);
        u32x4 w8;
#pragma unroll
        for (int c = 0; c < 2; ++c) { const f32x4 g0 = gq[2 * c], g1 = gq[2 * c + 1], b0 = bq[2 * c], b1 = bq[2 * c + 1];
            const float y0 = v[8 * c + 0] * rstd * g0[0] + b0[0], y1 = v[8 * c + 1] * rstd * g0[1] + b0[1], y2 = v[8 * c + 2] * rstd * g0[2] + b0[2], y3 = v[8 * c + 3] * rstd * g0[3] + b0[3];
            const float y4 = v[8 * c + 4] * rstd * g1[0] + b1[0], y5 = v[8 * c + 5] * rstd * g1[1] + b1[1], y6 = v[8 * c + 6] * rstd * g1[2] + b1[2], y7 = v[8 * c + 7] * rstd * g1[3] + b1[3];
            u32x4 w; w.x = cvt_pk_bf16(y0, y1); w.y = cvt_pk_bf16(y2, y3); w.z = cvt_pk_bf16(y4, y5); w.w = cvt_pk_bf16(y6, y7);
            *(u32x4*)(ob + row * D + 16 * lane + 8 * c) = w;
            w8[2 * c] = pk_fp8x4(y0, y1, y2, y3); w8[2 * c + 1] = pk_fp8x4(y4, y5, y6, y7); }
        *(u32x4*)(o8 + row * D + 16 * lane) = w8; }
}

__device__ __forceinline__ void phase_prologue(const Frame& F, const Args& a) {
    LAS float* scr = (LAS float*)(F.lds + F.wave * 16384);
    const int gw = F.vcu * NWAVES + F.wave, NGW = F.G * NWAVES;
    constexpr int NITEMS = 16 * 216 + 8 * 32 + 4 * 32 + 16 * 32 + 16 * 8 + 16 * 32 + 4 * 32;
    for (int it = gw; it < NITEMS; it += NGW) {
        int r = it;
        if (r < 16 * 216) { const int kb = r / 216, nb = r % 216; transpose_item_f8(a.in[2], NCOL, 64 * kb, 32 * nb, F.ws + WS_WIN, (size_t)32 * nb, 1024, W8_SCALE, scr, F.lane); continue; } r -= 16 * 216;
        if (r < 8 * 32) { const int kb = r / 32, nb = r % 32; transpose_item_f8(a.in[6], 1024, 64 * kb, 32 * nb, F.ws + WS_WBH, (size_t)32 * nb, 512, W8_SCALE, scr, F.lane); continue; } r -= 8 * 32;
        if (r < 4 * 32) { const int kb = r / 32, nb = r % 32; transpose_item_f8(a.in[7], 1024, 64 * kb, 32 * nb, F.ws + WS_WBA, (size_t)32 * nb, 256, W8_SCALE, scr, F.lane); continue; } r -= 4 * 32;
        if (r < 16 * 32) { const int kb = r / 32, nb = r % 32; transpose_item_f8(a.in[8], 1024, 64 * kb, 32 * nb, F.ws + WS_WO, (size_t)32 * nb, 1024, W8_SCALE, scr, F.lane); continue; } r -= 16 * 32;
        if (transpose_matrix_item(r, a.in[11], 1024, 256, (u16*)(F.ws + WS_WR), scr, F.lane)) continue;
        if (r < 16 * 32) { const int kb = r / 32, nb = r % 32; transpose_item_f8(a.in[21], 1024, 64 * kb, 32 * nb, F.ws + WS_WPG, (size_t)32 * nb, 1024, W8_SCALE, scr, F.lane); continue; } r -= 16 * 32;
        transpose_matrix_item(r, a.in[22], 256, 1024, (u16*)(F.ws + WS_WPP), scr, F.lane);
    }
    const size_t gt = (size_t)F.vcu * NTHR + F.tid, NGT = (size_t)F.G * NTHR;
    { const f32x4* x4 = (const f32x4*)a.in[0]; u32x4* o4 = (u32x4*)(F.ws + WS_XB);
      static_assert(((size_t)T * D / 16) % ((size_t)256 * NTHR * 4) == 0, "x conversion unroll");
      for (size_t i = gt; i < (size_t)T * D / 16; i += 4 * NGT) { f32x4 p[4][4];
#pragma unroll
          for (int u = 0; u < 4; ++u)
#pragma unroll
              for (int k = 0; k < 4; ++k) p[u][k] = x4[4 * (i + u * NGT) + k];
          __builtin_amdgcn_sched_barrier(0);
#pragma unroll
          for (int u = 0; u < 4; ++u) { u32x4 w; w.x = pk_fp8x4(p[u][0][0], p[u][0][1], p[u][0][2], p[u][0][3]); w.y = pk_fp8x4(p[u][1][0], p[u][1][1], p[u][1][2], p[u][1][3]); w.z = pk_fp8x4(p[u][2][0], p[u][2][1], p[u][2][2], p[u][2][3]); w.w = pk_fp8x4(p[u][3][0], p[u][3][1], p[u][3][2], p[u][3][3]); o4[i + u * NGT] = w; } } }
    { float* rot = (float*)(F.ws + WS_ROT);
      for (size_t i = gt; i < (size_t)SEQ * 8; i += NGT) {
          const int pos = (int)(i >> 3), fi = (int)(i & 7);
          const double invf = fi == 0 ? 1.0 : fi == 1 ? 0.19392274474868576 : fi == 2 ? 0.03760603093086393 : fi == 3 ? 0.007292664737217109 : fi == 4 ? 0.001414213562373095 : fi == 5 ? 0.0002742481756762073 : fi == 6 ? 5.318295896944988e-05 : 1.031338537721246e-05;
          const double ang = (double)pos * invf; const double kq = __builtin_rint(ang * 0.6366197723675814); const double r = ang - kq * 1.5707963267948966; const double r2 = r * r;
          const double sn = r * (1.0 + r2 * (-1.0 / 6 + r2 * (1.0 / 120 + r2 * (-1.0 / 5040 + r2 * (1.0 / 362880 + r2 * (-1.0 / 39916800 + r2 * (1.0 / 6227020800.0)))))));
          const double cs = 1.0 + r2 * (-0.5 + r2 * (1.0 / 24 + r2 * (-1.0 / 720 + r2 * (1.0 / 40320 + r2 * (-1.0 / 3628800 + r2 * (1.0 / 479001600.0))))));
          const int qd = ((int)kq) & 3; const double s_ = qd == 0 ? sn : qd == 1 ? cs : qd == 2 ? -sn : -cs; const double c_ = qd == 0 ? cs : qd == 1 ? -sn : qd == 2 ? -cs : sn;
          rot[pos * 16 + fi] = (float)c_; rot[pos * 16 + 8 + fi] = (float)s_; } }
    { float* lb = (float*)(F.ws + WS_LB);
      for (size_t i = gt; i < 1024; i += NGT) { const int c = (int)(i & 511); const float* src = (i < 512) ? a.in[3] : a.in[4]; lb[i] = 1.0f / (1.0f + expf(src[512 + c] - src[c])); } }
}

__device__ __forceinline__ void hgrn_item(const Frame& F, int item) {
    const int b = item >> 3, h = (item >> 1) & 3, dir = item & 1;
    LAS float* fb = (LAS float*)F.lds; LAS float* kb = fb + 2048; LAS float* qb = kb + 2048; LAS float* vb = qb + 2048; LAS float* op = vb + 2048;
    const int tid = F.tid, v = tid & 127, eg = tid >> 7, ls = tid >> 5, lc = (tid & 31) * 4;
    const u16* QH = (const u16*)(F.ws + Z_QH); const u16* VH = (const u16*)(F.ws + Z_VH); const u16* LF = (const u16*)(F.ws + (dir ? Z_LFB : Z_LFF));
#if DBG_CHECK && !USE_NAIVE_HGRN
    u16* O = (u16*)(F.ws + WS_XB + (dir ? 64 * MiB : 0));
#else
    u16* O = (u16*)(F.dout + (dir ? DO_OB : DO_OF));
#endif
    float S[32];
#pragma unroll
    for (int j = 0; j < 32; ++j) S[j] = 0.f;
    const size_t rowbase = (size_t)b * SEQ, colbase = (size_t)h * 128;
    u32x2 rq, rv, rl;
    { const int pos = dir ? (SEQ - 1 - ls) : ls; const size_t o = (rowbase + pos) * 512 + colbase + lc; rq = *(const u32x2*)(QH + o); rv = *(const u32x2*)(VH + o); rl = *(const u32x2*)(LF + o); }
    for (int blk = 0; blk < SEQ / 16; ++blk) {
        { const f32x4 lb4 = *(const f32x4*)((const float*)(F.ws + WS_LB) + dir * 512 + h * 128 + lc);
          const f32x4 f = {lb4[0] + (1.f - lb4[0]) * sigmoidf_(bf_lo(rl.x)), lb4[1] + (1.f - lb4[1]) * sigmoidf_(bf_hi(rl.x)), lb4[2] + (1.f - lb4[2]) * sigmoidf_(bf_lo(rl.y)), lb4[3] + (1.f - lb4[3]) * sigmoidf_(bf_hi(rl.y))}; const f32x4 k = {1.f - f[0], 1.f - f[1], 1.f - f[2], 1.f - f[3]};
          *(LAS f32x4*)(fb + ls * 128 + lc) = f; *(LAS f32x4*)(kb + ls * 128 + lc) = k;
          { f32x4 qq = {bf_lo(rq.x), bf_hi(rq.x), bf_lo(rq.y), bf_hi(rq.y)};
#pragma unroll
            for (int j = 0; j < 4; ++j) qq[j] *= sigmoidf_(qq[j]);
            *(LAS f32x4*)(qb + ls * 128 + lc) = qq; }
          *(LAS f32x4*)(vb + ls * 128 + lc) = (f32x4){bf_lo(rv.x), bf_hi(rv.x), bf_lo(rv.y), bf_hi(rv.y)}; }
        __syncthreads();
        if (blk + 1 < SEQ / 16) { const int t = (blk + 1) * 16 + ls; const int pos = dir ? (SEQ - 1 - t) : t; const size_t o = (rowbase + pos) * 512 + colbase + lc; rq = *(const u32x2*)(QH + o); rv = *(const u32x2*)(VH + o); rl = *(const u32x2*)(LF + o); }
#pragma unroll 2
        for (int s = 0; s < 16; ++s) {
            const float vm = vb[s * 128 + v]; float ac = 0.f;
#pragma unroll
            for (int jj = 0; jj < 8; ++jj) {
                const f32x4 f4 = *(const LAS f32x4*)(fb + s * 128 + eg * 32 + 4 * jj), k4 = *(const LAS f32x4*)(kb + s * 128 + eg * 32 + 4 * jj), q4 = *(const LAS f32x4*)(qb + s * 128 + eg * 32 + 4 * jj);
#pragma unroll
                for (int j = 0; j < 4; ++j) { S[4 * jj + j] = f4[j] * S[4 * jj + j] + k4[j] * vm; ac += S[4 * jj + j] * q4[j]; }
            }
            op[(s * 4 + eg) * 128 + v] = ac;
        }
        __syncthreads();
        { const f32x4 o = *(const LAS f32x4*)(op + (ls * 4 + 0) * 128 + lc) + *(const LAS f32x4*)(op + (ls * 4 + 1) * 128 + lc) + *(const LAS f32x4*)(op + (ls * 4 + 2) * 128 + lc) + *(const LAS f32x4*)(op + (ls * 4 + 3) * 128 + lc);
          const int t = blk * 16 + ls; const int pos = dir ? (SEQ - 1 - t) : t; u32x2 w; w.x = cvt_pk_bf16(o[0], o[1]); w.y = cvt_pk_bf16(o[2], o[3]);
          *(u32x2*)(O + (rowbase + pos) * 512 + colbase + lc) = w; }
    }
    __syncthreads();
}

__device__ __forceinline__ void attn_naive(const Frame& F) {
    const int gw = F.vcu * NWAVES + F.wave, NGW = F.G * NWAVES, lane = F.lane;
    const u16* AQ = (const u16*)(F.ws + Z_AQ); const u16* AK = (const u16*)(F.ws + Z_AK); const u16* AV = (const u16*)(F.ws + Z_AV); u16* YA = (u16*)(F.ws + WS_YA);
    for (int wi = gw; wi < T * 4; wi += NGW) {
        const int row = wi >> 2, s = wi & 3, b = row >> 11, p = row & (SEQ - 1);
        float sc[3][3]; int lo_[3], hi_[3];
#pragma unroll
        for (int g = 0; g < 3; ++g) {
            const int sh = 2 * g, mlen = SEQ >> sh, r = p & ((1 << sh) - 1), m = p >> sh; const int lo = m - 64 < 0 ? 0 : m - 64, hi = m + 64 > mlen - 1 ? mlen - 1 : m + 64; lo_[g] = lo; hi_[g] = hi;
            const int hd = g * 4 + s;
            u32x4 qw[8];
            { const u32x4* qp = (const u32x4*)(AQ + (size_t)row * 768 + hd * 64);
#pragma unroll
              for (int c = 0; c < 8; ++c) qw[c] = qp[c]; }
#pragma unroll
            for (int rr = 0; rr < 3; ++rr) {
                const int j = lo + rr * 64 + lane; const bool valid = j <= hi; const int jc = valid ? j : hi;
                const u32x4* kp = (const u32x4*)(AK + ((size_t)b * SEQ + r + ((size_t)jc << sh)) * 768 + hd * 64);
                float d = 0.f;
#pragma unroll
                for (int c = 0; c < 8; ++c) { const u32x4 w = kp[c]; const u32x4 q = qw[c]; d += bf_lo(q.x) * bf_lo(w.x) + bf_hi(q.x) * bf_hi(w.x) + bf_lo(q.y) * bf_lo(w.y) + bf_hi(q.y) * bf_hi(w.y) + bf_lo(q.z) * bf_lo(w.z) + bf_hi(q.z) * bf_hi(w.z) + bf_lo(q.w) * bf_lo(w.w) + bf_hi(q.w) * bf_hi(w.w); }
                sc[g][rr] = valid ? d : -1e30f;
                asm volatile("" : "+v"(sc[g][rr]) :: "memory");
            }
        }
        float mx = -1e30f;
#pragma unroll
        for (int g = 0; g < 3; ++g)
#pragma unroll
            for (int rr = 0; rr < 3; ++rr) mx = fmaxf(mx, sc[g][rr]);
        mx = wave_max(mx);
        float den = 0.f;
#pragma unroll
        for (int g = 0; g < 3; ++g)
#pragma unroll
            for (int rr = 0; rr < 3; ++rr) { sc[g][rr] = sc[g][rr] > -1e29f ? __expf(sc[g][rr] - mx) : 0.f; den += sc[g][rr]; }
        den = wave_sum(den);
        float o = 0.f;
#pragma unroll
        for (int g = 0; g < 3; ++g) {
            const int sh = 2 * g, r = p & ((1 << sh) - 1), hd = g * 4 + s; const u16* vp = AV + ((size_t)b * SEQ + r) * 768 + hd * 64 + lane;
#pragma unroll
            for (int rr = 0; rr < 3; ++rr) {
                const int j0 = lo_[g] + rr * 64; int cnt = hi_[g] - j0 + 1; cnt = cnt > 64 ? 64 : cnt;
                const float e = sc[g][rr];
#pragma unroll 4
                for (int jj = 0; jj < cnt; ++jj) { const float pj = __uint_as_float(__builtin_amdgcn_readlane(__float_as_uint(e), jj)); o += pj * bf1(vp[((size_t)(j0 + jj) << sh) * 768]); }
            }
        }
        o = o / den;
        const float on = __shfl_down(o, 1);
        if ((lane & 1) == 0) *(unsigned*)(YA + (size_t)row * 256 + s * 64 + lane) = cvt_pk_bf16(o, on);
    }
}


typedef float f32x16 __attribute__((ext_vector_type(16)));
constexpr size_t DO_OP = 128 * MiB, DO_ML = 224 * MiB;
__device__ __forceinline__ bf16x8 pack_pt(const f32x16& x, const int s) {
    u32x4 p;
    asm volatile("v_cvt_pk_bf16_f32 %0, %4, %5\n\tv_cvt_pk_bf16_f32 %1, %6, %7\n\tv_cvt_pk_bf16_f32 %2, %8, %9\n\tv_cvt_pk_bf16_f32 %3, %10, %11\n\ts_nop 1"
                 : "=&v"(p[0]), "=&v"(p[1]), "=&v"(p[2]), "=&v"(p[3])
                 : "v"(x[8 * s]), "v"(x[8 * s + 1]), "v"(x[8 * s + 2]), "v"(x[8 * s + 3]), "v"(x[8 * s + 4]), "v"(x[8 * s + 5]), "v"(x[8 * s + 6]), "v"(x[8 * s + 7]));
    return __builtin_bit_cast(bf16x8, p);
}
__device__ __forceinline__ void attn_mfma(const Frame& F) {
    const int lane = F.lane, c = lane & 31, h = lane >> 5;
    LAS unsigned char* vbuf = F.lds + F.wave * 4608;
    const unsigned vb_addr = (unsigned)(size_t)vbuf;
    const u16* AQ = (const u16*)(F.ws + Z_AQ); const u16* AK = (const u16*)(F.ws + Z_AK); const u16* AV = (const u16*)(F.ws + Z_AV);
    u16* OP = (u16*)(F.dout + DO_OP); float* ML = (float*)(F.dout + DO_ML);
    const int gw = F.vcu * NWAVES + F.wave, NGW = F.G * NWAVES;
    const int blk = (lane >> 4) & 1, q4 = (lane & 15) >> 2, p4 = lane & 3;
    for (int it = gw; it < 32 * 12 * 64; it += NGW) {
        const int x = it & 63, bh = it >> 6, hd = bh % 12, b = bh / 12, g = hd >> 2, sh = 2 * g;
        const int nqb = 64 >> sh, r = x >> (6 - sh), qb = x & (nqb - 1), mlen = SEQ >> sh, m0 = qb * 32;
        const size_t rowb = (size_t)b * SEQ + r;
        const size_t qrow = rowb + ((size_t)(m0 + c) << sh);
        bf16x8 qf[4];
#pragma unroll
        for (int s = 0; s < 4; ++s) qf[s] = *(const bf16x8*)(AQ + qrow * 768 + hd * 64 + 16 * s + 8 * h);
        f32x16 st[5];
        bf16x8 kf[5][4];
#pragma unroll
        for (int kb = 0; kb < 5; ++kb) {
            int mk = m0 - 64 + 32 * kb + c; mk = mk < 0 ? 0 : (mk > mlen - 1 ? mlen - 1 : mk);
            const u16* kp = AK + (rowb + ((size_t)mk << sh)) * 768 + hd * 64 + 8 * h;
#pragma unroll
            for (int s = 0; s < 4; ++s) kf[kb][s] = *(const bf16x8*)(kp + 16 * s);
        }
        __builtin_amdgcn_sched_barrier(0);
#pragma unroll
        for (int kb = 0; kb < 5; ++kb) {
            f32x16 acc;
#pragma unroll
            for (int i = 0; i < 16; ++i) acc[i] = 0.f;
#pragma unroll
            for (int s = 0; s < 4; ++s) acc = __builtin_amdgcn_mfma_f32_32x32x16_bf16(kf[kb][s], qf[s], acc, 0, 0, 0);
            st[kb] = acc;
        }
        float mx = -1e30f;
#pragma unroll
        for (int kb = 0; kb < 5; ++kb)
#pragma unroll
            for (int i = 0; i < 16; ++i) { const int rel = 32 * kb - 64 + ((i & 3) + 8 * (i >> 2) + 4 * h) - c; const int key = m0 + c + rel; const bool valid = (key >= 0) && (key < mlen) && (rel >= -64) && (rel <= 64);
                const float v = valid ? st[kb][i] : -1e30f; st[kb][i] = v; mx = fmaxf(mx, v); }
        mx = fmaxf(mx, __shfl_xor(mx, 32));
        float l = 0.f;
#pragma unroll
        for (int kb = 0; kb < 5; ++kb)
#pragma unroll
            for (int i = 0; i < 16; ++i) { const float p = st[kb][i] > -1e29f ? __expf(st[kb][i] - mx) : 0.f; st[kb][i] = p; l += p; }
        l += __shfl_xor(l, 32);
        f32x16 y0, y1;
#pragma unroll
        for (int i = 0; i < 16; ++i) { y0[i] = 0.f; y1[i] = 0.f; }
        u32x4 vr[4];
#define LOADV(kb_) _Pragma("unroll") for (int i4 = 0; i4 < 4; ++i4) { const int row = (lane >> 3) + 8 * i4; int mk = m0 - 64 + 32 * (kb_) + row; mk = mk < 0 ? 0 : (mk > mlen - 1 ? mlen - 1 : mk); \
            vr[i4] = *(const u32x4*)(AV + (rowb + ((size_t)mk << sh)) * 768 + hd * 64 + (lane & 7) * 8); }
        LOADV(0)
#pragma unroll
        for (int kb = 0; kb < 5; ++kb) {
#pragma unroll
            for (int i4 = 0; i4 < 4; ++i4) { const int row = (lane >> 3) + 8 * i4; *(LAS u32x4*)(vbuf + row * 144 + (lane & 7) * 16) = vr[i4]; }
            if (kb < 4) { LOADV(kb + 1) }
            asm volatile("s_waitcnt lgkmcnt(0)" ::: "memory");
            u32x2 tq[2][4];
#pragma unroll
            for (int s = 0; s < 2; ++s) {
                const unsigned a0 = vb_addr + 144u * (unsigned)(16 * s + 4 * h + q4) + 2u * (unsigned)(16 * blk + 4 * p4);
                asm volatile("ds_read_b64_tr_b16 %0, %4\n\tds_read_b64_tr_b16 %1, %4 offset:1152\n\tds_read_b64_tr_b16 %2, %4 offset:64\n\tds_read_b64_tr_b16 %3, %4 offset:1216"
                             : "=&v"(tq[s][0]), "=&v"(tq[s][1]), "=&v"(tq[s][2]), "=&v"(tq[s][3]) : "v"(a0) : "memory");
            }
            asm volatile("s_waitcnt lgkmcnt(0)" : "+v"(tq[0][0]), "+v"(tq[0][1]), "+v"(tq[0][2]), "+v"(tq[0][3]), "+v"(tq[1][0]), "+v"(tq[1][1]), "+v"(tq[1][2]), "+v"(tq[1][3]) :: "memory");
#pragma unroll
            for (int s = 0; s < 2; ++s) {
                const bf16x8 xs = pack_pt(st[kb], s);
                u32x4 vv0, vv1; vv0.x = tq[s][0].x; vv0.y = tq[s][0].y; vv0.z = tq[s][1].x; vv0.w = tq[s][1].y; vv1.x = tq[s][2].x; vv1.y = tq[s][2].y; vv1.z = tq[s][3].x; vv1.w = tq[s][3].y;
                y0 = __builtin_amdgcn_mfma_f32_32x32x16_bf16(__builtin_bit_cast(bf16x8, vv0), xs, y0, 0, 0, 0);
                y1 = __builtin_amdgcn_mfma_f32_32x32x16_bf16(__builtin_bit_cast(bf16x8, vv1), xs, y1, 0, 0, 0);
            }
        }
#undef LOADV
        const float inv = 1.0f / l;
        u16* op = OP + qrow * 768 + hd * 64 + 4 * h;
#pragma unroll
        for (int gq = 0; gq < 4; ++gq) {
            u32x2 w0, w1; w0.x = cvt_pk_bf16(y0[4 * gq] * inv, y0[4 * gq + 1] * inv); w0.y = cvt_pk_bf16(y0[4 * gq + 2] * inv, y0[4 * gq + 3] * inv);
            w1.x = cvt_pk_bf16(y1[4 * gq] * inv, y1[4 * gq + 1] * inv); w1.y = cvt_pk_bf16(y1[4 * gq + 2] * inv, y1[4 * gq + 3] * inv);
            *(u32x2*)(op + 8 * gq) = w0; *(u32x2*)(op + 32 + 8 * gq) = w1; }
        if (h == 0) ML[qrow * 12 + hd] = mx + __logf(l);
    }
}


constexpr int HT_STRIDE = 272, HT_BYTES = 64 * HT_STRIDE;
constexpr int HL_QS = 0, HL_KS = HT_BYTES, HL_QIN = 2 * HT_BYTES, HL_KOUT = 3 * HT_BYTES, HL_V = 4 * HT_BYTES, HL_PSUM = 5 * HT_BYTES, HL_D = HL_PSUM + 4096;
#define TR2(dst0, dst1, addr, off1) asm volatile("ds_read_b64_tr_b16 %0, %2\n\tds_read_b64_tr_b16 %1, %2 offset:" #off1 "\n\ts_waitcnt lgkmcnt(0)" : "=&v"(dst0), "=&v"(dst1) : "v"(addr) : "memory")
__device__ __forceinline__ void hgrn_mfma_item(const Frame& F, int item, u16* OFp, u16* OBp) {
    const int b = item >> 3, hh = (item >> 1) & 3, dir = item & 1;
    const int tid = F.tid, lane = F.lane, wave = F.wave, vj = wave & 3, ci = wave >> 2, c = lane & 31, h = lane >> 5;
    const int blk = (lane >> 4) & 1, q4 = (lane & 15) >> 2, p4 = lane & 3;
    LAS unsigned char* L = F.lds; const unsigned Lb = (unsigned)(size_t)L;
    const int e2 = 2 * (tid & 63), part = tid >> 6;
    const u16* QH = (const u16*)(F.ws + Z_QH); const u16* VH = (const u16*)(F.ws + Z_VH); const u16* LF = (const u16*)(F.ws + (dir ? Z_LFB : Z_LFF));
    u16* O = dir ? OBp : OFp;
    const size_t rowbase = (size_t)b * SEQ, colbase = (size_t)hh * 128;
    f32x16 S[4];
#pragma unroll
    for (int et = 0; et < 4; ++et)
#pragma unroll
        for (int i = 0; i < 16; ++i) S[et][i] = 0.f;
    const f32x2 lbv = *(const f32x2*)((const float*)(F.ws + WS_LB) + dir * 512 + hh * 128 + e2);
    unsigned rq[8], rv[8], rl[8];
#pragma unroll
    for (int j = 0; j < 8; ++j) { const int tt = part * 8 + j; const int pos = dir ? (SEQ - 1 - tt) : tt; const size_t o = (rowbase + pos) * 512 + colbase + e2; rq[j] = *(const u16*)((const unsigned char*)QH + o); rv[j] = *(const u16*)((const unsigned char*)VH + o); rl[j] = *(const unsigned*)(LF + o); }
    for (int chunk = 0; chunk < SEQ / 64; ++chunk) {
        float bl0[8], bl1[8], fk0[8], fk1[8]; float r0 = 0.f, r1 = 0.f;
#pragma unroll
        for (int j = 0; j < 8; ++j) { const float f0 = lbv.x + (1.f - lbv.x) * sigmoidf_(bf_lo(rl[j])), f1 = lbv.y + (1.f - lbv.y) * sigmoidf_(bf_hi(rl[j])); fk0[j] = 1.f - f0; fk1[j] = 1.f - f1; r0 += __logf(f0); r1 += __logf(f1); bl0[j] = r0; bl1[j] = r1; }
        *(LAS f32x2*)(L + HL_PSUM + (part * 128 + e2) * 4) = (f32x2){r0, r1};
        __syncthreads();
        float offs0 = 0.f, offs1 = 0.f, bref0 = 0.f, bref1 = 0.f, blast0 = 0.f, blast1 = 0.f;
#pragma unroll
        for (int pp = 0; pp < 8; ++pp) { const f32x2 t = *(const LAS f32x2*)(L + HL_PSUM + (pp * 128 + e2) * 4); if (pp < part) { offs0 += t.x; offs1 += t.y; } if (pp < 4) { bref0 += t.x; bref1 += t.y; } blast0 += t.x; blast1 += t.y; }
        const float Cr0 = __expf(bref0), Cr1 = __expf(bref1), Cl0 = __expf(blast0 - bref0), Cl1 = __expf(blast1 - bref1);
        if (part == 0) *(LAS f32x2*)(L + HL_D + e2 * 4) = (f32x2){__expf(blast0), __expf(blast1)};
#pragma unroll
        for (int j = 0; j < 8; ++j) {
            const int t = part * 8 + j; const unsigned a = (unsigned)(t * HT_STRIDE + e2 * 2);
            const float E0 = __expf(offs0 + bl0[j] - bref0), E1 = __expf(offs1 + bl1[j] - bref1); const float R0 = __builtin_amdgcn_rcpf(E0), R1 = __builtin_amdgcn_rcpf(E1);
            const f32x2_t qq_ = __builtin_amdgcn_cvt_pk_f32_fp8((int)rq[j], false), vv_ = __builtin_amdgcn_cvt_pk_f32_fp8((int)rv[j], false);
            float q0 = qq_.x, q1 = qq_.y; q0 *= sigmoidf_(q0); q1 *= sigmoidf_(q1); const float k0 = fk0[j], k1 = fk1[j];
            *(LAS unsigned*)(L + HL_QS + a) = cvt_pk_bf16(q0 * E0, q1 * E1);
            *(LAS unsigned*)(L + HL_KS + a) = cvt_pk_bf16(k0 * R0, k1 * R1);
            *(LAS unsigned*)(L + HL_QIN + a) = cvt_pk_bf16(q0 * E0 * Cr0, q1 * E1 * Cr1);
            *(LAS unsigned*)(L + HL_KOUT + a) = cvt_pk_bf16(k0 * R0 * Cl0, k1 * R1 * Cl1);
            *(LAS unsigned*)(L + HL_V + a) = cvt_pk_bf16(vv_.x, vv_.y);
        }
        __syncthreads();
        if (chunk + 1 < SEQ / 64) {
#pragma unroll
            for (int j = 0; j < 8; ++j) { const int tt = (chunk + 1) * 64 + part * 8 + j; const int pos = dir ? (SEQ - 1 - tt) : tt; const size_t o = (rowbase + pos) * 512 + colbase + e2; rq[j] = *(const u16*)((const unsigned char*)QH + o); rv[j] = *(const u16*)((const unsigned char*)VH + o); rl[j] = *(const unsigned*)(LF + o); }
        }
        f32x16 z;
#pragma unroll
        for (int i = 0; i < 16; ++i) z[i] = 0.f;
#pragma unroll
        for (int et = 0; et < 4; ++et)
#pragma unroll
            for (int st = 0; st < 2; ++st) {
                const bf16x8 A = pack_pt(S[et], st);
                const LAS unsigned char* qp = L + HL_QIN + (32 * ci + c) * HT_STRIDE + (32 * et + 16 * st + 4 * h) * 2;
                const u32x2 lo = *(const LAS u32x2*)qp, hi = *(const LAS u32x2*)(qp + 16);
                u32x4 bb; bb.x = lo.x; bb.y = lo.y; bb.z = hi.x; bb.w = hi.y;
                z = __builtin_amdgcn_mfma_f32_32x32x16_bf16(A, __builtin_bit_cast(bf16x8, bb), z, 0, 0, 0);
            }
#pragma unroll
        for (int stile = 0; stile < 2; ++stile) {
            if (stile <= ci) {
                f32x16 pt;
#pragma unroll
                for (int i = 0; i < 16; ++i) pt[i] = 0.f;
#pragma unroll
                for (int ek = 0; ek < 8; ++ek) {
                    const bf16x8 A = *(const LAS bf16x8*)(L + HL_KS + (32 * stile + c) * HT_STRIDE + (16 * ek + 8 * h) * 2);
                    const bf16x8 B = *(const LAS bf16x8*)(L + HL_QS + (32 * ci + c) * HT_STRIDE + (16 * ek + 8 * h) * 2);
                    pt = __builtin_amdgcn_mfma_f32_32x32x16_bf16(A, B, pt, 0, 0, 0);
                }
#pragma unroll
                for (int i = 0; i < 16; ++i) { const int srow = 32 * stile + (i & 3) + 8 * (i >> 2) + 4 * h; pt[i] = (srow <= 32 * ci + c) ? pt[i] : 0.f; }
#pragma unroll
                for (int st = 0; st < 2; ++st) {
                    const bf16x8 Bp = pack_pt(pt, st);
                    u32x2 t0, t1; const unsigned a0 = Lb + HL_V + (unsigned)((32 * stile + 16 * st + 4 * h + q4) * HT_STRIDE + (32 * vj + 16 * blk + 4 * p4) * 2);
                    TR2(t0, t1, a0, 2176);
                    u32x4 av; av.x = t0.x; av.y = t0.y; av.z = t1.x; av.w = t1.y;
                    z = __builtin_amdgcn_mfma_f32_32x32x16_bf16(__builtin_bit_cast(bf16x8, av), Bp, z, 0, 0, 0);
                }
            }
        }
        { const int tt = chunk * 64 + 32 * ci + c; const int pos = dir ? (SEQ - 1 - tt) : tt; u16* op = O + (rowbase + pos) * 512 + colbase + 32 * vj + 4 * h;
#pragma unroll
          for (int gq = 0; gq < 4; ++gq) { u32x2 w; w.x = cvt_pk_bf16(z[4 * gq], z[4 * gq + 1]); w.y = cvt_pk_bf16(z[4 * gq + 2], z[4 * gq + 3]); *(u32x2*)(op + 8 * gq) = w; } }
        bf16x8 Vb[4];
#pragma unroll
        for (int tk = 0; tk < 4; ++tk) { u32x2 t0, t1; const unsigned a0 = Lb + HL_V + (unsigned)((16 * tk + 8 * h + q4) * HT_STRIDE + (32 * vj + 16 * blk + 4 * p4) * 2);
            TR2(t0, t1, a0, 1088);
            u32x4 bv; bv.x = t0.x; bv.y = t0.y; bv.z = t1.x; bv.w = t1.y; Vb[tk] = __builtin_bit_cast(bf16x8, bv); }
#pragma unroll
        for (int et = 0; et < 4; ++et) {
#pragma unroll
            for (int gq = 0; gq < 4; ++gq) { const f32x4 dv = *(const LAS f32x4*)(L + HL_D + (32 * et + 8 * gq + 4 * h) * 4);
#pragma unroll
                for (int e = 0; e < 4; ++e) S[et][4 * gq + e] *= dv[e]; }
#pragma unroll
            for (int tk = 0; tk < 4; ++tk) { u32x2 t0, t1; const unsigned a0 = Lb + HL_KOUT + (unsigned)((16 * tk + 8 * h + q4) * HT_STRIDE + (32 * et + 16 * blk + 4 * p4) * 2);
                TR2(t0, t1, a0, 1088);
                u32x4 ak; ak.x = t0.x; ak.y = t0.y; ak.z = t1.x; ak.w = t1.y;
                S[et] = __builtin_amdgcn_mfma_f32_32x32x16_bf16(__builtin_bit_cast(bf16x8, ak), Vb[tk], S[et], 0, 0, 0); }
        }
    }
    __syncthreads();
}

__device__ __forceinline__ void phase_hg_combine(const Frame& F, const Args& a) {
    const int gw = F.vcu * NWAVES + F.wave, NGW = F.G * NWAVES, lane = F.lane;
    const u16* OF = (const u16*)(F.dout + DO_OF); const u16* OB = (const u16*)(F.dout + DO_OB); const u16* GS = (const u16*)(F.ws + Z_GS); u16* YH = (u16*)(F.ws + WS_YH);
    const u16* OP = (const u16*)(F.dout + DO_OP); const float* ML = (const float*)(F.dout + DO_ML); u16* YA = (u16*)(F.ws + WS_YA);
    const f32x4 ng0 = *(const f32x4*)(a.in[5] + 8 * lane), ng1 = *(const f32x4*)(a.in[5] + 8 * lane + 4);
    const int sl = lane >> 4, dd = (4 * lane) & 63;
    constexpr int NR = 4;
    for (int row0 = gw; row0 < T; row0 += NR * NGW) {
        u32x4 fv[NR], bv[NR]; u32x2 gv[NR], av[NR][3]; float lv[NR][3];
#pragma unroll
        for (int r = 0; r < NR; ++r) { const int row = row0 + r * NGW; const size_t o = (size_t)row * 512 + 8 * lane;
            fv[r] = *(const u32x4*)(OF + o); bv[r] = *(const u32x4*)(OB + o); gv[r] = *(const u32x2*)((const unsigned char*)GS + o);
#pragma unroll
            for (int k = 0; k < 3; ++k) { lv[r][k] = ML[(size_t)row * 12 + 4 * k + sl]; av[r][k] = *(const u32x2*)(OP + (size_t)row * 768 + (4 * k + sl) * 64 + dd); } }
        __builtin_amdgcn_sched_barrier(0);
#pragma unroll
        for (int r = 0; r < NR; ++r) { const int row = row0 + r * NGW; const size_t o = (size_t)row * 512 + 8 * lane;
            const u32x4 f = fv[r], bq = bv[r]; const u32x2 g = gv[r];
            float v[8] = {bf_lo(f.x) + bf_lo(bq.x), bf_hi(f.x) + bf_hi(bq.x), bf_lo(f.y) + bf_lo(bq.y), bf_hi(f.y) + bf_hi(bq.y), bf_lo(f.z) + bf_lo(bq.z), bf_hi(f.z) + bf_hi(bq.z), bf_lo(f.w) + bf_lo(bq.w), bf_hi(f.w) + bf_hi(bq.w)};
            float ss = 0.f;
#pragma unroll
            for (int j = 0; j < 8; ++j) ss += v[j] * v[j];
            ss += __int_as_float(__builtin_amdgcn_update_dpp(0, __float_as_int(ss), 0xB1, 0xF, 0xF, true)); ss += __int_as_float(__builtin_amdgcn_update_dpp(0, __float_as_int(ss), 0x4E, 0xF, 0xF, true));
            ss += __int_as_float(__builtin_amdgcn_update_dpp(0, __float_as_int(ss), 0x141, 0xF, 0xF, true)); ss += __int_as_float(__builtin_amdgcn_update_dpp(0, __float_as_int(ss), 0x140, 0xF, 0xF, true));
            const float rs = 1.0f / sqrtf(ss * (1.f / 128.f) + LN_EPS);
            float gg[8]; { float t0[4], t1[4]; fp8x4_to_f32(g.x, t0); fp8x4_to_f32(g.y, t1);
#pragma unroll
              for (int j = 0; j < 4; ++j) { gg[j] = t0[j]; gg[4 + j] = t1[j]; } }
#pragma unroll
            for (int j = 0; j < 8; ++j) gg[j] *= sigmoidf_(gg[j]);
            u32x2 w; w.x = pk_fp8x4(v[0] * rs * ng0[0] * gg[0], v[1] * rs * ng0[1] * gg[1], v[2] * rs * ng0[2] * gg[2], v[3] * rs * ng0[3] * gg[3]);
            w.y = pk_fp8x4(v[4] * rs * ng1[0] * gg[4], v[5] * rs * ng1[1] * gg[5], v[6] * rs * ng1[2] * gg[6], v[7] * rs * ng1[3] * gg[7]);
            *(u32x2*)((unsigned char*)YH + o) = w;
            const float l0 = lv[r][0], l1 = lv[r][1], l2 = lv[r][2];
            const float lm = fmaxf(l0, fmaxf(l1, l2)); float w0 = __expf(l0 - lm), w1 = __expf(l1 - lm), w2 = __expf(l2 - lm); const float ws_ = 1.0f / (w0 + w1 + w2); w0 *= ws_; w1 *= ws_; w2 *= ws_;
            const u32x2 a0 = av[r][0], a1 = av[r][1], a2 = av[r][2];
            const unsigned wv = pk_fp8x4(w0 * bf_lo(a0.x) + w1 * bf_lo(a1.x) + w2 * bf_lo(a2.x), w0 * bf_hi(a0.x) + w1 * bf_hi(a1.x) + w2 * bf_hi(a2.x), w0 * bf_lo(a0.y) + w1 * bf_lo(a1.y) + w2 * bf_lo(a2.y), w0 * bf_hi(a0.y) + w1 * bf_hi(a1.y) + w2 * bf_hi(a2.y));
            *(unsigned*)((unsigned char*)YA + (size_t)row * 256 + 4 * lane) = wv;
        }
    }
}

template <bool DO_LN, bool DO_CONV> __device__ __forceinline__ void phase_ln1_convert(const Frame& F, const Args& a, int part = 0, int nparts = 1) {
    const int gw = F.vcu * NWAVES + F.wave, NGW = F.G * NWAVES;
    const float* X1 = (const float*)(F.ws + WS_X1PRE); u16* X1B = (u16*)(F.ws + WS_XB);
    if constexpr (DO_LN)
    for (int row = gw; row < T; row += 4 * NGW) ln1_rows16<4>((const u16*)X1, (size_t)row, (size_t)NGW, a.in[9], a.in[10], X1B, F.lane, F.ws + WS_X1F8);
    if constexpr (!DO_CONV) return;
    LAS float* scr = (LAS float*)(F.lds + F.wave * 16384);
    unsigned char* WGU = F.ws + WS_WGU; unsigned char* WD = F.ws + WS_WD;
    constexpr int PER_E = 384, NIT = 257 * PER_E;
    const int lane = F.lane;
#define CV_DECODE(it_, sp_, ldw_, dp_, kd_) { const int e = (it_) / PER_E, r = (it_) % PER_E; const int which = r >> 7, q = r & 127; \
        if (which < 2) { const float* src = (e < 256) ? a.in[13 + which] + (size_t)e * 1024 * 256 : a.in[16 + which]; const int kb = q >> 3, nb = q & 7; ldw_ = 256; kd_ = 1024; \
            sp_ = src + (size_t)(64 * kb + (lane >> 5)) * 256 + 32 * nb + (lane & 31); dp_ = WGU + ((size_t)e * 512 + (nb >> 2) * 256 + which * 128 + (nb & 3) * 32) * 1024 + 64 * kb; } \
        else { const float* src = (e < 256) ? a.in[15] + (size_t)e * 256 * 1024 : a.in[18]; const int kb = q >> 5, nb = q & 31; ldw_ = 1024; kd_ = 256; \
            sp_ = src + (size_t)(64 * kb + (lane >> 5)) * 1024 + 32 * nb + (lane & 31); dp_ = WD + ((size_t)e * 1024 + 32 * nb) * 256 + 64 * kb; } }
#define CV_LOAD(tv_, sp_, ldw_) { _Pragma("unroll") for (int i = 0; i < 32; ++i) tv_[i] = sp_[(size_t)(2 * i) * ldw_]; }
#define CV_FINISH(tv_, dp_, kd_) { _Pragma("unroll") for (int i = 0; i < 32; ++i) scr[(2 * i + (lane >> 5)) * 33 + (lane & 31)] = tv_[i]; \
        LDS_WAIT(); asm volatile("" ::: "memory"); const int c = lane & 7; \
        _Pragma("unroll") for (int j = 0; j < 4; ++j) { const int n = (lane >> 3) + 8 * j; const LAS float* sp = scr + (8 * c) * 33 + n; \
            u32x2 o; o.x = pk_fp8x4(sp[0 * 33] * W8_SCALE, sp[1 * 33] * W8_SCALE, sp[2 * 33] * W8_SCALE, sp[3 * 33] * W8_SCALE); o.y = pk_fp8x4(sp[4 * 33] * W8_SCALE, sp[5 * 33] * W8_SCALE, sp[6 * 33] * W8_SCALE, sp[7 * 33] * W8_SCALE); \
            *(u32x2*)(dp_ + (size_t)n * kd_ + 8 * c) = o; } \
        LDS_WAIT(); asm volatile("" ::: "memory"); }
    float tva[32], tvb[32]; const float* spa = nullptr; const float* spb = nullptr; unsigned char* dpa = nullptr; unsigned char* dpb = nullptr; int lda = 0, ldb = 0, kda = 0, kdb = 0;
    const int step = nparts * NGW; int it = gw + part * NGW;
    if (it < NIT) { CV_DECODE(it, spa, lda, dpa, kda) CV_LOAD(tva, spa, lda) }
    for (; it < NIT; it += 2 * step) {
        const bool hb = it + step < NIT, ha = it + 2 * step < NIT;
        if (hb) { CV_DECODE(it + step, spb, ldb, dpb, kdb) CV_LOAD(tvb, spb, ldb) }
        CV_FINISH(tva, dpa, kda)
        if (ha) { CV_DECODE(it + 2 * step, spa, lda, dpa, kda) CV_LOAD(tva, spa, lda) }
        if (hb) CV_FINISH(tvb, dpb, kdb)
    }
#undef CV_DECODE
#undef CV_LOAD
#undef CV_FINISH
}

__device__ __forceinline__ void phase_topk(const Frame& F, const Args& a) {
    LAS int* hist = (LAS int*)F.lds;
    for (int i = F.tid; i < 8 * 256; i += NTHR) hist[i] = 0;
    __syncthreads();
    const int w = F.vcu, lane = F.lane;
    const float* logits = (const float*)(F.ws + WS_LOGITS); u16* tok_e = (u16*)(F.ws + WS_TOKE); u16* tok_r = (u16*)(F.ws + WS_TOKR); float* tok_g = (float*)(F.ws + WS_TOKG);
    const f32x4 bs = *(const f32x4*)(a.in[12] + 4 * lane);
    constexpr int TB = 4;
    for (int i0 = 0; i0 < 32; i0 += TB) {
        float s0[TB], s1[TB], s2[TB], s3[TB], v0[TB], v1[TB], v2[TB], v3[TB], my_s[TB]; int my_e[TB];
        const float NINF = -__builtin_inff();
        { float b0[TB], b1[TB], b2[TB], b3[TB], m1[TB], m2[TB], gs[TB]; int rank[TB];
#pragma unroll
          for (int u = 0; u < TB; ++u) { const int t = w * 256 + F.wave * 32 + i0 + u; const f32x4 lg = *(const f32x4*)(logits + (size_t)t * 256 + 4 * lane);
              s0[u] = sigmoidf_(lg[0]); s1[u] = sigmoidf_(lg[1]); s2[u] = sigmoidf_(lg[2]); s3[u] = sigmoidf_(lg[3]);
              b0[u] = s0[u] + bs[0]; b1[u] = s1[u] + bs[1]; b2[u] = s2[u] + bs[2]; b3[u] = s3[u] + bs[3];
              const float h01 = fmaxf(b0[u], b1[u]), l01 = fminf(b0[u], b1[u]), h23 = fmaxf(b2[u], b3[u]), l23 = fminf(b2[u], b3[u]);
              m1[u] = fmaxf(h01, h23); m2[u] = fmaxf(fminf(h01, h23), fmaxf(l01, l23)); }
#define TOP2_STEP(CTRL) _Pragma("unroll") for (int u = 0; u < TB; ++u) { const float p1 = dpp_f<CTRL>(m1[u]), p2 = dpp_f<CTRL>(m2[u]); const float n1 = fmaxf(m1[u], p1), n2 = fmaxf(fminf(m1[u], p1), fmaxf(m2[u], p2)); m1[u] = n1; m2[u] = n2; }
          TOP2_STEP(0xB1) TOP2_STEP(0x4E) TOP2_STEP(0x141)
#undef TOP2_STEP
          const int mygroup = lane >> 3;
#pragma unroll
          for (int u = 0; u < TB; ++u) { gs[u] = m1[u] + m2[u]; rank[u] = 0; }
#pragma unroll
          for (int j = 0; j < 8; ++j)
#pragma unroll
              for (int u = 0; u < TB; ++u) { const float gj = rdlane_f(gs[u], 8 * j); rank[u] += (gj > gs[u] || (gj == gs[u] && j < mygroup)) ? 1 : 0; }
#pragma unroll
          for (int u = 0; u < TB; ++u) { const bool sel = rank[u] < 4; v0[u] = sel ? b0[u] : NINF; v1[u] = sel ? b1[u] : NINF; v2[u] = sel ? b2[u] : NINF; v3[u] = sel ? b3[u] : NINF; my_e[u] = 0; my_s[u] = 0.f; } }
#pragma unroll
        for (int k = 0; k < 8; ++k) {
            float bv[TB]; int bi[TB];
#pragma unroll
            for (int u = 0; u < TB; ++u) { bv[u] = v0[u]; bi[u] = 4 * lane;
                if (v1[u] > bv[u]) { bv[u] = v1[u]; bi[u] = 4 * lane + 1; }
                if (v2[u] > bv[u]) { bv[u] = v2[u]; bi[u] = 4 * lane + 2; }
                if (v3[u] > bv[u]) { bv[u] = v3[u]; bi[u] = 4 * lane + 3; } }
#define AMX_STEP(CTRL) _Pragma("unroll") for (int u = 0; u < TB; ++u) { const float ov = dpp_f<CTRL>(bv[u]); const int oi = dpp_i<CTRL>(bi[u]); if (ov > bv[u] || (ov == bv[u] && oi < bi[u])) { bv[u] = ov; bi[u] = oi; } }
            AMX_STEP(0xB1) AMX_STEP(0x4E) AMX_STEP(0x141) AMX_STEP(0x140)
#undef AMX_STEP
#pragma unroll
            for (int u = 0; u < TB; ++u) { float fv = rdlane_f(bv[u], 0); int fi = __builtin_amdgcn_readlane(bi[u], 0);
#pragma unroll
                for (int rw = 1; rw < 4; ++rw) { const float ov = rdlane_f(bv[u], 16 * rw); const int oi = __builtin_amdgcn_readlane(bi[u], 16 * rw); if (ov > fv || (ov == fv && oi < fi)) { fv = ov; fi = oi; } }
                bv[u] = fv; bi[u] = fi; }
#pragma unroll
            for (int u = 0; u < TB; ++u) { const int owner = bi[u] >> 2, wi = bi[u] & 3;
                const float cand = wi == 0 ? s0[u] : wi == 1 ? s1[u] : wi == 2 ? s2[u] : s3[u];
                const float sk = rdlane_f(cand, owner);
                if (lane == owner) { if (wi == 0) v0[u] = NINF; else if (wi == 1) v1[u] = NINF; else if (wi == 2) v2[u] = NINF; else v3[u] = NINF; }
                if (lane == k) { my_e[u] = bi[u]; my_s[u] = sk; } }
        }
#pragma unroll
        for (int u = 0; u < TB; ++u) { const int t = w * 256 + F.wave * 32 + i0 + u;
            float sum = (lane < 8) ? my_s[u] : 0.f; sum += dpp_f<0xB1>(sum); sum += dpp_f<0x4E>(sum); sum += dpp_f<0x141>(sum);
            if (lane < 8) { const int rk = hist[F.wave * 256 + my_e[u]]; hist[F.wave * 256 + my_e[u]] = rk + 1; tok_e[(size_t)t * 8 + lane] = (u16)my_e[u]; tok_r[(size_t)t * 8 + lane] = (u16)rk; tok_g[(size_t)t * 8 + lane] = my_s[u] / sum * 2.5f; } }
    }
    __syncthreads();
    if (F.tid < 256) { int run = 0;
#pragma unroll
        for (int wv = 0; wv < 8; ++wv) { const int h = hist[wv * 256 + F.tid]; hist[wv * 256 + F.tid] = run; run += h; }
        ((int*)(F.ws + WS_HIST))[w * 256 + F.tid] = run; }
    __syncthreads();
    for (int i = 0; i < 32; ++i) { const int t = w * 256 + F.wave * 32 + i; if (lane < 8) { const int e = tok_e[(size_t)t * 8 + lane]; tok_r[(size_t)t * 8 + lane] = (u16)(tok_r[(size_t)t * 8 + lane] + hist[F.wave * 256 + e]); } }
    __syncthreads();
}

__device__ __forceinline__ void phase_sort(const Frame& F) {
    LAS int* start = (LAS int*)F.lds; LAS int* base = start + 260; LAS int* tot = base + 260; LAS int* pad = tot + 260; LAS int* dbase = pad + 260;
    const int w = F.vcu, qd = w / WPC, wl = w % WPC, tid = F.tid;
    const int* hist = (const int*)(F.ws + WS_HIST);
    int mytot = 0, mypre = 0;
    if (tid < 256) {
        for (int w2 = qd * WPC; w2 < qd * WPC + WPC; ++w2) { const int h = hist[w2 * 256 + tid]; mytot += h; mypre += (w2 < w) ? h : 0; }
        tot[tid] = mytot; pad[tid] = (mytot + 255) & ~255;
    }
    __syncthreads();
    if (tid == 0) { int s = 0, d = 0; for (int e = 0; e < 256; ++e) { start[e] = s; s += pad[e]; dbase[e] = d; d += tot[e]; } start[256] = s; }
    __syncthreads();
    if (tid < 256) { base[tid] = start[tid] + mypre; dbase[tid] += mypre; }
    __syncthreads();
    int* stok = (int*)(F.ws + WS_STOK) + (size_t)qd * QTILES * 256; float* sgate = (float*)(F.ws + WS_SGATE) + (size_t)qd * QTILES * 256; int* sdst = (int*)(F.ws + WS_SDST) + (size_t)qd * QTILES * 256;
    int* tile_e = (int*)(F.ws + WS_TILEE) + qd * QTILES;
    const u16* tok_e = (const u16*)(F.ws + WS_TOKE); const u16* tok_r = (const u16*)(F.ws + WS_TOKR); const float* tok_g = (const float*)(F.ws + WS_TOKG);
    for (int aidx = tid; aidx < 2048; aidx += NTHR) {
        const int t = w * 256 + (aidx >> 3), k = aidx & 7; const int e = tok_e[(size_t)t * 8 + k], rk = tok_r[(size_t)t * 8 + k];
        const int slot = base[e] + rk, dn = dbase[e] + rk; stok[slot] = t; sgate[slot] = tok_g[(size_t)t * 8 + k]; sdst[slot] = dn; ((int*)(F.ws + WS_TOKD))[(size_t)t * 8 + k] = dn;
    }
    const int ssh = start[256];
    if (tid < 256) { const int t = w * 256 + tid; const int slot = ssh + (t - qd * TQ); stok[slot] = t; sgate[slot] = 1.0f; sdst[slot] = TQ * 8 + (t - qd * TQ); }
    if (tid < 256 && (tid % WPC) == wl) {
        const int e = tid; const int s0 = start[e], n = tot[e], np = pad[e];
        for (int j = n; j < np; ++j) { stok[s0 + j] = qd * TQ; sgate[s0 + j] = 0.f; sdst[s0 + j] = TQ * NSLOT; }
        for (int tl = s0 >> 8; tl < (s0 + np) >> 8; ++tl) tile_e[tl] = e;
    }
    if (wl == 0 && tid < TQ / 256) tile_e[(ssh >> 8) + tid] = 256;
    if (wl == 0 && tid == 0) ((int*)(F.ws + WS_NTILES))[qd] = (ssh >> 8) + TQ / 256;
    __syncthreads();
}


constexpr int DN_ROWP = 80, DN_PLANE = 256 * DN_ROWP;
__device__ __forceinline__ void moe_down_phase(const Frame& F, int qd) {
    unsigned char* ws = F.ws; LAS unsigned char* L = F.lds; const int tid = F.tid, lane = F.lane, wave = F.wave, i16 = lane & 15, q = lane >> 4;
    const int ntiles = __builtin_amdgcn_readfirstlane(((const int*)(ws + WS_NTILES))[qd]);
    const int* tile_e = (const int*)(ws + WS_TILEE) + qd * QTILES;
    LAS int* estart = (LAS int*)(L + 4 * DN_PLANE);
    LAS int* te = estart + 512;
    for (int i = tid; i < ntiles; i += NTHR) te[i] = tile_e[i];
    __syncthreads();
    if (tid < 258) { int lo = 0, hi = ntiles; while (lo < hi) { const int mid = (lo + hi) >> 1; if (te[mid] < tid) lo = mid + 1; else hi = mid; } estart[tid] = lo; }
    __syncthreads();
    const long U = (long)ntiles * 4; const int u0 = (int)((long)F.vcu * U / F.G), u1 = (int)((long)(F.vcu + 1) * U / F.G);
    const unsigned char* H8 = ws + WS_H; const unsigned char* WD8 = ws + WS_WD; unsigned char* YS = ws + WS_YS;
    const int* sdst = (const int*)(ws + WS_SDST) + (size_t)qd * QTILES * 256; const float* sgate = (const float*)(ws + WS_SGATE) + (size_t)qd * QTILES * 256;
    int sc1; asm volatile("v_mov_b32 %0, 0x7f7f7f7f" : "=v"(sc1));
    int cur_key = -1, e = 0;
#define DN_DECODE(u_, e_, pn_, tile_) { while (4 * estart[e_ + 1] <= (u_)) ++e_; const int ts_ = estart[e_], nte_ = estart[e_ + 1] - ts_, r_ = (u_) - 4 * ts_; pn_ = r_ / nte_; tile_ = ts_ + r_ % nte_; }
#define DN_LOADA(dst, tile_) { const size_t row0_ = (size_t)(tile_) * 256 + wave * 32; \
        _Pragma("unroll") for (int rg = 0; rg < 2; ++rg) { _Pragma("unroll") for (int ks = 0; ks < 2; ++ks) { const unsigned char* ap = H8 + (row0_ + 16 * rg + i16) * 256 + 128 * ks + 32 * q; const i32x4 lo = *(const i32x4*)ap, hi = *(const i32x4*)(ap + 16); dst[rg][ks] = __builtin_shufflevector(lo, hi, 0, 1, 2, 3, 4, 5, 6, 7); } \
            } }
#define DN_LOADN(tile_) { const size_t row0_ = (size_t)(tile_) * 256 + wave * 32; \
        _Pragma("unroll") for (int rg = 0; rg < 2; ++rg) { _Pragma("unroll") for (int ks = 0; ks < 2; ++ks) { const unsigned char* ap = H8 + (row0_ + 16 * rg + i16) * 256 + 128 * ks + 32 * q; \
            asm volatile("global_load_dwordx4 %0, %2, off\n\tglobal_load_dwordx4 %1, %2, off offset:16" : "=&v"(nl[rg][ks]), "=&v"(nh[rg][ks]) : "v"(ap) : "memory"); } \
            { const size_t rr_ = row0_ + 16 * rg + i16; const int* dp_ = sdst + rr_; const float* gp_ = sgate + rr_; \
              asm volatile("global_load_dword %0, %2, off\n\tglobal_load_dword %1, %3, off" : "=&v"(ndd[rg]), "=&v"(ngg[rg]) : "v"(dp_), "v"(gp_) : "memory"); } } }
    i32x8 af[2][2]; i32x4 nl[2][2] = {}, nh[2][2] = {}; unsigned ndd[2] = {0u, 0u}; float ngg[2] = {0.f, 0.f};
    unsigned dd[2] = {0u, 0u}; float gg[2] = {0.f, 0.f};
    int pn = 0, tile = 0, en = 0, pnn = 0, tilen = 0;
    if (u0 < u1) { DN_DECODE(u0, e, pn, tile) DN_LOADA(af, tile) en = e;
#pragma unroll
        for (int rg = 0; rg < 2; ++rg) { const size_t rr = (size_t)tile * 256 + wave * 32 + 16 * rg + i16; dd[rg] = (unsigned)sdst[rr]; gg[rg] = sgate[rr] * (Y8_SCALE / (W8_SCALE * H8_SCALE)); }
        asm volatile("" : "+v"(af[0][0]), "+v"(af[0][1]), "+v"(af[1][0]), "+v"(af[1][1]), "+v"(dd[0]), "+v"(dd[1]), "+v"(gg[0]), "+v"(gg[1]));
    }
    for (int u = u0; u < u1; ++u) {
        const int key = e * 4 + pn;
        if (key != cur_key) {
            __syncthreads();
            const unsigned char* src = WD8 + ((size_t)e * 1024 + (size_t)pn * 256) * 256;
#pragma unroll
            for (int j = 0; j < 8; ++j) { const int p = tid + NTHR * j, rho = p >> 4, c = p & 15; const int n = (rho & ~63) + 16 * ((rho & 15) >> 2) + 4 * ((rho >> 4) & 3) + (rho & 3);
                *(LAS u32x4*)(L + ((c >> 1) & 3) * DN_PLANE + rho * DN_ROWP + (c >> 3) * 32 + (c & 1) * 16) = *(const u32x4*)(src + (size_t)n * 256 + 16 * c); }
            __syncthreads();
            cur_key = key;
        }
        const bool more = u + 1 < u1;
        if (more) { DN_DECODE(u + 1, en, pnn, tilen) DN_LOADN(tilen) }
        int vb = q * DN_PLANE + i16 * DN_ROWP; asm volatile("" : "+v"(vb));
        unsigned char* yp0 = YS + (size_t)dd[0] * D + pn * 256 + 16 * q; unsigned char* yp1 = YS + (size_t)dd[1] * D + pn * 256 + 16 * q; const float g0 = gg[0], g1 = gg[1];
#define DN_LDB(s_) ({ const LAS unsigned char* bp_ = L + vb + ((s_) >> 1) * (16 * DN_ROWP) + ((s_) & 1) * 32; const i32x4 lo_ = *(const LAS i32x4*)bp_, hi_ = *(const LAS i32x4*)(bp_ + 16); __builtin_shufflevector(lo_, hi_, 0, 1, 2, 3, 4, 5, 6, 7); })
        i32x8 bq[3]; bq[0] = DN_LDB(0); bq[1] = DN_LDB(1);
#pragma unroll
        for (int hb = 0; hb < 2; ++hb) {
            f32x4 acc[2][8];
#pragma unroll
            for (int rg = 0; rg < 2; ++rg)
#pragma unroll
                for (int ng = 0; ng < 8; ++ng) acc[rg][ng] = (f32x4){0.f, 0.f, 0.f, 0.f};
#pragma unroll
            for (int s2 = 0; s2 < 16; ++s2) { const int st = 16 * hb + s2;
                if (st + 2 < 32) bq[(st + 2) % 3] = DN_LDB(st + 2);
#pragma unroll
                for (int rg = 0; rg < 2; ++rg) acc[rg][s2 >> 1] = __builtin_amdgcn_mfma_scale_f32_16x16x128_f8f6f4(bq[st % 3], af[rg][st & 1], acc[rg][s2 >> 1], 0, 0, 0, sc1, 0, sc1);
                __builtin_amdgcn_sched_barrier(0);
            }
            if (hb == 1) {
                asm volatile("s_waitcnt vmcnt(0)" : "+v"(nl[0][0]), "+v"(nl[0][1]), "+v"(nl[1][0]), "+v"(nl[1][1]), "+v"(nh[0][0]), "+v"(nh[0][1]), "+v"(nh[1][0]), "+v"(nh[1][1]), "+v"(ndd[0]), "+v"(ndd[1]), "+v"(ngg[0]), "+v"(ngg[1]) :: "memory");
                dd[0] = ndd[0]; dd[1] = ndd[1]; gg[0] = ngg[0] * (Y8_SCALE / (W8_SCALE * H8_SCALE)); gg[1] = ngg[1] * (Y8_SCALE / (W8_SCALE * H8_SCALE));
#pragma unroll
                for (int rg = 0; rg < 2; ++rg) { af[rg][0] = __builtin_shufflevector(nl[rg][0], nh[rg][0], 0, 1, 2, 3, 4, 5, 6, 7); af[rg][1] = __builtin_shufflevector(nl[rg][1], nh[rg][1], 0, 1, 2, 3, 4, 5, 6, 7); }
            }
#pragma unroll
            for (int rg = 0; rg < 2; ++rg) { unsigned char* yp = (rg ? yp1 : yp0) + 128 * hb; const float g = rg ? g1 : g0;
#pragma unroll
                for (int cb = 0; cb < 2; ++cb) { u32x4 w;
#pragma unroll
                    for (int k = 0; k < 4; ++k) { const f32x4 v = acc[rg][4 * cb + k] * g; w[k] = pk_fp8x4(v[0], v[1], v[2], v[3]); }
                    *(u32x4*)(yp + 64 * cb) = w; } }
        }
#undef DN_LDB
        e = en; pn = pnn; tile = tilen;
    }
#undef DN_DECODE
#undef DN_LOADA
#undef DN_LOADN
    __syncthreads();
}

__device__ __forceinline__ void phase_moe_combine(const Frame& F, const Args& a, int qd) {
    const int gw = F.vcu * NWAVES + F.wave, NGW = F.G * NWAVES, lane = F.lane;
    const u16* X1B = (const u16*)(F.ws + WS_XB) + (size_t)qd * TQ * D; const unsigned char* YS = F.ws + WS_YS; u16* X2B = (u16*)(F.ws + WS_X2B) + (size_t)qd * TQ * D;
    typedef float f32x2v __attribute__((ext_vector_type(2)));
    constexpr int NT = 2;
    f32x4 gq[4], bq[4];
#pragma unroll
    for (int k = 0; k < 4; ++k) { gq[k] = *(const f32x4*)(a.in[19] + 16 * lane + 4 * k); bq[k] = *(const f32x4*)(a.in[20] + 16 * lane + 4 * k); }
    for (int tl0 = gw; tl0 < TQ; tl0 += NT * NGW) {
        int mydn[NT]; u32x4 yy[NT][NSLOT], xx[NT][2];
#pragma unroll
        for (int t = 0; t < NT; ++t) { const int tl = tl0 + t * NGW; mydn[t] = (lane < 8) ? ((const int*)(F.ws + WS_TOKD))[((size_t)qd * TQ + tl) * 8 + lane] : 0; }
#pragma unroll
        for (int t = 0; t < NT; ++t) { const int tl = tl0 + t * NGW;
#pragma unroll
            for (int c = 0; c < 2; ++c) xx[t][c] = *(const u32x4*)(X1B + (size_t)tl * D + 16 * lane + 8 * c);
#pragma unroll
            for (int k = 0; k < NSLOT; ++k) { const int dn = (k < 8) ? __builtin_amdgcn_readlane(mydn[t], k) : TQ * 8 + tl; yy[t][k] = *(const u32x4*)(YS + (size_t)dn * D + 16 * lane); } }
        __builtin_amdgcn_sched_barrier(0);
#pragma unroll
        for (int t = 0; t < NT; ++t) { const int tl = tl0 + t * NGW;
            float v[16];
#pragma unroll
            for (int c = 0; c < 2; ++c) { const u32x4 x = xx[t][c];
                v[8 * c + 0] = ALPHA * bf_lo(x.x); v[8 * c + 1] = ALPHA * bf_hi(x.x); v[8 * c + 2] = ALPHA * bf_lo(x.y); v[8 * c + 3] = ALPHA * bf_hi(x.y); v[8 * c + 4] = ALPHA * bf_lo(x.z); v[8 * c + 5] = ALPHA * bf_hi(x.z); v[8 * c + 6] = ALPHA * bf_lo(x.w); v[8 * c + 7] = ALPHA * bf_hi(x.w); }
            float ys[16];
#pragma unroll
            for (int j = 0; j < 16; ++j) ys[j] = 0.f;
#pragma unroll
            for (int k = 0; k < NSLOT; ++k)
#pragma unroll
                for (int q = 0; q < 4; ++q) { const int wv = (int)yy[t][k][q]; const f32x2v lo = __builtin_amdgcn_cvt_pk_f32_fp8(wv, false), hi = __builtin_amdgcn_cvt_pk_f32_fp8(wv, true);
                    ys[4 * q + 0] += lo.x; ys[4 * q + 1] += lo.y; ys[4 * q + 2] += hi.x; ys[4 * q + 3] += hi.y; }
#pragma unroll
            for (int j = 0; j < 16; ++j) v[j] += ys[j] * (1.0f / Y8_SCALE);
            float s = 0.f;
#pragma unroll
            for (int j = 0; j < 16; ++j) s += v[j];
            const float mean = wave_sum(s) * (1.f / D); float s2 = 0.f;
#pragma unroll
            for (int j = 0; j < 16; ++j) { v[j] -= mean; s2 += v[j] * v[j]; }
            const float rstd = 1.f / sqrtf(wave_sum(s2) * (1.f / D) + LN_EPS);
            u32x4 w8;
#pragma unroll
            for (int c = 0; c < 2; ++c) { const int col = 16 * lane + 8 * c; const f32x4 g0 = gq[2 * c], g1 = gq[2 * c + 1], b0 = bq[2 * c], b1 = bq[2 * c + 1];
                u32x4 w; w.x = cvt_pk_bf16(v[8 * c + 0] * rstd * g0[0] + b0[0], v[8 * c + 1] * rstd * g0[1] + b0[1]); w.y = cvt_pk_bf16(v[8 * c + 2] * rstd * g0[2] + b0[2], v[8 * c + 3] * rstd * g0[3] + b0[3]);
                w.z = cvt_pk_bf16(v[8 * c + 4] * rstd * g1[0] + b1[0], v[8 * c + 5] * rstd * g1[1] + b1[1]); w.w = cvt_pk_bf16(v[8 * c + 6] * rstd * g1[2] + b1[2], v[8 * c + 7] * rstd * g1[3] + b1[3]);
                *(u32x4*)(X2B + (size_t)tl * D + col) = w;
                w8[2 * c] = pk_fp8x4(bf_lo(w.x), bf_hi(w.x), bf_lo(w.y), bf_hi(w.y)); w8[2 * c + 1] = pk_fp8x4(bf_lo(w.z), bf_hi(w.z), bf_lo(w.w), bf_hi(w.w)); }
            *(u32x4*)(F.ws + WS_X2F8 + ((size_t)qd * TQ + tl) * D + 16 * lane) = w8;
        }
    }
}

constexpr int LDS_BYTES = 163840;
static_assert(pg8::LDS_ROWIDX + pg8::LDS_ROWSLOTS * 1024 <= LDS_BYTES && (QTILES * 2 + 255) / 256 <= pg8::LDS_ROWSLOTS, "LDS side tables");
constexpr int MISC_OFF = 131072 + 4096;
constexpr int PH_FIXED = 11, PH_PER_Q = 2, PH_TAIL0 = PH_FIXED + NQ * PH_PER_Q, NPHASE = PH_TAIL0 + 2;

__global__ void __launch_bounds__(NTHR, 2) fwd_kernel(Args args) {
    extern __shared__ __attribute__((aligned(16))) unsigned char lds_raw[];
#define MKFRAME() Frame F; { int t_ = threadIdx.x; asm volatile("" : "+v"(t_)); F.lds = (LAS unsigned char*)lds_raw; F.tid = t_; F.lane = t_ & 63; F.wave = __builtin_amdgcn_readfirstlane(t_ >> 6); \
        F.G = gridDim.x; const int bx_ = blockIdx.x; F.vcu = (F.G % 8 == 0) ? (bx_ % 8) * (F.G / 8) + bx_ / 8 : bx_; size_t z_ = 0; asm volatile("" : "+s"(z_)); F.ws = args.ws + z_;     F.dout = (unsigned char*)args.out; }
    LAS unsigned char* const lds0 = (LAS unsigned char*)lds_raw;
    volatile LAS unsigned* MISC = (volatile LAS unsigned*)(lds0 + MISC_OFF);
    if (threadIdx.x < 64) MISC[threadIdx.x] = 0u;
    __syncthreads();
    unsigned* barw = (unsigned*)(args.ws + WS_CTL) + CW_BAR;
    const int lo = args.lo, hi = args.hi;
    XcdBarrier bar; bar.bar = barw; bar.x = 0; bar.st = nullptr;
    if (hi - lo > 1) bar = xcd_barrier_post(barw, MISC + 8);
#ifndef PHASE_MASK
#define PHASE_MASK 0xFFFFFFFFu
#endif
#define IN(k) (((PHASE_MASK >> (k)) & 1u) && lo <= (k) && (k) < hi)
#define INQ(j) (((PHASE_MASK >> (PH_FIXED + (j))) & 1u) && lo <= (pb + (j)) && (pb + (j)) < hi)
#define SEAMQ(j) do { if (lo <= (pb + (j)) && (pb + (j)) + 1 < hi) xcd_barrier(bar); STAMP(pb + (j) + 1); } while (0)
#if DBG_TIME
#define STAMP(i) do { if (blockIdx.x == 0 && threadIdx.x == 0) ((unsigned long long*)(args.ws + WS_CTL + 60 * 1024))[i] = __builtin_amdgcn_s_memrealtime(); } while (0)
#else
#define STAMP(i) do { } while (0)
#endif
    STAMP(0);
#define SEAM(k) do { if (lo <= (k) && (k) + 1 < hi) xcd_barrier(bar); STAMP((k) + 1); } while (0)
    const int G = gridDim.x, c = (int)blockIdx.x;
    const bool wg_odd_t = (blockIdx.x & 1) != 0  ;

    if (IN(0)) { MKFRAME(); phase_prologue(F, args); }
    SEAM(0);
    if (IN(1)) {
        MKFRAME(); unsigned char* ws = F.ws;
        pg8::DenseOrder S; S.init(ws + WS_XB, ws + WS_WIN, T, NCOL, 512, G, c);
        pg8::EpiZ E{ws, (const float*)(ws + WS_ROT), (const float*)(ws + WS_LB), 1.0f / W8_SCALE};
        for (int rep = 0; rep < DUPN(7); ++rep) pg8::gemm_phase<false, 2>(F.lds, 512, S, E);
    }
    SEAM(1);
    if (IN(2)) {
        MKFRAME();
#ifndef NO_HGRN
#if USE_NAIVE_HGRN
        for (int it = F.vcu; it < 256; it += G) hgrn_item(F, it);
#else
        for (int it = F.vcu; it < 256; it += G) hgrn_mfma_item(F, it, (u16*)(F.dout + DO_OF), (u16*)(F.dout + DO_OB));
#if DBG_CHECK
        for (int it = F.vcu; it < 256; it += G) hgrn_item(F, it);
#endif
#endif
#endif
        STAMP(40);
#if USE_NAIVE_ATTN
        attn_naive(F);
#else
        for (int rep2 = 0; rep2 < DUPN(15); ++rep2) attn_mfma(F);
#endif
    }
    SEAM(2);
    if (IN(3)) { MKFRAME(); for (int rep = 0; rep < DUPN(8); ++rep) phase_hg_combine(F, args); }
    SEAM(3);
    if (IN(4)) {
        MKFRAME(); unsigned char* ws = F.ws;
        pg8::DenseOrder S; S.init(ws + WS_YH, ws + WS_WBH, T, D, 256, G, c);
        pg8::EpiGated<false> E{(const u16*)(ws + Z_GTH), (u16*)(F.dout + DO_MERGED), nullptr, D};
        pg8::gemm_phase<false, 2, false>(F.lds, 256, S, E);
    }
    SEAM(4);
    if (IN(5) && !DBG_SKIP_YA) {
        MKFRAME(); unsigned char* ws = F.ws;
        pg8::DenseOrder S; S.init(ws + WS_YA, ws + WS_WBA, T, D, 128, G, c);
        pg8::EpiGated<true> E{(const u16*)(ws + Z_GTA), (u16*)(F.dout + DO_MERGED), F.dout + DO_MERGED8, D};
        pg8::gemm_phase<true, 2, false>(F.lds, 128, S, E);
    }
    SEAM(5);
    if (IN(6)) {
        MKFRAME(); unsigned char* ws = F.ws;
        pg8::DenseOrder S; S.init(F.dout + DO_MERGED8, ws + WS_WO, T, D, 512, G, c);
        pg8::EpiBf16Res E{args.in[0], (u16*)(ws + WS_X1PRE), D, ALPHA, 1.0f / (W8_SCALE * M8_SCALE)};
        pg8::gemm_phase<false, 2>(F.lds, 512, S, E);
    }
    SEAM(6);
    if (IN(7)) { MKFRAME(); phase_ln1_convert<true, false>(F, args); }
    SEAM(7);
    if (IN(8) && !wg_odd_t) { { MKFRAME(); phase_ln1_convert<false, true>(F, args, 0, 3); } VM_WAIT(); __syncthreads(); }
    if (IN(8)) {
        MKFRAME(); unsigned char* ws = F.ws;
        pg8::DenseOrder S; S.init(ws + WS_XB, ws + WS_WR, T, 256, 1024, G, c);
        pg8::EpiF32Res E{(float*)(ws + WS_LOGITS), nullptr, nullptr, 256, 0.f, 1.f};
        for (int rep = 0; rep < DUPN(11); ++rep) pg8::gemm_phase(F.lds, 1024, S, E);
    }
    if (IN(8) && wg_odd_t) { VM_WAIT(); __syncthreads(); MKFRAME(); phase_ln1_convert<false, true>(F, args, 0, 3); }
    SEAM(8);
    if (IN(9) && !wg_odd_t) { { MKFRAME(); phase_ln1_convert<false, true>(F, args, 1, 3); } VM_WAIT(); __syncthreads(); }
    if (IN(9)) { MKFRAME(); phase_topk(F, args); }
    if (IN(9) && wg_odd_t) { VM_WAIT(); __syncthreads(); MKFRAME(); phase_ln1_convert<false, true>(F, args, 1, 3); }
    SEAM(9);
    if (IN(10) && !wg_odd_t) { { MKFRAME(); phase_ln1_convert<false, true>(F, args, 2, 3); } VM_WAIT(); __syncthreads(); }
    if (IN(10)) { MKFRAME(); phase_sort(F); }
    if (IN(10) && wg_odd_t) { VM_WAIT(); __syncthreads(); MKFRAME(); phase_ln1_convert<false, true>(F, args, 2, 3); }
    SEAM(10);
    for (int qd = 0; qd < NQ; ++qd) {
        const int pb = PH_FIXED + qd * PH_PER_Q;
        const size_t lo_off = (size_t)qd * QTILES * 256;
        const bool wg_odd = (blockIdx.x & 1) != 0  ;
        if (INQ(0) && qd > 0 && !wg_odd) { MKFRAME(); phase_moe_combine(F, args, qd - 1); }
        if (INQ(0)) {
            MKFRAME(); unsigned char* ws = F.ws;
            const int ntiles = __builtin_amdgcn_readfirstlane(((const int*)(ws + WS_NTILES))[qd]);
            pg8::MoeOrder<2, true> S; S.A = (const char*)(ws + WS_X1F8); S.W = (const char*)(ws + WS_WGU); S.lds = F.lds; S.slot_tok = (const int*)(ws + WS_STOK) + lo_off; S.sdst = nullptr; S.sgate = nullptr;
            S.ntiles = ntiles; S.G = G; S.vc = F.vcu; S.K = 512; S.wstride_e = (size_t)512 * 1024; S.wstride_pn = (size_t)256 * 1024;
            S.load_table((const int*)(ws + WS_TILEE) + qd * QTILES, F.tid);
            pg8::EpiSwiglu E{ws + WS_H};
            for (int rep = 0; rep < DUPN(0); ++rep) pg8::gemm_phase<false, 2>(F.lds, 512, S, E);
        }
        if (INQ(0) && qd > 0 && wg_odd) { __syncthreads(); MKFRAME(); phase_moe_combine(F, args, qd - 1); }
        SEAMQ(0);
        if (INQ(1)) { MKFRAME(); moe_down_phase(F, qd); }
        SEAMQ(1);
    }
    if (IN(PH_TAIL0) && !wg_odd_t) { MKFRAME(); phase_moe_combine(F, args, NQ - 1); }
    if (IN(PH_TAIL0)) {
        { MKFRAME(); unsigned char* ws = F.ws; const int pm = F.vcu;
          const f32x4* p4 = (const f32x4*)(args.in[1] + (size_t)pm * 256 * 256); u32x4* o4 = (u32x4*)(ws + WS_PB + (size_t)pm * 256 * 256 * 2);
          for (int i = F.tid; i < 256 * 256 / 8; i += NTHR) { const f32x4 p = p4[2 * i], q = p4[2 * i + 1]; u32x4 w; w.x = cvt_pk_bf16(p[0], p[1]); w.y = cvt_pk_bf16(p[2], p[3]); w.z = cvt_pk_bf16(q[0], q[1]); w.w = cvt_pk_bf16(q[2], q[3]); o4[i] = w; } }
        VM_WAIT(); __syncthreads(); __builtin_amdgcn_fence(__ATOMIC_ACQUIRE, "agent"); VM_WAIT();
        { MKFRAME(); unsigned char* ws = F.ws; pg8::PanelOrder S; S.A = (const char*)(ws + WS_PB); S.Bt = (const char*)(ws + WS_WPP); S.pm = F.vcu; S.nN = 4; S.K = 256;
          pg8::EpiBf16 E{(u16*)(ws + WS_P2), D};
          pg8::gemm_phase<true>(F.lds, 256, S, E); }
        VM_WAIT(); __syncthreads();
    }
    if (IN(PH_TAIL0) && wg_odd_t) { MKFRAME(); phase_moe_combine(F, args, NQ - 1); }
    SEAM(PH_TAIL0);
    if (IN(PH_TAIL0 + 1)) {
        { MKFRAME(); unsigned char* ws = F.ws; pg8::PanelOrder S; S.A = (const char*)(ws + WS_X2F8); S.Bt = (const char*)(ws + WS_WPG); S.pm = F.vcu; S.nN = 4; S.K = 512;
          pg8::EpiPle E{(u16*)(ws + WS_X3PRE), (const u16*)(ws + WS_X2B), (const u16*)(ws + WS_P2), D, 1.0f / W8_SCALE};
          pg8::gemm_phase<false, 2>(F.lds, 512, S, E); }
        VM_WAIT(); __syncthreads(); __builtin_amdgcn_fence(__ATOMIC_ACQUIRE, "agent"); VM_WAIT();
        { MKFRAME(); unsigned char* ws = F.ws; const int pm = F.vcu;
          for (int r = F.wave; r < 256; r += 4 * NWAVES) ln_rows<false, 4, true>((const u16*)(ws + WS_X3PRE), (size_t)pm * 256 + r, (size_t)NWAVES, args.in[23], args.in[24], args.out, F.lane); }
    }
#undef IN
#undef SEAM
#undef INQ
#undef SEAMQ
}


#ifndef DBG_CHECK
#define DBG_CHECK 0
#endif
#if DBG_CHECK
constexpr int CHK_WORD0 = 12288;
struct ChkArgs { const float* in[25]; float* out; unsigned char* ws; int mode, qd; };
__device__ __forceinline__ float dotb(const u16* a, const u16* b, int K) { float s = 0.f; for (int k = 0; k < K; k += 8) { const u32x4 x = *(const u32x4*)(a + k), y = *(const u32x4*)(b + k);
    s += bf_lo(x.x) * bf_lo(y.x) + bf_hi(x.x) * bf_hi(y.x) + bf_lo(x.y) * bf_lo(y.y) + bf_hi(x.y) * bf_hi(y.y) + bf_lo(x.z) * bf_lo(y.z) + bf_hi(x.z) * bf_hi(y.z) + bf_lo(x.w) * bf_lo(y.w) + bf_hi(x.w) * bf_hi(y.w); } return s; }
__device__ __forceinline__ float sigm(float z) { return 1.f / (1.f + expf(-z)); }
__device__ __forceinline__ bool badv(float got, float ref, float rel, float ab) { return !(fabsf(got - ref) <= rel * fabsf(ref) + ab); }
__global__ void chk_kernel(ChkArgs a) {
    unsigned char* ws = a.ws; unsigned* res = (unsigned*)(ws + WS_CTL) + CHK_WORD0; const int mode = a.mode, qd = a.qd;
    const size_t gt = (size_t)blockIdx.x * blockDim.x + threadIdx.x, NGT = (size_t)gridDim.x * blockDim.x;
    const u16* XB = (const u16*)(ws + WS_XB); const u16* WIN = (const u16*)(ws + WS_WIN);
    unsigned bad = 0;
    if (mode == 1) { for (size_t i = gt; i < (size_t)T * D; i += NGT) { if (badv(bf1(XB[i]), a.in[0][i], 0.005f, 1e-6f)) ++bad; } }
    else if (mode >= 2 && mode <= 11) {
        const int ty = mode - 2; const int ncol = ty < 5 ? 512 : ty < 8 ? 768 : 1024; const int cbase = ty < 5 ? 512 * ty : ty < 8 ? 2560 + 768 * (ty - 5) : 4864 + 1024 * (ty - 8);
        const size_t zoff[10] = {Z_QH, Z_VH, Z_LFF, Z_LFB, Z_GS, Z_AQ, Z_AK, Z_AV, Z_GTH, Z_GTA}; const u16* Zt = (const u16*)(ws + zoff[ty]); const float* lb = (const float*)(ws + WS_LB); const float* rot = (const float*)(ws + WS_ROT);
        for (size_t i = gt; i < (size_t)(T / 8) * ncol; i += NGT) { const int row = (int)(i / ncol) * 8 + 3, c = (int)(i % ncol);
            float z = dotb(XB + (size_t)row * D, WIN + (size_t)(cbase + c) * D, D), ref, got = bf1(Zt[(size_t)row * ncol + c]);
            if (ty <= 4 || ty == 7 || ty == 8 || ty == 9) ref = z;
            else { const int d = c & 63; ref = z; if (d < 16) { const int cp = (d < 8) ? c + 8 : c - 8; const float zp = dotb(XB + (size_t)row * D, WIN + (size_t)(cbase + cp) * D, D); const int fi = d & 7, pos = row & (SEQ - 1); const float cs = rot[pos * 16 + fi], sn = rot[pos * 16 + 8 + fi]; ref = (d < 8) ? z * cs - zp * sn : z * cs + zp * sn; } if (ty == 5) ref *= 0.125f; }
            if (badv(got, ref, 0.02f, 0.02f)) { ++bad; if (mode == 10) { atomicAdd(res + 80 + ((c & 255) >> 2), 1u); atomicAdd(res + 160 + ((row & 255) >> 2), 1u); atomicAdd(res + 240 + ((row >> 8) & 255), 1u); if (got > 1.5f || got < -0.5f) atomicAdd(res + 500, 1u); atomicAdd(res + 600 + ((((row >> 8) & 31) >> 3) * 8 + ((row >> 6) & 1) * 4 + ((c >> 5) & 3)), 1u); } } } }
    else if (mode == 12) { const u16* Zt = (const u16*)(ws + Z_GTH); unsigned nm = 0, no = 0; for (size_t i = gt; i < (size_t)2 * T * D; i += NGT) { const u16 h = Zt[i]; if (h == 0x3C3C) ++nm; else { const float g = bf1(h); if (!(g >= 0.f && g <= 1.f)) ++no; } }
        for (int o = 32; o >= 1; o >>= 1) { nm += __shfl_xor(nm, o); no += __shfl_xor(no, o); } if ((threadIdx.x & 63) == 0) { if (nm) atomicAdd(res + 700, nm); if (no) atomicAdd(res + 701, no); } }
    else if (mode == 25) { const u16* AQ = (const u16*)(ws + Z_AQ); const u16* AK = (const u16*)(ws + Z_AK); const u16* AV = (const u16*)(ws + Z_AV); const u16* YA = (const u16*)(ws + WS_YA);
        for (size_t i = gt; i < (size_t)(T / 64) * 256; i += NGT) { const int row = (int)(i / 256) * 64 + 7, sl = (int)((i % 256) / 64), d = (int)(i % 64); const int b = row >> 11, p = row & (SEQ - 1);
            float mx = -1e30f; for (int pass = 0; pass < 2; ++pass) { float den = 0.f, o = 0.f; for (int g = 0; g < 3; ++g) { const int sh = 2 * g, mlen = SEQ >> sh, r = p & ((1 << sh) - 1), m = p >> sh, hd = g * 4 + sl; const int lo = m - 64 < 0 ? 0 : m - 64, hi = m + 64 > mlen - 1 ? mlen - 1 : m + 64;
                    for (int j = lo; j <= hi; ++j) { const size_t kr = (size_t)b * SEQ + r + ((size_t)j << sh); const float sc = dotb(AQ + (size_t)row * 768 + hd * 64, AK + kr * 768 + hd * 64, 64); if (pass == 0) mx = fmaxf(mx, sc); else { const float e = expf(sc - mx); den += e; o += e * bf1(AV[kr * 768 + hd * 64 + d]); } } }
                if (pass == 1) { if (badv(bf1(YA[(size_t)row * 256 + sl * 64 + d]), o / den, 0.03f, 0.004f)) ++bad; } } } }
    else if (mode == 26) { const u16* A0 = (const u16*)((unsigned char*)a.out + DO_OF); const u16* R0 = (const u16*)(ws + WS_XB);
        for (size_t i = gt; i < (size_t)2 * T * 512; i += NGT) { if (badv(bf1(A0[i]), bf1(R0[i]), 0.03f, 0.03f)) ++bad; } }
    else if (mode == 13) { const u16* YH = (const u16*)(ws + WS_YH); const u16* YA = (const u16*)(ws + WS_YA); const u16* GH = (const u16*)(ws + Z_GTH); const u16* GA = (const u16*)(ws + Z_GTA); const u16* M = (const u16*)((unsigned char*)a.out + DO_MERGED);
        for (size_t i = gt; i < (size_t)(T / 4) * D; i += NGT) { const int row = (int)(i / D) * 4 + 1, c = (int)(i % D);
            const float ref = sigm(bf1(GH[(size_t)row * D + c])) * dotb(YH + (size_t)row * 512, (const u16*)(ws + WS_WBH) + (size_t)c * 512, 512) + sigm(bf1(GA[(size_t)row * D + c])) * dotb(YA + (size_t)row * 256, (const u16*)(ws + WS_WBA) + (size_t)c * 256, 256);
            if (badv(bf1(M[(size_t)row * D + c]), ref, 0.02f, 0.01f)) ++bad; } }
    else if (mode == 14) { const u16* M = (const u16*)((unsigned char*)a.out + DO_MERGED); const float* X1 = (const float*)(ws + WS_X1PRE);
        for (size_t i = gt; i < (size_t)T * D; i += NGT) { const int row = (int)(i / D), c = (int)(i % D);
            const float ref = ALPHA * a.in[0][i] + dotb(M + (size_t)row * D, (const u16*)(ws + WS_WO) + (size_t)c * D, D); if (badv(X1[i], ref, 0.002f, 0.002f)) ++bad; } }
    else if (mode == 15) { const float* X1 = (const float*)(ws + WS_X1PRE);
        for (size_t row = gt; row < T; row += NGT) { float m = 0.f; for (int c = 0; c < D; ++c) m += X1[row * D + c]; m /= D; float v = 0.f; for (int c = 0; c < D; ++c) { const float d = X1[row * D + c] - m; v += d * d; } const float rs = 1.f / sqrtf(v / D + LN_EPS);
            for (int c = 0; c < D; ++c) { const float ref = (X1[row * D + c] - m) * rs * a.in[9][c] + a.in[10][c]; if (badv(bf1(XB[row * D + c]), ref, 0.01f, 0.01f)) ++bad; } } }
    else if (mode == 16) { const float* LG = (const float*)(ws + WS_LOGITS);
        for (size_t i = gt; i < (size_t)T * 256; i += NGT) { const int row = (int)(i / 256), c = (int)(i % 256); if (badv(LG[i], dotb(XB + (size_t)row * D, (const u16*)(ws + WS_WR) + (size_t)c * D, D), 0.002f, 0.002f)) ++bad; } }
    else if (mode == 17) { const float* LG = (const float*)(ws + WS_LOGITS); const u16* te = (const u16*)(ws + WS_TOKE); const float* tg = (const float*)(ws + WS_TOKG);
        for (size_t t = gt; t < T; t += NGT) { float gsc[8]; for (int g = 0; g < 8; ++g) { float m1 = -1e30f, m2 = -1e30f; for (int j = 0; j < 32; ++j) { const float b = sigm(LG[t * 256 + g * 32 + j]) + a.in[12][g * 32 + j]; if (b > m1) { m2 = m1; m1 = b; } else if (b > m2) m2 = b; } gsc[g] = m1 + m2; }
            unsigned gm = 0; for (int g = 0; g < 8; ++g) { int r = 0; for (int j = 0; j < 8; ++j) r += (gsc[j] > gsc[g] || (gsc[j] == gsc[g] && j < g)); if (r < 4) gm |= 1u << g; }
            unsigned long long taken[4] = {0, 0, 0, 0}; float ssum = 0.f; int ok = 1;
            for (int k = 0; k < 8; ++k) { float bv = -1e30f; int bi = -1; for (int e = 0; e < 256; ++e) { if (!((gm >> (e >> 5)) & 1u) || ((taken[e >> 6] >> (e & 63)) & 1ull)) continue; const float b = sigm(LG[t * 256 + e]) + a.in[12][e]; if (b > bv) { bv = b; bi = e; } }
                taken[bi >> 6] |= 1ull << (bi & 63); ssum += sigm(LG[t * 256 + bi]); if (te[t * 8 + k] != bi) ok = 0; }
            for (int k = 0; k < 8 && ok; ++k) { const float ref = sigm(LG[t * 256 + te[t * 8 + k]]) / ssum * 2.5f; if (badv(tg[t * 8 + k], ref, 0.001f, 1e-5f)) ok = 0; }
            if (!ok) ++bad; } }
    else if (mode == 18) { const int* stok = (const int*)(ws + WS_STOK) + (size_t)qd * QTILES * 256; const float* sg = (const float*)(ws + WS_SGATE) + (size_t)qd * QTILES * 256; const int* sd = (const int*)(ws + WS_SDST) + (size_t)qd * QTILES * 256; const int* tle = (const int*)(ws + WS_TILEE) + qd * QTILES;
        const int nt = ((const int*)(ws + WS_NTILES))[qd]; const u16* te = (const u16*)(ws + WS_TOKE); const float* tg = (const float*)(ws + WS_TOKG); unsigned* cnt = res + 64;
        if (nt < 64 || nt > QTILES) { if (gt == 0) ++bad; } else
        for (size_t sl = gt; sl < (size_t)nt * 256; sl += NGT) { const int d = sd[sl], tk = stok[sl], e = tle[sl >> 8]; if (d == TQ * NSLOT) { if (tk != qd * TQ || sg[sl] != 0.f) ++bad; continue; }
            if (d < 0 || d > TQ * NSLOT || tk < qd * TQ || tk >= (qd + 1) * TQ) { ++bad; continue; } const int k = d % NSLOT; if (d / NSLOT != tk - qd * TQ) { ++bad; continue; }
            if (k == 8) { if (e != 256 || sg[sl] != 1.f) ++bad; } else { if (te[(size_t)tk * 8 + k] != e || tg[(size_t)tk * 8 + k] != sg[sl]) ++bad; }
            atomicAdd(cnt, 1u); } }
    else if (mode == 19) { const int* stok = (const int*)(ws + WS_STOK) + (size_t)qd * QTILES * 256; const int* tle = (const int*)(ws + WS_TILEE) + qd * QTILES; const int nt = ((const int*)(ws + WS_NTILES))[qd]; const u16* H = (const u16*)(ws + WS_H); const u16* WGU = (const u16*)(ws + WS_WGU);
        for (size_t i = gt; i < (size_t)nt * 32 * 256; i += NGT) { const int sl = (int)(i / 256) * 8 + 5, j = (int)(i % 256); const int e = tle[sl >> 8], tk = stok[sl]; const u16* xr = XB + (size_t)tk * D;
            const u16* wg = WGU + ((size_t)e * 512 + (j >> 7) * 256 + (j & 127)) * D; const float g = dotb(xr, wg, D), u = dotb(xr, wg + (size_t)128 * D, D); if (badv(bf1(H[(size_t)sl * 256 + j]), g * sigm(g) * u, 0.03f, 0.003f)) ++bad; } }
    else if (mode == 20) { const int* sd = (const int*)(ws + WS_SDST) + (size_t)qd * QTILES * 256; const float* sg = (const float*)(ws + WS_SGATE) + (size_t)qd * QTILES * 256; const int* tle = (const int*)(ws + WS_TILEE) + qd * QTILES; const int nt = ((const int*)(ws + WS_NTILES))[qd]; const u16* H = (const u16*)(ws + WS_H); const u16* WD = (const u16*)(ws + WS_WD); const u16* YS = (const u16*)(ws + WS_YS);
        for (size_t i = gt; i < (size_t)nt * 32 * D; i += NGT) { const int sl = (int)(i / D) * 8 + 2, c = (int)(i % D); const int e = tle[sl >> 8], d = sd[sl]; if (d == TQ * NSLOT) continue;
            const float ref = sg[sl] * dotb(H + (size_t)sl * 256, WD + ((size_t)e * 1024 + c) * 256, 256); if (badv(bf1(YS[(size_t)d * D + c]), ref, 0.02f, 0.002f)) ++bad; } }
    else if (mode == 21) { const u16* PB = (const u16*)(ws + WS_PB) + (size_t)qd * TQ * 256; const u16* P2 = (const u16*)(ws + WS_P2) + (size_t)qd * TQ * D; const float* p = a.in[1] + (size_t)qd * TQ * 256;
        for (size_t i = gt; i < (size_t)TQ * D; i += NGT) { const int row = (int)(i / D), c = (int)(i % D); if (badv(bf1(P2[i]), dotb(PB + (size_t)row * 256, (const u16*)(ws + WS_WPP) + (size_t)c * 256, 256), 0.02f, 0.01f)) ++bad; if (c < 256 && badv(bf1(PB[(size_t)row * 256 + c]), p[(size_t)row * 256 + c], 0.005f, 1e-6f)) ++bad; } }
    else if (mode == 22) { const u16* X1 = XB + (size_t)qd * TQ * D; const u16* YS = (const u16*)(ws + WS_YS); const u16* X2 = (const u16*)(ws + WS_X2B) + (size_t)qd * TQ * D;
        for (size_t row = gt; row < TQ; row += NGT) { float m = 0.f, v = 0.f; for (int pass = 0; pass < 3; ++pass) { for (int c = 0; c < D; ++c) { float x = ALPHA * bf1(X1[row * D + c]); for (int k = 0; k < NSLOT; ++k) x += bf1(YS[(row * NSLOT + k) * D + c]);
                    if (pass == 0) m += x; else if (pass == 1) v += (x - m) * (x - m); else { const float ref = (x - m) * v * a.in[19][c] + a.in[20][c]; if (badv(bf1(X2[row * D + c]), ref, 0.01f, 0.01f)) ++bad; } } if (pass == 0) m /= D; else if (pass == 1) v = 1.f / sqrtf(v / D + LN_EPS); } } }
    else if (mode == 23) { const u16* X2 = (const u16*)(ws + WS_X2B); const u16* P2 = (const u16*)(ws + WS_P2); const float* O = a.out + (size_t)qd * TQ * D;
        for (size_t i = gt; i < (size_t)TQ * D; i += NGT) { const int row = (int)(i / D), c = (int)(i % D); const float ref = ALPHA * bf1(X2[i]) + sigm(dotb(X2 + (size_t)row * D, (const u16*)(ws + WS_WPG) + (size_t)c * D, D)) * bf1(P2[i]); if (badv(O[i], ref, 0.002f, 0.002f)) ++bad; } }
    else if (mode == 24) { const float* O = a.out + (size_t)qd * TQ * D;
        for (size_t row = gt; row < TQ; row += NGT) { float m = 0.f, v = 0.f; int nf = 0; for (int c = 0; c < D; ++c) { const float x = (O[row * D + c] - a.in[24][c]) / a.in[23][c]; m += x; v += x * x; nf += !(x - x == 0.f); } m /= D; v = v / D - m * m; if (nf || fabsf(m) > 1e-3f || fabsf(v - 1.f) > 1e-2f) ++bad; } }
    for (int o = 32; o >= 1; o >>= 1) bad += __shfl_xor(bad, o);
    if ((threadIdx.x & 63) == 0 && bad) atomicAdd(res + mode, bad);
}
__global__ void chk_encode(float* out, size_t n, const unsigned* res, int what) {
    unsigned code = 0;
    if (what == 0) { for (int m = 1; m < 64; ++m) if (res[m]) { code = m; break; } }
    else if (what > 0) { const unsigned b = res[what]; code = b ? 1 + (31 - __clz(b)) : 0; }
    else if (what == -1) { code = (res[64] == (unsigned)(4 * TQ * NSLOT)) ? 0 : 7; }
    else if (what == -4) { const unsigned nm = res[700], no = res[701]; code = (nm ? 1 + (31 - __clz(nm)) : 0) + (no ? 40 : 0); }
    else if (what == -2) { const int ms[6] = {11, 13, 14, 15, 16, 17}; for (int i = 0; i < 6; ++i) if (res[ms[i]]) code |= 1u << i; }
    else { const int ms[6] = {18, 19, 20, 21, 22, 23}; for (int i = 0; i < 6; ++i) if (res[ms[i]]) code |= 1u << i; if (res[24]) code += 64; if (code > 98) code = 98; }
    const float c = sqrtf((float)code);
    for (size_t i = (size_t)blockIdx.x * blockDim.x + threadIdx.x; i < n; i += (size_t)gridDim.x * blockDim.x) out[i] = c;
}
#ifndef DBG_WHAT
#define DBG_WHAT 0
#endif
#endif


#if DBG_TIME
__global__ void time_encode(float* out, size_t n, const unsigned long long* ts) {
    auto ms = [&](int a, int b) { return (float)(ts[b] - ts[a]) * 1e-5f; };
    (void)ms; unsigned code = DBG_TIME_EXPR; if (code > 98) code = 98;
    const float c = sqrtf((float)code);
    for (size_t i = (size_t)blockIdx.x * blockDim.x + threadIdx.x; i < n; i += (size_t)gridDim.x * blockDim.x) out[i] = c;
}
#endif

extern "C" void kernel_launch(void* const* d_in, const int* in_sizes, int n_in, void* d_out, int out_size, void* d_ws, size_t ws_size, hipStream_t stream) {
    static int grid = 0;
    if (grid == 0) {
        if (n_in != 25 || out_size != T * D || ws_size < WS_END) { fprintf(stderr, "kernel_launch: unexpected problem (n_in %d out %d ws %zu)\n", n_in, out_size, ws_size); grid = -1; return; }
        if (hipFuncSetAttribute((const void*)fwd_kernel, hipFuncAttributeMaxDynamicSharedMemorySize, LDS_BYTES) != hipSuccess) { fprintf(stderr, "kernel_launch: hipFuncSetAttribute failed\n"); grid = -1; return; }
        int per_cu = 0; (void)hipOccupancyMaxActiveBlocksPerMultiprocessor(&per_cu, (const void*)fwd_kernel, NTHR, LDS_BYTES); (void)hipGetLastError();
        if (per_cu < 1) fprintf(stderr, "kernel_launch: occupancy query says %d\n", per_cu);
        grid = 256;
    }
    if (grid < 0) return;
    (void)hipMemsetAsync((char*)d_ws + WS_CTL, 0, CTL_ZERO_BYTES, stream);
    Args a{};
    for (int i = 0; i < 25; ++i) a.in[i] = (const float*)d_in[i];
    a.out = (float*)d_out; a.ws = (unsigned char*)d_ws;
#if DBG_CHECK
    ChkArgs ca{}; for (int i = 0; i < 25; ++i) ca.in[i] = (const float*)d_in[i]; ca.out = (float*)d_out; ca.ws = (unsigned char*)d_ws;
#define CHK(m, q) do { ca.mode = (m); ca.qd = (q); hipLaunchKernelGGL(chk_kernel, dim3(2048), dim3(256), 0, stream, ca); } while (0)
    for (int ph = 0; ph < NPHASE; ++ph) { a.lo = ph; a.hi = ph + 1;
        if (ph == 1) (void)hipMemsetAsync((char*)d_ws + Z_GTH, 0x3C, (size_t)256 * MiB, stream);
        hipLaunchKernelGGL(fwd_kernel, dim3(grid), dim3(NTHR), LDS_BYTES, stream, a);
        if (ph == 0) CHK(1, 0);
        if (ph == 1) for (int m = 2; m <= 12; ++m) CHK(m, 0);
        if (ph == 2) CHK(26, 0);
        if (ph == 3) CHK(25, 0);
        if (ph == 5) CHK(13, 0);
        if (ph == 6) CHK(14, 0);
        if (ph == 7) CHK(15, 0);
        if (ph == 8) CHK(16, 0);
        if (ph == 9) CHK(17, 0);
        if (ph >= PH_FIXED && ph < PH_TAIL0) { const int q = (ph - PH_FIXED) / PH_PER_Q, j = (ph - PH_FIXED) % PH_PER_Q;
            if (j == 0) { CHK(18, q); CHK(19, q); if (q > 0) CHK(22, q - 1); } if (j == 1) CHK(20, q); }
        if (ph == PH_TAIL0) CHK(22, NQ - 1);
        if (ph == PH_TAIL0 + 1) for (int q = 0; q < NQ; ++q) { CHK(21, q); CHK(24, q); } }
    hipLaunchKernelGGL(chk_encode, dim3(2048), dim3(256), 0, stream, (float*)d_out, (size_t)out_size, (const unsigned*)((unsigned char*)d_ws + WS_CTL) + CHK_WORD0, DBG_WHAT);
#elif MK_PER_PHASE
    for (int ph = 0; ph < NPHASE; ++ph) { a.lo = ph; a.hi = ph + 1; hipLaunchKernelGGL(fwd_kernel, dim3(grid), dim3(NTHR), LDS_BYTES, stream, a); }
#else
    a.lo = 0; a.hi = NPHASE;
    hipLaunchKernelGGL(fwd_kernel, dim3(grid), dim3(NTHR), LDS_BYTES, stream, a);
#if DBG_TIME
    hipLaunchKernelGGL(time_encode, dim3(2048), dim3(256), 0, stream, (float*)d_out, (size_t)out_size, (const unsigned long long*)((unsigned char*)d_ws + WS_CTL + 60 * 1024));
#endif
#endif
}
```
